# Optimizing an MI355X kernel written in HIP

```python
import math
import jax, jax.numpy as jnp
from jax import lax
import numpy as np

D_MODEL = 1024
BATCH = 16
SEQ = 4096
DEPTH = 4

MEM_LEN = 256
N_MEM_HEADS = 4
MEM_HEAD_DIM = D_MODEL // N_MEM_HEADS
D_FF = 2816
MIX_WIDTH = D_MODEL
GROUP_WIDTH = MIX_WIDTH // 4
MLSTM_HEADS = 4
MLSTM_HEAD_DIM = GROUP_WIDTH // MLSTM_HEADS
MLSTM_CHUNK = 64
CONV_WIDTH = 4
POOL_GROUPS = 4
POOL_WINDOWS = (2, 4, 8, 16)
POOL_GROUP_DIM = GROUP_WIDTH // POOL_GROUPS
DIL_HEADS = 4
DIL_HEAD_DIM = GROUP_WIDTH // DIL_HEADS
DIL_PATTERNS = ((128, 1), (512, 4), (2048, 16))
DIFF_HEADS = 4
DIFF_HEAD_DIM = GROUP_WIDTH // DIFF_HEADS
DIFF_QK_HALF = DIFF_HEAD_DIM // 2
ATTN_BLOCK = 128
T5_BUCKETS = 32
T5_MAX_DIST = 2048
N_BIAS_HEADS = DIL_HEADS + DIFF_HEADS
IN_WIDTHS = (GROUP_WIDTH, GROUP_WIDTH, GROUP_WIDTH, GROUP_WIDTH, MLSTM_HEADS, MLSTM_HEADS,
             GROUP_WIDTH,
             GROUP_WIDTH, GROUP_WIDTH, GROUP_WIDTH,
             GROUP_WIDTH, GROUP_WIDTH, GROUP_WIDTH)
IN_WIDTH = sum(IN_WIDTHS)
RMS_EPS = 1e-6
SUBLN_EPS = 1e-5

kernel_name = "hybrid_parallel_groups_mlstm_pool_dilated_diff"


def _rms_norm(x, g, eps=RMS_EPS):
    xf = x.astype(jnp.float32)
    y = xf * lax.rsqrt(jnp.mean(xf * xf, axis=-1, keepdims=True) + eps)
    return (y * g.astype(jnp.float32)).astype(x.dtype)


def _swiglu(u, w_gate, w_up, w_down):
    return (jax.nn.silu(u @ w_gate) * (u @ w_up)) @ w_down


def _split_cols(z, widths):
    out, off = [], 0
    for w in widths:
        out.append(z[..., off:off + w])
        off += w
    return out


def _t5_bucket(dist):
    max_exact = T5_BUCKETS // 2
    d = jnp.maximum(dist, 1).astype(jnp.float32)
    large = max_exact + (jnp.log(d / max_exact) / math.log(T5_MAX_DIST / max_exact)
                         * (T5_BUCKETS - max_exact)).astype(jnp.int32)
    large = jnp.minimum(large, T5_BUCKETS - 1)
    return jnp.where(dist < max_exact, dist, large)


def _causal_conv(u, w, b):
    K, S = w.shape[0], u.shape[1]
    up = jnp.pad(u, ((0, 0), (K - 1, 0), (0, 0)))
    out = b
    for j in range(K):
        out = out + up[:, j:j + S] * w[j]
    return out


def _mlstm(q, k, v, o, ig, fg, conv_w, conv_b, gate_b, norm_g):
    B, S, _ = q.shape
    H, dh, L = MLSTM_HEADS, MLSTM_HEAD_DIM, MLSTM_CHUNK
    f32 = jnp.float32
    qk = jax.nn.silu(_causal_conv(jnp.concatenate([q, k], axis=-1), conv_w, conv_b))
    q, k = qk[..., :GROUP_WIDTH], qk[..., GROUP_WIDTH:]
    nc = S // L

    def to_chunks(t):
        return t.astype(f32).reshape(B, nc, L, H, dh).transpose(1, 0, 3, 2, 4)

    def gate_chunks(t):
        return t.reshape(B, nc, L, H).transpose(1, 0, 3, 2)

    qc, kc, vc = to_chunks(q), to_chunks(k) * (dh ** -0.5), to_chunks(v)
    gb = gate_b.astype(f32)
    igc = gate_chunks(ig.astype(f32) + gb[:H])
    lfc = gate_chunks(jax.nn.log_sigmoid(fg.astype(f32) + gb[H:]))
    causal = jnp.tril(jnp.ones((L, L), dtype=bool))

    def step(carry, xs):
        C, n, m = carry
        qq, kk, vv, ii, lf = xs
        b = jnp.cumsum(lf, axis=-1)
        dmat = b[..., :, None] - b[..., None, :] + ii[..., None, :]
        dmat = jnp.where(causal, dmat, -jnp.inf)
        inter_log = b + m[..., None]
        m_t = jnp.maximum(inter_log, jnp.max(dmat, axis=-1))
        inter_w = jnp.exp(inter_log - m_t)
        sc = jnp.einsum('bhtd,bhsd->bhts', qq, kk) * jnp.exp(dmat - m_t[..., None])
        num = inter_w[..., None] * jnp.einsum('bhtd,bhde->bhte', qq, C) \
            + jnp.einsum('bhts,bhse->bhte', sc, vv)
        den = inter_w * jnp.einsum('bhtd,bhd->bht', qq, n) + jnp.sum(sc, axis=-1)
        hh = num / jnp.maximum(jnp.abs(den), jnp.exp(-m_t))[..., None]
        b_last = b[..., -1]
        m_new = m_t[..., -1]
        w_s = jnp.exp(b_last[..., None] - b + ii - m_new[..., None])
        carry_w = jnp.exp(b_last + m - m_new)
        C_new = carry_w[..., None, None] * C + jnp.einsum('bhs,bhsd,bhse->bhde', w_s, kk, vv)
        n_new = carry_w[..., None] * n + jnp.einsum('bhs,bhsd->bhd', w_s, kk)
        return (C_new, n_new, m_new), hh

    init = (jnp.zeros((B, H, dh, dh), f32), jnp.zeros((B, H, dh), f32), jnp.zeros((B, H), f32))
    _, hc = lax.scan(step, init, (qc, kc, vc, igc, lfc))
    hs = hc.transpose(1, 0, 3, 2, 4).reshape(B, S, H, dh)
    mu = jnp.mean(hs, axis=-1, keepdims=True)
    var = jnp.mean(jnp.square(hs - mu), axis=-1, keepdims=True)
    hn = (hs - mu) * lax.rsqrt(var + RMS_EPS) * norm_g.astype(f32).reshape(H, dh)
    y = hn.reshape(B, S, H * dh) * jax.nn.sigmoid(o.astype(f32))
    return y.astype(o.dtype)


def _multiscale_pool(u, w_grp, scale):
    B, S, _ = u.shape
    G, c = POOL_GROUPS, POOL_GROUP_DIM
    f32 = jnp.float32
    ug = u.astype(f32).reshape(B, S, G, c)
    cs = jnp.pad(jnp.cumsum(ug, axis=1), ((0, 0), (1, 0), (0, 0), (0, 0)))
    t = jnp.arange(S)[:, None]
    win = jnp.array(POOL_WINDOWS, dtype=jnp.int32)[None, :]
    lo = jnp.maximum(t + 1 - win, 0)
    g = jnp.arange(G)[None, :]
    total = cs[:, 1:] - cs[:, lo, g]
    mean = total / jnp.minimum(t + 1, win).astype(f32)[None, :, :, None]
    y = jnp.einsum('bsgc,gcd->bsgd', mean - ug, w_grp.astype(f32))
    return (y.reshape(B, S, G * c) * scale.astype(f32)).astype(u.dtype)


def _dilated_branch(q, k, v, bias, dil, n_back):
    B, S, H, dh = q.shape
    f32 = jnp.float32
    L = S // dil
    blk = n_back
    nb = -(-L // blk)
    Lp = nb * blk

    def to_blocks(t):
        t = t.reshape(B, L, dil, H, dh).transpose(0, 2, 3, 1, 4)
        t = jnp.pad(t, ((0, 0), (0, 0), (0, 0), (0, Lp - L), (0, 0)))
        return t.reshape(B, dil, H, nb, blk, dh)

    def with_prev(t):
        prev = jnp.pad(t, ((0, 0), (0, 0), (0, 0), (1, 0), (0, 0), (0, 0)))[:, :, :, :nb]
        return jnp.concatenate([prev, t], axis=4)

    qb = to_blocks(q)
    kb = with_prev(to_blocks(k))
    vb = with_prev(to_blocks(v)).astype(f32)
    s = jnp.einsum('brhnqc,brhnkc->brhnqk', qb, kb).astype(f32) * (dh ** -0.5)
    qi = jnp.arange(blk)[:, None]
    kj = jnp.arange(2 * blk)[None, :]
    delta = qi + blk - kj
    key_idx = jnp.arange(nb)[:, None, None] * blk - blk + kj[None]
    valid = ((delta >= 0) & (delta <= n_back))[None] & (key_idx >= 0)
    s = s + bias[:, jnp.clip(delta, 0, n_back)][None, None, :, None]
    s = jnp.where(valid[None, None, None], s, -jnp.inf)
    m = jnp.max(s, axis=-1, keepdims=True)
    p = jnp.exp(s - m)
    l = jnp.sum(p, axis=-1)
    o = jnp.einsum('brhnqk,brhnkc->brhnqc', p, vb) / l[..., None]
    lse = m[..., 0] + jnp.log(l)
    o = o.reshape(B, dil, H, Lp, dh)[:, :, :, :L].transpose(0, 3, 1, 2, 4).reshape(B, S, H, dh)
    lse = lse.reshape(B, dil, H, Lp)[:, :, :, :L].transpose(0, 3, 1, 2).reshape(B, S, H)
    return o, lse


def _dilated_attention(q, k, v, dil_biases):
    B, S, H, dh = q.shape
    outs, lses = [], []
    for (w, d), b in zip(DIL_PATTERNS, dil_biases):
        o, lse = _dilated_branch(q, k, v, b, d, w // d)
        outs.append(o)
        lses.append(lse)
    wts = jax.nn.softmax(jnp.stack(lses), axis=0)
    o = jnp.sum(wts[..., None] * jnp.stack(outs), axis=0)
    return o.reshape(B, S, H * dh).astype(q.dtype)


def _diff_attention(q, k, v, lam_vecs, subln_g, bias_by_dist, lam_init):
    B, S, H, dv = q.shape
    dk = DIFF_QK_HALF
    f32 = jnp.float32
    scale = dk ** -0.5
    lv = lam_vecs.astype(f32)
    lam = jnp.exp(jnp.sum(lv[0] * lv[1])) - jnp.exp(jnp.sum(lv[2] * lv[3])) + lam_init
    kh = k.transpose(0, 2, 1, 3)
    k1, k2 = kh[..., :dk], kh[..., dk:]
    vh = v.transpose(0, 2, 1, 3).astype(f32)
    nq = S // ATTN_BLOCK
    qb = q.transpose(0, 2, 1, 3).reshape(B, H, nq, ATTN_BLOCK, 2 * dk).transpose(2, 0, 1, 3, 4)
    key_pos = jnp.arange(S)

    def block(args):
        qblk, start = args
        dist = start + jnp.arange(ATTN_BLOCK)[:, None] - key_pos[None, :]
        causal = dist >= 0
        bias = bias_by_dist[:, jnp.clip(dist, 0, S - 1)]

        def attn_map(qq, kk):
            s = jnp.einsum('bhqd,bhkd->bhqk', qq, kk).astype(f32) * scale + bias
            return jax.nn.softmax(jnp.where(causal, s, -jnp.inf), axis=-1)

        a = attn_map(qblk[..., :dk], k1) - lam * attn_map(qblk[..., dk:], k2)
        return jnp.einsum('bhqk,bhkd->bhqd', a, vh)

    o = lax.map(block, (qb, jnp.arange(nq) * ATTN_BLOCK))
    o = o.transpose(1, 0, 3, 2, 4).reshape(B, S, H, dv)
    o = o * lax.rsqrt(jnp.mean(o * o, axis=-1, keepdims=True) + SUBLN_EPS) * subln_g.astype(f32)
    o = o * (1.0 - lam_init)
    return o.reshape(B, S, H * dv).astype(q.dtype)


def _hybrid_mixer(u, w_in, w_out, conv_w, conv_b, gate_b, mlstm_g, pool_w, pool_scale,
                  dil_biases, lam_vecs, subln_g, diff_bias, lam_init):
    B, S, _ = u.shape
    z = u @ w_in
    qa, ka, va, oa, ia, fa, pb, qc, kc, vc, qd, kd, vd = _split_cols(z, IN_WIDTHS)
    ya = _mlstm(qa, ka, va, oa, ia, fa, conv_w, conv_b, gate_b, mlstm_g)
    yb = _multiscale_pool(pb, pool_w, pool_scale)
    yc = _dilated_attention(qc.reshape(B, S, DIL_HEADS, DIL_HEAD_DIM),
                            kc.reshape(B, S, DIL_HEADS, DIL_HEAD_DIM),
                            vc.reshape(B, S, DIL_HEADS, DIL_HEAD_DIM), dil_biases)
    yd = _diff_attention(qd.reshape(B, S, DIFF_HEADS, DIFF_HEAD_DIM),
                         kd.reshape(B, S, DIFF_HEADS, DIFF_HEAD_DIM),
                         vd.reshape(B, S, DIFF_HEADS, DIFF_HEAD_DIM),
                         lam_vecs, subln_g, diff_bias, lam_init)
    y = jnp.concatenate([ya, yb, yc, yd], axis=-1)
    return y @ w_out


def _cross_attention(u, mem_n, wq, wkv, wo):
    B, S, D = u.shape
    M = mem_n.shape[1]
    q = (u @ wq).reshape(B, S, N_MEM_HEADS, MEM_HEAD_DIM)
    kv = mem_n @ wkv
    k = kv[..., :D].reshape(B, M, N_MEM_HEADS, MEM_HEAD_DIM)
    v = kv[..., D:].reshape(B, M, N_MEM_HEADS, MEM_HEAD_DIM)
    s = jnp.einsum('bshd,bmhd->bhsm', q, k).astype(jnp.float32) * (MEM_HEAD_DIM ** -0.5)
    p = jax.nn.softmax(s, axis=-1)
    o = jnp.einsum('bhsm,bmhd->bshd', p, v.astype(jnp.float32)).astype(u.dtype)
    return o.reshape(B, S, D) @ wo


def setup_inputs(seed: int = 0) -> dict:
    key = jax.random.key(seed)
    keys = jax.random.split(key, 40)
    counter = [0]
    f32 = jnp.float32
    Lr, D, F = DEPTH, D_MODEL, D_FF

    def next_key():
        kk = keys[counter[0]]
        counter[0] += 1
        return kk

    def nrm(shape, scale):
        return jax.random.normal(next_key(), shape, f32) * scale

    def gain(shape):
        return 1.0 + 0.05 * jax.random.normal(next_key(), shape, f32)

    fgate_init = jnp.broadcast_to(jnp.linspace(3.0, 6.0, MLSTM_HEADS, dtype=f32), (Lr, MLSTM_HEADS))
    return {
        "x": nrm((BATCH, SEQ, D), 1.0),
        "mem": nrm((BATCH, MEM_LEN, D), 1.0),
        "t5_bias": nrm((T5_BUCKETS, N_BIAS_HEADS), 0.5),
        "ffn1_norm": gain((Lr, D)),
        "ffn1_w_gate": nrm((Lr, D, F), D ** -0.5),
        "ffn1_w_up": nrm((Lr, D, F), D ** -0.5),
        "ffn1_w_down": nrm((Lr, F, D), F ** -0.5),
        "mix_norm": gain((Lr, D)),
        "w_in": nrm((Lr, D, IN_WIDTH), D ** -0.5),
        "mlstm_conv_w": nrm((Lr, CONV_WIDTH, 2 * GROUP_WIDTH), CONV_WIDTH ** -0.5),
        "mlstm_conv_b": nrm((Lr, 2 * GROUP_WIDTH), 0.02),
        "mlstm_gate_b": jnp.concatenate([nrm((Lr, MLSTM_HEADS), 0.1),
                                         fgate_init + nrm((Lr, MLSTM_HEADS), 0.1)], axis=-1),
        "mlstm_norm": gain((Lr, GROUP_WIDTH)),
        "pool_w": nrm((Lr, POOL_GROUPS, POOL_GROUP_DIM, POOL_GROUP_DIM), POOL_GROUP_DIM ** -0.5),
        "pool_scale": gain((Lr, GROUP_WIDTH)),
        "diff_lambda": nrm((Lr, 4, DIFF_QK_HALF), 0.1),
        "diff_subln": gain((Lr, DIFF_HEAD_DIM)),
        "w_out": nrm((Lr, MIX_WIDTH, D), MIX_WIDTH ** -0.5),
        "xattn_norm": gain((Lr, D)),
        "mem_norm": gain((Lr, D)),
        "xattn_wq": nrm((Lr, D, D), D ** -0.5),
        "xattn_wkv": nrm((Lr, D, 2 * D), D ** -0.5),
        "xattn_wo": nrm((Lr, D, D), D ** -0.5),
        "ffn2_norm": gain((Lr, D)),
        "ffn2_w_gate": nrm((Lr, D, F), D ** -0.5),
        "ffn2_w_up": nrm((Lr, D, F), D ** -0.5),
        "ffn2_w_down": nrm((Lr, F, D), F ** -0.5),
        "final_norm": gain((D,)),
    }


def reference(x, mem, t5_bias, ffn1_norm, ffn1_w_gate, ffn1_w_up, ffn1_w_down, mix_norm, w_in,
              mlstm_conv_w, mlstm_conv_b, mlstm_gate_b, mlstm_norm, pool_w, pool_scale,
              diff_lambda, diff_subln, w_out, xattn_norm, mem_norm, xattn_wq, xattn_wkv, xattn_wo,
              ffn2_norm, ffn2_w_gate, ffn2_w_up, ffn2_w_down, final_norm):
    S = x.shape[1]
    dil_biases = [t5_bias[_t5_bucket(jnp.arange(w // d + 1) * d), :DIL_HEADS].T
                  for (w, d) in DIL_PATTERNS]
    diff_bias = t5_bias[_t5_bucket(jnp.arange(S)), DIL_HEADS:].T
    h = x
    for l in range(DEPTH):
        lam_init = 0.8 - 0.6 * math.exp(-0.3 * l)
        h = h + 0.5 * _swiglu(_rms_norm(h, ffn1_norm[l]), ffn1_w_gate[l], ffn1_w_up[l], ffn1_w_down[l])
        h = h + _hybrid_mixer(_rms_norm(h, mix_norm[l]), w_in[l], w_out[l],
                              mlstm_conv_w[l], mlstm_conv_b[l], mlstm_gate_b[l], mlstm_norm[l],
                              pool_w[l], pool_scale[l], dil_biases,
                              diff_lambda[l], diff_subln[l], diff_bias, lam_init)
        h = h + _cross_attention(_rms_norm(h, xattn_norm[l]), _rms_norm(mem, mem_norm[l]),
                                 xattn_wq[l], xattn_wkv[l], xattn_wo[l])
        h = h + 0.5 * _swiglu(_rms_norm(h, ffn2_norm[l]), ffn2_w_gate[l], ffn2_w_up[l], ffn2_w_down[l])
    return _rms_norm(h, final_norm)
```

```cpp
#include <hip/hip_runtime.h>
#include <hip/hip_cooperative_groups.h>
#include <cstdio>
#include <cstdint>
namespace cg = cooperative_groups;

#ifndef MK_MULTI
#define MK_MULTI 0
#endif

#ifndef R_DIFF
#define R_DIFF 1
#endif
#ifndef R_DIL
#define R_DIL 1
#endif
#ifndef R_POOL
#define R_POOL 1
#endif
#ifndef R_MLA
#define R_MLA 1
#endif
#ifndef R_MLC
#define R_MLC 1
#endif
#ifndef R_UP
#define R_UP 1
#endif
#ifndef R_WIN
#define R_WIN 1
#endif
#ifndef R_GATES
#define R_GATES 1
#endif
#ifndef R_PRO
#define R_PRO 1
#endif
#ifndef R_RES1
#define R_RES1 1
#endif
#ifndef R_RES6
#define R_RES6 1
#endif
#ifndef R_WQ
#define R_WQ 1
#endif
#define REP(n) for (int rep_ = 0; rep_ < (n); ++rep_)
#define DI __device__ __forceinline__
#define LAS __attribute__((address_space(3)))
typedef unsigned short bf16_t;
typedef short bf16x8 __attribute__((ext_vector_type(8)));
typedef float f32x4 __attribute__((ext_vector_type(4)));
typedef float f32x16 __attribute__((ext_vector_type(16)));
typedef unsigned u32x4 __attribute__((ext_vector_type(4)));
typedef unsigned u32x2 __attribute__((ext_vector_type(2)));
typedef float f32x2_t __attribute__((ext_vector_type(2)));
typedef __bf16 bf16x2_t __attribute__((ext_vector_type(2)));

constexpr int DM = 1024, NB = 16, SEQ = 4096, MTOK = NB * SEQ, DEPTH = 4, MEMLEN = 256, MMEM = NB * MEMLEN, FF = 2816, ZW = 2816, INW = 2824;
constexpr int ZQA = 0, ZKA = 256, ZVA = 512, ZOA = 768, ZPB = 1024, ZQC = 1280, ZKC = 1536, ZVC = 1792, ZQD = 2048, ZKD = 2304, ZVD = 2560;
constexpr float LOG2E = 1.4426950408889634f;
constexpr float NEGBIG = -1e30f;

constexpr size_t W_GU1 = 0, W_D1 = W_GU1 + (size_t)2 * FF * DM * 2, W_IN = W_D1 + (size_t)DM * FF * 2, W_OUT = W_IN + (size_t)3072 * DM * 2,
                 W_Q = W_OUT + (size_t)DM * DM * 2, W_O = W_Q + (size_t)DM * DM * 2, W_GU2 = W_O + (size_t)DM * DM * 2, W_D2 = W_GU2 + (size_t)2 * FF * DM * 2,
                 W_LAYER = W_D2 + (size_t)DM * FF * 2;
constexpr size_t OFF_WK = DEPTH * W_LAYER, OFF_WV = OFF_WK + (size_t)DEPTH * DM * DM * 2, OFF_HB = OFF_WV + (size_t)DEPTH * DM * DM * 2;
constexpr size_t OFF_DST = OFF_HB;
constexpr size_t OFF_OPART = OFF_HB + (size_t)64 * 64 * 4096 * 4;
constexpr size_t OFF_Z = OFF_HB + (size_t)MTOK * DM * 2;
constexpr size_t OFF_Y = OFF_Z + (size_t)MTOK * ZW * 2;
constexpr size_t OFF_KB = OFF_Y + (size_t)MTOK * DM * 2;
constexpr size_t OFF_VT = OFF_KB + (size_t)MMEM * 4096 * 2;
constexpr size_t OFF_MEMB = OFF_VT + (size_t)4096 * MMEM * 2;
constexpr size_t OFF_GATES = OFF_MEMB + (size_t)MMEM * DM * 2;
constexpr size_t OFF_SS = OFF_GATES + (size_t)MTOK * 8 * 4;
constexpr size_t OFF_LSEP = OFF_SS + (size_t)17 * MTOK * 16 * 4;
constexpr size_t OFF_NST = OFF_LSEP + (size_t)2 * MTOK * 4 * 4;
constexpr size_t OFF_SCAL = OFF_NST + (size_t)4096 * 64 * 4;
constexpr size_t OFF_DIFFB = OFF_SCAL + 65536;
constexpr size_t OFF_DILB = OFF_DIFFB + 65536;
constexpr size_t OFF_LAM = OFF_DILB + 8192;
constexpr size_t OFF_RSM = OFF_LAM + 256;
constexpr size_t OFF_CTL = OFF_RSM + 16384;
constexpr size_t CTL_BYTES = 16384;
constexpr size_t OFF_END = OFF_CTL + CTL_BYTES;
static_assert(OFF_OPART + (size_t)2 * MTOK * 256 * 2 <= OFF_Z, "alias map");
static_assert(OFF_END < (size_t)1073741824, "workspace");

constexpr int LDS_BYTES = 147456;
constexpr int LDS_EXTRA = 131072;

struct Params {
    const float* in[28];
    float* out;
    unsigned char* ws;
    int ph_lo, ph_hi, coop, pad;
};
enum { I_X = 0, I_MEM, I_T5, I_F1N, I_F1G, I_F1U, I_F1D, I_MIXN, I_WIN, I_CONVW, I_CONVB, I_GATEB, I_MLN, I_POOLW, I_POOLS, I_LAMV, I_SUBLN, I_WOUT,
       I_XN, I_MEMN, I_XWQ, I_XWKV, I_XWO, I_F2N, I_F2G, I_F2U, I_F2D, I_FINN };

DI unsigned cvtpk(float lo, float hi) { f32x2_t v = {lo, hi}; bf16x2_t b = __builtin_convertvector(v, bf16x2_t); return __builtin_bit_cast(unsigned, b); }
DI float bflo(unsigned w) { return __uint_as_float(w << 16); }
DI float bfhi(unsigned w) { return __uint_as_float(w & 0xffff0000u); }
DI float bf2f(bf16_t x) { return __uint_as_float((unsigned)x << 16); }
DI float ex2(float x) { return __builtin_amdgcn_exp2f(x); }
DI float rcpf_(float x) { return __builtin_amdgcn_rcpf(x); }
DI int crow(int i, int hi) { return (i & 3) + 8 * (i >> 2) + 4 * hi; }
DI float wave_sum(float v) {
#pragma unroll
    for (int o = 1; o < 64; o <<= 1) v += __shfl_xor(v, o);
    return v;
}
DI float wave_max(float v) {
#pragma unroll
    for (int o = 1; o < 64; o <<= 1) v = fmaxf(v, __shfl_xor(v, o));
    return v;
}
DI float silu_f(float g) { return g * rcpf_(1.f + ex2(-g * LOG2E)); }
DI float sigmoid_f(float g) { return rcpf_(1.f + ex2(-g * LOG2E)); }
#define LDS_WAIT() asm volatile("s_waitcnt lgkmcnt(0)" ::: "memory")
DI bf16x8 mk8(u32x2 lo, u32x2 hi) { u32x4 w = {lo.x, lo.y, hi.x, hi.y}; return __builtin_bit_cast(bf16x8, w); }
DI bf16x8 pack8(float a0, float a1, float a2, float a3, float a4, float a5, float a6, float a7) {
    u32x4 w = {cvtpk(a0, a1), cvtpk(a2, a3), cvtpk(a4, a5), cvtpk(a6, a7)}; return __builtin_bit_cast(bf16x8, w);
}
DI float rowss(const float* ss, int row) {
    const f32x4* q = (const f32x4*)(ss + (size_t)row * 16); const f32x4 a = q[0], b = q[1], c = q[2], d = q[3];
    const float t = ((a[0] + a[1]) + (a[2] + a[3])) + ((b[0] + b[1]) + (b[2] + b[3])) + ((c[0] + c[1]) + (c[2] + c[3])) + ((d[0] + d[1]) + (d[2] + d[3]));
    return rsqrtf(t * (1.f / 1024.f) + 1e-6f);
}
#define MFMA32(a, b, c) __builtin_amdgcn_mfma_f32_32x32x16_bf16((a), (b), (c), 0, 0, 0)

namespace pg8 {
constexpr int BM = 256, BK = 64, HALF = 128, HTB = HALF * BK * 2, STAGE_BYTES = 8 * HTB, NXCD = 8, WGM = 8;
DI int lds_byte(int r, int c) { const int st = (r >> 4) * 2 + (c >> 5), rr = r & 15, cc = c & 31, ob = rr * 64 + cc * 2; return st * 1024 + (ob ^ (((ob >> 9) & 1) << 5)); }
DI void stage_rc(int b, int& R, int& C) { const int st = b / 1024, sb = b % 1024, swz = sb ^ (((sb >> 9) & 1) << 5); R = (st >> 1) * 16 + swz / 64; C = (st & 1) * 32 + (swz % 64) / 2; }
DI int perm32(int rho) { const int n = rho >> 4, i = rho & 15; return 8 * (i >> 2) + 4 * n + (i & 3); }

struct Unit { const char* a; const char* b; int orow, ocol, pm, pn; };
struct Gemm {
    const bf16_t* A; const bf16_t* B; int lda, ldb, K, nM, nN; long a_pmdiv, a_pmmod, a_pn, b_pmdiv, b_pmmod, b_pn; int div, ocol_step; int kstepA, kstepB;
};
DI Gemm plain_gemm(const bf16_t* A, const bf16_t* B, int Mrows, int N, int K) {
    Gemm g; g.A = A; g.B = B; g.lda = K; g.ldb = K; g.K = K; g.nM = Mrows / BM; g.nN = N / BM; g.a_pmdiv = (long)BM * K; g.a_pmmod = 0; g.a_pn = 0; g.b_pmdiv = 0; g.b_pmmod = 0; g.b_pn = (long)BM * K;
    g.div = 1; g.ocol_step = BM; g.kstepA = BK * 2; g.kstepB = BK * 2; return g;
}
struct Order {
    Gemm g; int nwg, G, c;
    DI void init(const Gemm& g_, int G_, int c_) { g = g_; nwg = g.nM * g.nN; G = G_; c = c_; }
    DI bool next(int i, Unit& u) const {
        const long L = (long)i * G + c; if (L >= nwg) return false;
        int wgid = (int)L; { const int q = nwg / NXCD, r = nwg % NXCD, xcd = wgid % NXCD, off = wgid / NXCD; wgid = (xcd < r ? xcd * (q + 1) : r * (q + 1) + (xcd - r) * q) + off; }
        const int nN = g.nN, nM = g.nM, nig = WGM * nN, gid = wgid / nig, fm = gid * WGM, gsz = (nM - fm) < WGM ? (nM - fm) : WGM;
        const int pm = fm + ((wgid % nig) % gsz), pn = (wgid % nig) / gsz;
        u.pm = pm; u.pn = pn; u.orow = pm * BM; u.ocol = pn * g.ocol_step;
        const int pq = pm / g.div, pr = pm - pq * g.div;
        u.a = (const char*)(g.A + (long)pq * g.a_pmdiv + (long)pr * g.a_pmmod + (long)pn * g.a_pn);
        u.b = (const char*)(g.B + (long)pq * g.b_pmdiv + (long)pr * g.b_pmmod + (long)pn * g.b_pn);
        return true;
    }
};

struct EpiBf16 {
    static constexpr bool PERM = true;
    bf16_t* O; int ldc; const float* ss; const float* rowscale; const float* colscale; float scale; int zspecial;
    DI void operator()(f32x4 (&acc)[2][2][4][2], const Unit& u, int wr, int wc, int fr, int fq, int wid, int lane) const {
        const int row0 = u.orow + wr * 64 + fr, col0 = u.ocol + wc * 32 + 8 * fq;
        float sc = scale;
        if (zspecial) { if (u.pn == 5) sc *= 0.125f * LOG2E; else if (u.pn == 8) sc *= 0.17677669529663687f * LOG2E; }
        if (colscale) {
#pragma unroll
            for (int bj = 0; bj < 2; ++bj)
#pragma unroll
                for (int n = 0; n < 2; ++n) { const f32x4 cs = *(const f32x4*)(colscale + col0 + bj * HALF + 4 * n);
#pragma unroll
                    for (int ai = 0; ai < 2; ++ai)
#pragma unroll
                        for (int m = 0; m < 4; ++m) acc[ai][bj][m][n] *= cs; }
            asm volatile("" ::: "memory");
        }
#pragma unroll
        for (int ai = 0; ai < 2; ++ai)
#pragma unroll
            for (int m = 0; m < 4; ++m) {
                const int row = row0 + ai * HALF + m * 16;
                float rs = sc;
                if (ss) rs *= rowss(ss, row);
                if (rowscale) rs *= rowscale[row];
                bf16_t* rowp = O + (size_t)row * ldc + col0;
#pragma unroll
                for (int bj = 0; bj < 2; ++bj) {
                    const f32x4 v0 = acc[ai][bj][m][0] * rs, v1 = acc[ai][bj][m][1] * rs;
                    u32x4 w; w.x = cvtpk(v0[0], v0[1]); w.y = cvtpk(v0[2], v0[3]); w.z = cvtpk(v1[0], v1[1]); w.w = cvtpk(v1[2], v1[3]);
                    *(u32x4*)(rowp + bj * HALF) = w;
                }
                asm volatile("" ::: "memory");
            }
    }
};
struct EpiZ {
    static constexpr bool PERM = true;
    bf16_t* O; float* gates; const float* ss;
    DI void operator()(f32x4 (&acc)[2][2][4][2], const Unit& u, int wr, int wc, int fr, int fq, int wid, int lane) const {
        const int row0 = u.orow + wr * 64 + fr, col0 = u.ocol + wc * 32 + 8 * fq;
        if (u.pn == 11) {
            if (wc == 0 && fq == 0) {
#pragma unroll
                for (int ai = 0; ai < 2; ++ai)
#pragma unroll
                    for (int m = 0; m < 4; ++m) { const int row = row0 + ai * HALF + m * 16; const float rs = rowss(ss, row);
                        *(f32x4*)(gates + (size_t)row * 8) = acc[ai][0][m][0] * rs; *(f32x4*)(gates + (size_t)row * 8 + 4) = acc[ai][0][m][1] * rs; }
            }
            return;
        }
        float sc = 1.f;
        if (u.pn == 5) sc = 0.125f * LOG2E; else if (u.pn == 8) sc = 0.17677669529663687f * LOG2E;
#pragma unroll
        for (int ai = 0; ai < 2; ++ai)
#pragma unroll
            for (int m = 0; m < 4; ++m) {
                const int row = row0 + ai * HALF + m * 16;
                const float rs = sc * rowss(ss, row);
                bf16_t* rowp = O + (size_t)row * ZW + col0;
#pragma unroll
                for (int bj = 0; bj < 2; ++bj) {
                    const f32x4 v0 = acc[ai][bj][m][0] * rs, v1 = acc[ai][bj][m][1] * rs;
                    u32x4 w; w.x = cvtpk(v0[0], v0[1]); w.y = cvtpk(v0[2], v0[3]); w.z = cvtpk(v1[0], v1[1]); w.w = cvtpk(v1[2], v1[3]);
                    *(u32x4*)(rowp + bj * HALF) = w;
                }
                asm volatile("" ::: "memory");
            }
    }
};
struct EpiSwiGLU {
    static constexpr bool PERM = true;
    bf16_t* O; int ldc; const float* ss;
    DI void operator()(f32x4 (&acc)[2][2][4][2], const Unit& u, int wr, int wc, int fr, int fq, int wid, int lane) const {
        const int row0 = u.orow + wr * 64 + fr, col0 = u.ocol + wc * 32 + 8 * fq;
#pragma unroll
        for (int ai = 0; ai < 2; ++ai)
#pragma unroll
            for (int m = 0; m < 4; ++m) {
                const int row = row0 + ai * HALF + m * 16;
                const float rs = rowss(ss, row);
                float o[8];
#pragma unroll
                for (int n = 0; n < 2; ++n)
#pragma unroll
                    for (int j = 0; j < 4; ++j) { const float g = acc[ai][0][m][n][j] * rs, up = acc[ai][1][m][n][j] * rs; o[4 * n + j] = silu_f(g) * up; }
                u32x4 w; w.x = cvtpk(o[0], o[1]); w.y = cvtpk(o[2], o[3]); w.z = cvtpk(o[4], o[5]); w.w = cvtpk(o[6], o[7]);
                __builtin_nontemporal_store(w, (u32x4*)(O + ((size_t)(u.pm * (FF / 64) + (col0 >> 6)) * 256 + (row & 255)) * 64 + (col0 & 63)));
                asm volatile("" ::: "memory");
            }
    }
};
struct EpiResid {
    static constexpr bool PERM = true;
    bf16_t* hb; float* ssout; float alpha;
    DI void operator()(f32x4 (&acc)[2][2][4][2], const Unit& u, int wr, int wc, int fr, int fq, int wid, int lane) const {
        const int row0 = u.orow + wr * 64 + fr, col0 = u.ocol + wc * 32 + 8 * fq;
#pragma unroll
        for (int ai = 0; ai < 2; ++ai) {
            u32x4 r[4][2];
#pragma unroll
            for (int m = 0; m < 4; ++m) { const size_t off = (size_t)(row0 + ai * HALF + m * 16) * DM + col0;
#pragma unroll
                for (int bj = 0; bj < 2; ++bj) r[m][bj] = *(const u32x4*)(hb + off + bj * HALF); }
#pragma unroll
            for (int m = 0; m < 4; ++m) {
                const int row = row0 + ai * HALF + m * 16; const size_t off = (size_t)row * DM + col0; float ssq = 0.f;
#pragma unroll
                for (int bj = 0; bj < 2; ++bj) {
                    const u32x4 rr = r[m][bj]; const f32x4 a0 = acc[ai][bj][m][0] * alpha, a1 = acc[ai][bj][m][1] * alpha;
                    u32x4 w; w.x = cvtpk(bflo(rr.x) + a0[0], bfhi(rr.x) + a0[1]); w.y = cvtpk(bflo(rr.y) + a0[2], bfhi(rr.y) + a0[3]);
                    w.z = cvtpk(bflo(rr.z) + a1[0], bfhi(rr.z) + a1[1]); w.w = cvtpk(bflo(rr.w) + a1[2], bfhi(rr.w) + a1[3]);
                    *(u32x4*)(hb + off + bj * HALF) = w;
                    const float v0 = bflo(w.x), v1 = bfhi(w.x), v2 = bflo(w.y), v3 = bfhi(w.y), v4 = bflo(w.z), v5 = bfhi(w.z), v6 = bflo(w.w), v7 = bfhi(w.w);
                    ssq += ((v0 * v0 + v1 * v1) + (v2 * v2 + v3 * v3)) + ((v4 * v4 + v5 * v5) + (v6 * v6 + v7 * v7));
                }
                ssq += __shfl_xor(ssq, 16); ssq += __shfl_xor(ssq, 32);
                if (fq == 0) ssout[(size_t)row * 16 + u.pn * 4 + wc] = ssq;
            }
            asm volatile("" ::: "memory");
        }
    }
};
struct EpiSoftmax {
    static constexpr bool PERM = true;
    bf16_t* O; int ldc; LAS float* red; const float* ss; float scale;
    DI void operator()(f32x4 (&acc)[2][2][4][2], const Unit& u, int wr, int wc, int fr, int fq, int wid, int lane) const {
        float mloc[2][4];
#pragma unroll
        for (int ai = 0; ai < 2; ++ai)
#pragma unroll
            for (int m = 0; m < 4; ++m) {
                float mx = NEGBIG;
                const float rsc = rowss(ss, u.orow + ai * HALF + wr * 64 + m * 16 + fr) * scale;
#pragma unroll
                for (int bj = 0; bj < 2; ++bj)
#pragma unroll
                    for (int n = 0; n < 2; ++n) { const f32x4 x = acc[ai][bj][m][n] * rsc; acc[ai][bj][m][n] = x; mx = fmaxf(mx, fmaxf(fmaxf(x[0], x[1]), fmaxf(x[2], x[3]))); }
                mx = fmaxf(mx, __shfl_xor(mx, 16)); mx = fmaxf(mx, __shfl_xor(mx, 32));
                float sm = 0.f;
#pragma unroll
                for (int bj = 0; bj < 2; ++bj)
#pragma unroll
                    for (int n = 0; n < 2; ++n) { f32x4 x = acc[ai][bj][m][n]; x[0] = ex2(x[0] - mx); x[1] = ex2(x[1] - mx); x[2] = ex2(x[2] - mx); x[3] = ex2(x[3] - mx);
                        acc[ai][bj][m][n] = x; sm += (x[0] + x[1]) + (x[2] + x[3]); }
                sm += __shfl_xor(sm, 16); sm += __shfl_xor(sm, 32);
                mloc[ai][m] = mx;
                const int rl = ai * HALF + wr * 64 + m * 16 + fr;
                if (fq == 0) { red[(rl * 4 + wc) * 2] = mx; red[(rl * 4 + wc) * 2 + 1] = sm; }
            }
        asm volatile("s_waitcnt lgkmcnt(0)" ::: "memory"); __builtin_amdgcn_s_barrier(); asm volatile("" ::: "memory");
        const int row0 = u.orow + wr * 64 + fr, col0 = u.ocol + wc * 32 + 8 * fq;
#pragma unroll
        for (int ai = 0; ai < 2; ++ai)
#pragma unroll
            for (int m = 0; m < 4; ++m) {
                const int rl = ai * HALF + wr * 64 + m * 16 + fr;
                const f32x4 p0 = *(const LAS f32x4*)(red + rl * 8), p1 = *(const LAS f32x4*)(red + rl * 8 + 4);
                const float gm = fmaxf(fmaxf(p0[0], p0[2]), fmaxf(p1[0], p1[2]));
                const float tot = p0[1] * ex2(p0[0] - gm) + p0[3] * ex2(p0[2] - gm) + p1[1] * ex2(p1[0] - gm) + p1[3] * ex2(p1[2] - gm);
                const float f = ex2(mloc[ai][m] - gm) / tot;
                bf16_t* rowp = O + (size_t)(row0 + ai * HALF + m * 16) * ldc + col0;
#pragma unroll
                for (int bj = 0; bj < 2; ++bj) {
                    const f32x4 v0 = acc[ai][bj][m][0] * f, v1 = acc[ai][bj][m][1] * f;
                    u32x4 w; w.x = cvtpk(v0[0], v0[1]); w.y = cvtpk(v0[2], v0[3]); w.z = cvtpk(v1[0], v1[1]); w.w = cvtpk(v1[2], v1[3]);
                    *(u32x4*)(rowp + bj * HALF) = w;
                }
            }
        asm volatile("s_waitcnt lgkmcnt(0)" ::: "memory"); __builtin_amdgcn_s_barrier(); asm volatile("" ::: "memory");
    }
};

template <class Epi>
DI void gemm_phase(LAS unsigned char* lds, const Gemm g, const Order& S, const Epi& E) {
    int tid_ = threadIdx.x; asm volatile("" : "+v"(tid_));
    const int tid = tid_, wid = __builtin_amdgcn_readfirstlane(tid >> 6), lane = tid & 63, wr = wid >> 2, wc = wid & 3, fr = lane & 15, fq = lane >> 4;
    const int K = g.K, nt = K / BK;
    unsigned voffA[2], voffB[2];
#pragma unroll
    for (int i = 0; i < 2; ++i) { int R, C; stage_rc(tid * 16 + i * 8192, R, C); const int Rb = Epi::PERM ? ((R & ~31) + perm32(R & 31)) : R;
        voffA[i] = (unsigned)(R * g.lda + C) * 2u; voffB[i] = (unsigned)(Rb * g.ldb + C) * 2u; }
    const size_t kstepA = (size_t)g.kstepA, kstepB = (size_t)g.kstepB;
    const size_t hstepA = (size_t)HALF * g.lda * 2, hstepB = (size_t)HALF * g.ldb * 2;
    const unsigned ldsw = (unsigned)wid * 1024u;
    const int aoff = lds_byte(wr * 64 + fr, fq * 8), boff = lds_byte(wc * 32 + fr, fq * 8);
#define PG8_SA(b, h) (((b) * 2 + (h)) * HTB)
#define PG8_SB(b, h) ((4 + (b) * 2 + (h)) * HTB)
#define PG8_STAGE(bufoff, gbase, voff) do { _Pragma("unroll") for (int _i = 0; _i < 2; ++_i) \
        __builtin_amdgcn_global_load_lds((const unsigned*)((const char*)(gbase) + (voff)[_i]), (LAS unsigned*)(lds + (bufoff) + ldsw + _i * 8192), 16, 0, 0); } while (0)
#define PG8_LDA(dst, b, h) do { _Pragma("unroll") for (int m = 0; m < 4; ++m) _Pragma("unroll") for (int k = 0; k < 2; ++k) dst[m][k] = *(const LAS bf16x8*)(lds + PG8_SA(b, h) + aoff + m * 2048 + k * 1024); } while (0)
#define PG8_LDB(dst, b, h) do { _Pragma("unroll") for (int n = 0; n < 2; ++n) _Pragma("unroll") for (int k = 0; k < 2; ++k) dst[n][k] = *(const LAS bf16x8*)(lds + PG8_SB(b, h) + boff + n * 2048 + k * 1024); } while (0)
#define PG8_MMA(ai, bj, At, Bt) do { __builtin_amdgcn_s_setprio(1); _Pragma("unroll") for (int m = 0; m < 4; ++m) _Pragma("unroll") for (int n = 0; n < 2; ++n) _Pragma("unroll") for (int k = 0; k < 2; ++k) \
        acc[ai][bj][m][n] = __builtin_amdgcn_mfma_f32_16x16x32_bf16(Bt[n][k], At[m][k], acc[ai][bj][m][n], 0, 0, 0); __builtin_amdgcn_s_setprio(0); } while (0)
#define PG8_WAIT_V(n) asm volatile("s_waitcnt vmcnt(" #n ")" ::: "memory")
#define PG8_WAIT_L(n) asm volatile("s_waitcnt lgkmcnt(" #n ")" ::: "memory")
#define PG8_BAR __builtin_amdgcn_s_barrier()
#define PG8_SCHED __builtin_amdgcn_sched_barrier(0)
    Unit cur, nxt; int ui = 0;
    if (!S.next(0, cur)) return;
    f32x4 acc[2][2][4][2];
#pragma unroll
    for (int a = 0; a < 2; ++a)
#pragma unroll
        for (int b = 0; b < 2; ++b)
#pragma unroll
            for (int m = 0; m < 4; ++m)
#pragma unroll
                for (int n = 0; n < 2; ++n) acc[a][b][m][n] = (f32x4){0.f, 0.f, 0.f, 0.f};
    bf16x8 At[4][2], B0[2][2], B1[2][2];
    const char* cA = cur.a; const char* cB = cur.b;
    PG8_STAGE(PG8_SB(0, 0), cB, voffB); PG8_STAGE(PG8_SB(0, 1), cB + hstepB, voffB); PG8_STAGE(PG8_SA(0, 0), cA, voffA); PG8_STAGE(PG8_SA(0, 1), cA + hstepA, voffA);
    if (wr == 1) PG8_BAR;
    PG8_WAIT_V(2); PG8_BAR;
    PG8_STAGE(PG8_SB(1, 0), cB + kstepB, voffB); PG8_STAGE(PG8_SA(1, 0), cA + kstepA, voffA); PG8_STAGE(PG8_SB(1, 1), cB + hstepB + kstepB, voffB);
    PG8_WAIT_V(6); PG8_BAR;
    for (;;) {
        const bool has_next = S.next(ui + 1, nxt);
        const char* nA = has_next ? nxt.a : cA; const char* nB = has_next ? nxt.b : cB;
        for (int t = 0; t < nt; t += 2) {
            const bool last = (t == nt - 2);
            const char* a1 = cA + (size_t)(t + 1) * kstepA;
            const char* a2 = last ? nA : cA + (size_t)(t + 2) * kstepA; const char* b2 = last ? nB : cB + (size_t)(t + 2) * kstepB;
            const char* a3 = a2 + kstepA; const char* b3 = b2 + kstepB;
            PG8_LDB(B0, 0, 0); PG8_LDB(B1, 0, 1); PG8_SCHED; PG8_LDA(At, 0, 0); PG8_STAGE(PG8_SA(1, 1), a1 + hstepA, voffA);
            PG8_WAIT_V(8); PG8_WAIT_L(0); PG8_BAR; PG8_MMA(0, 0, At, B0); PG8_MMA(0, 1, At, B1); PG8_BAR; PG8_SCHED;
            PG8_LDA(At, 0, 1); PG8_STAGE(PG8_SB(0, 0), b2, voffB); PG8_STAGE(PG8_SB(0, 1), b2 + hstepB, voffB); PG8_STAGE(PG8_SA(0, 0), a2, voffA);
            PG8_WAIT_V(8); PG8_WAIT_L(0); PG8_BAR; PG8_MMA(1, 0, At, B0); PG8_MMA(1, 1, At, B1); PG8_BAR; PG8_SCHED;
            PG8_LDB(B0, 1, 0); PG8_LDB(B1, 1, 1); PG8_SCHED; PG8_LDA(At, 1, 0); PG8_STAGE(PG8_SA(0, 1), a2 + hstepA, voffA);
            PG8_WAIT_V(8); PG8_WAIT_L(0); PG8_BAR; PG8_MMA(0, 0, At, B0); PG8_MMA(0, 1, At, B1); PG8_BAR; PG8_SCHED;
            PG8_LDA(At, 1, 1); PG8_STAGE(PG8_SB(1, 0), b3, voffB); PG8_STAGE(PG8_SB(1, 1), b3 + hstepB, voffB); PG8_STAGE(PG8_SA(1, 0), a3, voffA);
            PG8_WAIT_V(8); PG8_WAIT_L(0); PG8_BAR; PG8_MMA(1, 0, At, B0); PG8_MMA(1, 1, At, B1); PG8_BAR; PG8_SCHED;
        }
        if (wr == 0) PG8_BAR;
        E(acc, cur, wr, wc, fr, fq, wid, lane);
        if (!has_next) break;
#pragma unroll
        for (int a = 0; a < 2; ++a)
#pragma unroll
            for (int b = 0; b < 2; ++b)
#pragma unroll
                for (int m = 0; m < 4; ++m)
#pragma unroll
                    for (int n = 0; n < 2; ++n) acc[a][b][m][n] = (f32x4){0.f, 0.f, 0.f, 0.f};
        cur = nxt; cA = nA; cB = nB; ++ui;
        if (wr == 1) PG8_BAR;
    }
    PG8_WAIT_V(0);
    PG8_BAR;
#undef PG8_SA
#undef PG8_SB
#undef PG8_STAGE
#undef PG8_LDA
#undef PG8_LDB
#undef PG8_MMA
#undef PG8_WAIT_V
#undef PG8_WAIT_L
#undef PG8_BAR
#undef PG8_SCHED
}
}

#define XB_TMO      128
#define XB_XCNT(j)  (256  + 64 * (j))
#define XB_XSUB(j)  (1280 + 64 * (j))
#define XB_XGEN(j)  (2304 + 64 * (j))
#define XB_TOP      3328
#define XB_TOPGEN   3392
#define XCD_BAR_WORDS 3456
#define XB_SPIN_CAP (1u << 20)
DI unsigned xb_ld(unsigned* p)              { return __hip_atomic_load(p, __ATOMIC_RELAXED, __HIP_MEMORY_SCOPE_AGENT); }
DI unsigned xb_add(unsigned* p, unsigned v) { return __hip_atomic_fetch_add(p, v, __ATOMIC_RELAXED, __HIP_MEMORY_SCOPE_AGENT); }
DI unsigned xb_xcc_id() { return (unsigned)__builtin_amdgcn_s_getreg((3 << 11) | 20) & 0xFu; }
#define XB_SPIN(cond, bar) do { unsigned _sp = 0; while (cond) { __builtin_amdgcn_s_sleep(1); \
    if ((++_sp & 255u) == 0u) { if (xb_ld(&(bar)[XB_TMO])) break; if (_sp > XB_SPIN_CAP) { atomicAdd(&(bar)[XB_TMO], 1u); break; } } } } while (0)
struct XcdBarrier { unsigned* bar; unsigned x; volatile LAS unsigned* st; };
DI XcdBarrier xcd_barrier_post(unsigned* bar, volatile LAS unsigned* st) {
    XcdBarrier b; b.bar = bar; b.x = xb_xcc_id(); b.st = st;
    if (threadIdx.x == 0) (void)xb_add(&bar[XB_XCNT(b.x)], 1u);
    return b;
}
DI void xcd_barrier_complete(unsigned* bar, unsigned x, unsigned& nloc, unsigned& nx) {
    const unsigned G = gridDim.x * gridDim.y * gridDim.z;
    unsigned sum, cnt, mine, sp = 0u;
    for (;;) {
        sum = 0u; cnt = 0u; mine = 0u;
#pragma unroll
        for (unsigned j = 0; j < 16; ++j) { const unsigned c = xb_ld(&bar[XB_XCNT(j)]); sum += c; cnt += (c > 0u) ? 1u : 0u; mine = (j == x) ? c : mine; }
        if (sum == G) break;
        __builtin_amdgcn_s_sleep(1);
        if ((++sp & 255u) == 0u) { if (xb_ld(&bar[XB_TMO])) break; if (sp > XB_SPIN_CAP) { atomicAdd(&bar[XB_TMO], 1u); break; } }
    }
    nloc = mine > 0u ? mine : 1u; nx = cnt > 0u ? cnt : 1u;
}
DI void xcd_barrier(const XcdBarrier& b) {
    asm volatile("s_waitcnt vmcnt(0)" ::: "memory");
    __syncthreads();
    if (threadIdx.x == 0) {
        unsigned* bar = b.bar;
        __builtin_amdgcn_s_waitcnt(0);
        unsigned nloc = b.st[0], nx = b.st[1];
        if (nloc == 0u) { xcd_barrier_complete(bar, b.x, nloc, nx); b.st[0] = nloc; b.st[1] = nx; }
        const unsigned old = xb_add(&bar[XB_XSUB(b.x)], 1u);
        const unsigned gen = old / nloc;
        if (old + 1u == (gen + 1u) * nloc) {
            __builtin_amdgcn_fence(__ATOMIC_RELEASE, "agent");
            asm volatile("s_waitcnt vmcnt(0)" ::: "memory");
            const unsigned og = xb_add(&bar[XB_TOP], 1u);
            const unsigned tg = og / nx;
            if (og + 1u == (tg + 1u) * nx) xb_add(&bar[XB_TOPGEN], 1u);
            else XB_SPIN(xb_ld(&bar[XB_TOPGEN]) == tg, bar);
            __builtin_amdgcn_fence(__ATOMIC_ACQUIRE, "agent");
            xb_add(&bar[XB_XGEN(b.x)], 1u);
            asm volatile("s_waitcnt vmcnt(0)" ::: "memory");
        } else {
            XB_SPIN(xb_ld(&bar[XB_XGEN(b.x)]) == gen, bar);
            __builtin_amdgcn_fence(__ATOMIC_ACQUIRE, "agent");
            asm volatile("s_waitcnt vmcnt(0)" ::: "memory");
        }
    }
    __syncthreads();
}

struct Ctx {
    LAS unsigned char* lds; unsigned char* ldsg;
    int tid, lane, wid, bid, G;
    unsigned char* ws; float* out;
};
DI bf16_t* wsb(const Ctx& c, size_t off) { return (bf16_t*)(c.ws + off); }
DI float* wsf(const Ctx& c, size_t off) { return (float*)(c.ws + off); }
DI float* ssbuf(const Ctx& c, int i) { return (float*)(c.ws + OFF_SS) + (size_t)i * MTOK * 16; }

DI int t5_bucket(int dist) {
    if (dist < 16) return dist;
    const float v = logf((float)dist / 16.f) / 4.852030263919617f * 16.f;
    int large = 16 + (int)v; return large < 31 ? large : 31;
}

DI Ctx fresh(const Ctx& c0) {
    Ctx c = c0; int tid = threadIdx.x; asm volatile("" : "+v"(tid)); c.tid = tid; c.lane = tid & 63; c.wid = __builtin_amdgcn_readfirstlane(tid >> 6);
    asm volatile("" : "+s"(c.ws)); asm volatile("" : "+s"(c.out)); return c;
}
DI void transpose_item(const float* W, int ldw, int scol0, int k0, const float* gain, bf16_t* WT, int K, int drow0, LAS float* scr, int lane) {
    {
        f32x4 v[8]; float gs[8];
#pragma unroll
        for (int i = 0; i < 8; ++i) { const int kk = 8 * i + (lane >> 3); v[i] = *(const f32x4*)(W + (size_t)(k0 + kk) * ldw + scol0 + (lane & 7) * 4); gs[i] = gain ? gain[k0 + kk] : 1.f; }
#pragma unroll
        for (int i = 0; i < 8; ++i) { const int kk = 8 * i + (lane >> 3); LAS float* d = scr + kk * 33 + (lane & 7) * 4; d[0] = v[i][0] * gs[i]; d[1] = v[i][1] * gs[i]; d[2] = v[i][2] * gs[i]; d[3] = v[i][3] * gs[i]; }
    }
    LDS_WAIT(); asm volatile("" ::: "memory");
    const int c = lane & 7;
#pragma unroll
    for (int j = 0; j < 4; ++j) { const int n = (lane >> 3) + 8 * j; const LAS float* s = scr + (8 * c) * 33 + n;
        u32x4 o; o.x = cvtpk(s[0 * 33], s[1 * 33]); o.y = cvtpk(s[2 * 33], s[3 * 33]); o.z = cvtpk(s[4 * 33], s[5 * 33]); o.w = cvtpk(s[6 * 33], s[7 * 33]);
        *(u32x4*)(WT + (size_t)(drow0 + n) * K + k0 + 8 * c) = o; }
    LDS_WAIT(); asm volatile("" ::: "memory");
}
DI void tjob(const float* W, int ldw, int scol0, const float* gain, bf16_t* WT, int K, int ncols, int item, LAS float* scr, int lane) {
    const int nblk = ncols / 32, kb = item / nblk, nb = item % nblk;
    transpose_item(W, ldw, scol0 + 32 * nb, 64 * kb, gain, WT, K, 32 * nb, scr, lane);
}
DI void tjob_gu(const float* Wg, const float* Wu, const float* gain, bf16_t* WT, int item, LAS float* scr, int lane) {
    const int nblk = 2 * FF / 32, kb = item / nblk, nb = item % nblk, n0 = 32 * nb, p = n0 >> 8, w = n0 & 255;
    transpose_item(w < 128 ? Wg : Wu, FF, 128 * p + (w & 127), 64 * kb, gain, WT, DM, n0, scr, lane);
}
DI void ph_prologue(const Params& p, const Ctx& c0) {
    const Ctx c = fresh(c0);
    LAS float* scr = (LAS float*)(c.lds + c.wid * 16384);
    const int gw = c.bid * 8 + c.wid, NGW = c.G * 8, lane = c.lane;
    constexpr int I_GU = 16 * (2 * FF / 32), I_D = (FF / 64) * 32, I_INA = 16 * 32, I_INB = 16 * 56, I_INC = 16, I_SQ = 16 * 32;
    constexpr int PER_LAYER = 2 * I_GU + 2 * I_D + I_INA + I_INB + I_INC + 5 * I_SQ;
    for (int it = gw; it < DEPTH * PER_LAYER; it += NGW) {
        const int l = it / PER_LAYER; int r = it % PER_LAYER;
        unsigned char* wl = c.ws + (size_t)l * W_LAYER;
        if (r < I_GU) { tjob_gu(p.in[I_F1G] + (size_t)l * DM * FF, p.in[I_F1U] + (size_t)l * DM * FF, p.in[I_F1N] + l * DM, (bf16_t*)(wl + W_GU1), r, scr, lane); continue; } r -= I_GU;
        if (r < I_D) { tjob(p.in[I_F1D] + (size_t)l * FF * DM, DM, 0, nullptr, (bf16_t*)(wl + W_D1), FF, DM, r, scr, lane); continue; } r -= I_D;
        if (r < I_INA) { tjob(p.in[I_WIN] + (size_t)l * DM * INW, INW, 0, p.in[I_MIXN] + l * DM, (bf16_t*)(wl + W_IN), DM, 1024, r, scr, lane); continue; } r -= I_INA;
        if (r < I_INB) { tjob(p.in[I_WIN] + (size_t)l * DM * INW, INW, 1032, p.in[I_MIXN] + l * DM, (bf16_t*)(wl + W_IN) + (size_t)1024 * DM, DM, 1792, r, scr, lane); continue; } r -= I_INB;
        if (r < I_INC) { tjob(p.in[I_WIN] + (size_t)l * DM * INW, INW, 1024, p.in[I_MIXN] + l * DM, (bf16_t*)(wl + W_IN) + (size_t)2816 * DM, DM, 32, r, scr, lane); continue; } r -= I_INC;
        if (r < I_SQ) { tjob(p.in[I_WOUT] + (size_t)l * DM * DM, DM, 0, nullptr, (bf16_t*)(wl + W_OUT), DM, DM, r, scr, lane); continue; } r -= I_SQ;
        if (r < I_SQ) {
            const int kb = r >> 5, nb = r & 31; const int row = 64 * kb + lane; const float gsc = p.in[I_XN][l * DM + row];
            const f32x4* src = (const f32x4*)(p.in[I_XWQ] + (size_t)l * DM * DM + (size_t)row * DM + 32 * nb); u32x4* dst = (u32x4*)((bf16_t*)(wl + W_Q) + (size_t)row * DM + 32 * nb);
#pragma unroll
            for (int q4 = 0; q4 < 4; ++q4) { const f32x4 x0 = src[2 * q4] * gsc, x1 = src[2 * q4 + 1] * gsc; u32x4 w; w.x = cvtpk(x0[0], x0[1]); w.y = cvtpk(x0[2], x0[3]); w.z = cvtpk(x1[0], x1[1]); w.w = cvtpk(x1[2], x1[3]); dst[q4] = w; }
            continue; } r -= I_SQ;
        if (r < I_SQ) { tjob(p.in[I_XWO] + (size_t)l * DM * DM, DM, 0, nullptr, (bf16_t*)(wl + W_O), DM, DM, r, scr, lane); continue; } r -= I_SQ;
        if (r < I_GU) { tjob_gu(p.in[I_F2G] + (size_t)l * DM * FF, p.in[I_F2U] + (size_t)l * DM * FF, p.in[I_F2N] + l * DM, (bf16_t*)(wl + W_GU2), r, scr, lane); continue; } r -= I_GU;
        if (r < I_D) { tjob(p.in[I_F2D] + (size_t)l * FF * DM, DM, 0, nullptr, (bf16_t*)(wl + W_D2), FF, DM, r, scr, lane); continue; } r -= I_D;
        if (r < I_SQ) { tjob(p.in[I_XWKV] + (size_t)l * DM * 2 * DM, 2 * DM, 0, p.in[I_MEMN] + l * DM, wsb(c, OFF_WK) + (size_t)l * DM * DM, DM, DM, r, scr, lane); continue; } r -= I_SQ;
        tjob(p.in[I_XWKV] + (size_t)l * DM * 2 * DM, 2 * DM, DM, p.in[I_MEMN] + l * DM, wsb(c, OFF_WV) + (size_t)l * DM * DM, DM, DM, r, scr, lane);
    }
    for (int m = gw; m < MTOK + MMEM; m += NGW) {
        const bool isx = m < MTOK; const int row = isx ? m : m - MTOK;
        const f32x4* xr = (const f32x4*)((isx ? p.in[I_X] : p.in[I_MEM]) + (size_t)row * DM) + lane;
        unsigned long long* o8 = (unsigned long long*)((isx ? wsb(c, OFF_HB) : wsb(c, OFF_MEMB)) + (size_t)row * DM) + lane;
        float s = 0.f;
#pragma unroll
        for (int j = 0; j < 4; ++j) { const f32x4 v = xr[64 * j]; s += (v[0] * v[0] + v[1] * v[1]) + (v[2] * v[2] + v[3] * v[3]);
            o8[64 * j] = (unsigned long long)cvtpk(v[0], v[1]) | ((unsigned long long)cvtpk(v[2], v[3]) << 32); }
        s = wave_sum(s);
        if (lane == 0) { if (isx) { f32x4* q = (f32x4*)(ssbuf(c, 0) + (size_t)row * 16); q[0] = (f32x4){s, 0.f, 0.f, 0.f}; q[1] = (f32x4){0.f, 0.f, 0.f, 0.f}; q[2] = q[1]; q[3] = q[1]; } else wsf(c, OFF_RSM)[row] = rsqrtf(s * (1.f / DM) + 1e-6f); }
    }
    for (int l = 0; l < DEPTH; ++l) { u32x4* zz = (u32x4*)((bf16_t*)(c.ws + (size_t)l * W_LAYER + W_IN) + (size_t)2848 * DM); const int n16 = 224 * DM * 2 / 16;
        for (int i = c.bid * 512 + c.tid; i < n16; i += c.G * 512) zz[i] = (u32x4){0u, 0u, 0u, 0u}; }
    const int gt = c.bid * 512 + c.tid, NGT = c.G * 512;
    const float* t5 = p.in[I_T5];
    for (int i = gt; i < 4 * 4096; i += NGT) { const int h = i >> 12, d = i & 4095; wsf(c, OFF_DIFFB)[i] = t5[t5_bucket(d) * 8 + 4 + h] * LOG2E; }
    for (int i = gt; i < 3 * 4 * 132; i += NGT) { const int pp = i / (4 * 132), h = (i / 132) & 3, dl = i % 132; const int dil = pp == 0 ? 1 : (pp == 1 ? 4 : 16);
        wsf(c, OFF_DILB)[i] = dl <= 128 ? t5[t5_bucket(dl * dil) * 8 + h] * LOG2E : 0.f; }
    if (gt < DEPTH) { const float* lv = p.in[I_LAMV] + gt * 128; float a = 0.f, b = 0.f; for (int i = 0; i < 32; ++i) { a += lv[i] * lv[32 + i]; b += lv[64 + i] * lv[96 + i]; }
        const float lam_init = 0.8f - 0.6f * expf(-0.3f * (float)gt); wsf(c, OFF_LAM)[gt] = expf(a) - expf(b) + lam_init; }
}

DI void ph_gates(const Params& p, const Ctx& c0, int l) {
    const Ctx c = fresh(c0);
    LAS float* wg = (LAS float*)c.lds;
    const float* win = p.in[I_WIN] + (size_t)l * DM * INW; const float* gn = p.in[I_MIXN] + l * DM;
    for (int i = c.tid; i < DM * 8; i += 512) { const int k = i >> 3, cc = i & 7; wg[i] = win[(size_t)k * INW + 1024 + cc] * gn[k]; }
    __syncthreads();
    const float* h = c.out; const float* ss = ssbuf(c, 4 * l + 1); float* gates = wsf(c, OFF_GATES);
    for (int row = c.bid * 8 + c.wid; row < MTOK; row += c.G * 8) {
        float a[8];
#pragma unroll
        for (int j = 0; j < 8; ++j) a[j] = 0.f;
        const f32x4* xr = (const f32x4*)(h + (size_t)row * DM) + c.lane;
#pragma unroll
        for (int j = 0; j < 4; ++j) { const f32x4 v = xr[64 * j]; const int k0 = 4 * c.lane + 256 * j;
#pragma unroll
            for (int e = 0; e < 4; ++e) { const f32x4 w0 = *(const LAS f32x4*)(wg + (k0 + e) * 8), w1 = *(const LAS f32x4*)(wg + (k0 + e) * 8 + 4);
                a[0] += v[e] * w0[0]; a[1] += v[e] * w0[1]; a[2] += v[e] * w0[2]; a[3] += v[e] * w0[3]; a[4] += v[e] * w1[0]; a[5] += v[e] * w1[1]; a[6] += v[e] * w1[2]; a[7] += v[e] * w1[3]; } }
#pragma unroll
        for (int j = 0; j < 8; ++j) a[j] = wave_sum(a[j]);
        if (c.lane == 0) { const float rs = rowss(ss, row);
            *(f32x4*)(gates + (size_t)row * 8) = (f32x4){a[0] * rs, a[1] * rs, a[2] * rs, a[3] * rs}; *(f32x4*)(gates + (size_t)row * 8 + 4) = (f32x4){a[4] * rs, a[5] * rs, a[6] * rs, a[7] * rs}; }
    }
    __syncthreads();
}

DI void osm_update(f32x16& s, float& m, float& l, f32x16 (&O)[2], bf16x8& p0, bf16x8& p1) {
    float mx = fmaxf(s[0], s[1]);
#pragma unroll
    for (int i = 2; i < 16; ++i) mx = fmaxf(mx, s[i]);
    mx = fmaxf(mx, __shfl_xor(mx, 32));
    const float mn = fmaxf(m, mx);
    if (__any(mn > m)) {
        const float al = ex2(m - mn); l *= al;
#pragma unroll
        for (int i = 0; i < 16; ++i) { O[0][i] *= al; O[1][i] *= al; }
        m = mn;
    }
    const f32x2_t mm = {m, m}; f32x2_t acc2 = {0.f, 0.f};
#pragma unroll
    for (int i = 0; i < 8; ++i) { f32x2_t v = {s[2 * i], s[2 * i + 1]}; v = v - mm; v.x = ex2(v.x); v.y = ex2(v.y); acc2 = acc2 + v; s[2 * i] = v.x; s[2 * i + 1] = v.y; }
    l += acc2.x + acc2.y;
    p0 = pack8(s[0], s[1], s[2], s[3], s[4], s[5], s[6], s[7]);
    p1 = pack8(s[8], s[9], s[10], s[11], s[12], s[13], s[14], s[15]);
}

constexpr int DK_KP = 144, DK_VP = 136;
constexpr int DF_KOFF = 0, DF_VOFF = 2 * 64 * DK_KP, DF_TOFF = DF_VOFF + 2 * 64 * DK_VP;
DI void diff_attn_task(const Params& p, const Ctx& c, int l, int b, int h, int qb) {
    const int tid = c.tid, lane = c.lane, wid = c.wid, r32 = lane & 31, hi = lane >> 5;
    const bf16_t* z = wsb(c, OFF_Z);
    const size_t rowbase = (size_t)b * SEQ;
    LAS unsigned char* lds = c.lds;
    LAS float* tbl = (LAS float*)(lds + DF_TOFF);
    __syncthreads();
    { const float* src = wsf(c, OFF_DIFFB) + h * 4096; for (int i = tid; i < 4096; i += 512) tbl[i] = src[i]; }
    const int qw0 = qb * 256 + wid * 32, qpos = qw0 + r32;
    bf16x8 qf[4];
    { const bf16_t* qp = z + (rowbase + qpos) * ZW + ZQD + h * 64;
#pragma unroll
      for (int s = 0; s < 4; ++s) qf[s] = *(const bf16x8*)(qp + 16 * s + 8 * hi); }
    f32x16 O1[2], O2[2];
#pragma unroll
    for (int i = 0; i < 16; ++i) { O1[0][i] = 0.f; O1[1][i] = 0.f; O2[0][i] = 0.f; O2[1][i] = 0.f; }
    float m1 = NEGBIG, m2 = NEGBIG, l1 = 0.f, l2 = 0.f;
    const int NT = (qb + 1) * 4;
    const int skey = tid >> 3, schunk = tid & 7;
    const bf16_t* kbase = z + (rowbase + skey) * ZW + ZKD + h * 64 + schunk * 8;
    const bf16_t* vbase = z + (rowbase + skey) * ZW + ZVD + h * 64 + schunk * 8;
    u32x4 kreg = *(const u32x4*)kbase, vreg = *(const u32x4*)vbase;
#define DF_WRITE(buf) do { *(LAS u32x4*)(lds + DF_KOFF + (buf) * 64 * DK_KP + skey * DK_KP + schunk * 16) = kreg; \
        LAS bf16_t* vt_ = (LAS bf16_t*)(lds + DF_VOFF + (buf) * 64 * DK_VP + skey * 2); \
        vt_[(schunk * 8 + 0) * (DK_VP / 2)] = (bf16_t)(vreg.x & 0xffff); vt_[(schunk * 8 + 1) * (DK_VP / 2)] = (bf16_t)(vreg.x >> 16); \
        vt_[(schunk * 8 + 2) * (DK_VP / 2)] = (bf16_t)(vreg.y & 0xffff); vt_[(schunk * 8 + 3) * (DK_VP / 2)] = (bf16_t)(vreg.y >> 16); \
        vt_[(schunk * 8 + 4) * (DK_VP / 2)] = (bf16_t)(vreg.z & 0xffff); vt_[(schunk * 8 + 5) * (DK_VP / 2)] = (bf16_t)(vreg.z >> 16); \
        vt_[(schunk * 8 + 6) * (DK_VP / 2)] = (bf16_t)(vreg.w & 0xffff); vt_[(schunk * 8 + 7) * (DK_VP / 2)] = (bf16_t)(vreg.w >> 16); } while (0)
    DF_WRITE(0);
    __syncthreads();
    for (int t = 0; t < NT; ++t) {
        const int buf = t & 1;
        if (t + 1 < NT) { kreg = *(const u32x4*)(kbase + (size_t)(t + 1) * 64 * ZW); vreg = *(const u32x4*)(vbase + (size_t)(t + 1) * 64 * ZW); }
        if (64 * t <= qw0 + 31) {
            const LAS unsigned char* kimg = lds + DF_KOFF + buf * 64 * DK_KP;
            const LAS unsigned char* vimg = lds + DF_VOFF + buf * 64 * DK_VP;
#pragma unroll
            for (int sub = 0; sub < 2; ++sub) {
                const int key0 = 64 * t + 32 * sub;
                if (key0 <= qw0 + 31) {
                    const LAS unsigned char* kr = kimg + (32 * sub + r32) * DK_KP + hi * 16;
                    const bf16x8 k0 = *(const LAS bf16x8*)(kr), k1 = *(const LAS bf16x8*)(kr + 32), k2 = *(const LAS bf16x8*)(kr + 64), k3 = *(const LAS bf16x8*)(kr + 96);
                    f32x16 s1, s2, bv;
                    const int dbase = qpos - key0 - 4 * hi;
                    if (key0 + 31 > qw0) {
#pragma unroll
                        for (int i = 0; i < 16; ++i) { const int d = dbase - ((i & 3) + 8 * (i >> 2)); const float bi = tbl[d < 0 ? 0 : d]; bv[i] = d < 0 ? NEGBIG : bi; }
                    } else {
#pragma unroll
                        for (int i = 0; i < 16; ++i) bv[i] = tbl[dbase - ((i & 3) + 8 * (i >> 2))];
                    }
                    s1 = MFMA32(k0, qf[0], bv); s1 = MFMA32(k1, qf[1], s1);
                    s2 = MFMA32(k2, qf[2], bv); s2 = MFMA32(k3, qf[3], s2);
                    bf16x8 pa0, pa1, pb0, pb1;
                    osm_update(s1, m1, l1, O1, pa0, pa1);
                    osm_update(s2, m2, l2, O2, pb0, pb1);
#pragma unroll
                    for (int dvt = 0; dvt < 2; ++dvt) {
                        const LAS unsigned char* vr = vimg + (32 * dvt + r32) * DK_VP + (32 * sub + 4 * hi) * 2;
                        const bf16x8 v0 = mk8(*(const LAS u32x2*)(vr), *(const LAS u32x2*)(vr + 16));
                        const bf16x8 v1 = mk8(*(const LAS u32x2*)(vr + 32), *(const LAS u32x2*)(vr + 48));
                        O1[dvt] = MFMA32(v0, pa0, O1[dvt]); O1[dvt] = MFMA32(v1, pa1, O1[dvt]);
                        O2[dvt] = MFMA32(v0, pb0, O2[dvt]); O2[dvt] = MFMA32(v1, pb1, O2[dvt]);
                    }
                }
            }
        }
        if (t + 1 < NT) DF_WRITE(buf ^ 1);
        __syncthreads();
    }
#undef DF_WRITE
    l1 += __shfl_xor(l1, 32); l2 += __shfl_xor(l2, 32);
    const float lam = wsf(c, OFF_LAM)[l];
    const float lam_init = 0.8f - 0.6f * expf(-0.3f * (float)l);
    const float i1 = 1.f / l1, i2 = lam / l2;
    float ssq = 0.f;
#pragma unroll
    for (int dvt = 0; dvt < 2; ++dvt)
#pragma unroll
        for (int i = 0; i < 16; ++i) { const float o = O1[dvt][i] * i1 - O2[dvt][i] * i2; O1[dvt][i] = o; ssq += o * o; }
    ssq += __shfl_xor(ssq, 32);
    const float rn = rsqrtf(ssq * (1.f / 64.f) + 1e-5f) * (1.f - lam_init);
    const float* sg = p.in[I_SUBLN] + l * 64;
    bf16_t* yrow = wsb(c, OFF_Y) + (rowbase + qpos) * DM + 768 + h * 64;
#pragma unroll
    for (int dvt = 0; dvt < 2; ++dvt)
#pragma unroll
        for (int g = 0; g < 4; ++g) {
            const int dv = 32 * dvt + 8 * g + 4 * hi; const f32x4 gg = *(const f32x4*)(sg + dv);
            u32x2 w; w.x = cvtpk(O1[dvt][4 * g] * rn * gg[0], O1[dvt][4 * g + 1] * rn * gg[1]); w.y = cvtpk(O1[dvt][4 * g + 2] * rn * gg[2], O1[dvt][4 * g + 3] * rn * gg[3]);
            *(u32x2*)(yrow + dv) = w;
        }
}

constexpr int DL_NK = 384, DL_KP = 144, DL_VP = 776;
constexpr int DL_KOFF = 0, DL_VOFF = DL_NK * DL_KP, DL_TOFF = DL_VOFF + 64 * DL_VP;
DI void dil_attn_task(const Params& p, const Ctx& c, int pat, int b, int h, int res, int mb) {
    const int dil = pat == 0 ? 1 : (pat == 1 ? 4 : 16);
    const int tid = c.tid, lane = c.lane, wid = c.wid, r32 = lane & 31, hi = lane >> 5;
    const bf16_t* z = wsb(c, OFF_Z);
    const size_t rowbase = (size_t)b * SEQ;
    LAS unsigned char* lds = c.lds;
    LAS float* tbl = (LAS float*)(lds + DL_TOFF);
    __syncthreads();
    if (tid < 132) tbl[tid] = wsf(c, OFF_DILB)[(pat * 4 + h) * 132 + tid];
    const int mk0 = 256 * mb - 128;
    {
        u32x4 kreg[6], vreg[6];
#pragma unroll
        for (int it = 0; it < 6; ++it) {
            const int idx = tid + 512 * it, key = idx >> 3, chunk = idx & 7, mk = mk0 + key;
            kreg[it] = (u32x4){0u, 0u, 0u, 0u}; vreg[it] = (u32x4){0u, 0u, 0u, 0u};
            if (mk >= 0) { const bf16_t* rp = z + (rowbase + (size_t)mk * dil + res) * ZW + h * 64 + chunk * 8; kreg[it] = *(const u32x4*)(rp + ZKC); vreg[it] = *(const u32x4*)(rp + ZVC); }
        }
#pragma unroll
        for (int it = 0; it < 6; ++it) {
            const int idx = tid + 512 * it, key = idx >> 3, chunk = idx & 7;
            *(LAS u32x4*)(lds + DL_KOFF + key * DL_KP + chunk * 16) = kreg[it];
            LAS bf16_t* vt_ = (LAS bf16_t*)(lds + DL_VOFF + key * 2);
            vt_[(chunk * 8 + 0) * (DL_VP / 2)] = (bf16_t)(vreg[it].x & 0xffff); vt_[(chunk * 8 + 1) * (DL_VP / 2)] = (bf16_t)(vreg[it].x >> 16);
            vt_[(chunk * 8 + 2) * (DL_VP / 2)] = (bf16_t)(vreg[it].y & 0xffff); vt_[(chunk * 8 + 3) * (DL_VP / 2)] = (bf16_t)(vreg[it].y >> 16);
            vt_[(chunk * 8 + 4) * (DL_VP / 2)] = (bf16_t)(vreg[it].z & 0xffff); vt_[(chunk * 8 + 5) * (DL_VP / 2)] = (bf16_t)(vreg[it].z >> 16);
            vt_[(chunk * 8 + 6) * (DL_VP / 2)] = (bf16_t)(vreg[it].w & 0xffff); vt_[(chunk * 8 + 7) * (DL_VP / 2)] = (bf16_t)(vreg[it].w >> 16);
        }
    }
    const int mq = 256 * mb + 32 * wid + r32;
    const size_t qtok = rowbase + (size_t)mq * dil + res;
    bf16x8 qf[4];
    { const bf16_t* qp = z + qtok * ZW + ZQC + h * 64;
#pragma unroll
      for (int s = 0; s < 4; ++s) qf[s] = *(const bf16x8*)(qp + 16 * s + 8 * hi); }
    __syncthreads();
    f32x16 O[2];
#pragma unroll
    for (int i = 0; i < 16; ++i) { O[0][i] = 0.f; O[1][i] = 0.f; }
    float m = NEGBIG, lsum = 0.f;
    for (int j = 0; j < 5; ++j) {
        const int kt = wid + j;
        const LAS unsigned char* kr = lds + DL_KOFF + (32 * kt + r32) * DL_KP + hi * 16;
        f32x16 s;
        const int dbase = 128 - 32 * j + r32 - 4 * hi;
        const int mkb = mk0 + 32 * kt + 4 * hi;
        if (j == 0 || j == 4 || mb == 0) {
#pragma unroll
            for (int i = 0; i < 16; ++i) { const int cc = (i & 3) + 8 * (i >> 2); const int dl = dbase - cc; const bool ok = (dl >= 0) && (dl <= 128) && (mkb + cc >= 0);
                const int dc = dl < 0 ? 0 : (dl > 128 ? 128 : dl); s[i] = ok ? tbl[dc] : NEGBIG; }
        } else {
#pragma unroll
            for (int i = 0; i < 16; ++i) s[i] = tbl[dbase - ((i & 3) + 8 * (i >> 2))];
        }
#pragma unroll
        for (int ks = 0; ks < 4; ++ks) s = MFMA32(*(const LAS bf16x8*)(kr + 32 * ks), qf[ks], s);
        bf16x8 p0, p1;
        osm_update(s, m, lsum, O, p0, p1);
#pragma unroll
        for (int dvt = 0; dvt < 2; ++dvt) {
            const LAS unsigned char* vr = lds + DL_VOFF + (32 * dvt + r32) * DL_VP + (32 * kt + 4 * hi) * 2;
            const bf16x8 v0 = mk8(*(const LAS u32x2*)(vr), *(const LAS u32x2*)(vr + 16));
            const bf16x8 v1 = mk8(*(const LAS u32x2*)(vr + 32), *(const LAS u32x2*)(vr + 48));
            O[dvt] = MFMA32(v0, p0, O[dvt]); O[dvt] = MFMA32(v1, p1, O[dvt]);
        }
    }
    lsum += __shfl_xor(lsum, 32);
    const float inv = 1.f / lsum, lse = m + log2f(lsum);
    if (pat != 0) {
        bf16_t* orow = ((bf16_t*)((unsigned char*)c.out + (size_t)64 * 64 * 4096 * 4)) + ((size_t)(pat - 1) * MTOK + qtok) * 256 + h * 64;
#pragma unroll
        for (int dvt = 0; dvt < 2; ++dvt)
#pragma unroll
            for (int g = 0; g < 4; ++g) { u32x2 w; w.x = cvtpk(O[dvt][4 * g] * inv, O[dvt][4 * g + 1] * inv); w.y = cvtpk(O[dvt][4 * g + 2] * inv, O[dvt][4 * g + 3] * inv);
                *(u32x2*)(orow + 32 * dvt + 8 * g + 4 * hi) = w; }
        if (hi == 0) wsf(c, OFF_LSEP)[((size_t)(pat - 1) * MTOK + qtok) * 4 + h] = lse;
    } else {
        const float ls1 = wsf(c, OFF_LSEP)[qtok * 4 + h], ls2 = wsf(c, OFF_LSEP)[((size_t)MTOK + qtok) * 4 + h];
        const float mm = fmaxf(lse, fmaxf(ls1, ls2));
        const float w0 = ex2(lse - mm), w1 = ex2(ls1 - mm), w2 = ex2(ls2 - mm), wi = 1.f / (w0 + w1 + w2);
        const float a0 = w0 * wi * inv, a1 = w1 * wi, a2 = w2 * wi;
        const bf16_t* o1 = ((bf16_t*)((unsigned char*)c.out + (size_t)64 * 64 * 4096 * 4)) + qtok * 256 + h * 64; const bf16_t* o2 = o1 + (size_t)MTOK * 256;
        bf16_t* yrow = wsb(c, OFF_Y) + qtok * DM + 512 + h * 64;
#pragma unroll
        for (int dvt = 0; dvt < 2; ++dvt)
#pragma unroll
            for (int g = 0; g < 4; ++g) { const int dv = 32 * dvt + 8 * g + 4 * hi; const u32x2 x1 = *(const u32x2*)(o1 + dv), x2 = *(const u32x2*)(o2 + dv);
                const float r0 = O[dvt][4 * g] * a0 + bflo(x1.x) * a1 + bflo(x2.x) * a2, r1 = O[dvt][4 * g + 1] * a0 + bfhi(x1.x) * a1 + bfhi(x2.x) * a2;
                const float r2 = O[dvt][4 * g + 2] * a0 + bflo(x1.y) * a1 + bflo(x2.y) * a2, r3 = O[dvt][4 * g + 3] * a0 + bfhi(x1.y) * a1 + bfhi(x2.y) * a2;
                u32x2 w; w.x = cvtpk(r0, r1); w.y = cvtpk(r2, r3); *(u32x2*)(yrow + dv) = w; }
    }
}

DI void pool_x(const bf16_t* bp0, int w, int cnt, float icnt, bf16x8 (&xf)[4]) {
    float sum[4][8]; u32x4 cur[4];
#pragma unroll
    for (int ks = 0; ks < 4; ++ks) {
        const bf16_t* bp = bp0 + 16 * ks;
        cur[ks] = *(const u32x4*)bp; const u32x4 prv = (cnt > 1) ? *(const u32x4*)(bp - ZW) : (u32x4){0u, 0u, 0u, 0u};
        sum[ks][0] = bflo(cur[ks].x) + bflo(prv.x); sum[ks][1] = bfhi(cur[ks].x) + bfhi(prv.x); sum[ks][2] = bflo(cur[ks].y) + bflo(prv.y); sum[ks][3] = bfhi(cur[ks].y) + bfhi(prv.y);
        sum[ks][4] = bflo(cur[ks].z) + bflo(prv.z); sum[ks][5] = bfhi(cur[ks].z) + bfhi(prv.z); sum[ks][6] = bflo(cur[ks].w) + bflo(prv.w); sum[ks][7] = bfhi(cur[ks].w) + bfhi(prv.w);
    }
#pragma unroll 1
    for (int j0 = 2; j0 < w; j0 += 2) {
        u32x4 v0[4], v1[4];
#pragma unroll
        for (int ks = 0; ks < 4; ++ks) { v0[ks] = (u32x4){0u, 0u, 0u, 0u}; v1[ks] = (u32x4){0u, 0u, 0u, 0u};
            if (j0 < cnt) v0[ks] = *(const u32x4*)(bp0 + 16 * ks - (size_t)j0 * ZW);
            if (j0 + 1 < cnt) v1[ks] = *(const u32x4*)(bp0 + 16 * ks - (size_t)(j0 + 1) * ZW); }
#pragma unroll
        for (int ks = 0; ks < 4; ++ks) {
            sum[ks][0] += bflo(v0[ks].x) + bflo(v1[ks].x); sum[ks][1] += bfhi(v0[ks].x) + bfhi(v1[ks].x); sum[ks][2] += bflo(v0[ks].y) + bflo(v1[ks].y); sum[ks][3] += bfhi(v0[ks].y) + bfhi(v1[ks].y);
            sum[ks][4] += bflo(v0[ks].z) + bflo(v1[ks].z); sum[ks][5] += bfhi(v0[ks].z) + bfhi(v1[ks].z); sum[ks][6] += bflo(v0[ks].w) + bflo(v1[ks].w); sum[ks][7] += bfhi(v0[ks].w) + bfhi(v1[ks].w); }
    }
#pragma unroll
    for (int ks = 0; ks < 4; ++ks)
        xf[ks] = pack8(sum[ks][0] * icnt - bflo(cur[ks].x), sum[ks][1] * icnt - bfhi(cur[ks].x), sum[ks][2] * icnt - bflo(cur[ks].y), sum[ks][3] * icnt - bfhi(cur[ks].y),
                       sum[ks][4] * icnt - bflo(cur[ks].z), sum[ks][5] * icnt - bfhi(cur[ks].z), sum[ks][6] * icnt - bflo(cur[ks].w), sum[ks][7] * icnt - bfhi(cur[ks].w));
}
DI void pool_task(const Params& p, const Ctx& c, int l, int wt) {
    const int lane = c.lane, r32 = lane & 31, hi = lane >> 5;
    const int g = (wt + (wt >> 11)) & 3, rt = wt >> 2;
    const size_t row = (size_t)rt * 32 + r32; const int t = (int)(row & (SEQ - 1));
    const int w = 2 << g, cnt = (t + 1 < w) ? t + 1 : w; const float icnt = 1.f / (float)cnt;
    const bf16_t* z = wsb(c, OFF_Z);
    bf16x8 xf[4];
    const bf16_t* bp0 = z + row * ZW + ZPB + g * 64 + 8 * hi;
    pool_x(bp0, w, cnt, icnt, xf);
    const float* pw = p.in[I_POOLW] + ((size_t)l * 4 + g) * 64 * 64;
    const float* psc = p.in[I_POOLS] + l * 256 + g * 64;
    bf16_t* yrow = wsb(c, OFF_Y) + row * DM + 256 + g * 64;
#pragma unroll
    for (int dt = 0; dt < 2; ++dt) {
        f32x16 acc;
#pragma unroll
        for (int i = 0; i < 16; ++i) acc[i] = 0.f;
#pragma unroll
        for (int ks = 0; ks < 4; ++ks) {
            const float* wp = pw + (size_t)(16 * ks + 8 * hi) * 64 + 32 * dt + r32;
            const bf16x8 wf = pack8(wp[0], wp[64], wp[128], wp[192], wp[256], wp[320], wp[384], wp[448]);
            acc = MFMA32(wf, xf[ks], acc);
        }
#pragma unroll
        for (int gq = 0; gq < 4; ++gq) { const int dd = 32 * dt + 8 * gq + 4 * hi; const f32x4 sc = *(const f32x4*)(psc + dd);
            u32x2 wv; wv.x = cvtpk(acc[4 * gq] * sc[0], acc[4 * gq + 1] * sc[1]); wv.y = cvtpk(acc[4 * gq + 2] * sc[2], acc[4 * gq + 3] * sc[3]); *(u32x2*)(yrow + dd) = wv; }
    }
}

DI float scan_add(float v, int lane) {
#pragma unroll
    for (int o = 1; o < 64; o <<= 1) { const float n = __shfl_up(v, o); if (lane >= o) v += n; }
    return v;
}
DI float scan_max(float v, int lane) {
#pragma unroll
    for (int o = 1; o < 64; o <<= 1) { const float n = __shfl_up(v, o); if (lane >= o) v = fmaxf(v, n); }
    return v;
}
DI float log_sigmoid(float x) { return fminf(x, 0.f) - log1pf(expf(-fabsf(x))); }
DI void conv8(const bf16_t* zp, int t, const float* cw, const float* cb, float scale, float (&o)[8]) {
    const f32x4 b0 = *(const f32x4*)cb, b1 = *(const f32x4*)(cb + 4);
    o[0] = b0[0]; o[1] = b0[1]; o[2] = b0[2]; o[3] = b0[3]; o[4] = b1[0]; o[5] = b1[1]; o[6] = b1[2]; o[7] = b1[3];
#pragma unroll
    for (int tap = 0; tap < 4; ++tap) {
        if (t - 3 + tap >= 0) {
            const u32x4 v = *(const u32x4*)(zp - (size_t)(3 - tap) * ZW);
            const f32x4 w0 = *(const f32x4*)(cw + tap * 512), w1 = *(const f32x4*)(cw + tap * 512 + 4);
            o[0] += bflo(v.x) * w0[0]; o[1] += bfhi(v.x) * w0[1]; o[2] += bflo(v.y) * w0[2]; o[3] += bfhi(v.y) * w0[3];
            o[4] += bflo(v.z) * w1[0]; o[5] += bfhi(v.z) * w1[1]; o[6] += bflo(v.w) * w1[2]; o[7] += bfhi(v.w) * w1[3];
        }
    }
#pragma unroll
    for (int e = 0; e < 8; ++e) o[e] = silu_f(o[e]) * scale;
    asm volatile("" ::: "memory");
}
DI void conv_frag4(const bf16_t* zp, int t, const LAS float* cw, const LAS float* cb, int hi, float scale, bf16x8 (&out)[4]) {
    asm volatile("" ::: "memory");
#pragma unroll
    for (int kh = 0; kh < 2; ++kh) {
        u32x4 v[2][4];
#pragma unroll
        for (int k2 = 0; k2 < 2; ++k2)
#pragma unroll
            for (int tap = 0; tap < 4; ++tap) { v[k2][tap] = (u32x4){0u, 0u, 0u, 0u}; if (t - 3 + tap >= 0) v[k2][tap] = *(const u32x4*)(zp + 16 * (2 * kh + k2) - (size_t)(3 - tap) * ZW); }
#pragma unroll
        for (int k2 = 0; k2 < 2; ++k2) {
            const int ks = 2 * kh + k2, d0 = 16 * ks + 8 * hi;
            const f32x4 b0 = *(const LAS f32x4*)(cb + d0), b1 = *(const LAS f32x4*)(cb + d0 + 4);
            float o[8] = {b0[0], b0[1], b0[2], b0[3], b1[0], b1[1], b1[2], b1[3]};
#pragma unroll
            for (int tap = 0; tap < 4; ++tap) {
                const f32x4 w0 = *(const LAS f32x4*)(cw + tap * 64 + d0), w1 = *(const LAS f32x4*)(cw + tap * 64 + d0 + 4); const u32x4 x = v[k2][tap];
                o[0] += bflo(x.x) * w0[0]; o[1] += bfhi(x.x) * w0[1]; o[2] += bflo(x.y) * w0[2]; o[3] += bfhi(x.y) * w0[3];
                o[4] += bflo(x.z) * w1[0]; o[5] += bfhi(x.z) * w1[1]; o[6] += bflo(x.w) * w1[2]; o[7] += bfhi(x.w) * w1[3];
            }
            out[ks] = pack8(silu_f(o[0]) * scale, silu_f(o[1]) * scale, silu_f(o[2]) * scale, silu_f(o[3]) * scale, silu_f(o[4]) * scale, silu_f(o[5]) * scale, silu_f(o[6]) * scale, silu_f(o[7]) * scale);
        }
        asm volatile("" ::: "memory");
    }
}
DI void mlstm_a_task(const Params& p, const Ctx& c, int l, int task) {
    const int lane = c.lane, r32 = lane & 31, hi = lane >> 5;
    const int bh = task >> 6, ch = task & 63, b = bh >> 2, h = bh & 3, t0 = ch * 64;
    const size_t rowbase = (size_t)b * SEQ;
    const bf16_t* z = wsb(c, OFF_Z);
    const float* gates = wsf(c, OFF_GATES) + (rowbase + t0 + lane) * 8;
    const float* gb = p.in[I_GATEB] + l * 8;
    const float ig = gates[h] + gb[h], lf = log_sigmoid(gates[4 + h] + gb[4 + h]);
    const float bcs = scan_add(lf, lane);
    const float gp = ig - bcs;
    const float mu = wave_max(gp);
    const float ws_ = expf(gp - mu);
    const float Bc = __shfl(bcs, 63);
    if (lane == 0) { wsf(c, OFF_SCAL)[task] = Bc; wsf(c, OFF_SCAL)[4096 + task] = mu; }
    const float* cwl = p.in[I_CONVW] + (size_t)l * 4 * 512; const float* cbl = p.in[I_CONVB] + l * 512;
    f32x16 acc[2][2];
#pragma unroll
    for (int a = 0; a < 2; ++a)
#pragma unroll
        for (int bb = 0; bb < 2; ++bb)
#pragma unroll
            for (int i = 0; i < 16; ++i) acc[a][bb][i] = 0.f;
    float nsum[2] = {0.f, 0.f};
#pragma unroll
    for (int ks = 0; ks < 4; ++ks) {
        const int s0 = 16 * ks + 8 * hi;
        float wv[8];
#pragma unroll
        for (int j = 0; j < 8; ++j) wv[j] = __shfl(ws_, s0 + j);
        bf16x8 kf[2];
#pragma unroll
        for (int it = 0; it < 2; ++it) {
            const int chn = 256 + h * 64 + 32 * it + r32;
            const float w0 = cwl[chn], w1 = cwl[512 + chn], w2 = cwl[1024 + chn], w3 = cwl[1536 + chn], cb = cbl[chn];
            const bf16_t* kp = z + (rowbase + t0 + s0) * ZW + ZKA + h * 64 + 32 * it + r32;
            float raw[11];
#pragma unroll
            for (int x = 0; x < 11; ++x) raw[x] = (t0 + s0 - 3 + x >= 0) ? bf2f(kp[(long)(x - 3) * ZW]) : 0.f;
            float kk[8];
#pragma unroll
            for (int j = 0; j < 8; ++j) { const float o = cb + w0 * raw[j] + w1 * raw[j + 1] + w2 * raw[j + 2] + w3 * raw[j + 3]; kk[j] = silu_f(o) * 0.125f * wv[j]; nsum[it] += kk[j]; }
            kf[it] = pack8(kk[0], kk[1], kk[2], kk[3], kk[4], kk[5], kk[6], kk[7]);
        }
#pragma unroll
        for (int et = 0; et < 2; ++et) {
            const bf16_t* vp = z + (rowbase + t0 + s0) * ZW + ZVA + h * 64 + 32 * et + r32;
            u32x4 w; w.x = (unsigned)vp[0] | ((unsigned)vp[ZW] << 16); w.y = (unsigned)vp[2 * ZW] | ((unsigned)vp[3 * ZW] << 16);
            w.z = (unsigned)vp[4 * ZW] | ((unsigned)vp[5 * ZW] << 16); w.w = (unsigned)vp[6 * ZW] | ((unsigned)vp[7 * ZW] << 16);
            const bf16x8 vf = __builtin_bit_cast(bf16x8, w);
            acc[et][0] = MFMA32(vf, kf[0], acc[et][0]); acc[et][1] = MFMA32(vf, kf[1], acc[et][1]);
        }
    }
    float* D = ((float*)c.out) + (size_t)task * 4096;
#pragma unroll
    for (int et = 0; et < 2; ++et)
#pragma unroll
        for (int it = 0; it < 2; ++it)
#pragma unroll
            for (int i = 0; i < 16; ++i) D[(32 * et + crow(i, hi)) * 64 + 32 * it + r32] = acc[et][it][i];
    nsum[0] += __shfl_xor(nsum[0], 32); nsum[1] += __shfl_xor(nsum[1], 32);
    if (hi == 0) { wsf(c, OFF_NST)[(size_t)task * 64 + r32] = nsum[0]; wsf(c, OFF_NST)[(size_t)task * 64 + 32 + r32] = nsum[1]; }
}
DI void mlstm_scan(const Params& p, const Ctx& c) {
    const float* Bc = wsf(c, OFF_SCAL); const float* mu = Bc + 4096; float* mprev = wsf(c, OFF_SCAL) + 8192;
    float* D = ((float*)c.out); float* N = wsf(c, OFF_NST);
    LAS float* cwl = (LAS float*)c.lds; LAS float* swl = cwl + 64;
    for (int task = c.bid; task < 256; task += c.G) {
        const int bh = task >> 2, q = task & 3;
        __syncthreads();
        if (c.wid == 0) {
            const float B = Bc[bh * 64 + c.lane], u = mu[bh * 64 + c.lane];
            float m = 0.f, mycw = 0.f, mysw = 0.f, mymp = 0.f;
            for (int ch = 0; ch < 64; ++ch) {
                const float Bs = __shfl(B, ch), us = __shfl(u, ch);
                const float mnew = fmaxf(Bs + m, Bs + us);
                const float cw = expf(Bs + m - mnew), sw = expf(Bs + us - mnew);
                if (c.lane == ch) { mycw = cw; mysw = sw; mymp = m; }
                m = mnew;
            }
            cwl[c.lane] = mycw; swl[c.lane] = mysw;
            if (q == 0) mprev[bh * 64 + c.lane] = mymp;
        }
        __syncthreads();
        for (int idx = q * 1040 + c.tid; idx < (q + 1) * 1040; idx += 512) {
            float* base = idx < 4096 ? D + (size_t)bh * 64 * 4096 + idx : N + (size_t)bh * 64 * 64 + (idx - 4096);
            const size_t stride = idx < 4096 ? 4096 : 64;
            float d[64];
#pragma unroll
            for (int ch = 0; ch < 64; ++ch) d[ch] = base[(size_t)ch * stride];
            float C = 0.f;
#pragma unroll
            for (int ch = 0; ch < 64; ++ch) { const float dv = d[ch]; base[(size_t)ch * stride] = C; C = cwl[ch] * C + swl[ch] * dv; }
        }
    }
}
DI void mlstm_c_task(const Params& p, const Ctx& c, int l, int task) {
    const int lane = c.lane, r32 = lane & 31, hi = lane >> 5;
    const int bh = task >> 6, ch = task & 63, b = bh >> 2, h = bh & 3, t0 = ch * 64;
    const size_t rowbase = (size_t)b * SEQ;
    const bf16_t* z = wsb(c, OFF_Z);
    const float* gates = wsf(c, OFF_GATES) + (rowbase + t0 + lane) * 8;
    const float* gb = p.in[I_GATEB] + l * 8;
    const float ig = gates[h] + gb[h], lf = log_sigmoid(gates[4 + h] + gb[4 + h]);
    const float bcs = scan_add(lf, lane);
    const float gp = ig - bcs;
    const float mp = wsf(c, OFF_SCAL)[8192 + task];
    const float pm = scan_max(gp, lane);
    const float mt = bcs + fmaxf(mp, pm);
    const float bm = bcs - mt;
    const float iw = expf(bcs + mp - mt);
    const float flo = expf(-mt);
    const float* cwl = p.in[I_CONVW] + (size_t)l * 4 * 512; const float* cbl = p.in[I_CONVB] + l * 512;
    const float* Ct = ((float*)c.out) + (size_t)task * 4096;
    const float* nst = wsf(c, OFF_NST) + (size_t)task * 64;
    const float* ng = p.in[I_MLN] + l * 256 + h * 64;
#pragma unroll 1
    for (int tt = 0; tt < 2; ++tt) {
        const int tq = 32 * tt + r32;
        const float bm_t = __shfl(bm, tq), iw_t = __shfl(iw, tq), flo_t = __shfl(flo, tq);
        bf16x8 qf[4]; float qn = 0.f;
#pragma unroll
        for (int ks = 0; ks < 4; ++ks) { float o[8]; const int d0 = 16 * ks + 8 * hi;
            conv8(z + (rowbase + t0 + tq) * ZW + ZQA + h * 64 + d0, t0 + tq, cwl + h * 64 + d0, cbl + h * 64 + d0, 1.f, o);
            qf[ks] = pack8(o[0], o[1], o[2], o[3], o[4], o[5], o[6], o[7]);
            const u32x4 qw = __builtin_bit_cast(u32x4, qf[ks]);
            const f32x4 n0 = *(const f32x4*)(nst + d0), n1 = *(const f32x4*)(nst + d0 + 4);
            qn += bflo(qw.x) * n0[0] + bfhi(qw.x) * n0[1] + bflo(qw.y) * n0[2] + bfhi(qw.y) * n0[3] + bflo(qw.z) * n1[0] + bfhi(qw.z) * n1[1] + bflo(qw.w) * n1[2] + bfhi(qw.w) * n1[3]; }
        qn += __shfl_xor(qn, 32);
        f32x16 num[2];
#pragma unroll
        for (int i = 0; i < 16; ++i) { num[0][i] = 0.f; num[1][i] = 0.f; }
#pragma unroll
        for (int et = 0; et < 2; ++et)
#pragma unroll
            for (int ks = 0; ks < 4; ++ks) { const float* cp = Ct + (size_t)(32 * et + r32) * 64 + 16 * ks + 8 * hi; const f32x4 c0 = *(const f32x4*)cp, c1 = *(const f32x4*)(cp + 4);
                num[et] = MFMA32(pack8(c0[0], c0[1], c0[2], c0[3], c1[0], c1[1], c1[2], c1[3]), qf[ks], num[et]); }
#pragma unroll
        for (int i = 0; i < 16; ++i) { num[0][i] *= iw_t; num[1][i] *= iw_t; }
        float dsum = 0.f;
#pragma unroll 1
        for (int st = 0; st <= tt; ++st) {
            f32x16 s;
#pragma unroll
            for (int i = 0; i < 16; ++i) s[i] = 0.f;
#pragma unroll
            for (int ks = 0; ks < 4; ++ks) { float o[8]; const int sk = 32 * st + r32, d0 = 16 * ks + 8 * hi;
                conv8(z + (rowbase + t0 + sk) * ZW + ZKA + h * 64 + d0, t0 + sk, cwl + 256 + h * 64 + d0, cbl + 256 + h * 64 + d0, 0.125f, o);
                s = MFMA32(pack8(o[0], o[1], o[2], o[3], o[4], o[5], o[6], o[7]), qf[ks], s); }
#pragma unroll
            for (int i = 0; i < 16; ++i) { const int sp = 32 * st + crow(i, hi); const float gs = __shfl(gp, sp);
                const float wgt = (sp <= tq) ? expf(gs + bm_t) : 0.f; s[i] *= wgt; dsum += s[i]; }
            const bf16x8 p0 = pack8(s[0], s[1], s[2], s[3], s[4], s[5], s[6], s[7]), p1 = pack8(s[8], s[9], s[10], s[11], s[12], s[13], s[14], s[15]);
#pragma unroll
            for (int et = 0; et < 2; ++et)
#pragma unroll
                for (int k2 = 0; k2 < 2; ++k2) {
                    const bf16_t* vp = z + (rowbase + t0 + 32 * st + 16 * k2 + 4 * hi) * ZW + ZVA + h * 64 + 32 * et + r32;
                    u32x4 w; w.x = (unsigned)vp[0] | ((unsigned)vp[ZW] << 16); w.y = (unsigned)vp[2 * ZW] | ((unsigned)vp[3 * ZW] << 16);
                    w.z = (unsigned)vp[8 * ZW] | ((unsigned)vp[9 * ZW] << 16); w.w = (unsigned)vp[10 * ZW] | ((unsigned)vp[11 * ZW] << 16);
                    num[et] = MFMA32(__builtin_bit_cast(bf16x8, w), k2 == 0 ? p0 : p1, num[et]);
                }
        }
        dsum += __shfl_xor(dsum, 32);
        const float den = iw_t * qn + dsum;
        const float idn = 1.f / fmaxf(fabsf(den), flo_t);
        float sm = 0.f;
#pragma unroll
        for (int et = 0; et < 2; ++et)
#pragma unroll
            for (int i = 0; i < 16; ++i) { const float hv = num[et][i] * idn; num[et][i] = hv; sm += hv; }
        sm += __shfl_xor(sm, 32);
        const float mean = sm * (1.f / 64.f);
        float vs = 0.f;
#pragma unroll
        for (int et = 0; et < 2; ++et)
#pragma unroll
            for (int i = 0; i < 16; ++i) { const float d = num[et][i] - mean; num[et][i] = d; vs += d * d; }
        vs += __shfl_xor(vs, 32);
        const float rstd = rsqrtf(vs * (1.f / 64.f) + 1e-6f);
        const size_t tok = rowbase + t0 + tq;
        const bf16_t* orow = z + tok * ZW + ZOA + h * 64; bf16_t* yrow = wsb(c, OFF_Y) + tok * DM + h * 64;
#pragma unroll
        for (int et = 0; et < 2; ++et)
#pragma unroll
            for (int g = 0; g < 4; ++g) { const int e = 32 * et + 8 * g + 4 * hi; const f32x4 gg = *(const f32x4*)(ng + e); const u32x2 ov = *(const u32x2*)(orow + e);
                const float y0 = num[et][4 * g] * rstd * gg[0] * sigmoid_f(bflo(ov.x)), y1 = num[et][4 * g + 1] * rstd * gg[1] * sigmoid_f(bfhi(ov.x));
                const float y2 = num[et][4 * g + 2] * rstd * gg[2] * sigmoid_f(bflo(ov.y)), y3 = num[et][4 * g + 3] * rstd * gg[3] * sigmoid_f(bfhi(ov.y));
                u32x2 w; w.x = cvtpk(y0, y1); w.y = cvtpk(y2, y3); *(u32x2*)(yrow + e) = w; }
    }
}

DI int vcu_of(const Ctx& c) { return (c.G % 8 == 0) ? (c.bid % 8) * (c.G / 8) + c.bid / 8 : c.bid; }
DI void ph_mix1(const Params& p, const Ctx& c0, int l) {
    const Ctx c = fresh(c0); const int vb = vcu_of(c);
    REP(R_DIFF) for (int pt = vb; pt < 512; pt += c.G) { const int bh = pt >> 3, s = pt & 7; diff_attn_task(p, c, l, bh >> 2, bh & 3, 15 - s); diff_attn_task(p, c, l, bh >> 2, bh & 3, s); }
    REP(R_DIL) for (int i = vb; i < 1024; i += c.G) { const int bh = i >> 4, rest = i & 15; dil_attn_task(p, c, 1, bh >> 2, bh & 3, rest >> 2, rest & 3); }
    REP(R_DIL) for (int i = vb; i < 1024; i += c.G) { const int bh = i >> 4; dil_attn_task(p, c, 2, bh >> 2, bh & 3, i & 15, 0); }
    __syncthreads();
    REP(R_POOL) for (int wt = vb * 8 + c.wid; wt < 8192; wt += c.G * 8) pool_task(p, c, l, wt);
    REP(R_MLA) for (int tk = vb * 8 + c.wid; tk < 4096; tk += c.G * 8) mlstm_a_task(p, c, l, tk);
}
DI void ph_mix2(const Params& p, const Ctx& c0, int l) {
    const Ctx c = fresh(c0); const int vb = vcu_of(c);
    mlstm_scan(p, c);
    REP(R_DIL) for (int i = vb; i < 1024; i += c.G) { const int bh = i >> 4; dil_attn_task(p, c, 0, bh >> 2, bh & 3, 0, i & 15); }
    __syncthreads();
}
DI void ph_mix3(const Params& p, const Ctx& c0, int l) {
    const Ctx c = fresh(c0); const int vb = vcu_of(c);
    REP(R_MLC) for (int tk = vb * 8 + c.wid; tk < 4096; tk += c.G * 8) mlstm_c_task(p, c, l, tk);
}
DI void ph_final(const Params& p, const Ctx& c0) {
    const Ctx c = fresh(c0);
    const float* ss = ssbuf(c, 16); const float* g = p.in[I_FINN]; const bf16_t* hb = wsb(c, OFF_HB);
    for (int row = c.bid * 8 + c.wid; row < MTOK; row += c.G * 8) {
        const float rs = rowss(ss, row);
        f32x4* xr = (f32x4*)(c.out + (size_t)row * DM) + c.lane; const f32x4* gr = (const f32x4*)g + c.lane; const u32x2* hr = (const u32x2*)(hb + (size_t)row * DM) + c.lane;
#pragma unroll
        for (int j = 0; j < 4; ++j) { const u32x2 hv = hr[64 * j]; const f32x4 gg = gr[64 * j];
            xr[64 * j] = (f32x4){bflo(hv.x) * rs * gg[0], bfhi(hv.x) * rs * gg[1], bflo(hv.y) * rs * gg[2], bfhi(hv.y) * rs * gg[3]}; }
    }
}

DI void ph_ffn_up(const Params& p, const Ctx& c0, int l, int which) {
    const Ctx c = fresh(c0);
    pg8::Gemm g = pg8::plain_gemm(wsb(c, OFF_HB), (const bf16_t*)(c.ws + (size_t)l * W_LAYER + (which ? W_GU2 : W_GU1)), MTOK, 2 * FF, DM); g.ocol_step = 128;
    pg8::Order S; S.init(g, c.G, c.bid);
    pg8::EpiSwiGLU E{wsb(c, OFF_Z), FF, ssbuf(c, 4 * l + (which ? 3 : 0))};
    pg8::gemm_phase(c.lds, g, S, E);
}
DI void ph_resid(const Params& p, const Ctx& c0, const bf16_t* A, const bf16_t* Bt, int K, int ss_out, float alpha) {
    const Ctx c = fresh(c0);
    pg8::Gemm g = pg8::plain_gemm(A, Bt, MTOK, DM, K);
    if (K == FF) { g.lda = 64; g.kstepA = 256 * 64 * 2; g.a_pmdiv = (long)(FF / 64) * 256 * 64; }
    pg8::Order S; S.init(g, c.G, c.bid);
    pg8::EpiResid E{wsb(c, OFF_HB), ssbuf(c, ss_out), alpha};
    pg8::gemm_phase(c.lds, g, S, E);
}
DI void ph_kv(const Params& p, const Ctx& c0) {
    const Ctx c = fresh(c0);
    { pg8::Gemm g = pg8::plain_gemm(wsb(c, OFF_MEMB), wsb(c, OFF_WK), MMEM, 4096, DM); pg8::Order S; S.init(g, c.G, c.bid);
      pg8::EpiBf16 E{wsb(c, OFF_KB), 4096, nullptr, wsf(c, OFF_RSM), nullptr, 1.f, 0}; pg8::gemm_phase(c.lds, g, S, E); }
    { pg8::Gemm g = pg8::plain_gemm(wsb(c, OFF_MEMB), wsb(c, OFF_WV), MMEM, 4096, DM); pg8::Order S; S.init(g, c.G, c.bid);
      pg8::EpiBf16 E{wsb(c, OFF_VT), 4096, nullptr, wsf(c, OFF_RSM), nullptr, 1.f, 0}; pg8::gemm_phase(c.lds, g, S, E); }
}
DI void ph_win(const Params& p, const Ctx& c0, int l) {
    const Ctx c = fresh(c0);
    pg8::Gemm g = pg8::plain_gemm(wsb(c, OFF_HB), (const bf16_t*)(c.ws + (size_t)l * W_LAYER + W_IN), MTOK, 3072, DM);
    pg8::Order S; S.init(g, c.G, c.bid);
    pg8::EpiZ E{wsb(c, OFF_Z), wsf(c, OFF_GATES), ssbuf(c, 4 * l + 1)};
    pg8::gemm_phase(c.lds, g, S, E);
}
constexpr size_t OFF_MT = OFF_Z, OFF_VWT = OFF_Z + (size_t)16384 * DM * 2;
DI void ph_xpre(const Params& p, const Ctx& c0, int l) {
    const Ctx c = fresh(c0);
    const unsigned char* wl = c.ws + (size_t)l * W_LAYER;
    { pg8::Gemm g; g.A = wsb(c, OFF_KB) + l * 1024; g.B = (const bf16_t*)(wl + W_Q); g.lda = 4096; g.ldb = DM; g.K = 256; g.nM = 64; g.nN = 4;
      g.div = 4; g.a_pmdiv = 256L * 4096; g.a_pmmod = 256; g.a_pn = 0; g.b_pmdiv = 0; g.b_pmmod = 256; g.b_pn = 256L * DM; g.ocol_step = 256; g.kstepA = 128; g.kstepB = 128;
      pg8::Order S; S.init(g, c.G, c.bid);
      pg8::EpiBf16 E{wsb(c, OFF_MT), DM, nullptr, nullptr, nullptr, 1.f, 0}; pg8::gemm_phase(c.lds, g, S, E); }
    { pg8::Gemm g; g.A = (const bf16_t*)(wl + W_O); g.B = wsb(c, OFF_VT) + l * 1024; g.lda = DM; g.ldb = 4096; g.K = 256; g.nM = 64; g.nN = 4;
      g.div = 4; g.a_pmdiv = 0; g.a_pmmod = 256L * DM; g.a_pn = 256; g.b_pmdiv = 256L * 4096; g.b_pmmod = 0; g.b_pn = 256; g.ocol_step = 256; g.kstepA = 128; g.kstepB = 128;
      pg8::Order S; S.init(g, c.G, c.bid);
      pg8::EpiBf16 E{wsb(c, OFF_VWT), DM, nullptr, nullptr, nullptr, 1.f, 0}; pg8::gemm_phase(c.lds, g, S, E); }
}
DI void ph_xs(const Params& p, const Ctx& c0, int l) {
    const Ctx c = fresh(c0);
    pg8::Gemm g; g.A = wsb(c, OFF_HB); g.B = wsb(c, OFF_MT); g.lda = DM; g.ldb = DM; g.K = DM; g.nM = MTOK / 256; g.nN = 4;
    g.div = 16; g.a_pmdiv = 16L * 256 * DM; g.a_pmmod = 256L * DM; g.a_pn = 0; g.b_pmdiv = 4L * 256 * DM; g.b_pmmod = 0; g.b_pn = 256L * DM; g.ocol_step = 256; g.kstepA = 128; g.kstepB = 128;
    pg8::Order S; S.init(g, c.G, c.bid);
    pg8::EpiSoftmax E{wsb(c, OFF_Y), DM, (LAS float*)(c.lds + LDS_EXTRA), ssbuf(c, 4 * l + 2), 0.0625f * LOG2E};
    pg8::gemm_phase(c.lds, g, S, E);
}
DI void ph_xo(const Params& p, const Ctx& c0, int l) {
    const Ctx c = fresh(c0);
    pg8::Gemm g; g.A = wsb(c, OFF_Y); g.B = wsb(c, OFF_VWT); g.lda = DM; g.ldb = DM; g.K = DM; g.nM = MTOK / 256; g.nN = 4;
    g.div = 16; g.a_pmdiv = 16L * 256 * DM; g.a_pmmod = 256L * DM; g.a_pn = 0; g.b_pmdiv = 1024L * DM; g.b_pmmod = 0; g.b_pn = 256L * DM; g.ocol_step = 256; g.kstepA = 128; g.kstepB = 128;
    pg8::Order S; S.init(g, c.G, c.bid);
    pg8::EpiResid E{wsb(c, OFF_HB), ssbuf(c, 4 * l + 3), 1.f};
    pg8::gemm_phase(c.lds, g, S, E);
}

constexpr int PH_PER_LAYER = 11, PH_FINAL = 1 + PH_PER_LAYER * DEPTH, PH_TOTAL = PH_FINAL + 1;
__global__ void __launch_bounds__(512, 2) mega_fwd(Params pk) {
    extern __shared__ __attribute__((aligned(16))) unsigned char lds_raw[];
    volatile LAS unsigned* bst = (volatile LAS unsigned*)((LAS unsigned char*)lds_raw + LDS_EXTRA + 12288);
    XcdBarrier xbar; xbar.bar = (unsigned*)(pk.ws + OFF_CTL); xbar.x = 0; xbar.st = bst;
    if (pk.coop) { if (threadIdx.x < 4) bst[threadIdx.x] = 0u; __syncthreads(); xbar = xcd_barrier_post((unsigned*)(pk.ws + OFF_CTL), bst); }
    for (int ph = pk.ph_lo; ph < pk.ph_hi; ++ph) {
        int tid = threadIdx.x; asm volatile("" : "+v"(tid));
        const Params& p = pk;
        Ctx c; c.lds = (LAS unsigned char*)lds_raw; c.ldsg = lds_raw; c.tid = tid; c.lane = tid & 63; c.wid = __builtin_amdgcn_readfirstlane(tid >> 6);
        c.bid = blockIdx.x; c.G = gridDim.x; c.ws = pk.ws; c.out = pk.out;
        asm volatile("" : "+s"(c.ws)); asm volatile("" : "+s"(c.out));
        if (ph == 0) {
#ifndef NO_PRO
            REP(R_PRO) ph_prologue(p, c);
#endif
        }
        else if (ph == PH_FINAL) ph_final(p, c);
        else {
            const int l = (ph - 1) / PH_PER_LAYER, j = (ph - 1) % PH_PER_LAYER;
            const unsigned char* wl = c.ws + (size_t)l * W_LAYER;
#ifdef ONLY_CASE
            if (j != ONLY_CASE) continue;
#endif
            switch (j) {
                case 0: REP(R_UP) ph_ffn_up(p, c, l, 0); if (l == 0) ph_kv(p, c); break;
                case 1: ph_resid(p, c, wsb(c, OFF_Z), (const bf16_t*)(wl + W_D1), FF, 4 * l + 1, 0.5f); break;
                case 2: ph_win(p, c, l); break;
                case 3:
#ifndef NO_MIX1
                    ph_mix1(p, c, l);
#endif
                    break;
                case 4:
#ifndef NO_MIX2
                    ph_mix2(p, c, l);
#endif
                    break;
                case 5:
#ifndef NO_MIX3
                    ph_mix3(p, c, l);
#endif
                    break;
                case 6: ph_resid(p, c, wsb(c, OFF_Y), (const bf16_t*)(wl + W_OUT), DM, 4 * l + 2, 1.f); ph_xpre(p, c, l); break;
                case 7: ph_xs(p, c, l); break;
                case 8: ph_xo(p, c, l); break;
                case 9: ph_ffn_up(p, c, l, 1); break;
                default: ph_resid(p, c, wsb(c, OFF_Z), (const bf16_t*)(wl + W_D2), FF, 4 * l + 4, 0.5f); break;
            }
        }
        if (ph + 1 < pk.ph_hi && pk.coop) { if (ph == pk.ph_lo) cg::this_grid().sync(); else xcd_barrier(xbar); }
    }
}

extern "C" void kernel_launch(void* const* d_in, const int* in_sizes, int n_in, void* d_out, int out_size, void* d_ws, size_t ws_size, hipStream_t stream) {
    static int grid = 0;
    if (grid == 0) {
        if (n_in != 28 || out_size != MTOK * DM || ws_size < OFF_END) { fprintf(stderr, "kernel_launch: unexpected shapes (n_in %d out %d ws %zu)\n", n_in, out_size, ws_size); grid = -1; return; }
        int dev = 0, cus = 0, per_cu = 0;
        (void)hipGetDevice(&dev); (void)hipDeviceGetAttribute(&cus, hipDeviceAttributeMultiprocessorCount, dev);
        if (hipFuncSetAttribute((const void*)mega_fwd, hipFuncAttributeMaxDynamicSharedMemorySize, LDS_BYTES) != hipSuccess) { fprintf(stderr, "kernel_launch: hipFuncSetAttribute failed\n"); grid = -1; return; }
        if (hipOccupancyMaxActiveBlocksPerMultiprocessor(&per_cu, (const void*)mega_fwd, 512, LDS_BYTES) != hipSuccess || per_cu < 1) { fprintf(stderr, "kernel_launch: occupancy query says %d\n", per_cu); per_cu = 1; }
        (void)hipGetLastError();
        grid = cus * per_cu;
    }
    if (grid < 0) return;
    Params p{};
    for (int i = 0; i < 28; ++i) p.in[i] = (const float*)d_in[i];
    p.out = (float*)d_out; p.ws = (unsigned char*)d_ws; p.pad = 0;
    (void)hipMemsetAsync((unsigned char*)d_ws + OFF_CTL, 0, CTL_BYTES, stream);
#if MK_MULTI
    for (int ph = 0; ph < PH_TOTAL; ++ph) { p.ph_lo = ph; p.ph_hi = ph + 1; p.coop = 0; hipLaunchKernelGGL(mega_fwd, dim3(grid), dim3(512), LDS_BYTES, stream, p); }
#else
    p.ph_lo = 0; p.ph_hi = PH_TOTAL; p.coop = 1;
    void* args[] = {&p};
    hipError_t e = hipLaunchCooperativeKernel((const void*)mega_fwd, dim3(grid), dim3(512), args, LDS_BYTES, stream);
    if (e != hipSuccess) fprintf(stderr, "cooperative launch failed: %s (grid %d)\n", hipGetErrorString(e), grid);
#endif
}
```

```cpp
#include <hip/hip_runtime.h>
#include <hip/hip_cooperative_groups.h>
#include <cstdio>
#include <cstdint>
namespace cg = cooperative_groups;

#ifndef MK_MULTI
#define MK_MULTI 0
#endif

#ifndef R_DIFF
#define R_DIFF 1
#endif
#ifndef R_DIL
#define R_DIL 1
#endif
#ifndef R_POOL
#define R_POOL 1
#endif
#ifndef R_MLA
#define R_MLA 1
#endif
#ifndef R_MLC
#define R_MLC 1
#endif
#ifndef R_UP
#define R_UP 1
#endif
#ifndef R_WIN
#define R_WIN 1
#endif
#ifndef R_GATES
#define R_GATES 1
#endif
#ifndef R_PRO
#define R_PRO 1
#endif
#ifndef R_RES1
#define R_RES1 1
#endif
#ifndef R_RES6
#define R_RES6 1
#endif
#ifndef R_WQ
#define R_WQ 1
#endif
#define REP(n) for (int rep_ = 0; rep_ < (n); ++rep_)
#define DI __device__ __forceinline__
#define LAS __attribute__((address_space(3)))
typedef unsigned short bf16_t;
typedef short bf16x8 __attribute__((ext_vector_type(8)));
typedef float f32x4 __attribute__((ext_vector_type(4)));
typedef float f32x16 __attribute__((ext_vector_type(16)));
typedef unsigned u32x4 __attribute__((ext_vector_type(4)));
typedef unsigned u32x2 __attribute__((ext_vector_type(2)));
typedef float f32x2_t __attribute__((ext_vector_type(2)));
typedef __bf16 bf16x2_t __attribute__((ext_vector_type(2)));

constexpr int DM = 1024, NB = 16, SEQ = 4096, MTOK = NB * SEQ, DEPTH = 4, MEMLEN = 256, MMEM = NB * MEMLEN, FF = 2816, ZW = 2816, INW = 2824;
constexpr int ZQA = 0, ZKA = 256, ZVA = 512, ZOA = 768, ZPB = 1024, ZQC = 1280, ZKC = 1536, ZVC = 1792, ZQD = 2048, ZKD = 2304, ZVD = 2560;
constexpr float LOG2E = 1.4426950408889634f;
constexpr float NEGBIG = -1e30f;

constexpr size_t W_GU1 = 0, W_D1 = W_GU1 + (size_t)2 * FF * DM * 2, W_IN = W_D1 + (size_t)DM * FF * 2, W_OUT = W_IN + (size_t)3072 * DM * 2,
                 W_Q = W_OUT + (size_t)DM * DM * 2, W_O = W_Q + (size_t)DM * DM * 2, W_GU2 = W_O + (size_t)DM * DM * 2, W_D2 = W_GU2 + (size_t)2 * FF * DM * 2,
                 W_LAYER = W_D2 + (size_t)DM * FF * 2;
constexpr size_t OFF_WK = DEPTH * W_LAYER, OFF_WV = OFF_WK + (size_t)DEPTH * DM * DM * 2, OFF_HB = OFF_WV + (size_t)DEPTH * DM * DM * 2;
constexpr size_t OFF_DST = OFF_HB;
constexpr size_t OFF_OPART = OFF_HB + (size_t)64 * 64 * 4096 * 4;
constexpr size_t OFF_Z = OFF_HB + (size_t)MTOK * DM * 2;
constexpr size_t OFF_Y = OFF_Z + (size_t)MTOK * ZW * 2;
constexpr size_t OFF_KB = OFF_Y + (size_t)MTOK * DM * 2;
constexpr size_t OFF_VT = OFF_KB + (size_t)MMEM * 4096 * 2;
constexpr size_t OFF_MEMB = OFF_VT + (size_t)4096 * MMEM * 2;
constexpr size_t OFF_GATES = OFF_MEMB + (size_t)MMEM * DM * 2;
constexpr size_t OFF_SS = OFF_GATES + (size_t)MTOK * 8 * 4;
constexpr size_t OFF_LSEP = OFF_SS + (size_t)17 * MTOK * 16 * 4;
constexpr size_t OFF_NST = OFF_LSEP + (size_t)2 * MTOK * 4 * 4;
constexpr size_t OFF_SCAL = OFF_NST + (size_t)4096 * 64 * 4;
constexpr size_t OFF_DIFFB = OFF_SCAL + 65536;
constexpr size_t OFF_DILB = OFF_DIFFB + 65536;
constexpr size_t OFF_LAM = OFF_DILB + 8192;
constexpr size_t OFF_RSM = OFF_LAM + 256;
constexpr size_t OFF_CTL = OFF_RSM + 16384;
constexpr size_t CTL_BYTES = 16384;
constexpr size_t OFF_END = OFF_CTL + CTL_BYTES;
static_assert(OFF_OPART + (size_t)2 * MTOK * 256 * 2 <= OFF_Z, "alias map");
static_assert(OFF_END < (size_t)1073741824, "workspace");

constexpr int LDS_BYTES = 147456;
constexpr int LDS_EXTRA = 131072;

struct Params {
    const float* in[28];
    float* out;
    unsigned char* ws;
    int ph_lo, ph_hi, coop, pad;
};
enum { I_X = 0, I_MEM, I_T5, I_F1N, I_F1G, I_F1U, I_F1D, I_MIXN, I_WIN, I_CONVW, I_CONVB, I_GATEB, I_MLN, I_POOLW, I_POOLS, I_LAMV, I_SUBLN, I_WOUT,
       I_XN, I_MEMN, I_XWQ, I_XWKV, I_XWO, I_F2N, I_F2G, I_F2U, I_F2D, I_FINN };

DI unsigned cvtpk(float lo, float hi) { f32x2_t v = {lo, hi}; bf16x2_t b = __builtin_convertvector(v, bf16x2_t); return __builtin_bit_cast(unsigned, b); }
DI float bflo(unsigned w) { return __uint_as_float(w << 16); }
DI float bfhi(unsigned w) { return __uint_as_float(w & 0xffff0000u); }
DI float bf2f(bf16_t x) { return __uint_as_float((unsigned)x << 16); }
DI float ex2(float x) { return __builtin_amdgcn_exp2f(x); }
DI float rcpf_(float x) { return __builtin_amdgcn_rcpf(x); }
DI int crow(int i, int hi) { return (i & 3) + 8 * (i >> 2) + 4 * hi; }
DI float wave_sum(float v) {
#pragma unroll
    for (int o = 1; o < 64; o <<= 1) v += __shfl_xor(v, o);
    return v;
}
DI float wave_max(float v) {
#pragma unroll
    for (int o = 1; o < 64; o <<= 1) v = fmaxf(v, __shfl_xor(v, o));
    return v;
}
DI float silu_f(float g) { return g * rcpf_(1.f + ex2(-g * LOG2E)); }
DI float sigmoid_f(float g) { return rcpf_(1.f + ex2(-g * LOG2E)); }
#define LDS_WAIT() asm volatile("s_waitcnt lgkmcnt(0)" ::: "memory")
DI bf16x8 mk8(u32x2 lo, u32x2 hi) { u32x4 w = {lo.x, lo.y, hi.x, hi.y}; return __builtin_bit_cast(bf16x8, w); }
DI bf16x8 pack8(float a0, float a1, float a2, float a3, float a4, float a5, float a6, float a7) {
    u32x4 w = {cvtpk(a0, a1), cvtpk(a2, a3), cvtpk(a4, a5), cvtpk(a6, a7)}; return __builtin_bit_cast(bf16x8, w);
}
DI float rowss(const float* ss, int row) {
    const f32x4* q = (const f32x4*)(ss + (size_t)row * 16); const f32x4 a = q[0], b = q[1], c = q[2], d = q[3];
    const float t = ((a[0] + a[1]) + (a[2] + a[3])) + ((b[0] + b[1]) + (b[2] + b[3])) + ((c[0] + c[1]) + (c[2] + c[3])) + ((d[0] + d[1]) + (d[2] + d[3]));
    return rsqrtf(t * (1.f / 1024.f) + 1e-6f);
}
#define MFMA32(a, b, c) __builtin_amdgcn_mfma_f32_32x32x16_bf16((a), (b), (c), 0, 0, 0)

namespace pg8 {
constexpr int BM = 256, BK = 64, HALF = 128, HTB = HALF * BK * 2, STAGE_BYTES = 8 * HTB, NXCD = 8, WGM = 8;
DI int lds_byte(int r, int c) { const int st = (r >> 4) * 2 + (c >> 5), rr = r & 15, cc = c & 31, ob = rr * 64 + cc * 2; return st * 1024 + (ob ^ (((ob >> 9) & 1) << 5)); }
DI void stage_rc(int b, int& R, int& C) { const int st = b / 1024, sb = b % 1024, swz = sb ^ (((sb >> 9) & 1) << 5); R = (st >> 1) * 16 + swz / 64; C = (st & 1) * 32 + (swz % 64) / 2; }
DI int perm32(int rho) { const int n = rho >> 4, i = rho & 15; return 8 * (i >> 2) + 4 * n + (i & 3); }

struct Unit { const char* a; const char* b; int orow, ocol, pm, pn; };
struct Gemm {
    const bf16_t* A; const bf16_t* B; int lda, ldb, K, nM, nN; long a_pmdiv, a_pmmod, a_pn, b_pmdiv, b_pmmod, b_pn; int div, ocol_step; int kstepA, kstepB;
    int imgA;
};
DI Gemm plain_gemm(const bf16_t* A, const bf16_t* B, int Mrows, int N, int K) {
    Gemm g; g.A = A; g.B = B; g.lda = K; g.ldb = K; g.K = K; g.nM = Mrows / BM; g.nN = N / BM; g.a_pmdiv = (long)BM * K; g.a_pmmod = 0; g.a_pn = 0; g.b_pmdiv = 0; g.b_pmmod = 0; g.b_pn = (long)BM * K;
    g.div = 1; g.ocol_step = BM; g.kstepA = BK * 2; g.kstepB = BK * 2; g.imgA = 0; return g;
}
struct Order {
    Gemm g; int nwg, G, c;
    DI void init(const Gemm& g_, int G_, int c_) { g = g_; nwg = g.nM * g.nN; G = G_; c = c_; }
    DI bool next(int i, Unit& u) const {
        const long L = (long)i * G + c; if (L >= nwg) return false;
        int wgid = (int)L; { const int q = nwg / NXCD, r = nwg % NXCD, xcd = wgid % NXCD, off = wgid / NXCD; wgid = (xcd < r ? xcd * (q + 1) : r * (q + 1) + (xcd - r) * q) + off; }
        const int nN = g.nN, nM = g.nM, nig = WGM * nN, gid = wgid / nig, fm = gid * WGM, gsz = (nM - fm) < WGM ? (nM - fm) : WGM;
        const int pm = fm + ((wgid % nig) % gsz), pn = (wgid % nig) / gsz;
        u.pm = pm; u.pn = pn; u.orow = pm * BM; u.ocol = pn * g.ocol_step;
        const int pq = pm / g.div, pr = pm - pq * g.div;
        u.a = (const char*)(g.A + (long)pq * g.a_pmdiv + (long)pr * g.a_pmmod + (long)pn * g.a_pn);
        u.b = (const char*)(g.B + (long)pq * g.b_pmdiv + (long)pr * g.b_pmmod + (long)pn * g.b_pn);
        return true;
    }
};

struct EpiBf16 {
    static constexpr bool PERM = true;
    bf16_t* O; int ldc; const float* ss; const float* rowscale; const float* colscale; float scale; int zspecial;
    DI void operator()(f32x4 (&acc)[2][2][4][2], const Unit& u, int wr, int wc, int fr, int fq, int wid, int lane) const {
        const int row0 = u.orow + wr * 64 + fr, col0 = u.ocol + wc * 32 + 8 * fq;
        float sc = scale;
        if (zspecial) { if (u.pn == 5) sc *= 0.125f * LOG2E; else if (u.pn == 8) sc *= 0.17677669529663687f * LOG2E; }
        if (colscale) {
#pragma unroll
            for (int bj = 0; bj < 2; ++bj)
#pragma unroll
                for (int n = 0; n < 2; ++n) { const f32x4 cs = *(const f32x4*)(colscale + col0 + bj * HALF + 4 * n);
#pragma unroll
                    for (int ai = 0; ai < 2; ++ai)
#pragma unroll
                        for (int m = 0; m < 4; ++m) acc[ai][bj][m][n] *= cs; }
            asm volatile("" ::: "memory");
        }
#pragma unroll
        for (int ai = 0; ai < 2; ++ai)
#pragma unroll
            for (int m = 0; m < 4; ++m) {
                const int row = row0 + ai * HALF + m * 16;
                float rs = sc;
                if (ss) rs *= rowss(ss, row);
                if (rowscale) rs *= rowscale[row];
                bf16_t* rowp = O + (size_t)row * ldc + col0;
#pragma unroll
                for (int bj = 0; bj < 2; ++bj) {
                    const f32x4 v0 = acc[ai][bj][m][0] * rs, v1 = acc[ai][bj][m][1] * rs;
                    u32x4 w; w.x = cvtpk(v0[0], v0[1]); w.y = cvtpk(v0[2], v0[3]); w.z = cvtpk(v1[0], v1[1]); w.w = cvtpk(v1[2], v1[3]);
                    *(u32x4*)(rowp + bj * HALF) = w;
                }
                asm volatile("" ::: "memory");
            }
    }
};
struct EpiZ {
    static constexpr bool PERM = true;
    bf16_t* O; float* gates; const float* ss;
    DI void operator()(f32x4 (&acc)[2][2][4][2], const Unit& u, int wr, int wc, int fr, int fq, int wid, int lane) const {
        const int row0 = u.orow + wr * 64 + fr, col0 = u.ocol + wc * 32 + 8 * fq;
        if (u.pn == 11) {
            if (wc == 0 && fq == 0) {
#pragma unroll
                for (int ai = 0; ai < 2; ++ai)
#pragma unroll
                    for (int m = 0; m < 4; ++m) { const int row = row0 + ai * HALF + m * 16; const float rs = rowss(ss, row);
                        *(f32x4*)(gates + (size_t)row * 8) = acc[ai][0][m][0] * rs; *(f32x4*)(gates + (size_t)row * 8 + 4) = acc[ai][0][m][1] * rs; }
            }
            return;
        }
        float sc = 1.f;
        if (u.pn == 5) sc = 0.125f * LOG2E; else if (u.pn == 8) sc = 0.17677669529663687f * LOG2E;
#pragma unroll
        for (int ai = 0; ai < 2; ++ai)
#pragma unroll
            for (int m = 0; m < 4; ++m) {
                const int row = row0 + ai * HALF + m * 16;
                const float rs = sc * rowss(ss, row);
                bf16_t* rowp = O + (size_t)row * ZW + col0;
#pragma unroll
                for (int bj = 0; bj < 2; ++bj) {
                    const f32x4 v0 = acc[ai][bj][m][0] * rs, v1 = acc[ai][bj][m][1] * rs;
                    u32x4 w; w.x = cvtpk(v0[0], v0[1]); w.y = cvtpk(v0[2], v0[3]); w.z = cvtpk(v1[0], v1[1]); w.w = cvtpk(v1[2], v1[3]);
                    *(u32x4*)(rowp + bj * HALF) = w;
                }
                asm volatile("" ::: "memory");
            }
    }
};
struct EpiSwiGLU {
    static constexpr bool PERM = true;
    bf16_t* O; int ldc; const float* ss;
    DI void operator()(f32x4 (&acc)[2][2][4][2], const Unit& u, int wr, int wc, int fr, int fq, int wid, int lane) const {
        const int row0 = u.orow + wr * 64 + fr, col0 = u.ocol + wc * 32 + 8 * fq;
#pragma unroll
        for (int ai = 0; ai < 2; ++ai)
#pragma unroll
            for (int m = 0; m < 4; ++m) {
                const int row = row0 + ai * HALF + m * 16;
                const float rs = rowss(ss, row);
                float o[8];
#pragma unroll
                for (int n = 0; n < 2; ++n)
#pragma unroll
                    for (int j = 0; j < 4; ++j) { const float g = acc[ai][0][m][n][j] * rs, up = acc[ai][1][m][n][j] * rs; o[4 * n + j] = silu_f(g) * up; }
                u32x4 w; w.x = cvtpk(o[0], o[1]); w.y = cvtpk(o[2], o[3]); w.z = cvtpk(o[4], o[5]); w.w = cvtpk(o[6], o[7]);
                __builtin_nontemporal_store(w, (u32x4*)((unsigned char*)O + ((size_t)(u.pm * (FF / 64) + (col0 >> 6)) * 2 + ((row >> 7) & 1)) * 16384 + lds_byte(row & 127, col0 & 63)));
                asm volatile("" ::: "memory");
            }
    }
};
struct EpiResid {
    static constexpr bool PERM = true;
    bf16_t* hb; float* ssout; float alpha;
    DI void operator()(f32x4 (&acc)[2][2][4][2], const Unit& u, int wr, int wc, int fr, int fq, int wid, int lane) const {
        const int row0 = u.orow + wr * 64 + fr, col0 = u.ocol + wc * 32 + 8 * fq;
#pragma unroll
        for (int ai = 0; ai < 2; ++ai) {
            u32x4 r[4][2];
#pragma unroll
            for (int m = 0; m < 4; ++m) { const size_t off = (size_t)(row0 + ai * HALF + m * 16) * DM + col0;
#pragma unroll
                for (int bj = 0; bj < 2; ++bj) r[m][bj] = *(const u32x4*)(hb + off + bj * HALF); }
#pragma unroll
            for (int m = 0; m < 4; ++m) {
                const int row = row0 + ai * HALF + m * 16; const size_t off = (size_t)row * DM + col0; float ssq = 0.f;
#pragma unroll
                for (int bj = 0; bj < 2; ++bj) {
                    const u32x4 rr = r[m][bj]; const f32x4 a0 = acc[ai][bj][m][0] * alpha, a1 = acc[ai][bj][m][1] * alpha;
                    u32x4 w; w.x = cvtpk(bflo(rr.x) + a0[0], bfhi(rr.x) + a0[1]); w.y = cvtpk(bflo(rr.y) + a0[2], bfhi(rr.y) + a0[3]);
                    w.z = cvtpk(bflo(rr.z) + a1[0], bfhi(rr.z) + a1[1]); w.w = cvtpk(bflo(rr.w) + a1[2], bfhi(rr.w) + a1[3]);
                    *(u32x4*)(hb + off + bj * HALF) = w;
                    const float v0 = bflo(w.x), v1 = bfhi(w.x), v2 = bflo(w.y), v3 = bfhi(w.y), v4 = bflo(w.z), v5 = bfhi(w.z), v6 = bflo(w.w), v7 = bfhi(w.w);
                    ssq += ((v0 * v0 + v1 * v1) + (v2 * v2 + v3 * v3)) + ((v4 * v4 + v5 * v5) + (v6 * v6 + v7 * v7));
                }
                ssq += __shfl_xor(ssq, 16); ssq += __shfl_xor(ssq, 32);
                if (fq == 0) ssout[(size_t)row * 16 + u.pn * 4 + wc] = ssq;
            }
            asm volatile("" ::: "memory");
        }
    }
};
struct EpiSoftmax {
    static constexpr bool PERM = true;
    bf16_t* O; int ldc; LAS float* red; const float* ss; float scale;
    DI void operator()(f32x4 (&acc)[2][2][4][2], const Unit& u, int wr, int wc, int fr, int fq, int wid, int lane) const {
        float mloc[2][4];
#pragma unroll
        for (int ai = 0; ai < 2; ++ai)
#pragma unroll
            for (int m = 0; m < 4; ++m) {
                float mx = NEGBIG;
                const float rsc = rowss(ss, u.orow + ai * HALF + wr * 64 + m * 16 + fr) * scale;
#pragma unroll
                for (int bj = 0; bj < 2; ++bj)
#pragma unroll
                    for (int n = 0; n < 2; ++n) { const f32x4 x = acc[ai][bj][m][n] * rsc; acc[ai][bj][m][n] = x; mx = fmaxf(mx, fmaxf(fmaxf(x[0], x[1]), fmaxf(x[2], x[3]))); }
                mx = fmaxf(mx, __shfl_xor(mx, 16)); mx = fmaxf(mx, __shfl_xor(mx, 32));
                float sm = 0.f;
#pragma unroll
                for (int bj = 0; bj < 2; ++bj)
#pragma unroll
                    for (int n = 0; n < 2; ++n) { f32x4 x = acc[ai][bj][m][n]; x[0] = ex2(x[0] - mx); x[1] = ex2(x[1] - mx); x[2] = ex2(x[2] - mx); x[3] = ex2(x[3] - mx);
                        acc[ai][bj][m][n] = x; sm += (x[0] + x[1]) + (x[2] + x[3]); }
                sm += __shfl_xor(sm, 16); sm += __shfl_xor(sm, 32);
                mloc[ai][m] = mx;
                const int rl = ai * HALF + wr * 64 + m * 16 + fr;
                if (fq == 0) { red[(rl * 4 + wc) * 2] = mx; red[(rl * 4 + wc) * 2 + 1] = sm; }
            }
        asm volatile("s_waitcnt lgkmcnt(0)" ::: "memory"); __builtin_amdgcn_s_barrier(); asm volatile("" ::: "memory");
        const int row0 = u.orow + wr * 64 + fr, col0 = u.ocol + wc * 32 + 8 * fq;
#pragma unroll
        for (int ai = 0; ai < 2; ++ai)
#pragma unroll
            for (int m = 0; m < 4; ++m) {
                const int rl = ai * HALF + wr * 64 + m * 16 + fr;
                const f32x4 p0 = *(const LAS f32x4*)(red + rl * 8), p1 = *(const LAS f32x4*)(red + rl * 8 + 4);
                const float gm = fmaxf(fmaxf(p0[0], p0[2]), fmaxf(p1[0], p1[2]));
                const float tot = p0[1] * ex2(p0[0] - gm) + p0[3] * ex2(p0[2] - gm) + p1[1] * ex2(p1[0] - gm) + p1[3] * ex2(p1[2] - gm);
                const float f = ex2(mloc[ai][m] - gm) / tot;
                bf16_t* rowp = O + (size_t)(row0 + ai * HALF + m * 16) * ldc + col0;
#pragma unroll
                for (int bj = 0; bj < 2; ++bj) {
                    const f32x4 v0 = acc[ai][bj][m][0] * f, v1 = acc[ai][bj][m][1] * f;
                    u32x4 w; w.x = cvtpk(v0[0], v0[1]); w.y = cvtpk(v0[2], v0[3]); w.z = cvtpk(v1[0], v1[1]); w.w = cvtpk(v1[2], v1[3]);
                    *(u32x4*)(rowp + bj * HALF) = w;
                }
            }
        asm volatile("s_waitcnt lgkmcnt(0)" ::: "memory"); __builtin_amdgcn_s_barrier(); asm volatile("" ::: "memory");
    }
};

template <class Epi>
DI void gemm_phase(LAS unsigned char* lds, const Gemm g, const Order& S, const Epi& E) {
    int tid_ = threadIdx.x; asm volatile("" : "+v"(tid_));
    const int tid = tid_, wid = __builtin_amdgcn_readfirstlane(tid >> 6), lane = tid & 63, wr = wid >> 2, wc = wid & 3, fr = lane & 15, fq = lane >> 4;
    const int K = g.K, nt = K / BK;
    unsigned voffA[2], voffB[2];
#pragma unroll
    for (int i = 0; i < 2; ++i) { int R, C; stage_rc(tid * 16 + i * 8192, R, C); const int Rb = Epi::PERM ? ((R & ~31) + perm32(R & 31)) : R;
        voffA[i] = g.imgA ? (unsigned)(tid * 16 + i * 8192) : (unsigned)(R * g.lda + C) * 2u; voffB[i] = (unsigned)(Rb * g.ldb + C) * 2u; }
    const size_t kstepA = (size_t)g.kstepA, kstepB = (size_t)g.kstepB;
    const size_t hstepA = (size_t)HALF * g.lda * 2, hstepB = (size_t)HALF * g.ldb * 2;
    const unsigned ldsw = (unsigned)wid * 1024u;
    const int aoff = lds_byte(wr * 64 + fr, fq * 8), boff = lds_byte(wc * 32 + fr, fq * 8);
#define PG8_SA(b, h) (((b) * 2 + (h)) * HTB)
#define PG8_SB(b, h) ((4 + (b) * 2 + (h)) * HTB)
#define PG8_STAGE(bufoff, gbase, voff) do { _Pragma("unroll") for (int _i = 0; _i < 2; ++_i) \
        __builtin_amdgcn_global_load_lds((const unsigned*)((const char*)(gbase) + (voff)[_i]), (LAS unsigned*)(lds + (bufoff) + ldsw + _i * 8192), 16, 0, 0); } while (0)
#define PG8_LDA(dst, b, h) do { _Pragma("unroll") for (int m = 0; m < 4; ++m) _Pragma("unroll") for (int k = 0; k < 2; ++k) dst[m][k] = *(const LAS bf16x8*)(lds + PG8_SA(b, h) + aoff + m * 2048 + k * 1024); } while (0)
#define PG8_LDB(dst, b, h) do { _Pragma("unroll") for (int n = 0; n < 2; ++n) _Pragma("unroll") for (int k = 0; k < 2; ++k) dst[n][k] = *(const LAS bf16x8*)(lds + PG8_SB(b, h) + boff + n * 2048 + k * 1024); } while (0)
#define PG8_MMA(ai, bj, At, Bt) do { __builtin_amdgcn_s_setprio(1); _Pragma("unroll") for (int m = 0; m < 4; ++m) _Pragma("unroll") for (int n = 0; n < 2; ++n) _Pragma("unroll") for (int k = 0; k < 2; ++k) \
        acc[ai][bj][m][n] = __builtin_amdgcn_mfma_f32_16x16x32_bf16(Bt[n][k], At[m][k], acc[ai][bj][m][n], 0, 0, 0); __builtin_amdgcn_s_setprio(0); } while (0)
#define PG8_WAIT_V(n) asm volatile("s_waitcnt vmcnt(" #n ")" ::: "memory")
#define PG8_WAIT_L(n) asm volatile("s_waitcnt lgkmcnt(" #n ")" ::: "memory")
#define PG8_BAR __builtin_amdgcn_s_barrier()
#define PG8_SCHED __builtin_amdgcn_sched_barrier(0)
    Unit cur, nxt; int ui = 0;
    if (!S.next(0, cur)) return;
    f32x4 acc[2][2][4][2];
#pragma unroll
    for (int a = 0; a < 2; ++a)
#pragma unroll
        for (int b = 0; b < 2; ++b)
#pragma unroll
            for (int m = 0; m < 4; ++m)
#pragma unroll
                for (int n = 0; n < 2; ++n) acc[a][b][m][n] = (f32x4){0.f, 0.f, 0.f, 0.f};
    bf16x8 At[4][2], B0[2][2], B1[2][2];
    const char* cA = cur.a; const char* cB = cur.b;
    PG8_STAGE(PG8_SB(0, 0), cB, voffB); PG8_STAGE(PG8_SB(0, 1), cB + hstepB, voffB); PG8_STAGE(PG8_SA(0, 0), cA, voffA); PG8_STAGE(PG8_SA(0, 1), cA + hstepA, voffA);
    if (wr == 1) PG8_BAR;
    PG8_WAIT_V(2); PG8_BAR;
    PG8_STAGE(PG8_SB(1, 0), cB + kstepB, voffB); PG8_STAGE(PG8_SA(1, 0), cA + kstepA, voffA); PG8_STAGE(PG8_SB(1, 1), cB + hstepB + kstepB, voffB);
    PG8_WAIT_V(6); PG8_BAR;
    for (;;) {
        const bool has_next = S.next(ui + 1, nxt);
        const char* nA = has_next ? nxt.a : cA; const char* nB = has_next ? nxt.b : cB;
        for (int t = 0; t < nt; t += 2) {
            const bool last = (t == nt - 2);
            const char* a1 = cA + (size_t)(t + 1) * kstepA;
            const char* a2 = last ? nA : cA + (size_t)(t + 2) * kstepA; const char* b2 = last ? nB : cB + (size_t)(t + 2) * kstepB;
            const char* a3 = a2 + kstepA; const char* b3 = b2 + kstepB;
            PG8_LDB(B0, 0, 0); PG8_LDB(B1, 0, 1); PG8_SCHED; PG8_LDA(At, 0, 0); PG8_STAGE(PG8_SA(1, 1), a1 + hstepA, voffA);
            PG8_WAIT_V(8); PG8_WAIT_L(0); PG8_BAR; PG8_MMA(0, 0, At, B0); PG8_MMA(0, 1, At, B1); PG8_BAR; PG8_SCHED;
            PG8_LDA(At, 0, 1); PG8_STAGE(PG8_SB(0, 0), b2, voffB); PG8_STAGE(PG8_SB(0, 1), b2 + hstepB, voffB); PG8_STAGE(PG8_SA(0, 0), a2, voffA);
            PG8_WAIT_V(8); PG8_WAIT_L(0); PG8_BAR; PG8_MMA(1, 0, At, B0); PG8_MMA(1, 1, At, B1); PG8_BAR; PG8_SCHED;
            PG8_LDB(B0, 1, 0); PG8_LDB(B1, 1, 1); PG8_SCHED; PG8_LDA(At, 1, 0); PG8_STAGE(PG8_SA(0, 1), a2 + hstepA, voffA);
            PG8_WAIT_V(8); PG8_WAIT_L(0); PG8_BAR; PG8_MMA(0, 0, At, B0); PG8_MMA(0, 1, At, B1); PG8_BAR; PG8_SCHED;
            PG8_LDA(At, 1, 1); PG8_STAGE(PG8_SB(1, 0), b3, voffB); PG8_STAGE(PG8_SB(1, 1), b3 + hstepB, voffB); PG8_STAGE(PG8_SA(1, 0), a3, voffA);
            PG8_WAIT_V(8); PG8_WAIT_L(0); PG8_BAR; PG8_MMA(1, 0, At, B0); PG8_MMA(1, 1, At, B1); PG8_BAR; PG8_SCHED;
        }
        if (wr == 0) PG8_BAR;
        E(acc, cur, wr, wc, fr, fq, wid, lane);
        if (!has_next) break;
#pragma unroll
        for (int a = 0; a < 2; ++a)
#pragma unroll
            for (int b = 0; b < 2; ++b)
#pragma unroll
                for (int m = 0; m < 4; ++m)
#pragma unroll
                    for (int n = 0; n < 2; ++n) acc[a][b][m][n] = (f32x4){0.f, 0.f, 0.f, 0.f};
        cur = nxt; cA = nA; cB = nB; ++ui;
        if (wr == 1) PG8_BAR;
    }
    PG8_WAIT_V(0);
    PG8_BAR;
#undef PG8_SA
#undef PG8_SB
#undef PG8_STAGE
#undef PG8_LDA
#undef PG8_LDB
#undef PG8_MMA
#undef PG8_WAIT_V
#undef PG8_WAIT_L
#undef PG8_BAR
#undef PG8_SCHED
}
}

#define XB_TMO      128
#define XB_XCNT(j)  (256  + 64 * (j))
#define XB_XSUB(j)  (1280 + 64 * (j))
#define XB_XGEN(j)  (2304 + 64 * (j))
#define XB_TOP      3328
#define XB_TOPGEN   3392
#define XCD_BAR_WORDS 3456
#define XB_SPIN_CAP (1u << 20)
DI unsigned xb_ld(unsigned* p)              { return __hip_atomic_load(p, __ATOMIC_RELAXED, __HIP_MEMORY_SCOPE_AGENT); }
DI unsigned xb_add(unsigned* p, unsigned v) { return __hip_atomic_fetch_add(p, v, __ATOMIC_RELAXED, __HIP_MEMORY_SCOPE_AGENT); }
DI unsigned xb_xcc_id() { return (unsigned)__builtin_amdgcn_s_getreg((3 << 11) | 20) & 0xFu; }
#define XB_SPIN(cond, bar) do { unsigned _sp = 0; while (cond) { __builtin_amdgcn_s_sleep(1); \
    if ((++_sp & 255u) == 0u) { if (xb_ld(&(bar)[XB_TMO])) break; if (_sp > XB_SPIN_CAP) { atomicAdd(&(bar)[XB_TMO], 1u); break; } } } } while (0)
struct XcdBarrier { unsigned* bar; unsigned x; volatile LAS unsigned* st; };
DI XcdBarrier xcd_barrier_post(unsigned* bar, volatile LAS unsigned* st) {
    XcdBarrier b; b.bar = bar; b.x = xb_xcc_id(); b.st = st;
    if (threadIdx.x == 0) (void)xb_add(&bar[XB_XCNT(b.x)], 1u);
    return b;
}
DI void xcd_barrier_complete(unsigned* bar, unsigned x, unsigned& nloc, unsigned& nx) {
    const unsigned G = gridDim.x * gridDim.y * gridDim.z;
    unsigned sum, cnt, mine, sp = 0u;
    for (;;) {
        sum = 0u; cnt = 0u; mine = 0u;
#pragma unroll
        for (unsigned j = 0; j < 16; ++j) { const unsigned c = xb_ld(&bar[XB_XCNT(j)]); sum += c; cnt += (c > 0u) ? 1u : 0u; mine = (j == x) ? c : mine; }
        if (sum == G) break;
        __builtin_amdgcn_s_sleep(1);
        if ((++sp & 255u) == 0u) { if (xb_ld(&bar[XB_TMO])) break; if (sp > XB_SPIN_CAP) { atomicAdd(&bar[XB_TMO], 1u); break; } }
    }
    nloc = mine > 0u ? mine : 1u; nx = cnt > 0u ? cnt : 1u;
}
DI void xcd_barrier(const XcdBarrier& b) {
    asm volatile("s_waitcnt vmcnt(0)" ::: "memory");
    __syncthreads();
    if (threadIdx.x == 0) {
        unsigned* bar = b.bar;
        __builtin_amdgcn_s_waitcnt(0);
        unsigned nloc = b.st[0], nx = b.st[1];
        if (nloc == 0u) { xcd_barrier_complete(bar, b.x, nloc, nx); b.st[0] = nloc; b.st[1] = nx; }
        const unsigned old = xb_add(&bar[XB_XSUB(b.x)], 1u);
        const unsigned gen = old / nloc;
        if (old + 1u == (gen + 1u) * nloc) {
            __builtin_amdgcn_fence(__ATOMIC_RELEASE, "agent");
            asm volatile("s_waitcnt vmcnt(0)" ::: "memory");
            const unsigned og = xb_add(&bar[XB_TOP], 1u);
            const unsigned tg = og / nx;
            if (og + 1u == (tg + 1u) * nx) xb_add(&bar[XB_TOPGEN], 1u);
            else XB_SPIN(xb_ld(&bar[XB_TOPGEN]) == tg, bar);
            __builtin_amdgcn_fence(__ATOMIC_ACQUIRE, "agent");
            xb_add(&bar[XB_XGEN(b.x)], 1u);
            asm volatile("s_waitcnt vmcnt(0)" ::: "memory");
        } else {
            XB_SPIN(xb_ld(&bar[XB_XGEN(b.x)]) == gen, bar);
            __builtin_amdgcn_fence(__ATOMIC_ACQUIRE, "agent");
            asm volatile("s_waitcnt vmcnt(0)" ::: "memory");
        }
    }
    __syncthreads();
}

struct Ctx {
    LAS unsigned char* lds; unsigned char* ldsg;
    int tid, lane, wid, bid, G;
    unsigned char* ws; float* out;
};
DI bf16_t* wsb(const Ctx& c, size_t off) { return (bf16_t*)(c.ws + off); }
DI float* wsf(const Ctx& c, size_t off) { return (float*)(c.ws + off); }
DI float* ssbuf(const Ctx& c, int i) { return (float*)(c.ws + OFF_SS) + (size_t)i * MTOK * 16; }

DI int t5_bucket(int dist) {
    if (dist < 16) return dist;
    const float v = logf((float)dist / 16.f) / 4.852030263919617f * 16.f;
    int large = 16 + (int)v; return large < 31 ? large : 31;
}

DI Ctx fresh(const Ctx& c0) {
    Ctx c = c0; int tid = threadIdx.x; asm volatile("" : "+v"(tid)); c.tid = tid; c.lane = tid & 63; c.wid = __builtin_amdgcn_readfirstlane(tid >> 6);
    asm volatile("" : "+s"(c.ws)); asm volatile("" : "+s"(c.out)); return c;
}
DI void transpose_item(const float* W, int ldw, int scol0, int k0, const float* gain, bf16_t* WT, int K, int drow0, LAS float* scr, int lane) {
    {
        f32x4 v[8]; float gs[8];
#pragma unroll
        for (int i = 0; i < 8; ++i) { const int kk = 8 * i + (lane >> 3); v[i] = *(const f32x4*)(W + (size_t)(k0 + kk) * ldw + scol0 + (lane & 7) * 4); gs[i] = gain ? gain[k0 + kk] : 1.f; }
#pragma unroll
        for (int i = 0; i < 8; ++i) { const int kk = 8 * i + (lane >> 3); LAS float* d = scr + kk * 33 + (lane & 7) * 4; d[0] = v[i][0] * gs[i]; d[1] = v[i][1] * gs[i]; d[2] = v[i][2] * gs[i]; d[3] = v[i][3] * gs[i]; }
    }
    LDS_WAIT(); asm volatile("" ::: "memory");
    const int c = lane & 7;
#pragma unroll
    for (int j = 0; j < 4; ++j) { const int n = (lane >> 3) + 8 * j; const LAS float* s = scr + (8 * c) * 33 + n;
        u32x4 o; o.x = cvtpk(s[0 * 33], s[1 * 33]); o.y = cvtpk(s[2 * 33], s[3 * 33]); o.z = cvtpk(s[4 * 33], s[5 * 33]); o.w = cvtpk(s[6 * 33], s[7 * 33]);
        *(u32x4*)(WT + (size_t)(drow0 + n) * K + k0 + 8 * c) = o; }
    LDS_WAIT(); asm volatile("" ::: "memory");
}
DI void tjob(const float* W, int ldw, int scol0, const float* gain, bf16_t* WT, int K, int ncols, int item, LAS float* scr, int lane) {
    const int nblk = ncols / 32, kb = item / nblk, nb = item % nblk;
    transpose_item(W, ldw, scol0 + 32 * nb, 64 * kb, gain, WT, K, 32 * nb, scr, lane);
}
DI void tjob_gu(const float* Wg, const float* Wu, const float* gain, bf16_t* WT, int item, LAS float* scr, int lane) {
    const int nblk = 2 * FF / 32, kb = item / nblk, nb = item % nblk, n0 = 32 * nb, p = n0 >> 8, w = n0 & 255;
    transpose_item(w < 128 ? Wg : Wu, FF, 128 * p + (w & 127), 64 * kb, gain, WT, DM, n0, scr, lane);
}
DI void ph_prologue(const Params& p, const Ctx& c0) {
    const Ctx c = fresh(c0);
    LAS float* scr = (LAS float*)(c.lds + c.wid * 16384);
    const int gw = c.bid * 8 + c.wid, NGW = c.G * 8, lane = c.lane;
    constexpr int I_GU = 16 * (2 * FF / 32), I_D = (FF / 64) * 32, I_INA = 16 * 32, I_INB = 16 * 56, I_INC = 16, I_SQ = 16 * 32;
    constexpr int PER_LAYER = 2 * I_GU + 2 * I_D + I_INA + I_INB + I_INC + 5 * I_SQ;
    for (int it = gw; it < DEPTH * PER_LAYER; it += NGW) {
        const int l = it / PER_LAYER; int r = it % PER_LAYER;
        unsigned char* wl = c.ws + (size_t)l * W_LAYER;
        if (r < I_GU) { tjob_gu(p.in[I_F1G] + (size_t)l * DM * FF, p.in[I_F1U] + (size_t)l * DM * FF, p.in[I_F1N] + l * DM, (bf16_t*)(wl + W_GU1), r, scr, lane); continue; } r -= I_GU;
        if (r < I_D) { tjob(p.in[I_F1D] + (size_t)l * FF * DM, DM, 0, nullptr, (bf16_t*)(wl + W_D1), FF, DM, r, scr, lane); continue; } r -= I_D;
        if (r < I_INA) { tjob(p.in[I_WIN] + (size_t)l * DM * INW, INW, 0, p.in[I_MIXN] + l * DM, (bf16_t*)(wl + W_IN), DM, 1024, r, scr, lane); continue; } r -= I_INA;
        if (r < I_INB) { tjob(p.in[I_WIN] + (size_t)l * DM * INW, INW, 1032, p.in[I_MIXN] + l * DM, (bf16_t*)(wl + W_IN) + (size_t)1024 * DM, DM, 1792, r, scr, lane); continue; } r -= I_INB;
        if (r < I_INC) { tjob(p.in[I_WIN] + (size_t)l * DM * INW, INW, 1024, p.in[I_MIXN] + l * DM, (bf16_t*)(wl + W_IN) + (size_t)2816 * DM, DM, 32, r, scr, lane); continue; } r -= I_INC;
        if (r < I_SQ) { tjob(p.in[I_WOUT] + (size_t)l * DM * DM, DM, 0, nullptr, (bf16_t*)(wl + W_OUT), DM, DM, r, scr, lane); continue; } r -= I_SQ;
        if (r < I_SQ) {
            const int kb = r >> 5, nb = r & 31; const int row = 64 * kb + lane; const float gsc = p.in[I_XN][l * DM + row];
            const f32x4* src = (const f32x4*)(p.in[I_XWQ] + (size_t)l * DM * DM + (size_t)row * DM + 32 * nb); u32x4* dst = (u32x4*)((bf16_t*)(wl + W_Q) + (size_t)row * DM + 32 * nb);
#pragma unroll
            for (int q4 = 0; q4 < 4; ++q4) { const f32x4 x0 = src[2 * q4] * gsc, x1 = src[2 * q4 + 1] * gsc; u32x4 w; w.x = cvtpk(x0[0], x0[1]); w.y = cvtpk(x0[2], x0[3]); w.z = cvtpk(x1[0], x1[1]); w.w = cvtpk(x1[2], x1[3]); dst[q4] = w; }
            continue; } r -= I_SQ;
        if (r < I_SQ) { tjob(p.in[I_XWO] + (size_t)l * DM * DM, DM, 0, nullptr, (bf16_t*)(wl + W_O), DM, DM, r, scr, lane); continue; } r -= I_SQ;
        if (r < I_GU) { tjob_gu(p.in[I_F2G] + (size_t)l * DM * FF, p.in[I_F2U] + (size_t)l * DM * FF, p.in[I_F2N] + l * DM, (bf16_t*)(wl + W_GU2), r, scr, lane); continue; } r -= I_GU;
        if (r < I_D) { tjob(p.in[I_F2D] + (size_t)l * FF * DM, DM, 0, nullptr, (bf16_t*)(wl + W_D2), FF, DM, r, scr, lane); continue; } r -= I_D;
        if (r < I_SQ) { tjob(p.in[I_XWKV] + (size_t)l * DM * 2 * DM, 2 * DM, 0, p.in[I_MEMN] + l * DM, wsb(c, OFF_WK) + (size_t)l * DM * DM, DM, DM, r, scr, lane); continue; } r -= I_SQ;
        tjob(p.in[I_XWKV] + (size_t)l * DM * 2 * DM, 2 * DM, DM, p.in[I_MEMN] + l * DM, wsb(c, OFF_WV) + (size_t)l * DM * DM, DM, DM, r, scr, lane);
    }
    for (int m = gw; m < MTOK + MMEM; m += NGW) {
        const bool isx = m < MTOK; const int row = isx ? m : m - MTOK;
        const f32x4* xr = (const f32x4*)((isx ? p.in[I_X] : p.in[I_MEM]) + (size_t)row * DM) + lane;
        unsigned long long* o8 = (unsigned long long*)((isx ? wsb(c, OFF_HB) : wsb(c, OFF_MEMB)) + (size_t)row * DM) + lane;
        float s = 0.f;
#pragma unroll
        for (int j = 0; j < 4; ++j) { const f32x4 v = xr[64 * j]; s += (v[0] * v[0] + v[1] * v[1]) + (v[2] * v[2] + v[3] * v[3]);
            o8[64 * j] = (unsigned long long)cvtpk(v[0], v[1]) | ((unsigned long long)cvtpk(v[2], v[3]) << 32); }
        s = wave_sum(s);
        if (lane == 0) { if (isx) { f32x4* q = (f32x4*)(ssbuf(c, 0) + (size_t)row * 16); q[0] = (f32x4){s, 0.f, 0.f, 0.f}; q[1] = (f32x4){0.f, 0.f, 0.f, 0.f}; q[2] = q[1]; q[3] = q[1]; } else wsf(c, OFF_RSM)[row] = rsqrtf(s * (1.f / DM) + 1e-6f); }
    }
    for (int l = 0; l < DEPTH; ++l) { u32x4* zz = (u32x4*)((bf16_t*)(c.ws + (size_t)l * W_LAYER + W_IN) + (size_t)2848 * DM); const int n16 = 224 * DM * 2 / 16;
        for (int i = c.bid * 512 + c.tid; i < n16; i += c.G * 512) zz[i] = (u32x4){0u, 0u, 0u, 0u}; }
    const int gt = c.bid * 512 + c.tid, NGT = c.G * 512;
    const float* t5 = p.in[I_T5];
    for (int i = gt; i < 4 * 4096; i += NGT) { const int h = i >> 12, d = i & 4095; wsf(c, OFF_DIFFB)[i] = t5[t5_bucket(d) * 8 + 4 + h] * LOG2E; }
    for (int i = gt; i < 3 * 4 * 132; i += NGT) { const int pp = i / (4 * 132), h = (i / 132) & 3, dl = i % 132; const int dil = pp == 0 ? 1 : (pp == 1 ? 4 : 16);
        wsf(c, OFF_DILB)[i] = dl <= 128 ? t5[t5_bucket(dl * dil) * 8 + h] * LOG2E : 0.f; }
    if (gt < DEPTH) { const float* lv = p.in[I_LAMV] + gt * 128; float a = 0.f, b = 0.f; for (int i = 0; i < 32; ++i) { a += lv[i] * lv[32 + i]; b += lv[64 + i] * lv[96 + i]; }
        const float lam_init = 0.8f - 0.6f * expf(-0.3f * (float)gt); wsf(c, OFF_LAM)[gt] = expf(a) - expf(b) + lam_init; }
}

DI void ph_gates(const Params& p, const Ctx& c0, int l) {
    const Ctx c = fresh(c0);
    LAS float* wg = (LAS float*)c.lds;
    const float* win = p.in[I_WIN] + (size_t)l * DM * INW; const float* gn = p.in[I_MIXN] + l * DM;
    for (int i = c.tid; i < DM * 8; i += 512) { const int k = i >> 3, cc = i & 7; wg[i] = win[(size_t)k * INW + 1024 + cc] * gn[k]; }
    __syncthreads();
    const float* h = c.out; const float* ss = ssbuf(c, 4 * l + 1); float* gates = wsf(c, OFF_GATES);
    for (int row = c.bid * 8 + c.wid; row < MTOK; row += c.G * 8) {
        float a[8];
#pragma unroll
        for (int j = 0; j < 8; ++j) a[j] = 0.f;
        const f32x4* xr = (const f32x4*)(h + (size_t)row * DM) + c.lane;
#pragma unroll
        for (int j = 0; j < 4; ++j) { const f32x4 v = xr[64 * j]; const int k0 = 4 * c.lane + 256 * j;
#pragma unroll
            for (int e = 0; e < 4; ++e) { const f32x4 w0 = *(const LAS f32x4*)(wg + (k0 + e) * 8), w1 = *(const LAS f32x4*)(wg + (k0 + e) * 8 + 4);
                a[0] += v[e] * w0[0]; a[1] += v[e] * w0[1]; a[2] += v[e] * w0[2]; a[3] += v[e] * w0[3]; a[4] += v[e] * w1[0]; a[5] += v[e] * w1[1]; a[6] += v[e] * w1[2]; a[7] += v[e] * w1[3]; } }
#pragma unroll
        for (int j = 0; j < 8; ++j) a[j] = wave_sum(a[j]);
        if (c.lane == 0) { const float rs = rowss(ss, row);
            *(f32x4*)(gates + (size_t)row * 8) = (f32x4){a[0] * rs, a[1] * rs, a[2] * rs, a[3] * rs}; *(f32x4*)(gates + (size_t)row * 8 + 4) = (f32x4){a[4] * rs, a[5] * rs, a[6] * rs, a[7] * rs}; }
    }
    __syncthreads();
}

DI void osm_update(f32x16& s, float& m, float& l, f32x16 (&O)[2], bf16x8& p0, bf16x8& p1) {
    float mx = fmaxf(s[0], s[1]);
#pragma unroll
    for (int i = 2; i < 16; ++i) mx = fmaxf(mx, s[i]);
    mx = fmaxf(mx, __shfl_xor(mx, 32));
    const float mn = fmaxf(m, mx);
    if (__any(mn > m)) {
        const float al = ex2(m - mn); l *= al;
#pragma unroll
        for (int i = 0; i < 16; ++i) { O[0][i] *= al; O[1][i] *= al; }
        m = mn;
    }
    float sum = 0.f;
#pragma unroll
    for (int i = 0; i < 16; ++i) { s[i] = ex2(s[i] - m); sum += s[i]; }
    l += sum;
    p0 = pack8(s[0], s[1], s[2], s[3], s[4], s[5], s[6], s[7]);
    p1 = pack8(s[8], s[9], s[10], s[11], s[12], s[13], s[14], s[15]);
}

constexpr int DK_KP = 144, DK_VP = 136;
constexpr int DF_KOFF = 0, DF_VOFF = 2 * 64 * DK_KP, DF_TOFF = DF_VOFF + 2 * 64 * DK_VP;
DI void diff_attn_task(const Params& p, const Ctx& c, int l, int b, int h, int qb) {
    const int tid = c.tid, lane = c.lane, wid = c.wid, r32 = lane & 31, hi = lane >> 5;
    const bf16_t* z = wsb(c, OFF_Z);
    const size_t rowbase = (size_t)b * SEQ;
    LAS unsigned char* lds = c.lds;
    LAS float* tbl = (LAS float*)(lds + DF_TOFF);
    __syncthreads();
    { const float* src = wsf(c, OFF_DIFFB) + h * 4096; for (int i = tid; i < 4096; i += 512) tbl[i] = src[i]; }
    const int qw0 = qb * 256 + wid * 32, qpos = qw0 + r32;
    bf16x8 qf[4];
    { const bf16_t* qp = z + (rowbase + qpos) * ZW + ZQD + h * 64;
#pragma unroll
      for (int s = 0; s < 4; ++s) qf[s] = *(const bf16x8*)(qp + 16 * s + 8 * hi); }
    f32x16 O1[2], O2[2];
#pragma unroll
    for (int i = 0; i < 16; ++i) { O1[0][i] = 0.f; O1[1][i] = 0.f; O2[0][i] = 0.f; O2[1][i] = 0.f; }
    float m1 = NEGBIG, m2 = NEGBIG, l1 = 0.f, l2 = 0.f;
    const int NT = (qb + 1) * 4;
    const int skey = tid >> 3, schunk = tid & 7;
    const bf16_t* kbase = z + (rowbase + skey) * ZW + ZKD + h * 64 + schunk * 8;
    const bf16_t* vbase = z + (rowbase + skey) * ZW + ZVD + h * 64 + schunk * 8;
    u32x4 kreg = *(const u32x4*)kbase, vreg = *(const u32x4*)vbase;
#define DF_WRITE(buf) do { *(LAS u32x4*)(lds + DF_KOFF + (buf) * 64 * DK_KP + skey * DK_KP + schunk * 16) = kreg; \
        LAS bf16_t* vt_ = (LAS bf16_t*)(lds + DF_VOFF + (buf) * 64 * DK_VP + skey * 2); \
        vt_[(schunk * 8 + 0) * (DK_VP / 2)] = (bf16_t)(vreg.x & 0xffff); vt_[(schunk * 8 + 1) * (DK_VP / 2)] = (bf16_t)(vreg.x >> 16); \
        vt_[(schunk * 8 + 2) * (DK_VP / 2)] = (bf16_t)(vreg.y & 0xffff); vt_[(schunk * 8 + 3) * (DK_VP / 2)] = (bf16_t)(vreg.y >> 16); \
        vt_[(schunk * 8 + 4) * (DK_VP / 2)] = (bf16_t)(vreg.z & 0xffff); vt_[(schunk * 8 + 5) * (DK_VP / 2)] = (bf16_t)(vreg.z >> 16); \
        vt_[(schunk * 8 + 6) * (DK_VP / 2)] = (bf16_t)(vreg.w & 0xffff); vt_[(schunk * 8 + 7) * (DK_VP / 2)] = (bf16_t)(vreg.w >> 16); } while (0)
    DF_WRITE(0);
    __syncthreads();
    for (int t = 0; t < NT; ++t) {
        const int buf = t & 1;
        if (t + 1 < NT) { kreg = *(const u32x4*)(kbase + (size_t)(t + 1) * 64 * ZW); vreg = *(const u32x4*)(vbase + (size_t)(t + 1) * 64 * ZW); }
        if (64 * t <= qw0 + 31) {
            const LAS unsigned char* kimg = lds + DF_KOFF + buf * 64 * DK_KP;
            const LAS unsigned char* vimg = lds + DF_VOFF + buf * 64 * DK_VP;
#pragma unroll
            for (int sub = 0; sub < 2; ++sub) {
                const int key0 = 64 * t + 32 * sub;
                if (key0 <= qw0 + 31) {
                    const LAS unsigned char* kr = kimg + (32 * sub + r32) * DK_KP + hi * 16;
                    const bf16x8 k0 = *(const LAS bf16x8*)(kr), k1 = *(const LAS bf16x8*)(kr + 32), k2 = *(const LAS bf16x8*)(kr + 64), k3 = *(const LAS bf16x8*)(kr + 96);
                    f32x16 s1, s2, bv;
                    const int dbase = qpos - key0 - 4 * hi;
                    if (key0 + 31 > qw0) {
#pragma unroll
                        for (int i = 0; i < 16; ++i) { const int d = dbase - ((i & 3) + 8 * (i >> 2)); const float bi = tbl[d < 0 ? 0 : d]; bv[i] = d < 0 ? NEGBIG : bi; }
                    } else {
#pragma unroll
                        for (int i = 0; i < 16; ++i) bv[i] = tbl[dbase - ((i & 3) + 8 * (i >> 2))];
                    }
                    s1 = MFMA32(k0, qf[0], bv); s1 = MFMA32(k1, qf[1], s1);
                    s2 = MFMA32(k2, qf[2], bv); s2 = MFMA32(k3, qf[3], s2);
                    bf16x8 pa0, pa1, pb0, pb1;
                    osm_update(s1, m1, l1, O1, pa0, pa1);
                    osm_update(s2, m2, l2, O2, pb0, pb1);
#pragma unroll
                    for (int dvt = 0; dvt < 2; ++dvt) {
                        const LAS unsigned char* vr = vimg + (32 * dvt + r32) * DK_VP + (32 * sub + 4 * hi) * 2;
                        const bf16x8 v0 = mk8(*(const LAS u32x2*)(vr), *(const LAS u32x2*)(vr + 16));
                        const bf16x8 v1 = mk8(*(const LAS u32x2*)(vr + 32), *(const LAS u32x2*)(vr + 48));
                        O1[dvt] = MFMA32(v0, pa0, O1[dvt]); O1[dvt] = MFMA32(v1, pa1, O1[dvt]);
                        O2[dvt] = MFMA32(v0, pb0, O2[dvt]); O2[dvt] = MFMA32(v1, pb1, O2[dvt]);
                    }
                }
            }
        }
        if (t + 1 < NT) DF_WRITE(buf ^ 1);
        __syncthreads();
    }
#undef DF_WRITE
    l1 += __shfl_xor(l1, 32); l2 += __shfl_xor(l2, 32);
    const float lam = wsf(c, OFF_LAM)[l];
    const float lam_init = 0.8f - 0.6f * expf(-0.3f * (float)l);
    const float i1 = 1.f / l1, i2 = lam / l2;
    float ssq = 0.f;
#pragma unroll
    for (int dvt = 0; dvt < 2; ++dvt)
#pragma unroll
        for (int i = 0; i < 16; ++i) { const float o = O1[dvt][i] * i1 - O2[dvt][i] * i2; O1[dvt][i] = o; ssq += o * o; }
    ssq += __shfl_xor(ssq, 32);
    const float rn = rsqrtf(ssq * (1.f / 64.f) + 1e-5f) * (1.f - lam_init);
    const float* sg = p.in[I_SUBLN] + l * 64;
    bf16_t* yrow = wsb(c, OFF_Y) + (rowbase + qpos) * DM + 768 + h * 64;
#pragma unroll
    for (int dvt = 0; dvt < 2; ++dvt)
#pragma unroll
        for (int g = 0; g < 4; ++g) {
            const int dv = 32 * dvt + 8 * g + 4 * hi; const f32x4 gg = *(const f32x4*)(sg + dv);
            u32x2 w; w.x = cvtpk(O1[dvt][4 * g] * rn * gg[0], O1[dvt][4 * g + 1] * rn * gg[1]); w.y = cvtpk(O1[dvt][4 * g + 2] * rn * gg[2], O1[dvt][4 * g + 3] * rn * gg[3]);
            *(u32x2*)(yrow + dv) = w;
        }
}

constexpr int DL_NK = 384, DL_KP = 144, DL_VP = 776;
constexpr int DL_KOFF = 0, DL_VOFF = DL_NK * DL_KP, DL_TOFF = DL_VOFF + 64 * DL_VP;
DI void dil_attn_task(const Params& p, const Ctx& c, int pat, int b, int h, int res, int mb) {
    const int dil = pat == 0 ? 1 : (pat == 1 ? 4 : 16);
    const int tid = c.tid, lane = c.lane, wid = c.wid, r32 = lane & 31, hi = lane >> 5;
    const bf16_t* z = wsb(c, OFF_Z);
    const size_t rowbase = (size_t)b * SEQ;
    LAS unsigned char* lds = c.lds;
    LAS float* tbl = (LAS float*)(lds + DL_TOFF);
    __syncthreads();
    if (tid < 132) tbl[tid] = wsf(c, OFF_DILB)[(pat * 4 + h) * 132 + tid];
    const int mk0 = 256 * mb - 128;
    {
        u32x4 kreg[6], vreg[6];
#pragma unroll
        for (int it = 0; it < 6; ++it) {
            const int idx = tid + 512 * it, key = idx >> 3, chunk = idx & 7, mk = mk0 + key;
            kreg[it] = (u32x4){0u, 0u, 0u, 0u}; vreg[it] = (u32x4){0u, 0u, 0u, 0u};
            if (mk >= 0) { const bf16_t* rp = z + (rowbase + (size_t)mk * dil + res) * ZW + h * 64 + chunk * 8; kreg[it] = *(const u32x4*)(rp + ZKC); vreg[it] = *(const u32x4*)(rp + ZVC); }
        }
#pragma unroll
        for (int it = 0; it < 6; ++it) {
            const int idx = tid + 512 * it, key = idx >> 3, chunk = idx & 7;
            *(LAS u32x4*)(lds + DL_KOFF + key * DL_KP + chunk * 16) = kreg[it];
            LAS bf16_t* vt_ = (LAS bf16_t*)(lds + DL_VOFF + key * 2);
            vt_[(chunk * 8 + 0) * (DL_VP / 2)] = (bf16_t)(vreg[it].x & 0xffff); vt_[(chunk * 8 + 1) * (DL_VP / 2)] = (bf16_t)(vreg[it].x >> 16);
            vt_[(chunk * 8 + 2) * (DL_VP / 2)] = (bf16_t)(vreg[it].y & 0xffff); vt_[(chunk * 8 + 3) * (DL_VP / 2)] = (bf16_t)(vreg[it].y >> 16);
            vt_[(chunk * 8 + 4) * (DL_VP / 2)] = (bf16_t)(vreg[it].z & 0xffff); vt_[(chunk * 8 + 5) * (DL_VP / 2)] = (bf16_t)(vreg[it].z >> 16);
            vt_[(chunk * 8 + 6) * (DL_VP / 2)] = (bf16_t)(vreg[it].w & 0xffff); vt_[(chunk * 8 + 7) * (DL_VP / 2)] = (bf16_t)(vreg[it].w >> 16);
        }
    }
    const int mq = 256 * mb + 32 * wid + r32;
    const size_t qtok = rowbase + (size_t)mq * dil + res;
    bf16x8 qf[4];
    { const bf16_t* qp = z + qtok * ZW + ZQC + h * 64;
#pragma unroll
      for (int s = 0; s < 4; ++s) qf[s] = *(const bf16x8*)(qp + 16 * s + 8 * hi); }
    __syncthreads();
    f32x16 O[2];
#pragma unroll
    for (int i = 0; i < 16; ++i) { O[0][i] = 0.f; O[1][i] = 0.f; }
    float m = NEGBIG, lsum = 0.f;
    for (int j = 0; j < 5; ++j) {
        const int kt = wid + j;
        const LAS unsigned char* kr = lds + DL_KOFF + (32 * kt + r32) * DL_KP + hi * 16;
        f32x16 s;
        const int dbase = 128 - 32 * j + r32 - 4 * hi;
        const int mkb = mk0 + 32 * kt + 4 * hi;
        if (j == 0 || j == 4 || mb == 0) {
#pragma unroll
            for (int i = 0; i < 16; ++i) { const int cc = (i & 3) + 8 * (i >> 2); const int dl = dbase - cc; const bool ok = (dl >= 0) && (dl <= 128) && (mkb + cc >= 0);
                const int dc = dl < 0 ? 0 : (dl > 128 ? 128 : dl); s[i] = ok ? tbl[dc] : NEGBIG; }
        } else {
#pragma unroll
            for (int i = 0; i < 16; ++i) s[i] = tbl[dbase - ((i & 3) + 8 * (i >> 2))];
        }
#pragma unroll
        for (int ks = 0; ks < 4; ++ks) s = MFMA32(*(const LAS bf16x8*)(kr + 32 * ks), qf[ks], s);
        bf16x8 p0, p1;
        osm_update(s, m, lsum, O, p0, p1);
#pragma unroll
        for (int dvt = 0; dvt < 2; ++dvt) {
            const LAS unsigned char* vr = lds + DL_VOFF + (32 * dvt + r32) * DL_VP + (32 * kt + 4 * hi) * 2;
            const bf16x8 v0 = mk8(*(const LAS u32x2*)(vr), *(const LAS u32x2*)(vr + 16));
            const bf16x8 v1 = mk8(*(const LAS u32x2*)(vr + 32), *(const LAS u32x2*)(vr + 48));
            O[dvt] = MFMA32(v0, p0, O[dvt]); O[dvt] = MFMA32(v1, p1, O[dvt]);
        }
    }
    lsum += __shfl_xor(lsum, 32);
    const float inv = 1.f / lsum, lse = m + log2f(lsum);
    if (pat != 0) {
        bf16_t* orow = ((bf16_t*)((unsigned char*)c.out + (size_t)64 * 64 * 4096 * 4)) + ((size_t)(pat - 1) * MTOK + qtok) * 256 + h * 64;
#pragma unroll
        for (int dvt = 0; dvt < 2; ++dvt)
#pragma unroll
            for (int g = 0; g < 4; ++g) { u32x2 w; w.x = cvtpk(O[dvt][4 * g] * inv, O[dvt][4 * g + 1] * inv); w.y = cvtpk(O[dvt][4 * g + 2] * inv, O[dvt][4 * g + 3] * inv);
                *(u32x2*)(orow + 32 * dvt + 8 * g + 4 * hi) = w; }
        if (hi == 0) wsf(c, OFF_LSEP)[((size_t)(pat - 1) * MTOK + qtok) * 4 + h] = lse;
    } else {
        const float ls1 = wsf(c, OFF_LSEP)[qtok * 4 + h], ls2 = wsf(c, OFF_LSEP)[((size_t)MTOK + qtok) * 4 + h];
        const float mm = fmaxf(lse, fmaxf(ls1, ls2));
        const float w0 = ex2(lse - mm), w1 = ex2(ls1 - mm), w2 = ex2(ls2 - mm), wi = 1.f / (w0 + w1 + w2);
        const float a0 = w0 * wi * inv, a1 = w1 * wi, a2 = w2 * wi;
        const bf16_t* o1 = ((bf16_t*)((unsigned char*)c.out + (size_t)64 * 64 * 4096 * 4)) + qtok * 256 + h * 64; const bf16_t* o2 = o1 + (size_t)MTOK * 256;
        bf16_t* yrow = wsb(c, OFF_Y) + qtok * DM + 512 + h * 64;
#pragma unroll
        for (int dvt = 0; dvt < 2; ++dvt)
#pragma unroll
            for (int g = 0; g < 4; ++g) { const int dv = 32 * dvt + 8 * g + 4 * hi; const u32x2 x1 = *(const u32x2*)(o1 + dv), x2 = *(const u32x2*)(o2 + dv);
                const float r0 = O[dvt][4 * g] * a0 + bflo(x1.x) * a1 + bflo(x2.x) * a2, r1 = O[dvt][4 * g + 1] * a0 + bfhi(x1.x) * a1 + bfhi(x2.x) * a2;
                const float r2 = O[dvt][4 * g + 2] * a0 + bflo(x1.y) * a1 + bflo(x2.y) * a2, r3 = O[dvt][4 * g + 3] * a0 + bfhi(x1.y) * a1 + bfhi(x2.y) * a2;
                u32x2 w; w.x = cvtpk(r0, r1); w.y = cvtpk(r2, r3); *(u32x2*)(yrow + dv) = w; }
    }
}

DI void pool_x(const bf16_t* bp0, int w, int cnt, float icnt, bf16x8 (&xf)[4]) {
    float sum[4][8]; u32x4 cur[4];
#pragma unroll
    for (int ks = 0; ks < 4; ++ks) {
        const bf16_t* bp = bp0 + 16 * ks;
        cur[ks] = *(const u32x4*)bp; const u32x4 prv = (cnt > 1) ? *(const u32x4*)(bp - ZW) : (u32x4){0u, 0u, 0u, 0u};
        sum[ks][0] = bflo(cur[ks].x) + bflo(prv.x); sum[ks][1] = bfhi(cur[ks].x) + bfhi(prv.x); sum[ks][2] = bflo(cur[ks].y) + bflo(prv.y); sum[ks][3] = bfhi(cur[ks].y) + bfhi(prv.y);
        sum[ks][4] = bflo(cur[ks].z) + bflo(prv.z); sum[ks][5] = bfhi(cur[ks].z) + bfhi(prv.z); sum[ks][6] = bflo(cur[ks].w) + bflo(prv.w); sum[ks][7] = bfhi(cur[ks].w) + bfhi(prv.w);
    }
#pragma unroll 1
    for (int j0 = 2; j0 < w; j0 += 2) {
        u32x4 v0[4], v1[4];
#pragma unroll
        for (int ks = 0; ks < 4; ++ks) { v0[ks] = (u32x4){0u, 0u, 0u, 0u}; v1[ks] = (u32x4){0u, 0u, 0u, 0u};
            if (j0 < cnt) v0[ks] = *(const u32x4*)(bp0 + 16 * ks - (size_t)j0 * ZW);
            if (j0 + 1 < cnt) v1[ks] = *(const u32x4*)(bp0 + 16 * ks - (size_t)(j0 + 1) * ZW); }
#pragma unroll
        for (int ks = 0; ks < 4; ++ks) {
            sum[ks][0] += bflo(v0[ks].x) + bflo(v1[ks].x); sum[ks][1] += bfhi(v0[ks].x) + bfhi(v1[ks].x); sum[ks][2] += bflo(v0[ks].y) + bflo(v1[ks].y); sum[ks][3] += bfhi(v0[ks].y) + bfhi(v1[ks].y);
            sum[ks][4] += bflo(v0[ks].z) + bflo(v1[ks].z); sum[ks][5] += bfhi(v0[ks].z) + bfhi(v1[ks].z); sum[ks][6] += bflo(v0[ks].w) + bflo(v1[ks].w); sum[ks][7] += bfhi(v0[ks].w) + bfhi(v1[ks].w); }
    }
#pragma unroll
    for (int ks = 0; ks < 4; ++ks)
        xf[ks] = pack8(sum[ks][0] * icnt - bflo(cur[ks].x), sum[ks][1] * icnt - bfhi(cur[ks].x), sum[ks][2] * icnt - bflo(cur[ks].y), sum[ks][3] * icnt - bfhi(cur[ks].y),
                       sum[ks][4] * icnt - bflo(cur[ks].z), sum[ks][5] * icnt - bfhi(cur[ks].z), sum[ks][6] * icnt - bflo(cur[ks].w), sum[ks][7] * icnt - bfhi(cur[ks].w));
}
DI void pool_task(const Params& p, const Ctx& c, int l, int wt) {
    const int lane = c.lane, r32 = lane & 31, hi = lane >> 5;
    const int g = (wt + (wt >> 11)) & 3, rt = wt >> 2;
    const size_t row = (size_t)rt * 32 + r32; const int t = (int)(row & (SEQ - 1));
    const int w = 2 << g, cnt = (t + 1 < w) ? t + 1 : w; const float icnt = 1.f / (float)cnt;
    const bf16_t* z = wsb(c, OFF_Z);
    bf16x8 xf[4];
    const bf16_t* bp0 = z + row * ZW + ZPB + g * 64 + 8 * hi;
    pool_x(bp0, w, cnt, icnt, xf);
    const float* pw = p.in[I_POOLW] + ((size_t)l * 4 + g) * 64 * 64;
    const float* psc = p.in[I_POOLS] + l * 256 + g * 64;
    bf16_t* yrow = wsb(c, OFF_Y) + row * DM + 256 + g * 64;
#pragma unroll
    for (int dt = 0; dt < 2; ++dt) {
        f32x16 acc;
#pragma unroll
        for (int i = 0; i < 16; ++i) acc[i] = 0.f;
#pragma unroll
        for (int ks = 0; ks < 4; ++ks) {
            const float* wp = pw + (size_t)(16 * ks + 8 * hi) * 64 + 32 * dt + r32;
            const bf16x8 wf = pack8(wp[0], wp[64], wp[128], wp[192], wp[256], wp[320], wp[384], wp[448]);
            acc = MFMA32(wf, xf[ks], acc);
        }
#pragma unroll
        for (int gq = 0; gq < 4; ++gq) { const int dd = 32 * dt + 8 * gq + 4 * hi; const f32x4 sc = *(const f32x4*)(psc + dd);
            u32x2 wv; wv.x = cvtpk(acc[4 * gq] * sc[0], acc[4 * gq + 1] * sc[1]); wv.y = cvtpk(acc[4 * gq + 2] * sc[2], acc[4 * gq + 3] * sc[3]); *(u32x2*)(yrow + dd) = wv; }
    }
}

DI float scan_add(float v, int lane) {
#pragma unroll
    for (int o = 1; o < 64; o <<= 1) { const float n = __shfl_up(v, o); if (lane >= o) v += n; }
    return v;
}
DI float scan_max(float v, int lane) {
#pragma unroll
    for (int o = 1; o < 64; o <<= 1) { const float n = __shfl_up(v, o); if (lane >= o) v = fmaxf(v, n); }
    return v;
}
DI float log_sigmoid(float x) { return fminf(x, 0.f) - log1pf(expf(-fabsf(x))); }
DI void conv8(const bf16_t* zp, int t, const float* cw, const float* cb, float scale, float (&o)[8]) {
    const f32x4 b0 = *(const f32x4*)cb, b1 = *(const f32x4*)(cb + 4);
    o[0] = b0[0]; o[1] = b0[1]; o[2] = b0[2]; o[3] = b0[3]; o[4] = b1[0]; o[5] = b1[1]; o[6] = b1[2]; o[7] = b1[3];
#pragma unroll
    for (int tap = 0; tap < 4; ++tap) {
        if (t - 3 + tap >= 0) {
            const u32x4 v = *(const u32x4*)(zp - (size_t)(3 - tap) * ZW);
            const f32x4 w0 = *(const f32x4*)(cw + tap * 512), w1 = *(const f32x4*)(cw + tap * 512 + 4);
            o[0] += bflo(v.x) * w0[0]; o[1] += bfhi(v.x) * w0[1]; o[2] += bflo(v.y) * w0[2]; o[3] += bfhi(v.y) * w0[3];
            o[4] += bflo(v.z) * w1[0]; o[5] += bfhi(v.z) * w1[1]; o[6] += bflo(v.w) * w1[2]; o[7] += bfhi(v.w) * w1[3];
        }
    }
#pragma unroll
    for (int e = 0; e < 8; ++e) o[e] = silu_f(o[e]) * scale;
    asm volatile("" ::: "memory");
}
DI void conv_frag4(const bf16_t* zp, int t, const LAS float* cw, const LAS float* cb, int hi, float scale, bf16x8 (&out)[4]) {
    asm volatile("" ::: "memory");
#pragma unroll
    for (int kh = 0; kh < 2; ++kh) {
        u32x4 v[2][4];
#pragma unroll
        for (int k2 = 0; k2 < 2; ++k2)
#pragma unroll
            for (int tap = 0; tap < 4; ++tap) { v[k2][tap] = (u32x4){0u, 0u, 0u, 0u}; if (t - 3 + tap >= 0) v[k2][tap] = *(const u32x4*)(zp + 16 * (2 * kh + k2) - (size_t)(3 - tap) * ZW); }
#pragma unroll
        for (int k2 = 0; k2 < 2; ++k2) {
            const int ks = 2 * kh + k2, d0 = 16 * ks + 8 * hi;
            const f32x4 b0 = *(const LAS f32x4*)(cb + d0), b1 = *(const LAS f32x4*)(cb + d0 + 4);
            float o[8] = {b0[0], b0[1], b0[2], b0[3], b1[0], b1[1], b1[2], b1[3]};
#pragma unroll
            for (int tap = 0; tap < 4; ++tap) {
                const f32x4 w0 = *(const LAS f32x4*)(cw + tap * 64 + d0), w1 = *(const LAS f32x4*)(cw + tap * 64 + d0 + 4); const u32x4 x = v[k2][tap];
                o[0] += bflo(x.x) * w0[0]; o[1] += bfhi(x.x) * w0[1]; o[2] += bflo(x.y) * w0[2]; o[3] += bfhi(x.y) * w0[3];
                o[4] += bflo(x.z) * w1[0]; o[5] += bfhi(x.z) * w1[1]; o[6] += bflo(x.w) * w1[2]; o[7] += bfhi(x.w) * w1[3];
            }
            out[ks] = pack8(silu_f(o[0]) * scale, silu_f(o[1]) * scale, silu_f(o[2]) * scale, silu_f(o[3]) * scale, silu_f(o[4]) * scale, silu_f(o[5]) * scale, silu_f(o[6]) * scale, silu_f(o[7]) * scale);
        }
        asm volatile("" ::: "memory");
    }
}
DI void mlstm_a_task(const Params& p, const Ctx& c, int l, int task) {
    const int lane = c.lane, r32 = lane & 31, hi = lane >> 5;
    const int bh = task >> 6, ch = task & 63, b = bh >> 2, h = bh & 3, t0 = ch * 64;
    const size_t rowbase = (size_t)b * SEQ;
    const bf16_t* z = wsb(c, OFF_Z);
    const float* gates = wsf(c, OFF_GATES) + (rowbase + t0 + lane) * 8;
    const float* gb = p.in[I_GATEB] + l * 8;
    const float ig = gates[h] + gb[h], lf = log_sigmoid(gates[4 + h] + gb[4 + h]);
    const float bcs = scan_add(lf, lane);
    const float gp = ig - bcs;
    const float mu = wave_max(gp);
    const float ws_ = expf(gp - mu);
    const float Bc = __shfl(bcs, 63);
    if (lane == 0) { wsf(c, OFF_SCAL)[task] = Bc; wsf(c, OFF_SCAL)[4096 + task] = mu; }
    const float* cwl = p.in[I_CONVW] + (size_t)l * 4 * 512; const float* cbl = p.in[I_CONVB] + l * 512;
    f32x16 acc[2][2];
#pragma unroll
    for (int a = 0; a < 2; ++a)
#pragma unroll
        for (int bb = 0; bb < 2; ++bb)
#pragma unroll
            for (int i = 0; i < 16; ++i) acc[a][bb][i] = 0.f;
    float nsum[2] = {0.f, 0.f};
#pragma unroll
    for (int ks = 0; ks < 4; ++ks) {
        const int s0 = 16 * ks + 8 * hi;
        float wv[8];
#pragma unroll
        for (int j = 0; j < 8; ++j) wv[j] = __shfl(ws_, s0 + j);
        bf16x8 kf[2];
#pragma unroll
        for (int it = 0; it < 2; ++it) {
            const int chn = 256 + h * 64 + 32 * it + r32;
            const float w0 = cwl[chn], w1 = cwl[512 + chn], w2 = cwl[1024 + chn], w3 = cwl[1536 + chn], cb = cbl[chn];
            const bf16_t* kp = z + (rowbase + t0 + s0) * ZW + ZKA + h * 64 + 32 * it + r32;
            float raw[11];
#pragma unroll
            for (int x = 0; x < 11; ++x) raw[x] = (t0 + s0 - 3 + x >= 0) ? bf2f(kp[(long)(x - 3) * ZW]) : 0.f;
            float kk[8];
#pragma unroll
            for (int j = 0; j < 8; ++j) { const float o = cb + w0 * raw[j] + w1 * raw[j + 1] + w2 * raw[j + 2] + w3 * raw[j + 3]; kk[j] = silu_f(o) * 0.125f * wv[j]; nsum[it] += kk[j]; }
            kf[it] = pack8(kk[0], kk[1], kk[2], kk[3], kk[4], kk[5], kk[6], kk[7]);
        }
#pragma unroll
        for (int et = 0; et < 2; ++et) {
            const bf16_t* vp = z + (rowbase + t0 + s0) * ZW + ZVA + h * 64 + 32 * et + r32;
            u32x4 w; w.x = (unsigned)vp[0] | ((unsigned)vp[ZW] << 16); w.y = (unsigned)vp[2 * ZW] | ((unsigned)vp[3 * ZW] << 16);
            w.z = (unsigned)vp[4 * ZW] | ((unsigned)vp[5 * ZW] << 16); w.w = (unsigned)vp[6 * ZW] | ((unsigned)vp[7 * ZW] << 16);
            const bf16x8 vf = __builtin_bit_cast(bf16x8, w);
            acc[et][0] = MFMA32(vf, kf[0], acc[et][0]); acc[et][1] = MFMA32(vf, kf[1], acc[et][1]);
        }
    }
    float* D = ((float*)c.out) + (size_t)task * 4096;
#pragma unroll
    for (int et = 0; et < 2; ++et)
#pragma unroll
        for (int it = 0; it < 2; ++it)
#pragma unroll
            for (int i = 0; i < 16; ++i) D[(32 * et + crow(i, hi)) * 64 + 32 * it + r32] = acc[et][it][i];
    nsum[0] += __shfl_xor(nsum[0], 32); nsum[1] += __shfl_xor(nsum[1], 32);
    if (hi == 0) { wsf(c, OFF_NST)[(size_t)task * 64 + r32] = nsum[0]; wsf(c, OFF_NST)[(size_t)task * 64 + 32 + r32] = nsum[1]; }
}
DI void mlstm_scan(const Params& p, const Ctx& c) {
    const float* Bc = wsf(c, OFF_SCAL); const float* mu = Bc + 4096; float* mprev = wsf(c, OFF_SCAL) + 8192;
    float* D = ((float*)c.out); float* N = wsf(c, OFF_NST);
    LAS float* cwl = (LAS float*)c.lds; LAS float* swl = cwl + 64;
    for (int task = c.bid; task < 256; task += c.G) {
        const int bh = task >> 2, q = task & 3;
        __syncthreads();
        if (c.wid == 0) {
            const float B = Bc[bh * 64 + c.lane], u = mu[bh * 64 + c.lane];
            float m = 0.f, mycw = 0.f, mysw = 0.f, mymp = 0.f;
            for (int ch = 0; ch < 64; ++ch) {
                const float Bs = __shfl(B, ch), us = __shfl(u, ch);
                const float mnew = fmaxf(Bs + m, Bs + us);
                const float cw = expf(Bs + m - mnew), sw = expf(Bs + us - mnew);
                if (c.lane == ch) { mycw = cw; mysw = sw; mymp = m; }
                m = mnew;
            }
            cwl[c.lane] = mycw; swl[c.lane] = mysw;
            if (q == 0) mprev[bh * 64 + c.lane] = mymp;
        }
        __syncthreads();
        for (int idx = q * 1040 + c.tid; idx < (q + 1) * 1040; idx += 512) {
            float* base = idx < 4096 ? D + (size_t)bh * 64 * 4096 + idx : N + (size_t)bh * 64 * 64 + (idx - 4096);
            const size_t stride = idx < 4096 ? 4096 : 64;
            float d[64];
#pragma unroll
            for (int ch = 0; ch < 64; ++ch) d[ch] = base[(size_t)ch * stride];
            float C = 0.f;
#pragma unroll
            for (int ch = 0; ch < 64; ++ch) { const float dv = d[ch]; base[(size_t)ch * stride] = C; C = cwl[ch] * C + swl[ch] * dv; }
        }
    }
}
DI void mlstm_c_task(const Params& p, const Ctx& c, int l, int task) {
    const int lane = c.lane, r32 = lane & 31, hi = lane >> 5;
    const int bh = task >> 6, ch = task & 63, b = bh >> 2, h = bh & 3, t0 = ch * 64;
    const size_t rowbase = (size_t)b * SEQ;
    const bf16_t* z = wsb(c, OFF_Z);
    const float* gates = wsf(c, OFF_GATES) + (rowbase + t0 + lane) * 8;
    const float* gb = p.in[I_GATEB] + l * 8;
    const float ig = gates[h] + gb[h], lf = log_sigmoid(gates[4 + h] + gb[4 + h]);
    const float bcs = scan_add(lf, lane);
    const float gp = ig - bcs;
    const float mp = wsf(c, OFF_SCAL)[8192 + task];
    const float pm = scan_max(gp, lane);
    const float mt = bcs + fmaxf(mp, pm);
    const float bm = bcs - mt;
    const float iw = expf(bcs + mp - mt);
    const float flo = expf(-mt);
    const float* cwl = p.in[I_CONVW] + (size_t)l * 4 * 512; const float* cbl = p.in[I_CONVB] + l * 512;
    const float* Ct = ((float*)c.out) + (size_t)task * 4096;
    const float* nst = wsf(c, OFF_NST) + (size_t)task * 64;
    const float* ng = p.in[I_MLN] + l * 256 + h * 64;
#pragma unroll 1
    for (int tt = 0; tt < 2; ++tt) {
        const int tq = 32 * tt + r32;
        const float bm_t = __shfl(bm, tq), iw_t = __shfl(iw, tq), flo_t = __shfl(flo, tq);
        bf16x8 qf[4]; float qn = 0.f;
#pragma unroll
        for (int ks = 0; ks < 4; ++ks) { float o[8]; const int d0 = 16 * ks + 8 * hi;
            conv8(z + (rowbase + t0 + tq) * ZW + ZQA + h * 64 + d0, t0 + tq, cwl + h * 64 + d0, cbl + h * 64 + d0, 1.f, o);
            qf[ks] = pack8(o[0], o[1], o[2], o[3], o[4], o[5], o[6], o[7]);
            const u32x4 qw = __builtin_bit_cast(u32x4, qf[ks]);
            const f32x4 n0 = *(const f32x4*)(nst + d0), n1 = *(const f32x4*)(nst + d0 + 4);
            qn += bflo(qw.x) * n0[0] + bfhi(qw.x) * n0[1] + bflo(qw.y) * n0[2] + bfhi(qw.y) * n0[3] + bflo(qw.z) * n1[0] + bfhi(qw.z) * n1[1] + bflo(qw.w) * n1[2] + bfhi(qw.w) * n1[3]; }
        qn += __shfl_xor(qn, 32);
        f32x16 num[2];
#pragma unroll
        for (int i = 0; i < 16; ++i) { num[0][i] = 0.f; num[1][i] = 0.f; }
#pragma unroll
        for (int et = 0; et < 2; ++et)
#pragma unroll
            for (int ks = 0; ks < 4; ++ks) { const float* cp = Ct + (size_t)(32 * et + r32) * 64 + 16 * ks + 8 * hi; const f32x4 c0 = *(const f32x4*)cp, c1 = *(const f32x4*)(cp + 4);
                num[et] = MFMA32(pack8(c0[0], c0[1], c0[2], c0[3], c1[0], c1[1], c1[2], c1[3]), qf[ks], num[et]); }
#pragma unroll
        for (int i = 0; i < 16; ++i) { num[0][i] *= iw_t; num[1][i] *= iw_t; }
        float dsum = 0.f;
#pragma unroll 1
        for (int st = 0; st <= tt; ++st) {
            f32x16 s;
#pragma unroll
            for (int i = 0; i < 16; ++i) s[i] = 0.f;
#pragma unroll
            for (int ks = 0; ks < 4; ++ks) { float o[8]; const int sk = 32 * st + r32, d0 = 16 * ks + 8 * hi;
                conv8(z + (rowbase + t0 + sk) * ZW + ZKA + h * 64 + d0, t0 + sk, cwl + 256 + h * 64 + d0, cbl + 256 + h * 64 + d0, 0.125f, o);
                s = MFMA32(pack8(o[0], o[1], o[2], o[3], o[4], o[5], o[6], o[7]), qf[ks], s); }
#pragma unroll
            for (int i = 0; i < 16; ++i) { const int sp = 32 * st + crow(i, hi); const float gs = __shfl(gp, sp);
                const float wgt = (sp <= tq) ? expf(gs + bm_t) : 0.f; s[i] *= wgt; dsum += s[i]; }
            const bf16x8 p0 = pack8(s[0], s[1], s[2], s[3], s[4], s[5], s[6], s[7]), p1 = pack8(s[8], s[9], s[10], s[11], s[12], s[13], s[14], s[15]);
#pragma unroll
            for (int et = 0; et < 2; ++et)
#pragma unroll
                for (int k2 = 0; k2 < 2; ++k2) {
                    const bf16_t* vp = z + (rowbase + t0 + 32 * st + 16 * k2 + 4 * hi) * ZW + ZVA + h * 64 + 32 * et + r32;
                    u32x4 w; w.x = (unsigned)vp[0] | ((unsigned)vp[ZW] << 16); w.y = (unsigned)vp[2 * ZW] | ((unsigned)vp[3 * ZW] << 16);
                    w.z = (unsigned)vp[8 * ZW] | ((unsigned)vp[9 * ZW] << 16); w.w = (unsigned)vp[10 * ZW] | ((unsigned)vp[11 * ZW] << 16);
                    num[et] = MFMA32(__builtin_bit_cast(bf16x8, w), k2 == 0 ? p0 : p1, num[et]);
                }
        }
        dsum += __shfl_xor(dsum, 32);
        const float den = iw_t * qn + dsum;
        const float idn = 1.f / fmaxf(fabsf(den), flo_t);
        float sm = 0.f;
#pragma unroll
        for (int et = 0; et < 2; ++et)
#pragma unroll
            for (int i = 0; i < 16; ++i) { const float hv = num[et][i] * idn; num[et][i] = hv; sm += hv; }
        sm += __shfl_xor(sm, 32);
        const float mean = sm * (1.f / 64.f);
        float vs = 0.f;
#pragma unroll
        for (int et = 0; et < 2; ++et)
#pragma unroll
            for (int i = 0; i < 16; ++i) { const float d = num[et][i] - mean; num[et][i] = d; vs += d * d; }
        vs += __shfl_xor(vs, 32);
        const float rstd = rsqrtf(vs * (1.f / 64.f) + 1e-6f);
        const size_t tok = rowbase + t0 + tq;
        const bf16_t* orow = z + tok * ZW + ZOA + h * 64; bf16_t* yrow = wsb(c, OFF_Y) + tok * DM + h * 64;
#pragma unroll
        for (int et = 0; et < 2; ++et)
#pragma unroll
            for (int g = 0; g < 4; ++g) { const int e = 32 * et + 8 * g + 4 * hi; const f32x4 gg = *(const f32x4*)(ng + e); const u32x2 ov = *(const u32x2*)(orow + e);
                const float y0 = num[et][4 * g] * rstd * gg[0] * sigmoid_f(bflo(ov.x)), y1 = num[et][4 * g + 1] * rstd * gg[1] * sigmoid_f(bfhi(ov.x));
                const float y2 = num[et][4 * g + 2] * rstd * gg[2] * sigmoid_f(bflo(ov.y)), y3 = num[et][4 * g + 3] * rstd * gg[3] * sigmoid_f(bfhi(ov.y));
                u32x2 w; w.x = cvtpk(y0, y1); w.y = cvtpk(y2, y3); *(u32x2*)(yrow + e) = w; }
    }
}

DI void ph_mix1(const Params& p, const Ctx& c0, int l) {
    const Ctx c = fresh(c0);
    REP(R_DIFF) for (int pt = c.bid; pt < 512; pt += c.G) { const int bh = pt >> 3, s = pt & 7; diff_attn_task(p, c, l, bh >> 2, bh & 3, 15 - s); diff_attn_task(p, c, l, bh >> 2, bh & 3, s); }
    REP(R_DIL) for (int i = c.bid; i < 1024; i += c.G) { const int bh = i >> 4, rest = i & 15; dil_attn_task(p, c, 1, bh >> 2, bh & 3, rest >> 2, rest & 3); }
    REP(R_DIL) for (int i = c.bid; i < 1024; i += c.G) { const int bh = i >> 4; dil_attn_task(p, c, 2, bh >> 2, bh & 3, i & 15, 0); }
    __syncthreads();
    REP(R_POOL) for (int wt = c.bid * 8 + c.wid; wt < 8192; wt += c.G * 8) pool_task(p, c, l, wt);
    REP(R_MLA) for (int tk = c.bid * 8 + c.wid; tk < 4096; tk += c.G * 8) mlstm_a_task(p, c, l, tk);
}
DI void ph_mix2(const Params& p, const Ctx& c0, int l) {
    const Ctx c = fresh(c0);
    mlstm_scan(p, c);
    REP(R_DIL) for (int i = c.bid; i < 1024; i += c.G) { const int bh = i >> 4; dil_attn_task(p, c, 0, bh >> 2, bh & 3, 0, i & 15); }
    __syncthreads();
}
DI void ph_mix3(const Params& p, const Ctx& c0, int l) {
    const Ctx c = fresh(c0);
    REP(R_MLC) for (int tk = c.bid * 8 + c.wid; tk < 4096; tk += c.G * 8) mlstm_c_task(p, c, l, tk);
}
DI void ph_final(const Params& p, const Ctx& c0) {
    const Ctx c = fresh(c0);
    const float* ss = ssbuf(c, 16); const float* g = p.in[I_FINN]; const bf16_t* hb = wsb(c, OFF_HB);
    for (int row = c.bid * 8 + c.wid; row < MTOK; row += c.G * 8) {
        const float rs = rowss(ss, row);
        f32x4* xr = (f32x4*)(c.out + (size_t)row * DM) + c.lane; const f32x4* gr = (const f32x4*)g + c.lane; const u32x2* hr = (const u32x2*)(hb + (size_t)row * DM) + c.lane;
#pragma unroll
        for (int j = 0; j < 4; ++j) { const u32x2 hv = hr[64 * j]; const f32x4 gg = gr[64 * j];
            xr[64 * j] = (f32x4){bflo(hv.x) * rs * gg[0], bfhi(hv.x) * rs * gg[1], bflo(hv.y) * rs * gg[2], bfhi(hv.y) * rs * gg[3]}; }
    }
}

DI void ph_ffn_up(const Params& p, const Ctx& c0, int l, int which) {
    const Ctx c = fresh(c0);
    pg8::Gemm g = pg8::plain_gemm(wsb(c, OFF_HB), (const bf16_t*)(c.ws + (size_t)l * W_LAYER + (which ? W_GU2 : W_GU1)), MTOK, 2 * FF, DM); g.ocol_step = 128;
    pg8::Order S; S.init(g, c.G, c.bid);
    pg8::EpiSwiGLU E{wsb(c, OFF_Z), FF, ssbuf(c, 4 * l + (which ? 3 : 0))};
    pg8::gemm_phase(c.lds, g, S, E);
}
DI void ph_resid(const Params& p, const Ctx& c0, const bf16_t* A, const bf16_t* Bt, int K, int ss_out, float alpha) {
    const Ctx c = fresh(c0);
    pg8::Gemm g = pg8::plain_gemm(A, Bt, MTOK, DM, K);
    if (K == FF) { g.lda = 64; g.kstepA = 256 * 64 * 2; g.a_pmdiv = (long)(FF / 64) * 256 * 64; g.imgA = 1; }
    pg8::Order S; S.init(g, c.G, c.bid);
    pg8::EpiResid E{wsb(c, OFF_HB), ssbuf(c, ss_out), alpha};
    pg8::gemm_phase(c.lds, g, S, E);
}
DI void ph_kv(const Params& p, const Ctx& c0) {
    const Ctx c = fresh(c0);
    { pg8::Gemm g = pg8::plain_gemm(wsb(c, OFF_MEMB), wsb(c, OFF_WK), MMEM, 4096, DM); pg8::Order S; S.init(g, c.G, c.bid);
      pg8::EpiBf16 E{wsb(c, OFF_KB), 4096, nullptr, wsf(c, OFF_RSM), nullptr, 1.f, 0}; pg8::gemm_phase(c.lds, g, S, E); }
    { pg8::Gemm g = pg8::plain_gemm(wsb(c, OFF_MEMB), wsb(c, OFF_WV), MMEM, 4096, DM); pg8::Order S; S.init(g, c.G, c.bid);
      pg8::EpiBf16 E{wsb(c, OFF_VT), 4096, nullptr, wsf(c, OFF_RSM), nullptr, 1.f, 0}; pg8::gemm_phase(c.lds, g, S, E); }
}
DI void ph_win(const Params& p, const Ctx& c0, int l) {
    const Ctx c = fresh(c0);
    pg8::Gemm g = pg8::plain_gemm(wsb(c, OFF_HB), (const bf16_t*)(c.ws + (size_t)l * W_LAYER + W_IN), MTOK, 3072, DM);
    pg8::Order S; S.init(g, c.G, c.bid);
    pg8::EpiZ E{wsb(c, OFF_Z), wsf(c, OFF_GATES), ssbuf(c, 4 * l + 1)};
    pg8::gemm_phase(c.lds, g, S, E);
}
constexpr size_t OFF_MT = OFF_Z, OFF_VWT = OFF_Z + (size_t)16384 * DM * 2;
DI void ph_xpre(const Params& p, const Ctx& c0, int l) {
    const Ctx c = fresh(c0);
    const unsigned char* wl = c.ws + (size_t)l * W_LAYER;
    { pg8::Gemm g; g.A = wsb(c, OFF_KB) + l * 1024; g.B = (const bf16_t*)(wl + W_Q); g.lda = 4096; g.ldb = DM; g.K = 256; g.nM = 64; g.nN = 4;
      g.div = 4; g.a_pmdiv = 256L * 4096; g.a_pmmod = 256; g.a_pn = 0; g.b_pmdiv = 0; g.b_pmmod = 256; g.b_pn = 256L * DM; g.ocol_step = 256; g.kstepA = 128; g.kstepB = 128; g.imgA = 0;
      pg8::Order S; S.init(g, c.G, c.bid);
      pg8::EpiBf16 E{wsb(c, OFF_MT), DM, nullptr, nullptr, nullptr, 1.f, 0}; pg8::gemm_phase(c.lds, g, S, E); }
    { pg8::Gemm g; g.A = (const bf16_t*)(wl + W_O); g.B = wsb(c, OFF_VT) + l * 1024; g.lda = DM; g.ldb = 4096; g.K = 256; g.nM = 64; g.nN = 4;
      g.div = 4; g.a_pmdiv = 0; g.a_pmmod = 256L * DM; g.a_pn = 256; g.b_pmdiv = 256L * 4096; g.b_pmmod = 0; g.b_pn = 256; g.ocol_step = 256; g.kstepA = 128; g.kstepB = 128; g.imgA = 0;
      pg8::Order S; S.init(g, c.G, c.bid);
      pg8::EpiBf16 E{wsb(c, OFF_VWT), DM, nullptr, nullptr, nullptr, 1.f, 0}; pg8::gemm_phase(c.lds, g, S, E); }
}
DI void ph_xs(const Params& p, const Ctx& c0, int l) {
    const Ctx c = fresh(c0);
    pg8::Gemm g; g.A = wsb(c, OFF_HB); g.B = wsb(c, OFF_MT); g.lda = DM; g.ldb = DM; g.K = DM; g.nM = MTOK / 256; g.nN = 4;
    g.div = 16; g.a_pmdiv = 16L * 256 * DM; g.a_pmmod = 256L * DM; g.a_pn = 0; g.b_pmdiv = 4L * 256 * DM; g.b_pmmod = 0; g.b_pn = 256L * DM; g.ocol_step = 256; g.kstepA = 128; g.kstepB = 128; g.imgA = 0;
    pg8::Order S; S.init(g, c.G, c.bid);
    pg8::EpiSoftmax E{wsb(c, OFF_Y), DM, (LAS float*)(c.lds + LDS_EXTRA), ssbuf(c, 4 * l + 2), 0.0625f * LOG2E};
    pg8::gemm_phase(c.lds, g, S, E);
}
DI void ph_xo(const Params& p, const Ctx& c0, int l) {
    const Ctx c = fresh(c0);
    pg8::Gemm g; g.A = wsb(c, OFF_Y); g.B = wsb(c, OFF_VWT); g.lda = DM; g.ldb = DM; g.K = DM; g.nM = MTOK / 256; g.nN = 4;
    g.div = 16; g.a_pmdiv = 16L * 256 * DM; g.a_pmmod = 256L * DM; g.a_pn = 0; g.b_pmdiv = 1024L * DM; g.b_pmmod = 0; g.b_pn = 256L * DM; g.ocol_step = 256; g.kstepA = 128; g.kstepB = 128; g.imgA = 0;
    pg8::Order S; S.init(g, c.G, c.bid);
    pg8::EpiResid E{wsb(c, OFF_HB), ssbuf(c, 4 * l + 3), 1.f};
    pg8::gemm_phase(c.lds, g, S, E);
}

constexpr int PH_PER_LAYER = 11, PH_FINAL = 1 + PH_PER_LAYER * DEPTH, PH_TOTAL = PH_FINAL + 1;
__global__ void __launch_bounds__(512, 2) mega_fwd(Params pk) {
    extern __shared__ __attribute__((aligned(16))) unsigned char lds_raw[];
    volatile LAS unsigned* bst = (volatile LAS unsigned*)((LAS unsigned char*)lds_raw + LDS_EXTRA + 12288);
    XcdBarrier xbar; xbar.bar = (unsigned*)(pk.ws + OFF_CTL); xbar.x = 0; xbar.st = bst;
    if (pk.coop) { if (threadIdx.x < 4) bst[threadIdx.x] = 0u; __syncthreads(); xbar = xcd_barrier_post((unsigned*)(pk.ws + OFF_CTL), bst); }
    for (int ph = pk.ph_lo; ph < pk.ph_hi; ++ph) {
        int tid = threadIdx.x; asm volatile("" : "+v"(tid));
        const Params& p = pk;
        Ctx c; c.lds = (LAS unsigned char*)lds_raw; c.ldsg = lds_raw; c.tid = tid; c.lane = tid & 63; c.wid = __builtin_amdgcn_readfirstlane(tid >> 6);
        c.bid = blockIdx.x; c.G = gridDim.x; c.ws = pk.ws; c.out = pk.out;
        asm volatile("" : "+s"(c.ws)); asm volatile("" : "+s"(c.out));
        if (ph == 0) {
#ifndef NO_PRO
            REP(R_PRO) ph_prologue(p, c);
#endif
        }
        else if (ph == PH_FINAL) ph_final(p, c);
        else {
            const int l = (ph - 1) / PH_PER_LAYER, j = (ph - 1) % PH_PER_LAYER;
            const unsigned char* wl = c.ws + (size_t)l * W_LAYER;
#ifdef ONLY_CASE
            if (j != ONLY_CASE) continue;
#endif
            switch (j) {
                case 0: REP(R_UP) ph_ffn_up(p, c, l, 0); if (l == 0) ph_kv(p, c); break;
                case 1: ph_resid(p, c, wsb(c, OFF_Z), (const bf16_t*)(wl + W_D1), FF, 4 * l + 1, 0.5f); break;
                case 2: ph_win(p, c, l); break;
                case 3:
#ifndef NO_MIX1
                    ph_mix1(p, c, l);
#endif
                    break;
                case 4:
#ifndef NO_MIX2
                    ph_mix2(p, c, l);
#endif
                    break;
                case 5:
#ifndef NO_MIX3
                    ph_mix3(p, c, l);
#endif
                    break;
                case 6: ph_resid(p, c, wsb(c, OFF_Y), (const bf16_t*)(wl + W_OUT), DM, 4 * l + 2, 1.f); ph_xpre(p, c, l); break;
                case 7: ph_xs(p, c, l); break;
                case 8: ph_xo(p, c, l); break;
                case 9: ph_ffn_up(p, c, l, 1); break;
                default: ph_resid(p, c, wsb(c, OFF_Z), (const bf16_t*)(wl + W_D2), FF, 4 * l + 4, 0.5f); break;
            }
        }
        if (ph + 1 < pk.ph_hi && pk.coop) { if (ph == pk.ph_lo) cg::this_grid().sync(); else xcd_barrier(xbar); }
    }
}

extern "C" void kernel_launch(void* const* d_in, const int* in_sizes, int n_in, void* d_out, int out_size, void* d_ws, size_t ws_size, hipStream_t stream) {
    static int grid = 0;
    if (grid == 0) {
        if (n_in != 28 || out_size != MTOK * DM || ws_size < OFF_END) { fprintf(stderr, "kernel_launch: unexpected shapes (n_in %d out %d ws %zu)\n", n_in, out_size, ws_size); grid = -1; return; }
        int dev = 0, cus = 0, per_cu = 0;
        (void)hipGetDevice(&dev); (void)hipDeviceGetAttribute(&cus, hipDeviceAttributeMultiprocessorCount, dev);
        if (hipFuncSetAttribute((const void*)mega_fwd, hipFuncAttributeMaxDynamicSharedMemorySize, LDS_BYTES) != hipSuccess) { fprintf(stderr, "kernel_launch: hipFuncSetAttribute failed\n"); grid = -1; return; }
        if (hipOccupancyMaxActiveBlocksPerMultiprocessor(&per_cu, (const void*)mega_fwd, 512, LDS_BYTES) != hipSuccess || per_cu < 1) { fprintf(stderr, "kernel_launch: occupancy query says %d\n", per_cu); per_cu = 1; }
        (void)hipGetLastError();
        grid = cus * per_cu;
    }
    if (grid < 0) return;
    Params p{};
    for (int i = 0; i < 28; ++i) p.in[i] = (const float*)d_in[i];
    p.out = (float*)d_out; p.ws = (unsigned char*)d_ws; p.pad = 0;
    (void)hipMemsetAsync((unsigned char*)d_ws + OFF_CTL, 0, CTL_BYTES, stream);
#if MK_MULTI
    for (int ph = 0; ph < PH_TOTAL; ++ph) { p.ph_lo = ph; p.ph_hi = ph + 1; p.coop = 0; hipLaunchKernelGGL(mega_fwd, dim3(grid), dim3(512), LDS_BYTES, stream, p); }
#else
    p.ph_lo = 0; p.ph_hi = PH_TOTAL; p.coop = 1;
    void* args[] = {&p};
    hipError_t e = hipLaunchCooperativeKernel((const void*)mega_fwd, dim3(grid), dim3(512), args, LDS_BYTES, stream);
    if (e != hipSuccess) fprintf(stderr, "cooperative launch failed: %s (grid %d)\n", hipGetErrorString(e), grid);
#endif
}
```

```cpp
#include <hip/hip_runtime.h>
#include <hip/hip_cooperative_groups.h>
#include <cstdio>
#include <cstdint>
namespace cg = cooperative_groups;

#ifndef MK_MULTI
#define MK_MULTI 0
#endif

#ifndef R_DIFF
#define R_DIFF 1
#endif
#ifndef R_DIL
#define R_DIL 1
#endif
#ifndef R_POOL
#define R_POOL 1
#endif
#ifndef R_MLA
#define R_MLA 1
#endif
#ifndef R_MLC
#define R_MLC 1
#endif
#ifndef R_UP
#define R_UP 1
#endif
#ifndef R_WIN
#define R_WIN 1
#endif
#ifndef R_GATES
#define R_GATES 1
#endif
#ifndef R_PRO
#define R_PRO 1
#endif
#ifndef R_RES1
#define R_RES1 1
#endif
#ifndef R_RES6
#define R_RES6 1
#endif
#ifndef R_WQ
#define R_WQ 1
#endif
#define REP(n) for (int rep_ = 0; rep_ < (n); ++rep_)
#define DI __device__ __forceinline__
#define LAS __attribute__((address_space(3)))
typedef unsigned short bf16_t;
typedef short bf16x8 __attribute__((ext_vector_type(8)));
typedef float f32x4 __attribute__((ext_vector_type(4)));
typedef float f32x16 __attribute__((ext_vector_type(16)));
typedef unsigned u32x4 __attribute__((ext_vector_type(4)));
typedef unsigned u32x2 __attribute__((ext_vector_type(2)));
typedef float f32x2_t __attribute__((ext_vector_type(2)));
typedef __bf16 bf16x2_t __attribute__((ext_vector_type(2)));

constexpr int DM = 1024, NB = 16, SEQ = 4096, MTOK = NB * SEQ, DEPTH = 4, MEMLEN = 256, MMEM = NB * MEMLEN, FF = 2816, ZW = 2816, INW = 2824;
constexpr int ZQA = 0, ZKA = 256, ZVA = 512, ZOA = 768, ZPB = 1024, ZQC = 1280, ZKC = 1536, ZVC = 1792, ZQD = 2048, ZKD = 2304, ZVD = 2560;
constexpr float LOG2E = 1.4426950408889634f;
constexpr float NEGBIG = -1e30f;

constexpr size_t W_GU1 = 0, W_D1 = W_GU1 + (size_t)2 * FF * DM * 2, W_IN = W_D1 + (size_t)DM * FF * 2, W_OUT = W_IN + (size_t)3072 * DM * 2,
                 W_Q = W_OUT + (size_t)DM * DM * 2, W_O = W_Q + (size_t)DM * DM * 2, W_GU2 = W_O + (size_t)DM * DM * 2, W_D2 = W_GU2 + (size_t)2 * FF * DM * 2,
                 W_LAYER = W_D2 + (size_t)DM * FF * 2;
constexpr size_t OFF_WK = DEPTH * W_LAYER, OFF_WV = OFF_WK + (size_t)DEPTH * DM * DM * 2, OFF_HB = OFF_WV + (size_t)DEPTH * DM * DM * 2;
constexpr size_t OFF_DST = OFF_HB;
constexpr size_t OFF_OPART = OFF_HB + (size_t)64 * 64 * 4096 * 4;
constexpr size_t OFF_Z = OFF_HB + (size_t)MTOK * DM * 2;
constexpr size_t OFF_Y = OFF_Z + (size_t)MTOK * ZW * 2;
constexpr size_t OFF_KB = OFF_Y + (size_t)MTOK * DM * 2;
constexpr size_t OFF_VT = OFF_KB + (size_t)MMEM * 4096 * 2;
constexpr size_t OFF_MEMB = OFF_VT + (size_t)4096 * MMEM * 2;
constexpr size_t OFF_GATES = OFF_MEMB + (size_t)MMEM * DM * 2;
constexpr size_t OFF_SS = OFF_GATES + (size_t)MTOK * 8 * 4;
constexpr size_t OFF_LSEP = OFF_SS + (size_t)17 * MTOK * 16 * 4;
constexpr size_t OFF_NST = OFF_LSEP + (size_t)2 * MTOK * 4 * 4;
constexpr size_t OFF_SCAL = OFF_NST + (size_t)4096 * 64 * 4;
constexpr size_t OFF_DIFFB = OFF_SCAL + 65536;
constexpr size_t OFF_DILB = OFF_DIFFB + 65536;
constexpr size_t OFF_LAM = OFF_DILB + 8192;
constexpr size_t OFF_RSM = OFF_LAM + 256;
constexpr size_t OFF_CTL = OFF_RSM + 16384;
constexpr size_t CTL_BYTES = 16384;
constexpr size_t OFF_END = OFF_CTL + CTL_BYTES;
static_assert(OFF_OPART + (size_t)2 * MTOK * 256 * 2 <= OFF_Z, "alias map");
static_assert(OFF_END < (size_t)1073741824, "workspace");

constexpr int LDS_BYTES = 147456;
constexpr int LDS_EXTRA = 131072;

struct Params {
    const float* in[28];
    float* out;
    unsigned char* ws;
    int ph_lo, ph_hi, coop, pad;
};
enum { I_X = 0, I_MEM, I_T5, I_F1N, I_F1G, I_F1U, I_F1D, I_MIXN, I_WIN, I_CONVW, I_CONVB, I_GATEB, I_MLN, I_POOLW, I_POOLS, I_LAMV, I_SUBLN, I_WOUT,
       I_XN, I_MEMN, I_XWQ, I_XWKV, I_XWO, I_F2N, I_F2G, I_F2U, I_F2D, I_FINN };

DI unsigned cvtpk(float lo, float hi) { f32x2_t v = {lo, hi}; bf16x2_t b = __builtin_convertvector(v, bf16x2_t); return __builtin_bit_cast(unsigned, b); }
DI float bflo(unsigned w) { return __uint_as_float(w << 16); }
DI float bfhi(unsigned w) { return __uint_as_float(w & 0xffff0000u); }
DI float bf2f(bf16_t x) { return __uint_as_float((unsigned)x << 16); }
DI float ex2(float x) { return __builtin_amdgcn_exp2f(x); }
DI float rcpf_(float x) { return __builtin_amdgcn_rcpf(x); }
DI int crow(int i, int hi) { return (i & 3) + 8 * (i >> 2) + 4 * hi; }
DI float wave_sum(float v) {
#pragma unroll
    for (int o = 1; o < 64; o <<= 1) v += __shfl_xor(v, o);
    return v;
}
DI float wave_max(float v) {
#pragma unroll
    for (int o = 1; o < 64; o <<= 1) v = fmaxf(v, __shfl_xor(v, o));
    return v;
}
DI float silu_f(float g) { return g * rcpf_(1.f + ex2(-g * LOG2E)); }
DI float sigmoid_f(float g) { return rcpf_(1.f + ex2(-g * LOG2E)); }
#define LDS_WAIT() asm volatile("s_waitcnt lgkmcnt(0)" ::: "memory")
DI bf16x8 mk8(u32x2 lo, u32x2 hi) { u32x4 w = {lo.x, lo.y, hi.x, hi.y}; return __builtin_bit_cast(bf16x8, w); }
DI bf16x8 pack8(float a0, float a1, float a2, float a3, float a4, float a5, float a6, float a7) {
    u32x4 w = {cvtpk(a0, a1), cvtpk(a2, a3), cvtpk(a4, a5), cvtpk(a6, a7)}; return __builtin_bit_cast(bf16x8, w);
}
DI float rowss(const float* ss, int row) {
    const f32x4* q = (const f32x4*)(ss + (size_t)row * 16); const f32x4 a = q[0], b = q[1], c = q[2], d = q[3];
    const float t = ((a[0] + a[1]) + (a[2] + a[3])) + ((b[0] + b[1]) + (b[2] + b[3])) + ((c[0] + c[1]) + (c[2] + c[3])) + ((d[0] + d[1]) + (d[2] + d[3]));
    return rsqrtf(t * (1.f / 1024.f) + 1e-6f);
}
#define MFMA32(a, b, c) __builtin_amdgcn_mfma_f32_32x32x16_bf16((a), (b), (c), 0, 0, 0)

namespace pg8 {
constexpr int BM = 256, BK = 64, HALF = 128, HTB = HALF * BK * 2, STAGE_BYTES = 8 * HTB, NXCD = 8, WGM = 8;
DI int lds_byte(int r, int c) { const int st = (r >> 4) * 2 + (c >> 5), rr = r & 15, cc = c & 31, ob = rr * 64 + cc * 2; return st * 1024 + (ob ^ (((ob >> 9) & 1) << 5)); }
DI void stage_rc(int b, int& R, int& C) { const int st = b / 1024, sb = b % 1024, swz = sb ^ (((sb >> 9) & 1) << 5); R = (st >> 1) * 16 + swz / 64; C = (st & 1) * 32 + (swz % 64) / 2; }
DI int perm32(int rho) { const int n = rho >> 4, i = rho & 15; return 8 * (i >> 2) + 4 * n + (i & 3); }

struct Unit { const char* a; const char* b; int orow, ocol, pm, pn; };
struct Gemm {
    const bf16_t* A; const bf16_t* B; int lda, ldb, K, nM, nN; long a_pmdiv, a_pmmod, a_pn, b_pmdiv, b_pmmod, b_pn; int div, ocol_step; int kstepA, kstepB;
    int imgB;
    int imgA;
};
DI Gemm plain_gemm(const bf16_t* A, const bf16_t* B, int Mrows, int N, int K) {
    Gemm g; g.A = A; g.B = B; g.lda = K; g.ldb = K; g.K = K; g.nM = Mrows / BM; g.nN = N / BM; g.a_pmdiv = (long)BM * K; g.a_pmmod = 0; g.a_pn = 0; g.b_pmdiv = 0; g.b_pmmod = 0; g.b_pn = (long)BM * K;
    g.div = 1; g.ocol_step = BM; g.kstepA = BK * 2; g.kstepB = BK * 2; g.imgA = 0; g.imgB = 0; return g;
}
DI void use_img_b(Gemm& g) { g.imgB = 1; g.ldb = 64; g.kstepB = 256 * 64 * 2; g.b_pn = (long)(g.K / 64) * 256 * 64; }
struct Order {
    Gemm g; int nwg, G, c;
    DI void init(const Gemm& g_, int G_, int c_) { g = g_; nwg = g.nM * g.nN; G = G_; c = c_; }
    DI bool next(int i, Unit& u) const {
        const long L = (long)i * G + c; if (L >= nwg) return false;
        int wgid = (int)L; { const int q = nwg / NXCD, r = nwg % NXCD, xcd = wgid % NXCD, off = wgid / NXCD; wgid = (xcd < r ? xcd * (q + 1) : r * (q + 1) + (xcd - r) * q) + off; }
        const int nN = g.nN, nM = g.nM, nig = WGM * nN, gid = wgid / nig, fm = gid * WGM, gsz = (nM - fm) < WGM ? (nM - fm) : WGM;
        const int pm = fm + ((wgid % nig) % gsz), pn = (wgid % nig) / gsz;
        u.pm = pm; u.pn = pn; u.orow = pm * BM; u.ocol = pn * g.ocol_step;
        const int pq = pm / g.div, pr = pm - pq * g.div;
        u.a = (const char*)(g.A + (long)pq * g.a_pmdiv + (long)pr * g.a_pmmod + (long)pn * g.a_pn);
        u.b = (const char*)(g.B + (long)pq * g.b_pmdiv + (long)pr * g.b_pmmod + (long)pn * g.b_pn);
        return true;
    }
};

struct EpiBf16 {
    static constexpr bool PERM = true;
    bf16_t* O; int ldc; const float* ss; const float* rowscale; const float* colscale; float scale; int zspecial;
    DI void operator()(f32x4 (&acc)[2][2][4][2], const Unit& u, int wr, int wc, int fr, int fq, int wid, int lane) const {
        const int row0 = u.orow + wr * 64 + fr, col0 = u.ocol + wc * 32 + 8 * fq;
        float sc = scale;
        if (zspecial) { if (u.pn == 5) sc *= 0.125f * LOG2E; else if (u.pn == 8) sc *= 0.17677669529663687f * LOG2E; }
        if (colscale) {
#pragma unroll
            for (int bj = 0; bj < 2; ++bj)
#pragma unroll
                for (int n = 0; n < 2; ++n) { const f32x4 cs = *(const f32x4*)(colscale + col0 + bj * HALF + 4 * n);
#pragma unroll
                    for (int ai = 0; ai < 2; ++ai)
#pragma unroll
                        for (int m = 0; m < 4; ++m) acc[ai][bj][m][n] *= cs; }
            asm volatile("" ::: "memory");
        }
#pragma unroll
        for (int ai = 0; ai < 2; ++ai)
#pragma unroll
            for (int m = 0; m < 4; ++m) {
                const int row = row0 + ai * HALF + m * 16;
                float rs = sc;
                if (ss) rs *= rowss(ss, row);
                if (rowscale) rs *= rowscale[row];
                bf16_t* rowp = O + (size_t)row * ldc + col0;
#pragma unroll
                for (int bj = 0; bj < 2; ++bj) {
                    const f32x4 v0 = acc[ai][bj][m][0] * rs, v1 = acc[ai][bj][m][1] * rs;
                    u32x4 w; w.x = cvtpk(v0[0], v0[1]); w.y = cvtpk(v0[2], v0[3]); w.z = cvtpk(v1[0], v1[1]); w.w = cvtpk(v1[2], v1[3]);
                    *(u32x4*)(rowp + bj * HALF) = w;
                }
                asm volatile("" ::: "memory");
            }
    }
};
struct EpiZ {
    static constexpr bool PERM = true;
    bf16_t* O; float* gates; const float* ss;
    DI void operator()(f32x4 (&acc)[2][2][4][2], const Unit& u, int wr, int wc, int fr, int fq, int wid, int lane) const {
        const int row0 = u.orow + wr * 64 + fr, col0 = u.ocol + wc * 32 + 8 * fq;
        if (u.pn == 11) {
            if (wc == 0 && fq == 0) {
#pragma unroll
                for (int ai = 0; ai < 2; ++ai)
#pragma unroll
                    for (int m = 0; m < 4; ++m) { const int row = row0 + ai * HALF + m * 16; const float rs = rowss(ss, row);
                        *(f32x4*)(gates + (size_t)row * 8) = acc[ai][0][m][0] * rs; *(f32x4*)(gates + (size_t)row * 8 + 4) = acc[ai][0][m][1] * rs; }
            }
            return;
        }
        float sc = 1.f;
        if (u.pn == 5) sc = 0.125f * LOG2E; else if (u.pn == 8) sc = 0.17677669529663687f * LOG2E;
#pragma unroll
        for (int ai = 0; ai < 2; ++ai)
#pragma unroll
            for (int m = 0; m < 4; ++m) {
                const int row = row0 + ai * HALF + m * 16;
                const float rs = sc * rowss(ss, row);
                bf16_t* rowp = O + (size_t)row * ZW + col0;
#pragma unroll
                for (int bj = 0; bj < 2; ++bj) {
                    const f32x4 v0 = acc[ai][bj][m][0] * rs, v1 = acc[ai][bj][m][1] * rs;
                    u32x4 w; w.x = cvtpk(v0[0], v0[1]); w.y = cvtpk(v0[2], v0[3]); w.z = cvtpk(v1[0], v1[1]); w.w = cvtpk(v1[2], v1[3]);
                    *(u32x4*)(rowp + bj * HALF) = w;
                }
                asm volatile("" ::: "memory");
            }
    }
};
struct EpiSwiGLU {
    static constexpr bool PERM = true;
    bf16_t* O; int ldc; const float* ss;
    DI void operator()(f32x4 (&acc)[2][2][4][2], const Unit& u, int wr, int wc, int fr, int fq, int wid, int lane) const {
        const int row0 = u.orow + wr * 64 + fr, col0 = u.ocol + wc * 32 + 8 * fq;
#pragma unroll
        for (int ai = 0; ai < 2; ++ai)
#pragma unroll
            for (int m = 0; m < 4; ++m) {
                const int row = row0 + ai * HALF + m * 16;
                const float rs = rowss(ss, row);
                float o[8];
#pragma unroll
                for (int n = 0; n < 2; ++n)
#pragma unroll
                    for (int j = 0; j < 4; ++j) { const float g = acc[ai][0][m][n][j] * rs, up = acc[ai][1][m][n][j] * rs; o[4 * n + j] = silu_f(g) * up; }
                u32x4 w; w.x = cvtpk(o[0], o[1]); w.y = cvtpk(o[2], o[3]); w.z = cvtpk(o[4], o[5]); w.w = cvtpk(o[6], o[7]);
                __builtin_nontemporal_store(w, (u32x4*)((unsigned char*)O + ((size_t)(u.pm * (FF / 64) + (col0 >> 6)) * 2 + ((row >> 7) & 1)) * 16384 + lds_byte(row & 127, col0 & 63)));
                asm volatile("" ::: "memory");
            }
    }
};
struct EpiResid {
    static constexpr bool PERM = true;
    bf16_t* hb; float* ssout; float alpha;
    DI void operator()(f32x4 (&acc)[2][2][4][2], const Unit& u, int wr, int wc, int fr, int fq, int wid, int lane) const {
        const int row0 = u.orow + wr * 64 + fr, col0 = u.ocol + wc * 32 + 8 * fq;
#pragma unroll
        for (int ai = 0; ai < 2; ++ai) {
            u32x4 r[4][2];
#pragma unroll
            for (int m = 0; m < 4; ++m) { const size_t off = (size_t)(row0 + ai * HALF + m * 16) * DM + col0;
#pragma unroll
                for (int bj = 0; bj < 2; ++bj) r[m][bj] = *(const u32x4*)(hb + off + bj * HALF); }
#pragma unroll
            for (int m = 0; m < 4; ++m) {
                const int row = row0 + ai * HALF + m * 16; const size_t off = (size_t)row * DM + col0; float ssq = 0.f;
#pragma unroll
                for (int bj = 0; bj < 2; ++bj) {
                    const u32x4 rr = r[m][bj]; const f32x4 a0 = acc[ai][bj][m][0] * alpha, a1 = acc[ai][bj][m][1] * alpha;
                    u32x4 w; w.x = cvtpk(bflo(rr.x) + a0[0], bfhi(rr.x) + a0[1]); w.y = cvtpk(bflo(rr.y) + a0[2], bfhi(rr.y) + a0[3]);
                    w.z = cvtpk(bflo(rr.z) + a1[0], bfhi(rr.z) + a1[1]); w.w = cvtpk(bflo(rr.w) + a1[2], bfhi(rr.w) + a1[3]);
                    *(u32x4*)(hb + off + bj * HALF) = w;
                    const float v0 = bflo(w.x), v1 = bfhi(w.x), v2 = bflo(w.y), v3 = bfhi(w.y), v4 = bflo(w.z), v5 = bfhi(w.z), v6 = bflo(w.w), v7 = bfhi(w.w);
                    ssq += ((v0 * v0 + v1 * v1) + (v2 * v2 + v3 * v3)) + ((v4 * v4 + v5 * v5) + (v6 * v6 + v7 * v7));
                }
                ssq += __shfl_xor(ssq, 16); ssq += __shfl_xor(ssq, 32);
                if (fq == 0) ssout[(size_t)row * 16 + u.pn * 4 + wc] = ssq;
            }
            asm volatile("" ::: "memory");
        }
    }
};
struct EpiSoftmax {
    static constexpr bool PERM = true;
    bf16_t* O; int ldc; LAS float* red; const float* ss; float scale;
    DI void operator()(f32x4 (&acc)[2][2][4][2], const Unit& u, int wr, int wc, int fr, int fq, int wid, int lane) const {
        float mloc[2][4];
#pragma unroll
        for (int ai = 0; ai < 2; ++ai)
#pragma unroll
            for (int m = 0; m < 4; ++m) {
                float mx = NEGBIG;
                const float rsc = rowss(ss, u.orow + ai * HALF + wr * 64 + m * 16 + fr) * scale;
#pragma unroll
                for (int bj = 0; bj < 2; ++bj)
#pragma unroll
                    for (int n = 0; n < 2; ++n) { const f32x4 x = acc[ai][bj][m][n] * rsc; acc[ai][bj][m][n] = x; mx = fmaxf(mx, fmaxf(fmaxf(x[0], x[1]), fmaxf(x[2], x[3]))); }
                mx = fmaxf(mx, __shfl_xor(mx, 16)); mx = fmaxf(mx, __shfl_xor(mx, 32));
                float sm = 0.f;
#pragma unroll
                for (int bj = 0; bj < 2; ++bj)
#pragma unroll
                    for (int n = 0; n < 2; ++n) { f32x4 x = acc[ai][bj][m][n]; x[0] = ex2(x[0] - mx); x[1] = ex2(x[1] - mx); x[2] = ex2(x[2] - mx); x[3] = ex2(x[3] - mx);
                        acc[ai][bj][m][n] = x; sm += (x[0] + x[1]) + (x[2] + x[3]); }
                sm += __shfl_xor(sm, 16); sm += __shfl_xor(sm, 32);
                mloc[ai][m] = mx;
                const int rl = ai * HALF + wr * 64 + m * 16 + fr;
                if (fq == 0) { red[(rl * 4 + wc) * 2] = mx; red[(rl * 4 + wc) * 2 + 1] = sm; }
            }
        asm volatile("s_waitcnt lgkmcnt(0)" ::: "memory"); __builtin_amdgcn_s_barrier(); asm volatile("" ::: "memory");
        const int row0 = u.orow + wr * 64 + fr, col0 = u.ocol + wc * 32 + 8 * fq;
#pragma unroll
        for (int ai = 0; ai < 2; ++ai)
#pragma unroll
            for (int m = 0; m < 4; ++m) {
                const int rl = ai * HALF + wr * 64 + m * 16 + fr;
                const f32x4 p0 = *(const LAS f32x4*)(red + rl * 8), p1 = *(const LAS f32x4*)(red + rl * 8 + 4);
                const float gm = fmaxf(fmaxf(p0[0], p0[2]), fmaxf(p1[0], p1[2]));
                const float tot = p0[1] * ex2(p0[0] - gm) + p0[3] * ex2(p0[2] - gm) + p1[1] * ex2(p1[0] - gm) + p1[3] * ex2(p1[2] - gm);
                const float f = ex2(mloc[ai][m] - gm) / tot;
                bf16_t* rowp = O + (size_t)(row0 + ai * HALF + m * 16) * ldc + col0;
#pragma unroll
                for (int bj = 0; bj < 2; ++bj) {
                    const f32x4 v0 = acc[ai][bj][m][0] * f, v1 = acc[ai][bj][m][1] * f;
                    u32x4 w; w.x = cvtpk(v0[0], v0[1]); w.y = cvtpk(v0[2], v0[3]); w.z = cvtpk(v1[0], v1[1]); w.w = cvtpk(v1[2], v1[3]);
                    *(u32x4*)(rowp + bj * HALF) = w;
                }
            }
        asm volatile("s_waitcnt lgkmcnt(0)" ::: "memory"); __builtin_amdgcn_s_barrier(); asm volatile("" ::: "memory");
    }
};

template <class Epi>
DI void gemm_phase(LAS unsigned char* lds, const Gemm g, const Order& S, const Epi& E) {
    int tid_ = threadIdx.x; asm volatile("" : "+v"(tid_));
    const int tid = tid_, wid = __builtin_amdgcn_readfirstlane(tid >> 6), lane = tid & 63, wr = wid >> 2, wc = wid & 3, fr = lane & 15, fq = lane >> 4;
    const int K = g.K, nt = K / BK;
    unsigned voffA[2], voffB[2];
#pragma unroll
    for (int i = 0; i < 2; ++i) { int R, C; stage_rc(tid * 16 + i * 8192, R, C); const int Rb = Epi::PERM ? ((R & ~31) + perm32(R & 31)) : R;
        voffA[i] = g.imgA ? (unsigned)(tid * 16 + i * 8192) : (unsigned)(R * g.lda + C) * 2u; voffB[i] = g.imgB ? (unsigned)(tid * 16 + i * 8192) : (unsigned)(Rb * g.ldb + C) * 2u; }
    const size_t kstepA = (size_t)g.kstepA, kstepB = (size_t)g.kstepB;
    const size_t hstepA = (size_t)HALF * g.lda * 2, hstepB = (size_t)HALF * g.ldb * 2;
    const unsigned ldsw = (unsigned)wid * 1024u;
    const int aoff = lds_byte(wr * 64 + fr, fq * 8), boff = lds_byte(wc * 32 + fr, fq * 8);
#define PG8_SA(b, h) (((b) * 2 + (h)) * HTB)
#define PG8_SB(b, h) ((4 + (b) * 2 + (h)) * HTB)
#define PG8_STAGE(bufoff, gbase, voff) do { _Pragma("unroll") for (int _i = 0; _i < 2; ++_i) \
        __builtin_amdgcn_global_load_lds((const unsigned*)((const char*)(gbase) + (voff)[_i]), (LAS unsigned*)(lds + (bufoff) + ldsw + _i * 8192), 16, 0, 0); } while (0)
#define PG8_LDA(dst, b, h) do { _Pragma("unroll") for (int m = 0; m < 4; ++m) _Pragma("unroll") for (int k = 0; k < 2; ++k) dst[m][k] = *(const LAS bf16x8*)(lds + PG8_SA(b, h) + aoff + m * 2048 + k * 1024); } while (0)
#define PG8_LDB(dst, b, h) do { _Pragma("unroll") for (int n = 0; n < 2; ++n) _Pragma("unroll") for (int k = 0; k < 2; ++k) dst[n][k] = *(const LAS bf16x8*)(lds + PG8_SB(b, h) + boff + n * 2048 + k * 1024); } while (0)
#define PG8_MMA(ai, bj, At, Bt) do { __builtin_amdgcn_s_setprio(1); _Pragma("unroll") for (int m = 0; m < 4; ++m) _Pragma("unroll") for (int n = 0; n < 2; ++n) _Pragma("unroll") for (int k = 0; k < 2; ++k) \
        acc[ai][bj][m][n] = __builtin_amdgcn_mfma_f32_16x16x32_bf16(Bt[n][k], At[m][k], acc[ai][bj][m][n], 0, 0, 0); __builtin_amdgcn_s_setprio(0); } while (0)
#define PG8_WAIT_V(n) asm volatile("s_waitcnt vmcnt(" #n ")" ::: "memory")
#define PG8_WAIT_L(n) asm volatile("s_waitcnt lgkmcnt(" #n ")" ::: "memory")
#define PG8_BAR __builtin_amdgcn_s_barrier()
#define PG8_SCHED __builtin_amdgcn_sched_barrier(0)
    Unit cur, nxt; int ui = 0;
    if (!S.next(0, cur)) return;
    f32x4 acc[2][2][4][2];
#pragma unroll
    for (int a = 0; a < 2; ++a)
#pragma unroll
        for (int b = 0; b < 2; ++b)
#pragma unroll
            for (int m = 0; m < 4; ++m)
#pragma unroll
                for (int n = 0; n < 2; ++n) acc[a][b][m][n] = (f32x4){0.f, 0.f, 0.f, 0.f};
    bf16x8 At[4][2], B0[2][2], B1[2][2];
    const char* cA = cur.a; const char* cB = cur.b;
    PG8_STAGE(PG8_SB(0, 0), cB, voffB); PG8_STAGE(PG8_SB(0, 1), cB + hstepB, voffB); PG8_STAGE(PG8_SA(0, 0), cA, voffA); PG8_STAGE(PG8_SA(0, 1), cA + hstepA, voffA);
    if (wr == 1) PG8_BAR;
    PG8_WAIT_V(2); PG8_BAR;
    PG8_STAGE(PG8_SB(1, 0), cB + kstepB, voffB); PG8_STAGE(PG8_SA(1, 0), cA + kstepA, voffA); PG8_STAGE(PG8_SB(1, 1), cB + hstepB + kstepB, voffB);
    PG8_WAIT_V(6); PG8_BAR;
    for (;;) {
        const bool has_next = S.next(ui + 1, nxt);
        const char* nA = has_next ? nxt.a : cA; const char* nB = has_next ? nxt.b : cB;
        for (int t = 0; t < nt; t += 2) {
            const bool last = (t == nt - 2);
            const char* a1 = cA + (size_t)(t + 1) * kstepA;
            const char* a2 = last ? nA : cA + (size_t)(t + 2) * kstepA; const char* b2 = last ? nB : cB + (size_t)(t + 2) * kstepB;
            const char* a3 = a2 + kstepA; const char* b3 = b2 + kstepB;
            PG8_LDB(B0, 0, 0); PG8_LDB(B1, 0, 1); PG8_SCHED; PG8_LDA(At, 0, 0); PG8_STAGE(PG8_SA(1, 1), a1 + hstepA, voffA);
            PG8_WAIT_V(8); PG8_WAIT_L(0); PG8_BAR; PG8_MMA(0, 0, At, B0); PG8_MMA(0, 1, At, B1); PG8_BAR; PG8_SCHED;
            PG8_LDA(At, 0, 1); PG8_STAGE(PG8_SB(0, 0), b2, voffB); PG8_STAGE(PG8_SB(0, 1), b2 + hstepB, voffB); PG8_STAGE(PG8_SA(0, 0), a2, voffA);
            PG8_WAIT_V(8); PG8_WAIT_L(0); PG8_BAR; PG8_MMA(1, 0, At, B0); PG8_MMA(1, 1, At, B1); PG8_BAR; PG8_SCHED;
            PG8_LDB(B0, 1, 0); PG8_LDB(B1, 1, 1); PG8_SCHED; PG8_LDA(At, 1, 0); PG8_STAGE(PG8_SA(0, 1), a2 + hstepA, voffA);
            PG8_WAIT_V(8); PG8_WAIT_L(0); PG8_BAR; PG8_MMA(0, 0, At, B0); PG8_MMA(0, 1, At, B1); PG8_BAR; PG8_SCHED;
            PG8_LDA(At, 1, 1); PG8_STAGE(PG8_SB(1, 0), b3, voffB); PG8_STAGE(PG8_SB(1, 1), b3 + hstepB, voffB); PG8_STAGE(PG8_SA(1, 0), a3, voffA);
            PG8_WAIT_V(8); PG8_WAIT_L(0); PG8_BAR; PG8_MMA(1, 0, At, B0); PG8_MMA(1, 1, At, B1); PG8_BAR; PG8_SCHED;
        }
        if (wr == 0) PG8_BAR;
        E(acc, cur, wr, wc, fr, fq, wid, lane);
        if (!has_next) break;
#pragma unroll
        for (int a = 0; a < 2; ++a)
#pragma unroll
            for (int b = 0; b < 2; ++b)
#pragma unroll
                for (int m = 0; m < 4; ++m)
#pragma unroll
                    for (int n = 0; n < 2; ++n) acc[a][b][m][n] = (f32x4){0.f, 0.f, 0.f, 0.f};
        cur = nxt; cA = nA; cB = nB; ++ui;
        if (wr == 1) PG8_BAR;
    }
    PG8_WAIT_V(0);
    PG8_BAR;
#undef PG8_SA
#undef PG8_SB
#undef PG8_STAGE
#undef PG8_LDA
#undef PG8_LDB
#undef PG8_MMA
#undef PG8_WAIT_V
#undef PG8_WAIT_L
#undef PG8_BAR
#undef PG8_SCHED
}
}

#define XB_TMO      128
#define XB_XCNT(j)  (256  + 64 * (j))
#define XB_XSUB(j)  (1280 + 64 * (j))
#define XB_XGEN(j)  (2304 + 64 * (j))
#define XB_TOP      3328
#define XB_TOPGEN   3392
#define XCD_BAR_WORDS 3456
#define XB_SPIN_CAP (1u << 20)
DI unsigned xb_ld(unsigned* p)              { return __hip_atomic_load(p, __ATOMIC_RELAXED, __HIP_MEMORY_SCOPE_AGENT); }
DI unsigned xb_add(unsigned* p, unsigned v) { return __hip_atomic_fetch_add(p, v, __ATOMIC_RELAXED, __HIP_MEMORY_SCOPE_AGENT); }
DI unsigned xb_xcc_id() { return (unsigned)__builtin_amdgcn_s_getreg((3 << 11) | 20) & 0xFu; }
#define XB_SPIN(cond, bar) do { unsigned _sp = 0; while (cond) { __builtin_amdgcn_s_sleep(1); \
    if ((++_sp & 255u) == 0u) { if (xb_ld(&(bar)[XB_TMO])) break; if (_sp > XB_SPIN_CAP) { atomicAdd(&(bar)[XB_TMO], 1u); break; } } } } while (0)
struct XcdBarrier { unsigned* bar; unsigned x; volatile LAS unsigned* st; };
DI XcdBarrier xcd_barrier_post(unsigned* bar, volatile LAS unsigned* st) {
    XcdBarrier b; b.bar = bar; b.x = xb_xcc_id(); b.st = st;
    if (threadIdx.x == 0) (void)xb_add(&bar[XB_XCNT(b.x)], 1u);
    return b;
}
DI void xcd_barrier_complete(unsigned* bar, unsigned x, unsigned& nloc, unsigned& nx) {
    const unsigned G = gridDim.x * gridDim.y * gridDim.z;
    unsigned sum, cnt, mine, sp = 0u;
    for (;;) {
        sum = 0u; cnt = 0u; mine = 0u;
#pragma unroll
        for (unsigned j = 0; j < 16; ++j) { const unsigned c = xb_ld(&bar[XB_XCNT(j)]); sum += c; cnt += (c > 0u) ? 1u : 0u; mine = (j == x) ? c : mine; }
        if (sum == G) break;
        __builtin_amdgcn_s_sleep(1);
        if ((++sp & 255u) == 0u) { if (xb_ld(&bar[XB_TMO])) break; if (sp > XB_SPIN_CAP) { atomicAdd(&bar[XB_TMO], 1u); break; } }
    }
    nloc = mine > 0u ? mine : 1u; nx = cnt > 0u ? cnt : 1u;
}
DI void xcd_barrier(const XcdBarrier& b) {
    asm volatile("s_waitcnt vmcnt(0)" ::: "memory");
    __syncthreads();
    if (threadIdx.x == 0) {
        unsigned* bar = b.bar;
        __builtin_amdgcn_s_waitcnt(0);
        unsigned nloc = b.st[0], nx = b.st[1];
        if (nloc == 0u) { xcd_barrier_complete(bar, b.x, nloc, nx); b.st[0] = nloc; b.st[1] = nx; }
        const unsigned old = xb_add(&bar[XB_XSUB(b.x)], 1u);
        const unsigned gen = old / nloc;
        if (old + 1u == (gen + 1u) * nloc) {
            __builtin_amdgcn_fence(__ATOMIC_RELEASE, "agent");
            asm volatile("s_waitcnt vmcnt(0)" ::: "memory");
            const unsigned og = xb_add(&bar[XB_TOP], 1u);
            const unsigned tg = og / nx;
            if (og + 1u == (tg + 1u) * nx) xb_add(&bar[XB_TOPGEN], 1u);
            else XB_SPIN(xb_ld(&bar[XB_TOPGEN]) == tg, bar);
            __builtin_amdgcn_fence(__ATOMIC_ACQUIRE, "agent");
            xb_add(&bar[XB_XGEN(b.x)], 1u);
            asm volatile("s_waitcnt vmcnt(0)" ::: "memory");
        } else {
            XB_SPIN(xb_ld(&bar[XB_XGEN(b.x)]) == gen, bar);
            __builtin_amdgcn_fence(__ATOMIC_ACQUIRE, "agent");
            asm volatile("s_waitcnt vmcnt(0)" ::: "memory");
        }
    }
    __syncthreads();
}

struct Ctx {
    LAS unsigned char* lds; unsigned char* ldsg;
    int tid, lane, wid, bid, G;
    unsigned char* ws; float* out;
};
DI bf16_t* wsb(const Ctx& c, size_t off) { return (bf16_t*)(c.ws + off); }
DI float* wsf(const Ctx& c, size_t off) { return (float*)(c.ws + off); }
DI float* ssbuf(const Ctx& c, int i) { return (float*)(c.ws + OFF_SS) + (size_t)i * MTOK * 16; }

DI int t5_bucket(int dist) {
    if (dist < 16) return dist;
    const float v = logf((float)dist / 16.f) / 4.852030263919617f * 16.f;
    int large = 16 + (int)v; return large < 31 ? large : 31;
}

DI Ctx fresh(const Ctx& c0) {
    Ctx c = c0; int tid = threadIdx.x; asm volatile("" : "+v"(tid)); c.tid = tid; c.lane = tid & 63; c.wid = __builtin_amdgcn_readfirstlane(tid >> 6);
    asm volatile("" : "+s"(c.ws)); asm volatile("" : "+s"(c.out)); return c;
}
DI void transpose_item(const float* W, int ldw, int scol0, int k0, const float* gain, bf16_t* WT, int K, int drow0, LAS float* scr, int lane, bool img = false) {
    {
        f32x4 v[8]; float gs[8];
#pragma unroll
        for (int i = 0; i < 8; ++i) { const int kk = 8 * i + (lane >> 3); v[i] = *(const f32x4*)(W + (size_t)(k0 + kk) * ldw + scol0 + (lane & 7) * 4); gs[i] = gain ? gain[k0 + kk] : 1.f; }
#pragma unroll
        for (int i = 0; i < 8; ++i) { const int kk = 8 * i + (lane >> 3); LAS float* d = scr + kk * 33 + (lane & 7) * 4; d[0] = v[i][0] * gs[i]; d[1] = v[i][1] * gs[i]; d[2] = v[i][2] * gs[i]; d[3] = v[i][3] * gs[i]; }
    }
    LDS_WAIT(); asm volatile("" ::: "memory");
    const int c = lane & 7;
#pragma unroll
    for (int j = 0; j < 4; ++j) { const int n = (lane >> 3) + 8 * j; const LAS float* s = scr + (8 * c) * 33 + n;
        u32x4 o; o.x = cvtpk(s[0 * 33], s[1 * 33]); o.y = cvtpk(s[2 * 33], s[3 * 33]); o.z = cvtpk(s[4 * 33], s[5 * 33]); o.w = cvtpk(s[6 * 33], s[7 * 33]);
        if (img) { const int ng = drow0 + n, nl = ng & 255, r = nl & 127, q = r & 31, rs = (r & ~31) + 16 * ((q >> 2) & 1) + 4 * (q >> 3) + (q & 3);
            const int kk0 = k0 + 8 * c;
            *(u32x4*)((unsigned char*)WT + ((size_t)((ng >> 8) * (K >> 6) + (kk0 >> 6)) * 2 + (nl >> 7)) * 16384 + pg8::lds_byte(rs, kk0 & 63)) = o; }
        else *(u32x4*)(WT + (size_t)(drow0 + n) * K + k0 + 8 * c) = o; }
    LDS_WAIT(); asm volatile("" ::: "memory");
}
DI void tjob(const float* W, int ldw, int scol0, const float* gain, bf16_t* WT, int K, int ncols, int item, LAS float* scr, int lane, bool img = false, int drow_base = 0) {
    const int nblk = ncols / 32, kb = item / nblk, nb = item % nblk;
    transpose_item(W, ldw, scol0 + 32 * nb, 64 * kb, gain, WT, K, drow_base + 32 * nb, scr, lane, img);
}
DI void tjob_gu(const float* Wg, const float* Wu, const float* gain, bf16_t* WT, int item, LAS float* scr, int lane) {
    const int nblk = 2 * FF / 32, kb = item / nblk, nb = item % nblk, n0 = 32 * nb, p = n0 >> 8, w = n0 & 255;
    transpose_item(w < 128 ? Wg : Wu, FF, 128 * p + (w & 127), 64 * kb, gain, WT, DM, n0, scr, lane, true);
}
DI void ph_prologue(const Params& p, const Ctx& c0) {
    const Ctx c = fresh(c0);
    LAS float* scr = (LAS float*)(c.lds + c.wid * 16384);
    const int gw = c.bid * 8 + c.wid, NGW = c.G * 8, lane = c.lane;
    constexpr int I_GU = 16 * (2 * FF / 32), I_D = (FF / 64) * 32, I_INA = 16 * 32, I_INB = 16 * 56, I_INC = 16, I_SQ = 16 * 32;
    constexpr int PER_LAYER = 2 * I_GU + 2 * I_D + I_INA + I_INB + I_INC + 5 * I_SQ;
    for (int it = gw; it < DEPTH * PER_LAYER; it += NGW) {
        const int l = it / PER_LAYER; int r = it % PER_LAYER;
        unsigned char* wl = c.ws + (size_t)l * W_LAYER;
        if (r < I_GU) { tjob_gu(p.in[I_F1G] + (size_t)l * DM * FF, p.in[I_F1U] + (size_t)l * DM * FF, p.in[I_F1N] + l * DM, (bf16_t*)(wl + W_GU1), r, scr, lane); continue; } r -= I_GU;
        if (r < I_D) { tjob(p.in[I_F1D] + (size_t)l * FF * DM, DM, 0, nullptr, (bf16_t*)(wl + W_D1), FF, DM, r, scr, lane, true); continue; } r -= I_D;
        if (r < I_INA) { tjob(p.in[I_WIN] + (size_t)l * DM * INW, INW, 0, p.in[I_MIXN] + l * DM, (bf16_t*)(wl + W_IN), DM, 1024, r, scr, lane, true, 0); continue; } r -= I_INA;
        if (r < I_INB) { tjob(p.in[I_WIN] + (size_t)l * DM * INW, INW, 1032, p.in[I_MIXN] + l * DM, (bf16_t*)(wl + W_IN), DM, 1792, r, scr, lane, true, 1024); continue; } r -= I_INB;
        if (r < I_INC) { tjob(p.in[I_WIN] + (size_t)l * DM * INW, INW, 1024, p.in[I_MIXN] + l * DM, (bf16_t*)(wl + W_IN), DM, 32, r, scr, lane, true, 2816); continue; } r -= I_INC;
        if (r < I_SQ) { tjob(p.in[I_WOUT] + (size_t)l * DM * DM, DM, 0, nullptr, (bf16_t*)(wl + W_OUT), DM, DM, r, scr, lane); continue; } r -= I_SQ;
        if (r < I_SQ) {
            const int kb = r >> 5, nb = r & 31; const int row = 64 * kb + lane; const float gsc = p.in[I_XN][l * DM + row];
            const f32x4* src = (const f32x4*)(p.in[I_XWQ] + (size_t)l * DM * DM + (size_t)row * DM + 32 * nb); u32x4* dst = (u32x4*)((bf16_t*)(wl + W_Q) + (size_t)row * DM + 32 * nb);
#pragma unroll
            for (int q4 = 0; q4 < 4; ++q4) { const f32x4 x0 = src[2 * q4] * gsc, x1 = src[2 * q4 + 1] * gsc; u32x4 w; w.x = cvtpk(x0[0], x0[1]); w.y = cvtpk(x0[2], x0[3]); w.z = cvtpk(x1[0], x1[1]); w.w = cvtpk(x1[2], x1[3]); dst[q4] = w; }
            continue; } r -= I_SQ;
        if (r < I_SQ) { tjob(p.in[I_XWO] + (size_t)l * DM * DM, DM, 0, nullptr, (bf16_t*)(wl + W_O), DM, DM, r, scr, lane); continue; } r -= I_SQ;
        if (r < I_GU) { tjob_gu(p.in[I_F2G] + (size_t)l * DM * FF, p.in[I_F2U] + (size_t)l * DM * FF, p.in[I_F2N] + l * DM, (bf16_t*)(wl + W_GU2), r, scr, lane); continue; } r -= I_GU;
        if (r < I_D) { tjob(p.in[I_F2D] + (size_t)l * FF * DM, DM, 0, nullptr, (bf16_t*)(wl + W_D2), FF, DM, r, scr, lane, true); continue; } r -= I_D;
        if (r < I_SQ) { tjob(p.in[I_XWKV] + (size_t)l * DM * 2 * DM, 2 * DM, 0, p.in[I_MEMN] + l * DM, wsb(c, OFF_WK) + (size_t)l * DM * DM, DM, DM, r, scr, lane); continue; } r -= I_SQ;
        tjob(p.in[I_XWKV] + (size_t)l * DM * 2 * DM, 2 * DM, DM, p.in[I_MEMN] + l * DM, wsb(c, OFF_WV) + (size_t)l * DM * DM, DM, DM, r, scr, lane);
    }
    for (int m = gw; m < MTOK + MMEM; m += NGW) {
        const bool isx = m < MTOK; const int row = isx ? m : m - MTOK;
        const f32x4* xr = (const f32x4*)((isx ? p.in[I_X] : p.in[I_MEM]) + (size_t)row * DM) + lane;
        unsigned long long* o8 = (unsigned long long*)((isx ? wsb(c, OFF_HB) : wsb(c, OFF_MEMB)) + (size_t)row * DM) + lane;
        float s = 0.f;
#pragma unroll
        for (int j = 0; j < 4; ++j) { const f32x4 v = xr[64 * j]; s += (v[0] * v[0] + v[1] * v[1]) + (v[2] * v[2] + v[3] * v[3]);
            o8[64 * j] = (unsigned long long)cvtpk(v[0], v[1]) | ((unsigned long long)cvtpk(v[2], v[3]) << 32); }
        s = wave_sum(s);
        if (lane == 0) { if (isx) { f32x4* q = (f32x4*)(ssbuf(c, 0) + (size_t)row * 16); q[0] = (f32x4){s, 0.f, 0.f, 0.f}; q[1] = (f32x4){0.f, 0.f, 0.f, 0.f}; q[2] = q[1]; q[3] = q[1]; } else wsf(c, OFF_RSM)[row] = rsqrtf(s * (1.f / DM) + 1e-6f); }
    }
    for (int l = 0; l < DEPTH; ++l) { unsigned char* t11 = c.ws + (size_t)l * W_LAYER + W_IN + (size_t)11 * 16 * 32768;
        for (int i = c.bid * 512 + c.tid; i < 16 * 1792; i += c.G * 512) { const int kt = i / 1792, rem = i - kt * 1792; *(u32x4*)(t11 + (size_t)kt * 32768 + 4096 + (size_t)rem * 16) = (u32x4){0u, 0u, 0u, 0u}; } }
    const int gt = c.bid * 512 + c.tid, NGT = c.G * 512;
    const float* t5 = p.in[I_T5];
    for (int i = gt; i < 4 * 4096; i += NGT) { const int h = i >> 12, d = i & 4095; wsf(c, OFF_DIFFB)[i] = t5[t5_bucket(d) * 8 + 4 + h] * LOG2E; }
    for (int i = gt; i < 3 * 4 * 132; i += NGT) { const int pp = i / (4 * 132), h = (i / 132) & 3, dl = i % 132; const int dil = pp == 0 ? 1 : (pp == 1 ? 4 : 16);
        wsf(c, OFF_DILB)[i] = dl <= 128 ? t5[t5_bucket(dl * dil) * 8 + h] * LOG2E : 0.f; }
    if (gt < DEPTH) { const float* lv = p.in[I_LAMV] + gt * 128; float a = 0.f, b = 0.f; for (int i = 0; i < 32; ++i) { a += lv[i] * lv[32 + i]; b += lv[64 + i] * lv[96 + i]; }
        const float lam_init = 0.8f - 0.6f * expf(-0.3f * (float)gt); wsf(c, OFF_LAM)[gt] = expf(a) - expf(b) + lam_init; }
}

DI void ph_gates(const Params& p, const Ctx& c0, int l) {
    const Ctx c = fresh(c0);
    LAS float* wg = (LAS float*)c.lds;
    const float* win = p.in[I_WIN] + (size_t)l * DM * INW; const float* gn = p.in[I_MIXN] + l * DM;
    for (int i = c.tid; i < DM * 8; i += 512) { const int k = i >> 3, cc = i & 7; wg[i] = win[(size_t)k * INW + 1024 + cc] * gn[k]; }
    __syncthreads();
    const float* h = c.out; const float* ss = ssbuf(c, 4 * l + 1); float* gates = wsf(c, OFF_GATES);
    for (int row = c.bid * 8 + c.wid; row < MTOK; row += c.G * 8) {
        float a[8];
#pragma unroll
        for (int j = 0; j < 8; ++j) a[j] = 0.f;
        const f32x4* xr = (const f32x4*)(h + (size_t)row * DM) + c.lane;
#pragma unroll
        for (int j = 0; j < 4; ++j) { const f32x4 v = xr[64 * j]; const int k0 = 4 * c.lane + 256 * j;
#pragma unroll
            for (int e = 0; e < 4; ++e) { const f32x4 w0 = *(const LAS f32x4*)(wg + (k0 + e) * 8), w1 = *(const LAS f32x4*)(wg + (k0 + e) * 8 + 4);
                a[0] += v[e] * w0[0]; a[1] += v[e] * w0[1]; a[2] += v[e] * w0[2]; a[3] += v[e] * w0[3]; a[4] += v[e] * w1[0]; a[5] += v[e] * w1[1]; a[6] += v[e] * w1[2]; a[7] += v[e] * w1[3]; } }
#pragma unroll
        for (int j = 0; j < 8; ++j) a[j] = wave_sum(a[j]);
        if (c.lane == 0) { const float rs = rowss(ss, row);
            *(f32x4*)(gates + (size_t)row * 8) = (f32x4){a[0] * rs, a[1] * rs, a[2] * rs, a[3] * rs}; *(f32x4*)(gates + (size_t)row * 8 + 4) = (f32x4){a[4] * rs, a[5] * rs, a[6] * rs, a[7] * rs}; }
    }
    __syncthreads();
}

DI void osm_update(f32x16& s, float& m, float& l, f32x16 (&O)[2], bf16x8& p0, bf16x8& p1) {
    float mx = fmaxf(s[0], s[1]);
#pragma unroll
    for (int i = 2; i < 16; ++i) mx = fmaxf(mx, s[i]);
    mx = fmaxf(mx, __shfl_xor(mx, 32));
    const float mn = fmaxf(m, mx);
    if (__any(mn > m)) {
        const float al = ex2(m - mn); l *= al;
#pragma unroll
        for (int i = 0; i < 16; ++i) { O[0][i] *= al; O[1][i] *= al; }
        m = mn;
    }
    float sum = 0.f;
#pragma unroll
    for (int i = 0; i < 16; ++i) { s[i] = ex2(s[i] - m); sum += s[i]; }
    l += sum;
    p0 = pack8(s[0], s[1], s[2], s[3], s[4], s[5], s[6], s[7]);
    p1 = pack8(s[8], s[9], s[10], s[11], s[12], s[13], s[14], s[15]);
}

constexpr int DK_KP = 144, DK_VP = 136;
constexpr int DF_KOFF = 0, DF_VOFF = 2 * 64 * DK_KP, DF_TOFF = DF_VOFF + 2 * 64 * DK_VP;
DI void diff_attn_task(const Params& p, const Ctx& c, int l, int b, int h, int qb) {
    const int tid = c.tid, lane = c.lane, wid = c.wid, r32 = lane & 31, hi = lane >> 5;
    const bf16_t* z = wsb(c, OFF_Z);
    const size_t rowbase = (size_t)b * SEQ;
    LAS unsigned char* lds = c.lds;
    LAS float* tbl = (LAS float*)(lds + DF_TOFF);
    __syncthreads();
    { const float* src = wsf(c, OFF_DIFFB) + h * 4096; for (int i = tid; i < 4096; i += 512) tbl[i] = src[i]; }
    const int qw0 = qb * 256 + wid * 32, qpos = qw0 + r32;
    bf16x8 qf[4];
    { const bf16_t* qp = z + (rowbase + qpos) * ZW + ZQD + h * 64;
#pragma unroll
      for (int s = 0; s < 4; ++s) qf[s] = *(const bf16x8*)(qp + 16 * s + 8 * hi); }
    f32x16 O1[2], O2[2];
#pragma unroll
    for (int i = 0; i < 16; ++i) { O1[0][i] = 0.f; O1[1][i] = 0.f; O2[0][i] = 0.f; O2[1][i] = 0.f; }
    float m1 = NEGBIG, m2 = NEGBIG, l1 = 0.f, l2 = 0.f;
    const int NT = (qb + 1) * 4;
    const int skey = tid >> 3, schunk = tid & 7;
    const bf16_t* kbase = z + (rowbase + skey) * ZW + ZKD + h * 64 + schunk * 8;
    const bf16_t* vbase = z + (rowbase + skey) * ZW + ZVD + h * 64 + schunk * 8;
    u32x4 kreg = *(const u32x4*)kbase, vreg = *(const u32x4*)vbase;
#define DF_WRITE(buf) do { *(LAS u32x4*)(lds + DF_KOFF + (buf) * 64 * DK_KP + skey * DK_KP + schunk * 16) = kreg; \
        LAS bf16_t* vt_ = (LAS bf16_t*)(lds + DF_VOFF + (buf) * 64 * DK_VP + skey * 2); \
        vt_[(schunk * 8 + 0) * (DK_VP / 2)] = (bf16_t)(vreg.x & 0xffff); vt_[(schunk * 8 + 1) * (DK_VP / 2)] = (bf16_t)(vreg.x >> 16); \
        vt_[(schunk * 8 + 2) * (DK_VP / 2)] = (bf16_t)(vreg.y & 0xffff); vt_[(schunk * 8 + 3) * (DK_VP / 2)] = (bf16_t)(vreg.y >> 16); \
        vt_[(schunk * 8 + 4) * (DK_VP / 2)] = (bf16_t)(vreg.z & 0xffff); vt_[(schunk * 8 + 5) * (DK_VP / 2)] = (bf16_t)(vreg.z >> 16); \
        vt_[(schunk * 8 + 6) * (DK_VP / 2)] = (bf16_t)(vreg.w & 0xffff); vt_[(schunk * 8 + 7) * (DK_VP / 2)] = (bf16_t)(vreg.w >> 16); } while (0)
    DF_WRITE(0);
    __syncthreads();
    for (int t = 0; t < NT; ++t) {
        const int buf = t & 1;
        if (t + 1 < NT) { kreg = *(const u32x4*)(kbase + (size_t)(t + 1) * 64 * ZW); vreg = *(const u32x4*)(vbase + (size_t)(t + 1) * 64 * ZW); }
        if (64 * t <= qw0 + 31) {
            const LAS unsigned char* kimg = lds + DF_KOFF + buf * 64 * DK_KP;
            const LAS unsigned char* vimg = lds + DF_VOFF + buf * 64 * DK_VP;
#pragma unroll
            for (int sub = 0; sub < 2; ++sub) {
                const int key0 = 64 * t + 32 * sub;
                if (key0 <= qw0 + 31) {
                    const LAS unsigned char* kr = kimg + (32 * sub + r32) * DK_KP + hi * 16;
                    const bf16x8 k0 = *(const LAS bf16x8*)(kr), k1 = *(const LAS bf16x8*)(kr + 32), k2 = *(const LAS bf16x8*)(kr + 64), k3 = *(const LAS bf16x8*)(kr + 96);
                    f32x16 s1, s2, bv;
                    const int dbase = qpos - key0 - 4 * hi;
                    if (key0 + 31 > qw0) {
#pragma unroll
                        for (int i = 0; i < 16; ++i) { const int d = dbase - ((i & 3) + 8 * (i >> 2)); const float bi = tbl[d < 0 ? 0 : d]; bv[i] = d < 0 ? NEGBIG : bi; }
                    } else {
#pragma unroll
                        for (int i = 0; i < 16; ++i) bv[i] = tbl[dbase - ((i & 3) + 8 * (i >> 2))];
                    }
                    s1 = MFMA32(k0, qf[0], bv); s1 = MFMA32(k1, qf[1], s1);
                    s2 = MFMA32(k2, qf[2], bv); s2 = MFMA32(k3, qf[3], s2);
                    bf16x8 pa0, pa1, pb0, pb1;
                    osm_update(s1, m1, l1, O1, pa0, pa1);
                    osm_update(s2, m2, l2, O2, pb0, pb1);
#pragma unroll
                    for (int dvt = 0; dvt < 2; ++dvt) {
                        const LAS unsigned char* vr = vimg + (32 * dvt + r32) * DK_VP + (32 * sub + 4 * hi) * 2;
                        const bf16x8 v0 = mk8(*(const LAS u32x2*)(vr), *(const LAS u32x2*)(vr + 16));
                        const bf16x8 v1 = mk8(*(const LAS u32x2*)(vr + 32), *(const LAS u32x2*)(vr + 48));
                        O1[dvt] = MFMA32(v0, pa0, O1[dvt]); O1[dvt] = MFMA32(v1, pa1, O1[dvt]);
                        O2[dvt] = MFMA32(v0, pb0, O2[dvt]); O2[dvt] = MFMA32(v1, pb1, O2[dvt]);
                    }
                }
            }
        }
        if (t + 1 < NT) DF_WRITE(buf ^ 1);
        __syncthreads();
    }
#undef DF_WRITE
    l1 += __shfl_xor(l1, 32); l2 += __shfl_xor(l2, 32);
    const float lam = wsf(c, OFF_LAM)[l];
    const float lam_init = 0.8f - 0.6f * expf(-0.3f * (float)l);
    const float i1 = 1.f / l1, i2 = lam / l2;
    float ssq = 0.f;
#pragma unroll
    for (int dvt = 0; dvt < 2; ++dvt)
#pragma unroll
        for (int i = 0; i < 16; ++i) { const float o = O1[dvt][i] * i1 - O2[dvt][i] * i2; O1[dvt][i] = o; ssq += o * o; }
    ssq += __shfl_xor(ssq, 32);
    const float rn = rsqrtf(ssq * (1.f / 64.f) + 1e-5f) * (1.f - lam_init);
    const float* sg = p.in[I_SUBLN] + l * 64;
    bf16_t* yrow = wsb(c, OFF_Y) + (rowbase + qpos) * DM + 768 + h * 64;
#pragma unroll
    for (int dvt = 0; dvt < 2; ++dvt)
#pragma unroll
        for (int g = 0; g < 4; ++g) {
            const int dv = 32 * dvt + 8 * g + 4 * hi; const f32x4 gg = *(const f32x4*)(sg + dv);
            u32x2 w; w.x = cvtpk(O1[dvt][4 * g] * rn * gg[0], O1[dvt][4 * g + 1] * rn * gg[1]); w.y = cvtpk(O1[dvt][4 * g + 2] * rn * gg[2], O1[dvt][4 * g + 3] * rn * gg[3]);
            *(u32x2*)(yrow + dv) = w;
        }
}

constexpr int DL_NK = 384, DL_KP = 144, DL_VP = 776;
constexpr int DL_KOFF = 0, DL_VOFF = DL_NK * DL_KP, DL_TOFF = DL_VOFF + 64 * DL_VP;
DI void dil_attn_task(const Params& p, const Ctx& c, int pat, int b, int h, int res, int mb) {
    const int dil = pat == 0 ? 1 : (pat == 1 ? 4 : 16);
    const int tid = c.tid, lane = c.lane, wid = c.wid, r32 = lane & 31, hi = lane >> 5;
    const bf16_t* z = wsb(c, OFF_Z);
    const size_t rowbase = (size_t)b * SEQ;
    LAS unsigned char* lds = c.lds;
    LAS float* tbl = (LAS float*)(lds + DL_TOFF);
    __syncthreads();
    if (tid < 132) tbl[tid] = wsf(c, OFF_DILB)[(pat * 4 + h) * 132 + tid];
    const int mk0 = 256 * mb - 128;
    {
        u32x4 kreg[6], vreg[6];
#pragma unroll
        for (int it = 0; it < 6; ++it) {
            const int idx = tid + 512 * it, key = idx >> 3, chunk = idx & 7, mk = mk0 + key;
            kreg[it] = (u32x4){0u, 0u, 0u, 0u}; vreg[it] = (u32x4){0u, 0u, 0u, 0u};
            if (mk >= 0) { const bf16_t* rp = z + (rowbase + (size_t)mk * dil + res) * ZW + h * 64 + chunk * 8; kreg[it] = *(const u32x4*)(rp + ZKC); vreg[it] = *(const u32x4*)(rp + ZVC); }
        }
#pragma unroll
        for (int it = 0; it < 6; ++it) {
            const int idx = tid + 512 * it, key = idx >> 3, chunk = idx & 7;
            *(LAS u32x4*)(lds + DL_KOFF + key * DL_KP + chunk * 16) = kreg[it];
            LAS bf16_t* vt_ = (LAS bf16_t*)(lds + DL_VOFF + key * 2);
            vt_[(chunk * 8 + 0) * (DL_VP / 2)] = (bf16_t)(vreg[it].x & 0xffff); vt_[(chunk * 8 + 1) * (DL_VP / 2)] = (bf16_t)(vreg[it].x >> 16);
            vt_[(chunk * 8 + 2) * (DL_VP / 2)] = (bf16_t)(vreg[it].y & 0xffff); vt_[(chunk * 8 + 3) * (DL_VP / 2)] = (bf16_t)(vreg[it].y >> 16);
            vt_[(chunk * 8 + 4) * (DL_VP / 2)] = (bf16_t)(vreg[it].z & 0xffff); vt_[(chunk * 8 + 5) * (DL_VP / 2)] = (bf16_t)(vreg[it].z >> 16);
            vt_[(chunk * 8 + 6) * (DL_VP / 2)] = (bf16_t)(vreg[it].w & 0xffff); vt_[(chunk * 8 + 7) * (DL_VP / 2)] = (bf16_t)(vreg[it].w >> 16);
        }
    }
    const int mq = 256 * mb + 32 * wid + r32;
    const size_t qtok = rowbase + (size_t)mq * dil + res;
    bf16x8 qf[4];
    { const bf16_t* qp = z + qtok * ZW + ZQC + h * 64;
#pragma unroll
      for (int s = 0; s < 4; ++s) qf[s] = *(const bf16x8*)(qp + 16 * s + 8 * hi); }
    __syncthreads();
    f32x16 O[2];
#pragma unroll
    for (int i = 0; i < 16; ++i) { O[0][i] = 0.f; O[1][i] = 0.f; }
    float m = NEGBIG, lsum = 0.f;
    for (int j = 0; j < 5; ++j) {
        const int kt = wid + j;
        const LAS unsigned char* kr = lds + DL_KOFF + (32 * kt + r32) * DL_KP + hi * 16;
        f32x16 s;
        const int dbase = 128 - 32 * j + r32 - 4 * hi;
        const int mkb = mk0 + 32 * kt + 4 * hi;
        if (j == 0 || j == 4 || mb == 0) {
#pragma unroll
            for (int i = 0; i < 16; ++i) { const int cc = (i & 3) + 8 * (i >> 2); const int dl = dbase - cc; const bool ok = (dl >= 0) && (dl <= 128) && (mkb + cc >= 0);
                const int dc = dl < 0 ? 0 : (dl > 128 ? 128 : dl); s[i] = ok ? tbl[dc] : NEGBIG; }
        } else {
#pragma unroll
            for (int i = 0; i < 16; ++i) s[i] = tbl[dbase - ((i & 3) + 8 * (i >> 2))];
        }
#pragma unroll
        for (int ks = 0; ks < 4; ++ks) s = MFMA32(*(const LAS bf16x8*)(kr + 32 * ks), qf[ks], s);
        bf16x8 p0, p1;
        osm_update(s, m, lsum, O, p0, p1);
#pragma unroll
        for (int dvt = 0; dvt < 2; ++dvt) {
            const LAS unsigned char* vr = lds + DL_VOFF + (32 * dvt + r32) * DL_VP + (32 * kt + 4 * hi) * 2;
            const bf16x8 v0 = mk8(*(const LAS u32x2*)(vr), *(const LAS u32x2*)(vr + 16));
            const bf16x8 v1 = mk8(*(const LAS u32x2*)(vr + 32), *(const LAS u32x2*)(vr + 48));
            O[dvt] = MFMA32(v0, p0, O[dvt]); O[dvt] = MFMA32(v1, p1, O[dvt]);
        }
    }
    lsum += __shfl_xor(lsum, 32);
    const float inv = 1.f / lsum, lse = m + log2f(lsum);
    if (pat != 0) {
        bf16_t* orow = ((bf16_t*)((unsigned char*)c.out + (size_t)64 * 64 * 4096 * 4)) + ((size_t)(pat - 1) * MTOK + qtok) * 256 + h * 64;
#pragma unroll
        for (int dvt = 0; dvt < 2; ++dvt)
#pragma unroll
            for (int g = 0; g < 4; ++g) { u32x2 w; w.x = cvtpk(O[dvt][4 * g] * inv, O[dvt][4 * g + 1] * inv); w.y = cvtpk(O[dvt][4 * g + 2] * inv, O[dvt][4 * g + 3] * inv);
                *(u32x2*)(orow + 32 * dvt + 8 * g + 4 * hi) = w; }
        if (hi == 0) wsf(c, OFF_LSEP)[((size_t)(pat - 1) * MTOK + qtok) * 4 + h] = lse;
    } else {
        const float ls1 = wsf(c, OFF_LSEP)[qtok * 4 + h], ls2 = wsf(c, OFF_LSEP)[((size_t)MTOK + qtok) * 4 + h];
        const float mm = fmaxf(lse, fmaxf(ls1, ls2));
        const float w0 = ex2(lse - mm), w1 = ex2(ls1 - mm), w2 = ex2(ls2 - mm), wi = 1.f / (w0 + w1 + w2);
        const float a0 = w0 * wi * inv, a1 = w1 * wi, a2 = w2 * wi;
        const bf16_t* o1 = ((bf16_t*)((unsigned char*)c.out + (size_t)64 * 64 * 4096 * 4)) + qtok * 256 + h * 64; const bf16_t* o2 = o1 + (size_t)MTOK * 256;
        bf16_t* yrow = wsb(c, OFF_Y) + qtok * DM + 512 + h * 64;
#pragma unroll
        for (int dvt = 0; dvt < 2; ++dvt)
#pragma unroll
            for (int g = 0; g < 4; ++g) { const int dv = 32 * dvt + 8 * g + 4 * hi; const u32x2 x1 = *(const u32x2*)(o1 + dv), x2 = *(const u32x2*)(o2 + dv);
                const float r0 = O[dvt][4 * g] * a0 + bflo(x1.x) * a1 + bflo(x2.x) * a2, r1 = O[dvt][4 * g + 1] * a0 + bfhi(x1.x) * a1 + bfhi(x2.x) * a2;
                const float r2 = O[dvt][4 * g + 2] * a0 + bflo(x1.y) * a1 + bflo(x2.y) * a2, r3 = O[dvt][4 * g + 3] * a0 + bfhi(x1.y) * a1 + bfhi(x2.y) * a2;
                u32x2 w; w.x = cvtpk(r0, r1); w.y = cvtpk(r2, r3); *(u32x2*)(yrow + dv) = w; }
    }
}

DI void pool_x(const bf16_t* bp0, int w, int cnt, float icnt, bf16x8 (&xf)[4]) {
    float sum[4][8]; u32x4 cur[4];
#pragma unroll
    for (int ks = 0; ks < 4; ++ks) {
        const bf16_t* bp = bp0 + 16 * ks;
        cur[ks] = *(const u32x4*)bp; const u32x4 prv = (cnt > 1) ? *(const u32x4*)(bp - ZW) : (u32x4){0u, 0u, 0u, 0u};
        sum[ks][0] = bflo(cur[ks].x) + bflo(prv.x); sum[ks][1] = bfhi(cur[ks].x) + bfhi(prv.x); sum[ks][2] = bflo(cur[ks].y) + bflo(prv.y); sum[ks][3] = bfhi(cur[ks].y) + bfhi(prv.y);
        sum[ks][4] = bflo(cur[ks].z) + bflo(prv.z); sum[ks][5] = bfhi(cur[ks].z) + bfhi(prv.z); sum[ks][6] = bflo(cur[ks].w) + bflo(prv.w); sum[ks][7] = bfhi(cur[ks].w) + bfhi(prv.w);
    }
#pragma unroll 1
    for (int j0 = 2; j0 < w; j0 += 2) {
        u32x4 v0[4], v1[4];
#pragma unroll
        for (int ks = 0; ks < 4; ++ks) { v0[ks] = (u32x4){0u, 0u, 0u, 0u}; v1[ks] = (u32x4){0u, 0u, 0u, 0u};
            if (j0 < cnt) v0[ks] = *(const u32x4*)(bp0 + 16 * ks - (size_t)j0 * ZW);
            if (j0 + 1 < cnt) v1[ks] = *(const u32x4*)(bp0 + 16 * ks - (size_t)(j0 + 1) * ZW); }
#pragma unroll
        for (int ks = 0; ks < 4; ++ks) {
            sum[ks][0] += bflo(v0[ks].x) + bflo(v1[ks].x); sum[ks][1] += bfhi(v0[ks].x) + bfhi(v1[ks].x); sum[ks][2] += bflo(v0[ks].y) + bflo(v1[ks].y); sum[ks][3] += bfhi(v0[ks].y) + bfhi(v1[ks].y);
            sum[ks][4] += bflo(v0[ks].z) + bflo(v1[ks].z); sum[ks][5] += bfhi(v0[ks].z) + bfhi(v1[ks].z); sum[ks][6] += bflo(v0[ks].w) + bflo(v1[ks].w); sum[ks][7] += bfhi(v0[ks].w) + bfhi(v1[ks].w); }
    }
#pragma unroll
    for (int ks = 0; ks < 4; ++ks)
        xf[ks] = pack8(sum[ks][0] * icnt - bflo(cur[ks].x), sum[ks][1] * icnt - bfhi(cur[ks].x), sum[ks][2] * icnt - bflo(cur[ks].y), sum[ks][3] * icnt - bfhi(cur[ks].y),
                       sum[ks][4] * icnt - bflo(cur[ks].z), sum[ks][5] * icnt - bfhi(cur[ks].z), sum[ks][6] * icnt - bflo(cur[ks].w), sum[ks][7] * icnt - bfhi(cur[ks].w));
}
DI void pool_task(const Params& p, const Ctx& c, int l, int wt) {
    const int lane = c.lane, r32 = lane & 31, hi = lane >> 5;
    const int g = (wt + (wt >> 11)) & 3, rt = wt >> 2;
    const size_t row = (size_t)rt * 32 + r32; const int t = (int)(row & (SEQ - 1));
    const int w = 2 << g, cnt = (t + 1 < w) ? t + 1 : w; const float icnt = 1.f / (float)cnt;
    const bf16_t* z = wsb(c, OFF_Z);
    bf16x8 xf[4];
    const bf16_t* bp0 = z + row * ZW + ZPB + g * 64 + 8 * hi;
    pool_x(bp0, w, cnt, icnt, xf);
    const float* pw = p.in[I_POOLW] + ((size_t)l * 4 + g) * 64 * 64;
    const float* psc = p.in[I_POOLS] + l * 256 + g * 64;
    bf16_t* yrow = wsb(c, OFF_Y) + row * DM + 256 + g * 64;
#pragma unroll
    for (int dt = 0; dt < 2; ++dt) {
        f32x16 acc;
#pragma unroll
        for (int i = 0; i < 16; ++i) acc[i] = 0.f;
#pragma unroll
        for (int ks = 0; ks < 4; ++ks) {
            const float* wp = pw + (size_t)(16 * ks + 8 * hi) * 64 + 32 * dt + r32;
            const bf16x8 wf = pack8(wp[0], wp[64], wp[128], wp[192], wp[256], wp[320], wp[384], wp[448]);
            acc = MFMA32(wf, xf[ks], acc);
        }
#pragma unroll
        for (int gq = 0; gq < 4; ++gq) { const int dd = 32 * dt + 8 * gq + 4 * hi; const f32x4 sc = *(const f32x4*)(psc + dd);
            u32x2 wv; wv.x = cvtpk(acc[4 * gq] * sc[0], acc[4 * gq + 1] * sc[1]); wv.y = cvtpk(acc[4 * gq + 2] * sc[2], acc[4 * gq + 3] * sc[3]); *(u32x2*)(yrow + dd) = wv; }
    }
}

DI float scan_add(float v, int lane) {
#pragma unroll
    for (int o = 1; o < 64; o <<= 1) { const float n = __shfl_up(v, o); if (lane >= o) v += n; }
    return v;
}
DI float scan_max(float v, int lane) {
#pragma unroll
    for (int o = 1; o < 64; o <<= 1) { const float n = __shfl_up(v, o); if (lane >= o) v = fmaxf(v, n); }
    return v;
}
DI float log_sigmoid(float x) { return fminf(x, 0.f) - log1pf(expf(-fabsf(x))); }
DI void conv8(const bf16_t* zp, int t, const float* cw, const float* cb, float scale, float (&o)[8]) {
    const f32x4 b0 = *(const f32x4*)cb, b1 = *(const f32x4*)(cb + 4);
    o[0] = b0[0]; o[1] = b0[1]; o[2] = b0[2]; o[3] = b0[3]; o[4] = b1[0]; o[5] = b1[1]; o[6] = b1[2]; o[7] = b1[3];
#pragma unroll
    for (int tap = 0; tap < 4; ++tap) {
        if (t - 3 + tap >= 0) {
            const u32x4 v = *(const u32x4*)(zp - (size_t)(3 - tap) * ZW);
            const f32x4 w0 = *(const f32x4*)(cw + tap * 512), w1 = *(const f32x4*)(cw + tap * 512 + 4);
            o[0] += bflo(v.x) * w0[0]; o[1] += bfhi(v.x) * w0[1]; o[2] += bflo(v.y) * w0[2]; o[3] += bfhi(v.y) * w0[3];
            o[4] += bflo(v.z) * w1[0]; o[5] += bfhi(v.z) * w1[1]; o[6] += bflo(v.w) * w1[2]; o[7] += bfhi(v.w) * w1[3];
        }
    }
#pragma unroll
    for (int e = 0; e < 8; ++e) o[e] = silu_f(o[e]) * scale;
    asm volatile("" ::: "memory");
}
DI void conv_frag4(const bf16_t* zp, int t, const LAS float* cw, const LAS float* cb, int hi, float scale, bf16x8 (&out)[4]) {
    asm volatile("" ::: "memory");
#pragma unroll
    for (int kh = 0; kh < 2; ++kh) {
        u32x4 v[2][4];
#pragma unroll
        for (int k2 = 0; k2 < 2; ++k2)
#pragma unroll
            for (int tap = 0; tap < 4; ++tap) { v[k2][tap] = (u32x4){0u, 0u, 0u, 0u}; if (t - 3 + tap >= 0) v[k2][tap] = *(const u32x4*)(zp + 16 * (2 * kh + k2) - (size_t)(3 - tap) * ZW); }
#pragma unroll
        for (int k2 = 0; k2 < 2; ++k2) {
            const int ks = 2 * kh + k2, d0 = 16 * ks + 8 * hi;
            const f32x4 b0 = *(const LAS f32x4*)(cb + d0), b1 = *(const LAS f32x4*)(cb + d0 + 4);
            float o[8] = {b0[0], b0[1], b0[2], b0[3], b1[0], b1[1], b1[2], b1[3]};
#pragma unroll
            for (int tap = 0; tap < 4; ++tap) {
                const f32x4 w0 = *(const LAS f32x4*)(cw + tap * 64 + d0), w1 = *(const LAS f32x4*)(cw + tap * 64 + d0 + 4); const u32x4 x = v[k2][tap];
                o[0] += bflo(x.x) * w0[0]; o[1] += bfhi(x.x) * w0[1]; o[2] += bflo(x.y) * w0[2]; o[3] += bfhi(x.y) * w0[3];
                o[4] += bflo(x.z) * w1[0]; o[5] += bfhi(x.z) * w1[1]; o[6] += bflo(x.w) * w1[2]; o[7] += bfhi(x.w) * w1[3];
            }
            out[ks] = pack8(silu_f(o[0]) * scale, silu_f(o[1]) * scale, silu_f(o[2]) * scale, silu_f(o[3]) * scale, silu_f(o[4]) * scale, silu_f(o[5]) * scale, silu_f(o[6]) * scale, silu_f(o[7]) * scale);
        }
        asm volatile("" ::: "memory");
    }
}
DI void mlstm_a_task(const Params& p, const Ctx& c, int l, int task) {
    const int lane = c.lane, r32 = lane & 31, hi = lane >> 5;
    const int bh = task >> 6, ch = task & 63, b = bh >> 2, h = bh & 3, t0 = ch * 64;
    const size_t rowbase = (size_t)b * SEQ;
    const bf16_t* z = wsb(c, OFF_Z);
    const float* gates = wsf(c, OFF_GATES) + (rowbase + t0 + lane) * 8;
    const float* gb = p.in[I_GATEB] + l * 8;
    const float ig = gates[h] + gb[h], lf = log_sigmoid(gates[4 + h] + gb[4 + h]);
    const float bcs = scan_add(lf, lane);
    const float gp = ig - bcs;
    const float mu = wave_max(gp);
    const float ws_ = expf(gp - mu);
    const float Bc = __shfl(bcs, 63);
    if (lane == 0) { wsf(c, OFF_SCAL)[task] = Bc; wsf(c, OFF_SCAL)[4096 + task] = mu; }
    const float* cwl = p.in[I_CONVW] + (size_t)l * 4 * 512; const float* cbl = p.in[I_CONVB] + l * 512;
    f32x16 acc[2][2];
#pragma unroll
    for (int a = 0; a < 2; ++a)
#pragma unroll
        for (int bb = 0; bb < 2; ++bb)
#pragma unroll
            for (int i = 0; i < 16; ++i) acc[a][bb][i] = 0.f;
    float nsum[2] = {0.f, 0.f};
#pragma unroll
    for (int ks = 0; ks < 4; ++ks) {
        const int s0 = 16 * ks + 8 * hi;
        float wv[8];
#pragma unroll
        for (int j = 0; j < 8; ++j) wv[j] = __shfl(ws_, s0 + j);
        bf16x8 kf[2];
#pragma unroll
        for (int it = 0; it < 2; ++it) {
            const int chn = 256 + h * 64 + 32 * it + r32;
            const float w0 = cwl[chn], w1 = cwl[512 + chn], w2 = cwl[1024 + chn], w3 = cwl[1536 + chn], cb = cbl[chn];
            const bf16_t* kp = z + (rowbase + t0 + s0) * ZW + ZKA + h * 64 + 32 * it + r32;
            float raw[11];
#pragma unroll
            for (int x = 0; x < 11; ++x) raw[x] = (t0 + s0 - 3 + x >= 0) ? bf2f(kp[(long)(x - 3) * ZW]) : 0.f;
            float kk[8];
#pragma unroll
            for (int j = 0; j < 8; ++j) { const float o = cb + w0 * raw[j] + w1 * raw[j + 1] + w2 * raw[j + 2] + w3 * raw[j + 3]; kk[j] = silu_f(o) * 0.125f * wv[j]; nsum[it] += kk[j]; }
            kf[it] = pack8(kk[0], kk[1], kk[2], kk[3], kk[4], kk[5], kk[6], kk[7]);
        }
#pragma unroll
        for (int et = 0; et < 2; ++et) {
            const bf16_t* vp = z + (rowbase + t0 + s0) * ZW + ZVA + h * 64 + 32 * et + r32;
            u32x4 w; w.x = (unsigned)vp[0] | ((unsigned)vp[ZW] << 16); w.y = (unsigned)vp[2 * ZW] | ((unsigned)vp[3 * ZW] << 16);
            w.z = (unsigned)vp[4 * ZW] | ((unsigned)vp[5 * ZW] << 16); w.w = (unsigned)vp[6 * ZW] | ((unsigned)vp[7 * ZW] << 16);
            const bf16x8 vf = __builtin_bit_cast(bf16x8, w);
            acc[et][0] = MFMA32(vf, kf[0], acc[et][0]); acc[et][1] = MFMA32(vf, kf[1], acc[et][1]);
        }
    }
    float* D = ((float*)c.out) + (size_t)task * 4096;
#pragma unroll
    for (int et = 0; et < 2; ++et)
#pragma unroll
        for (int it = 0; it < 2; ++it)
#pragma unroll
            for (int i = 0; i < 16; ++i) D[(32 * et + crow(i, hi)) * 64 + 32 * it + r32] = acc[et][it][i];
    nsum[0] += __shfl_xor(nsum[0], 32); nsum[1] += __shfl_xor(nsum[1], 32);
    if (hi == 0) { wsf(c, OFF_NST)[(size_t)task * 64 + r32] = nsum[0]; wsf(c, OFF_NST)[(size_t)task * 64 + 32 + r32] = nsum[1]; }
}
DI void mlstm_scan(const Params& p, const Ctx& c) {
    const float* Bc = wsf(c, OFF_SCAL); const float* mu = Bc + 4096; float* mprev = wsf(c, OFF_SCAL) + 8192;
    float* D = ((float*)c.out); float* N = wsf(c, OFF_NST);
    LAS float* cwl = (LAS float*)c.lds; LAS float* swl = cwl + 64;
    for (int task = c.bid; task < 256; task += c.G) {
        const int bh = task >> 2, q = task & 3;
        __syncthreads();
        if (c.wid == 0) {
            const float B = Bc[bh * 64 + c.lane], u = mu[bh * 64 + c.lane];
            float m = 0.f, mycw = 0.f, mysw = 0.f, mymp = 0.f;
            for (int ch = 0; ch < 64; ++ch) {
                const float Bs = __shfl(B, ch), us = __shfl(u, ch);
                const float mnew = fmaxf(Bs + m, Bs + us);
                const float cw = expf(Bs + m - mnew), sw = expf(Bs + us - mnew);
                if (c.lane == ch) { mycw = cw; mysw = sw; mymp = m; }
                m = mnew;
            }
            cwl[c.lane] = mycw; swl[c.lane] = mysw;
            if (q == 0) mprev[bh * 64 + c.lane] = mymp;
        }
        __syncthreads();
        for (int idx = q * 1040 + c.tid; idx < (q + 1) * 1040; idx += 512) {
            float* base = idx < 4096 ? D + (size_t)bh * 64 * 4096 + idx : N + (size_t)bh * 64 * 64 + (idx - 4096);
            const size_t stride = idx < 4096 ? 4096 : 64;
            float d[64];
#pragma unroll
            for (int ch = 0; ch < 64; ++ch) d[ch] = base[(size_t)ch * stride];
            float C = 0.f;
#pragma unroll
            for (int ch = 0; ch < 64; ++ch) { const float dv = d[ch]; base[(size_t)ch * stride] = C; C = cwl[ch] * C + swl[ch] * dv; }
        }
    }
}
DI void mlstm_c_task(const Params& p, const Ctx& c, int l, int task) {
    const int lane = c.lane, r32 = lane & 31, hi = lane >> 5;
    const int bh = task >> 6, ch = task & 63, b = bh >> 2, h = bh & 3, t0 = ch * 64;
    const size_t rowbase = (size_t)b * SEQ;
    const bf16_t* z = wsb(c, OFF_Z);
    const float* gates = wsf(c, OFF_GATES) + (rowbase + t0 + lane) * 8;
    const float* gb = p.in[I_GATEB] + l * 8;
    const float ig = gates[h] + gb[h], lf = log_sigmoid(gates[4 + h] + gb[4 + h]);
    const float bcs = scan_add(lf, lane);
    const float gp = ig - bcs;
    const float mp = wsf(c, OFF_SCAL)[8192 + task];
    const float pm = scan_max(gp, lane);
    const float mt = bcs + fmaxf(mp, pm);
    const float bm = bcs - mt;
    const float iw = expf(bcs + mp - mt);
    const float flo = expf(-mt);
    const float* cwl = p.in[I_CONVW] + (size_t)l * 4 * 512; const float* cbl = p.in[I_CONVB] + l * 512;
    const float* Ct = ((float*)c.out) + (size_t)task * 4096;
    const float* nst = wsf(c, OFF_NST) + (size_t)task * 64;
    const float* ng = p.in[I_MLN] + l * 256 + h * 64;
#pragma unroll 1
    for (int tt = 0; tt < 2; ++tt) {
        const int tq = 32 * tt + r32;
        const float bm_t = __shfl(bm, tq), iw_t = __shfl(iw, tq), flo_t = __shfl(flo, tq);
        bf16x8 qf[4]; float qn = 0.f;
#pragma unroll
        for (int ks = 0; ks < 4; ++ks) { float o[8]; const int d0 = 16 * ks + 8 * hi;
            conv8(z + (rowbase + t0 + tq) * ZW + ZQA + h * 64 + d0, t0 + tq, cwl + h * 64 + d0, cbl + h * 64 + d0, 1.f, o);
            qf[ks] = pack8(o[0], o[1], o[2], o[3], o[4], o[5], o[6], o[7]);
            const u32x4 qw = __builtin_bit_cast(u32x4, qf[ks]);
            const f32x4 n0 = *(const f32x4*)(nst + d0), n1 = *(const f32x4*)(nst + d0 + 4);
            qn += bflo(qw.x) * n0[0] + bfhi(qw.x) * n0[1] + bflo(qw.y) * n0[2] + bfhi(qw.y) * n0[3] + bflo(qw.z) * n1[0] + bfhi(qw.z) * n1[1] + bflo(qw.w) * n1[2] + bfhi(qw.w) * n1[3]; }
        qn += __shfl_xor(qn, 32);
        f32x16 num[2];
#pragma unroll
        for (int i = 0; i < 16; ++i) { num[0][i] = 0.f; num[1][i] = 0.f; }
#pragma unroll
        for (int et = 0; et < 2; ++et)
#pragma unroll
            for (int ks = 0; ks < 4; ++ks) { const float* cp = Ct + (size_t)(32 * et + r32) * 64 + 16 * ks + 8 * hi; const f32x4 c0 = *(const f32x4*)cp, c1 = *(const f32x4*)(cp + 4);
                num[et] = MFMA32(pack8(c0[0], c0[1], c0[2], c0[3], c1[0], c1[1], c1[2], c1[3]), qf[ks], num[et]); }
#pragma unroll
        for (int i = 0; i < 16; ++i) { num[0][i] *= iw_t; num[1][i] *= iw_t; }
        float dsum = 0.f;
#pragma unroll 1
        for (int st = 0; st <= tt; ++st) {
            f32x16 s;
#pragma unroll
            for (int i = 0; i < 16; ++i) s[i] = 0.f;
#pragma unroll
            for (int ks = 0; ks < 4; ++ks) { float o[8]; const int sk = 32 * st + r32, d0 = 16 * ks + 8 * hi;
                conv8(z + (rowbase + t0 + sk) * ZW + ZKA + h * 64 + d0, t0 + sk, cwl + 256 + h * 64 + d0, cbl + 256 + h * 64 + d0, 0.125f, o);
                s = MFMA32(pack8(o[0], o[1], o[2], o[3], o[4], o[5], o[6], o[7]), qf[ks], s); }
#pragma unroll
            for (int i = 0; i < 16; ++i) { const int sp = 32 * st + crow(i, hi); const float gs = __shfl(gp, sp);
                const float wgt = (sp <= tq) ? expf(gs + bm_t) : 0.f; s[i] *= wgt; dsum += s[i]; }
            const bf16x8 p0 = pack8(s[0], s[1], s[2], s[3], s[4], s[5], s[6], s[7]), p1 = pack8(s[8], s[9], s[10], s[11], s[12], s[13], s[14], s[15]);
#pragma unroll
            for (int et = 0; et < 2; ++et)
#pragma unroll
                for (int k2 = 0; k2 < 2; ++k2) {
                    const bf16_t* vp = z + (rowbase + t0 + 32 * st + 16 * k2 + 4 * hi) * ZW + ZVA + h * 64 + 32 * et + r32;
                    u32x4 w; w.x = (unsigned)vp[0] | ((unsigned)vp[ZW] << 16); w.y = (unsigned)vp[2 * ZW] | ((unsigned)vp[3 * ZW] << 16);
                    w.z = (unsigned)vp[8 * ZW] | ((unsigned)vp[9 * ZW] << 16); w.w = (unsigned)vp[10 * ZW] | ((unsigned)vp[11 * ZW] << 16);
                    num[et] = MFMA32(__builtin_bit_cast(bf16x8, w), k2 == 0 ? p0 : p1, num[et]);
                }
        }
        dsum += __shfl_xor(dsum, 32);
        const float den = iw_t * qn + dsum;
        const float idn = 1.f / fmaxf(fabsf(den), flo_t);
        float sm = 0.f;
#pragma unroll
        for (int et = 0; et < 2; ++et)
#pragma unroll
            for (int i = 0; i < 16; ++i) { const float hv = num[et][i] * idn; num[et][i] = hv; sm += hv; }
        sm += __shfl_xor(sm, 32);
        const float mean = sm * (1.f / 64.f);
        float vs = 0.f;
#pragma unroll
        for (int et = 0; et < 2; ++et)
#pragma unroll
            for (int i = 0; i < 16; ++i) { const float d = num[et][i] - mean; num[et][i] = d; vs += d * d; }
        vs += __shfl_xor(vs, 32);
        const float rstd = rsqrtf(vs * (1.f / 64.f) + 1e-6f);
        const size_t tok = rowbase + t0 + tq;
        const bf16_t* orow = z + tok * ZW + ZOA + h * 64; bf16_t* yrow = wsb(c, OFF_Y) + tok * DM + h * 64;
#pragma unroll
        for (int et = 0; et < 2; ++et)
#pragma unroll
            for (int g = 0; g < 4; ++g) { const int e = 32 * et + 8 * g + 4 * hi; const f32x4 gg = *(const f32x4*)(ng + e); const u32x2 ov = *(const u32x2*)(orow + e);
                const float y0 = num[et][4 * g] * rstd * gg[0] * sigmoid_f(bflo(ov.x)), y1 = num[et][4 * g + 1] * rstd * gg[1] * sigmoid_f(bfhi(ov.x));
                const float y2 = num[et][4 * g + 2] * rstd * gg[2] * sigmoid_f(bflo(ov.y)), y3 = num[et][4 * g + 3] * rstd * gg[3] * sigmoid_f(bfhi(ov.y));
                u32x2 w; w.x = cvtpk(y0, y1); w.y = cvtpk(y2, y3); *(u32x2*)(yrow + e) = w; }
    }
}

DI void ph_mix1(const Params& p, const Ctx& c0, int l) {
    const Ctx c = fresh(c0);
    REP(R_DIFF) for (int pt = c.bid; pt < 512; pt += c.G) { const int bh = pt >> 3, s = pt & 7; diff_attn_task(p, c, l, bh >> 2, bh & 3, 15 - s); diff_attn_task(p, c, l, bh >> 2, bh & 3, s); }
    REP(R_DIL) for (int i = c.bid; i < 1024; i += c.G) { const int bh = i >> 4, rest = i & 15; dil_attn_task(p, c, 1, bh >> 2, bh & 3, rest >> 2, rest & 3); }
    REP(R_DIL) for (int i = c.bid; i < 1024; i += c.G) { const int bh = i >> 4; dil_attn_task(p, c, 2, bh >> 2, bh & 3, i & 15, 0); }
    __syncthreads();
    REP(R_POOL) for (int wt = c.bid * 8 + c.wid; wt < 8192; wt += c.G * 8) pool_task(p, c, l, wt);
    REP(R_MLA) for (int tk = c.bid * 8 + c.wid; tk < 4096; tk += c.G * 8) mlstm_a_task(p, c, l, tk);
}
DI void ph_mix2(const Params& p, const Ctx& c0, int l) {
    const Ctx c = fresh(c0);
    mlstm_scan(p, c);
    REP(R_DIL) for (int i = c.bid; i < 1024; i += c.G) { const int bh = i >> 4; dil_attn_task(p, c, 0, bh >> 2, bh & 3, 0, i & 15); }
    __syncthreads();
}
DI void ph_mix3(const Params& p, const Ctx& c0, int l) {
    const Ctx c = fresh(c0);
    REP(R_MLC) for (int tk = c.bid * 8 + c.wid; tk < 4096; tk += c.G * 8) mlstm_c_task(p, c, l, tk);
}
DI void ph_final(const Params& p, const Ctx& c0) {
    const Ctx c = fresh(c0);
    const float* ss = ssbuf(c, 16); const float* g = p.in[I_FINN]; const bf16_t* hb = wsb(c, OFF_HB);
    for (int row = c.bid * 8 + c.wid; row < MTOK; row += c.G * 8) {
        const float rs = rowss(ss, row);
        f32x4* xr = (f32x4*)(c.out + (size_t)row * DM) + c.lane; const f32x4* gr = (const f32x4*)g + c.lane; const u32x2* hr = (const u32x2*)(hb + (size_t)row * DM) + c.lane;
#pragma unroll
        for (int j = 0; j < 4; ++j) { const u32x2 hv = hr[64 * j]; const f32x4 gg = gr[64 * j];
            xr[64 * j] = (f32x4){bflo(hv.x) * rs * gg[0], bfhi(hv.x) * rs * gg[1], bflo(hv.y) * rs * gg[2], bfhi(hv.y) * rs * gg[3]}; }
    }
}

DI void ph_ffn_up(const Params& p, const Ctx& c0, int l, int which) {
    const Ctx c = fresh(c0);
    pg8::Gemm g = pg8::plain_gemm(wsb(c, OFF_HB), (const bf16_t*)(c.ws + (size_t)l * W_LAYER + (which ? W_GU2 : W_GU1)), MTOK, 2 * FF, DM); g.ocol_step = 128; pg8::use_img_b(g);
    pg8::Order S; S.init(g, c.G, c.bid);
    pg8::EpiSwiGLU E{wsb(c, OFF_Z), FF, ssbuf(c, 4 * l + (which ? 3 : 0))};
    pg8::gemm_phase(c.lds, g, S, E);
}
DI void ph_resid(const Params& p, const Ctx& c0, const bf16_t* A, const bf16_t* Bt, int K, int ss_out, float alpha) {
    const Ctx c = fresh(c0);
    pg8::Gemm g = pg8::plain_gemm(A, Bt, MTOK, DM, K);
    if (K == FF) { g.lda = 64; g.kstepA = 256 * 64 * 2; g.a_pmdiv = (long)(FF / 64) * 256 * 64; g.imgA = 1; pg8::use_img_b(g); }
    pg8::Order S; S.init(g, c.G, c.bid);
    pg8::EpiResid E{wsb(c, OFF_HB), ssbuf(c, ss_out), alpha};
    pg8::gemm_phase(c.lds, g, S, E);
}
DI void ph_kv(const Params& p, const Ctx& c0) {
    const Ctx c = fresh(c0);
    { pg8::Gemm g = pg8::plain_gemm(wsb(c, OFF_MEMB), wsb(c, OFF_WK), MMEM, 4096, DM); pg8::Order S; S.init(g, c.G, c.bid);
      pg8::EpiBf16 E{wsb(c, OFF_KB), 4096, nullptr, wsf(c, OFF_RSM), nullptr, 1.f, 0}; pg8::gemm_phase(c.lds, g, S, E); }
    { pg8::Gemm g = pg8::plain_gemm(wsb(c, OFF_MEMB), wsb(c, OFF_WV), MMEM, 4096, DM); pg8::Order S; S.init(g, c.G, c.bid);
      pg8::EpiBf16 E{wsb(c, OFF_VT), 4096, nullptr, wsf(c, OFF_RSM), nullptr, 1.f, 0}; pg8::gemm_phase(c.lds, g, S, E); }
}
DI void ph_win(const Params& p, const Ctx& c0, int l) {
    const Ctx c = fresh(c0);
    pg8::Gemm g = pg8::plain_gemm(wsb(c, OFF_HB), (const bf16_t*)(c.ws + (size_t)l * W_LAYER + W_IN), MTOK, 3072, DM); pg8::use_img_b(g);
    pg8::Order S; S.init(g, c.G, c.bid);
    pg8::EpiZ E{wsb(c, OFF_Z), wsf(c, OFF_GATES), ssbuf(c, 4 * l + 1)};
    pg8::gemm_phase(c.lds, g, S, E);
}
constexpr size_t OFF_MT = OFF_Z, OFF_VWT = OFF_Z + (size_t)16384 * DM * 2;
DI void ph_xpre(const Params& p, const Ctx& c0, int l) {
    const Ctx c = fresh(c0);
    const unsigned char* wl = c.ws + (size_t)l * W_LAYER;
    { pg8::Gemm g; g.A = wsb(c, OFF_KB) + l * 1024; g.B = (const bf16_t*)(wl + W_Q); g.lda = 4096; g.ldb = DM; g.K = 256; g.nM = 64; g.nN = 4;
      g.div = 4; g.a_pmdiv = 256L * 4096; g.a_pmmod = 256; g.a_pn = 0; g.b_pmdiv = 0; g.b_pmmod = 256; g.b_pn = 256L * DM; g.ocol_step = 256; g.kstepA = 128; g.kstepB = 128; g.imgA = 0; g.imgB = 0;
      pg8::Order S; S.init(g, c.G, c.bid);
      pg8::EpiBf16 E{wsb(c, OFF_MT), DM, nullptr, nullptr, nullptr, 1.f, 0}; pg8::gemm_phase(c.lds, g, S, E); }
    { pg8::Gemm g; g.A = (const bf16_t*)(wl + W_O); g.B = wsb(c, OFF_VT) + l * 1024; g.lda = DM; g.ldb = 4096; g.K = 256; g.nM = 64; g.nN = 4;
      g.div = 4; g.a_pmdiv = 0; g.a_pmmod = 256L * DM; g.a_pn = 256; g.b_pmdiv = 256L * 4096; g.b_pmmod = 0; g.b_pn = 256; g.ocol_step = 256; g.kstepA = 128; g.kstepB = 128; g.imgA = 0; g.imgB = 0;
      pg8::Order S; S.init(g, c.G, c.bid);
      pg8::EpiBf16 E{wsb(c, OFF_VWT), DM, nullptr, nullptr, nullptr, 1.f, 0}; pg8::gemm_phase(c.lds, g, S, E); }
}
DI void ph_xs(const Params& p, const Ctx& c0, int l) {
    const Ctx c = fresh(c0);
    pg8::Gemm g; g.A = wsb(c, OFF_HB); g.B = wsb(c, OFF_MT); g.lda = DM; g.ldb = DM; g.K = DM; g.nM = MTOK / 256; g.nN = 4;
    g.div = 16; g.a_pmdiv = 16L * 256 * DM; g.a_pmmod = 256L * DM; g.a_pn = 0; g.b_pmdiv = 4L * 256 * DM; g.b_pmmod = 0; g.b_pn = 256L * DM; g.ocol_step = 256; g.kstepA = 128; g.kstepB = 128; g.imgA = 0; g.imgB = 0;
    pg8::Order S; S.init(g, c.G, c.bid);
    pg8::EpiSoftmax E{wsb(c, OFF_Y), DM, (LAS float*)(c.lds + LDS_EXTRA), ssbuf(c, 4 * l + 2), 0.0625f * LOG2E};
    pg8::gemm_phase(c.lds, g, S, E);
}
DI void ph_xo(const Params& p, const Ctx& c0, int l) {
    const Ctx c = fresh(c0);
    pg8::Gemm g; g.A = wsb(c, OFF_Y); g.B = wsb(c, OFF_VWT); g.lda = DM; g.ldb = DM; g.K = DM; g.nM = MTOK / 256; g.nN = 4;
    g.div = 16; g.a_pmdiv = 16L * 256 * DM; g.a_pmmod = 256L * DM; g.a_pn = 0; g.b_pmdiv = 1024L * DM; g.b_pmmod = 0; g.b_pn = 256L * DM; g.ocol_step = 256; g.kstepA = 128; g.kstepB = 128; g.imgA = 0; g.imgB = 0;
    pg8::Order S; S.init(g, c.G, c.bid);
    pg8::EpiResid E{wsb(c, OFF_HB), ssbuf(c, 4 * l + 3), 1.f};
    pg8::gemm_phase(c.lds, g, S, E);
}

constexpr int PH_PER_LAYER = 11, PH_FINAL = 1 + PH_PER_LAYER * DEPTH, PH_TOTAL = PH_FINAL + 1;
__global__ void __launch_bounds__(512, 2) mega_fwd(Params pk) {
    extern __shared__ __attribute__((aligned(16))) unsigned char lds_raw[];
    volatile LAS unsigned* bst = (volatile LAS unsigned*)((LAS unsigned char*)lds_raw + LDS_EXTRA + 12288);
    XcdBarrier xbar; xbar.bar = (unsigned*)(pk.ws + OFF_CTL); xbar.x = 0; xbar.st = bst;
    if (pk.coop) { if (threadIdx.x < 4) bst[threadIdx.x] = 0u; __syncthreads(); xbar = xcd_barrier_post((unsigned*)(pk.ws + OFF_CTL), bst); }
    for (int ph = pk.ph_lo; ph < pk.ph_hi; ++ph) {
        int tid = threadIdx.x; asm volatile("" : "+v"(tid));
        const Params& p = pk;
        Ctx c; c.lds = (LAS unsigned char*)lds_raw; c.ldsg = lds_raw; c.tid = tid; c.lane = tid & 63; c.wid = __builtin_amdgcn_readfirstlane(tid >> 6);
        c.bid = blockIdx.x; c.G = gridDim.x; c.ws = pk.ws; c.out = pk.out;
        asm volatile("" : "+s"(c.ws)); asm volatile("" : "+s"(c.out));
        if (ph == 0) {
#ifndef NO_PRO
            REP(R_PRO) ph_prologue(p, c);
#endif
        }
        else if (ph == PH_FINAL) ph_final(p, c);
        else {
            const int l = (ph - 1) / PH_PER_LAYER, j = (ph - 1) % PH_PER_LAYER;
            const unsigned char* wl = c.ws + (size_t)l * W_LAYER;
#ifdef ONLY_CASE
            if (j != ONLY_CASE) continue;
#endif
            switch (j) {
                case 0: REP(R_UP) ph_ffn_up(p, c, l, 0); if (l == 0) ph_kv(p, c); break;
                case 1: ph_resid(p, c, wsb(c, OFF_Z), (const bf16_t*)(wl + W_D1), FF, 4 * l + 1, 0.5f); break;
                case 2: ph_win(p, c, l); break;
                case 3:
#ifndef NO_MIX1
                    ph_mix1(p, c, l);
#endif
                    break;
                case 4:
#ifndef NO_MIX2
                    ph_mix2(p, c, l);
#endif
                    break;
                case 5:
#ifndef NO_MIX3
                    ph_mix3(p, c, l);
#endif
                    break;
                case 6: ph_resid(p, c, wsb(c, OFF_Y), (const bf16_t*)(wl + W_OUT), DM, 4 * l + 2, 1.f); ph_xpre(p, c, l); break;
                case 7: ph_xs(p, c, l); break;
                case 8: ph_xo(p, c, l); break;
                case 9: ph_ffn_up(p, c, l, 1); break;
                default: ph_resid(p, c, wsb(c, OFF_Z), (const bf16_t*)(wl + W_D2), FF, 4 * l + 4, 0.5f); break;
            }
        }
        if (ph + 1 < pk.ph_hi && pk.coop) { if (ph == pk.ph_lo) cg::this_grid().sync(); else xcd_barrier(xbar); }
    }
}

extern "C" void kernel_launch(void* const* d_in, const int* in_sizes, int n_in, void* d_out, int out_size, void* d_ws, size_t ws_size, hipStream_t stream) {
    static int grid = 0;
    if (grid == 0) {
        if (n_in != 28 || out_size != MTOK * DM || ws_size < OFF_END) { fprintf(stderr, "kernel_launch: unexpected shapes (n_in %d out %d ws %zu)\n", n_in, out_size, ws_size); grid = -1; return; }
        int dev = 0, cus = 0, per_cu = 0;
        (void)hipGetDevice(&dev); (void)hipDeviceGetAttribute(&cus, hipDeviceAttributeMultiprocessorCount, dev);
        if (hipFuncSetAttribute((const void*)mega_fwd, hipFuncAttributeMaxDynamicSharedMemorySize, LDS_BYTES) != hipSuccess) { fprintf(stderr, "kernel_launch: hipFuncSetAttribute failed\n"); grid = -1; return; }
        if (hipOccupancyMaxActiveBlocksPerMultiprocessor(&per_cu, (const void*)mega_fwd, 512, LDS_BYTES) != hipSuccess || per_cu < 1) { fprintf(stderr, "kernel_launch: occupancy query says %d\n", per_cu); per_cu = 1; }
        (void)hipGetLastError();
        grid = cus * per_cu;
    }
    if (grid < 0) return;
    Params p{};
    for (int i = 0; i < 28; ++i) p.in[i] = (const float*)d_in[i];
    p.out = (float*)d_out; p.ws = (unsigned char*)d_ws; p.pad = 0;
    (void)hipMemsetAsync((unsigned char*)d_ws + OFF_CTL, 0, CTL_BYTES, stream);
#if MK_MULTI
    for (int ph = 0; ph < PH_TOTAL; ++ph) { p.ph_lo = ph; p.ph_hi = ph + 1; p.coop = 0; hipLaunchKernelGGL(mega_fwd, dim3(grid), dim3(512), LDS_BYTES, stream, p); }
#else
    p.ph_lo = 0; p.ph_hi = PH_TOTAL; p.coop = 1;
    void* args[] = {&p};
    hipError_t e = hipLaunchCooperativeKernel((const void*)mega_fwd, dim3(grid), dim3(512), args, LDS_BYTES, stream);
    if (e != hipSuccess) fprintf(stderr, "cooperative launch failed: %s (grid %d)\n", hipGetErrorString(e), grid);
#endif
}
```

```cpp
#include <hip/hip_runtime.h>
#include <hip/hip_cooperative_groups.h>
#include <cstdio>
#include <cstdint>
namespace cg = cooperative_groups;

#ifndef MK_MULTI
#define MK_MULTI 0
#endif

#ifndef R_DIFF
#define R_DIFF 1
#endif
#ifndef R_DIL
#define R_DIL 1
#endif
#ifndef R_POOL
#define R_POOL 1
#endif
#ifndef R_MLA
#define R_MLA 1
#endif
#ifndef R_MLC
#define R_MLC 1
#endif
#ifndef R_UP
#define R_UP 1
#endif
#ifndef R_WIN
#define R_WIN 1
#endif
#ifndef R_GATES
#define R_GATES 1
#endif
#ifndef R_PRO
#define R_PRO 1
#endif
#ifndef R_RES1
#define R_RES1 1
#endif
#ifndef R_RES6
#define R_RES6 1
#endif
#ifndef R_WQ
#define R_WQ 1
#endif
#define REP(n) for (int rep_ = 0; rep_ < (n); ++rep_)
#define DI __device__ __forceinline__
#define LAS __attribute__((address_space(3)))
typedef unsigned short bf16_t;
typedef short bf16x8 __attribute__((ext_vector_type(8)));
typedef float f32x4 __attribute__((ext_vector_type(4)));
typedef float f32x16 __attribute__((ext_vector_type(16)));
typedef unsigned u32x4 __attribute__((ext_vector_type(4)));
typedef unsigned u32x2 __attribute__((ext_vector_type(2)));
typedef float f32x2_t __attribute__((ext_vector_type(2)));
typedef __bf16 bf16x2_t __attribute__((ext_vector_type(2)));

constexpr int DM = 1024, NB = 16, SEQ = 4096, MTOK = NB * SEQ, DEPTH = 4, MEMLEN = 256, MMEM = NB * MEMLEN, FF = 2816, ZW = 2816, INW = 2824;
constexpr int ZQA = 0, ZKA = 256, ZVA = 512, ZOA = 768, ZPB = 1024, ZQC = 1280, ZKC = 1536, ZVC = 1792, ZQD = 2048, ZKD = 2304, ZVD = 2560;
constexpr float LOG2E = 1.4426950408889634f;
constexpr float NEGBIG = -1e30f;

constexpr size_t W_GU1 = 0, W_D1 = W_GU1 + (size_t)2 * FF * DM * 2, W_IN = W_D1 + (size_t)DM * FF * 2, W_OUT = W_IN + (size_t)3072 * DM * 2,
                 W_Q = W_OUT + (size_t)DM * DM * 2, W_O = W_Q + (size_t)DM * DM * 2, W_GU2 = W_O + (size_t)DM * DM * 2, W_D2 = W_GU2 + (size_t)2 * FF * DM * 2,
                 W_LAYER = W_D2 + (size_t)DM * FF * 2;
constexpr size_t OFF_WK = DEPTH * W_LAYER, OFF_WV = OFF_WK + (size_t)DEPTH * DM * DM * 2, OFF_HB = OFF_WV + (size_t)DEPTH * DM * DM * 2;
constexpr size_t OFF_DST = OFF_HB;
constexpr size_t OFF_OPART = OFF_HB + (size_t)64 * 64 * 4096 * 4;
constexpr size_t OFF_Z = OFF_HB + (size_t)MTOK * DM * 2;
constexpr size_t OFF_Y = OFF_Z + (size_t)MTOK * ZW * 2;
constexpr size_t OFF_KB = OFF_Y + (size_t)MTOK * DM * 2;
constexpr size_t OFF_VT = OFF_KB + (size_t)MMEM * 4096 * 2;
constexpr size_t OFF_MEMB = OFF_VT + (size_t)4096 * MMEM * 2;
constexpr size_t OFF_GATES = OFF_MEMB + (size_t)MMEM * DM * 2;
constexpr size_t OFF_SS = OFF_GATES + (size_t)MTOK * 8 * 4;
constexpr size_t OFF_LSEP = OFF_SS + (size_t)17 * MTOK * 16 * 4;
constexpr size_t OFF_NST = OFF_LSEP + (size_t)2 * MTOK * 4 * 4;
constexpr size_t OFF_SCAL = OFF_NST + (size_t)4096 * 64 * 4;
constexpr size_t OFF_DIFFB = OFF_SCAL + 65536;
constexpr size_t OFF_DILB = OFF_DIFFB + 65536;
constexpr size_t OFF_LAM = OFF_DILB + 8192;
constexpr size_t OFF_RSM = OFF_LAM + 256;
constexpr size_t OFF_CTL = OFF_RSM + 16384;
constexpr size_t CTL_BYTES = 16384;
constexpr size_t OFF_END = OFF_CTL + CTL_BYTES;
static_assert(OFF_OPART + (size_t)2 * MTOK * 256 * 2 <= OFF_Z, "alias map");
static_assert(OFF_END < (size_t)1073741824, "workspace");

constexpr int LDS_BYTES = 147456;
constexpr int LDS_EXTRA = 131072;

struct Params {
    const float* in[28];
    float* out;
    unsigned char* ws;
    int ph_lo, ph_hi, coop, pad;
};
enum { I_X = 0, I_MEM, I_T5, I_F1N, I_F1G, I_F1U, I_F1D, I_MIXN, I_WIN, I_CONVW, I_CONVB, I_GATEB, I_MLN, I_POOLW, I_POOLS, I_LAMV, I_SUBLN, I_WOUT,
       I_XN, I_MEMN, I_XWQ, I_XWKV, I_XWO, I_F2N, I_F2G, I_F2U, I_F2D, I_FINN };

DI unsigned cvtpk(float lo, float hi) { f32x2_t v = {lo, hi}; bf16x2_t b = __builtin_convertvector(v, bf16x2_t); return __builtin_bit_cast(unsigned, b); }
DI float bflo(unsigned w) { return __uint_as_float(w << 16); }
DI float bfhi(unsigned w) { return __uint_as_float(w & 0xffff0000u); }
DI float bf2f(bf16_t x) { return __uint_as_float((unsigned)x << 16); }
DI float ex2(float x) { return __builtin_amdgcn_exp2f(x); }
DI float rcpf_(float x) { return __builtin_amdgcn_rcpf(x); }
DI int crow(int i, int hi) { return (i & 3) + 8 * (i >> 2) + 4 * hi; }
DI float wave_sum(float v) {
#pragma unroll
    for (int o = 1; o < 64; o <<= 1) v += __shfl_xor(v, o);
    return v;
}
DI float wave_max(float v) {
#pragma unroll
    for (int o = 1; o < 64; o <<= 1) v = fmaxf(v, __shfl_xor(v, o));
    return v;
}
DI float silu_f(float g) { return g * rcpf_(1.f + ex2(-g * LOG2E)); }
DI float sigmoid_f(float g) { return rcpf_(1.f + ex2(-g * LOG2E)); }
#define LDS_WAIT() asm volatile("s_waitcnt lgkmcnt(0)" ::: "memory")
DI bf16x8 mk8(u32x2 lo, u32x2 hi) { u32x4 w = {lo.x, lo.y, hi.x, hi.y}; return __builtin_bit_cast(bf16x8, w); }
DI bf16x8 pack8(float a0, float a1, float a2, float a3, float a4, float a5, float a6, float a7) {
    u32x4 w = {cvtpk(a0, a1), cvtpk(a2, a3), cvtpk(a4, a5), cvtpk(a6, a7)}; return __builtin_bit_cast(bf16x8, w);
}
DI float rowss(const float* ss, int row) {
    const f32x4* q = (const f32x4*)(ss + (size_t)row * 16); const f32x4 a = q[0], b = q[1], c = q[2], d = q[3];
    const float t = ((a[0] + a[1]) + (a[2] + a[3])) + ((b[0] + b[1]) + (b[2] + b[3])) + ((c[0] + c[1]) + (c[2] + c[3])) + ((d[0] + d[1]) + (d[2] + d[3]));
    return rsqrtf(t * (1.f / 1024.f) + 1e-6f);
}
#define MFMA32(a, b, c) __builtin_amdgcn_mfma_f32_32x32x16_bf16((a), (b), (c), 0, 0, 0)

namespace pg8 {
constexpr int BM = 256, BK = 64, HALF = 128, HTB = HALF * BK * 2, STAGE_BYTES = 8 * HTB, NXCD = 8, WGM = 8;
DI int lds_byte(int r, int c) { const int st = (r >> 4) * 2 + (c >> 5), rr = r & 15, cc = c & 31, ob = rr * 64 + cc * 2; return st * 1024 + (ob ^ (((ob >> 9) & 1) << 5)); }
DI void stage_rc(int b, int& R, int& C) { const int st = b / 1024, sb = b % 1024, swz = sb ^ (((sb >> 9) & 1) << 5); R = (st >> 1) * 16 + swz / 64; C = (st & 1) * 32 + (swz % 64) / 2; }
DI int perm32(int rho) { const int n = rho >> 4, i = rho & 15; return 8 * (i >> 2) + 4 * n + (i & 3); }

DI size_t img_off(int row, int col) { return ((size_t)((row >> 8) * (DM / 64) + (col >> 6)) * 2 + ((row >> 7) & 1)) * 16384 + lds_byte(row & 127, col & 63); }
struct Unit { const char* a; const char* b; int orow, ocol, pm, pn; };
struct Gemm {
    const bf16_t* A; const bf16_t* B; int lda, ldb, K, nM, nN; long a_pmdiv, a_pmmod, a_pn, b_pmdiv, b_pmmod, b_pn; int div, ocol_step; int kstepA, kstepB;
    int imgB;
    int imgA;
};
DI Gemm plain_gemm(const bf16_t* A, const bf16_t* B, int Mrows, int N, int K) {
    Gemm g; g.A = A; g.B = B; g.lda = K; g.ldb = K; g.K = K; g.nM = Mrows / BM; g.nN = N / BM; g.a_pmdiv = (long)BM * K; g.a_pmmod = 0; g.a_pn = 0; g.b_pmdiv = 0; g.b_pmmod = 0; g.b_pn = (long)BM * K;
    g.div = 1; g.ocol_step = BM; g.kstepA = BK * 2; g.kstepB = BK * 2; g.imgA = 0; g.imgB = 0; return g;
}
DI void use_img_a(Gemm& g) { g.imgA = 1; g.lda = 64; g.kstepA = 256 * 64 * 2; }
DI void use_img_b(Gemm& g) { g.imgB = 1; g.ldb = 64; g.kstepB = 256 * 64 * 2; g.b_pn = (long)(g.K / 64) * 256 * 64; }
struct Order {
    Gemm g; int nwg, G, c;
    DI void init(const Gemm& g_, int G_, int c_) { g = g_; nwg = g.nM * g.nN; G = G_; c = c_; }
    DI bool next(int i, Unit& u) const {
        const long L = (long)i * G + c; if (L >= nwg) return false;
        int wgid = (int)L; { const int q = nwg / NXCD, r = nwg % NXCD, xcd = wgid % NXCD, off = wgid / NXCD; wgid = (xcd < r ? xcd * (q + 1) : r * (q + 1) + (xcd - r) * q) + off; }
        const int nN = g.nN, nM = g.nM, nig = WGM * nN, gid = wgid / nig, fm = gid * WGM, gsz = (nM - fm) < WGM ? (nM - fm) : WGM;
        const int pm = fm + ((wgid % nig) % gsz), pn = (wgid % nig) / gsz;
        u.pm = pm; u.pn = pn; u.orow = pm * BM; u.ocol = pn * g.ocol_step;
        const int pq = pm / g.div, pr = pm - pq * g.div;
        u.a = (const char*)(g.A + (long)pq * g.a_pmdiv + (long)pr * g.a_pmmod + (long)pn * g.a_pn);
        u.b = (const char*)(g.B + (long)pq * g.b_pmdiv + (long)pr * g.b_pmmod + (long)pn * g.b_pn);
        return true;
    }
};

struct EpiBf16 {
    static constexpr bool PERM = true;
    bf16_t* O; int ldc; const float* ss; const float* rowscale; const float* colscale; float scale; int zspecial;
    DI void operator()(f32x4 (&acc)[2][2][4][2], const Unit& u, int wr, int wc, int fr, int fq, int wid, int lane) const {
        const int row0 = u.orow + wr * 64 + fr, col0 = u.ocol + wc * 32 + 8 * fq;
        float sc = scale;
        if (zspecial) { if (u.pn == 5) sc *= 0.125f * LOG2E; else if (u.pn == 8) sc *= 0.17677669529663687f * LOG2E; }
        if (colscale) {
#pragma unroll
            for (int bj = 0; bj < 2; ++bj)
#pragma unroll
                for (int n = 0; n < 2; ++n) { const f32x4 cs = *(const f32x4*)(colscale + col0 + bj * HALF + 4 * n);
#pragma unroll
                    for (int ai = 0; ai < 2; ++ai)
#pragma unroll
                        for (int m = 0; m < 4; ++m) acc[ai][bj][m][n] *= cs; }
            asm volatile("" ::: "memory");
        }
#pragma unroll
        for (int ai = 0; ai < 2; ++ai)
#pragma unroll
            for (int m = 0; m < 4; ++m) {
                const int row = row0 + ai * HALF + m * 16;
                float rs = sc;
                if (ss) rs *= rowss(ss, row);
                if (rowscale) rs *= rowscale[row];
                bf16_t* rowp = O + (size_t)row * ldc + col0;
#pragma unroll
                for (int bj = 0; bj < 2; ++bj) {
                    const f32x4 v0 = acc[ai][bj][m][0] * rs, v1 = acc[ai][bj][m][1] * rs;
                    u32x4 w; w.x = cvtpk(v0[0], v0[1]); w.y = cvtpk(v0[2], v0[3]); w.z = cvtpk(v1[0], v1[1]); w.w = cvtpk(v1[2], v1[3]);
                    *(u32x4*)(rowp + bj * HALF) = w;
                }
                asm volatile("" ::: "memory");
            }
    }
};
struct EpiZ {
    static constexpr bool PERM = true;
    bf16_t* O; float* gates; const float* ss;
    DI void operator()(f32x4 (&acc)[2][2][4][2], const Unit& u, int wr, int wc, int fr, int fq, int wid, int lane) const {
        const int row0 = u.orow + wr * 64 + fr, col0 = u.ocol + wc * 32 + 8 * fq;
        if (u.pn == 11) {
            if (wc == 0 && fq == 0) {
#pragma unroll
                for (int ai = 0; ai < 2; ++ai)
#pragma unroll
                    for (int m = 0; m < 4; ++m) { const int row = row0 + ai * HALF + m * 16; const float rs = rowss(ss, row);
                        *(f32x4*)(gates + (size_t)row * 8) = acc[ai][0][m][0] * rs; *(f32x4*)(gates + (size_t)row * 8 + 4) = acc[ai][0][m][1] * rs; }
            }
            return;
        }
        float sc = 1.f;
        if (u.pn == 5) sc = 0.125f * LOG2E; else if (u.pn == 8) sc = 0.17677669529663687f * LOG2E;
#pragma unroll
        for (int ai = 0; ai < 2; ++ai)
#pragma unroll
            for (int m = 0; m < 4; ++m) {
                const int row = row0 + ai * HALF + m * 16;
                const float rs = sc * rowss(ss, row);
                bf16_t* rowp = O + (size_t)row * ZW + col0;
#pragma unroll
                for (int bj = 0; bj < 2; ++bj) {
                    const f32x4 v0 = acc[ai][bj][m][0] * rs, v1 = acc[ai][bj][m][1] * rs;
                    u32x4 w; w.x = cvtpk(v0[0], v0[1]); w.y = cvtpk(v0[2], v0[3]); w.z = cvtpk(v1[0], v1[1]); w.w = cvtpk(v1[2], v1[3]);
                    *(u32x4*)(rowp + bj * HALF) = w;
                }
                asm volatile("" ::: "memory");
            }
    }
};
struct EpiSwiGLU {
    static constexpr bool PERM = true;
    bf16_t* O; int ldc; const float* ss;
    DI void operator()(f32x4 (&acc)[2][2][4][2], const Unit& u, int wr, int wc, int fr, int fq, int wid, int lane) const {
        const int row0 = u.orow + wr * 64 + fr, col0 = u.ocol + wc * 32 + 8 * fq;
#pragma unroll
        for (int ai = 0; ai < 2; ++ai)
#pragma unroll
            for (int m = 0; m < 4; ++m) {
                const int row = row0 + ai * HALF + m * 16;
                const float rs = rowss(ss, row);
                float o[8];
#pragma unroll
                for (int n = 0; n < 2; ++n)
#pragma unroll
                    for (int j = 0; j < 4; ++j) { const float g = acc[ai][0][m][n][j] * rs, up = acc[ai][1][m][n][j] * rs; o[4 * n + j] = silu_f(g) * up; }
                u32x4 w; w.x = cvtpk(o[0], o[1]); w.y = cvtpk(o[2], o[3]); w.z = cvtpk(o[4], o[5]); w.w = cvtpk(o[6], o[7]);
                __builtin_nontemporal_store(w, (u32x4*)((unsigned char*)O + ((size_t)(u.pm * (FF / 64) + (col0 >> 6)) * 2 + ((row >> 7) & 1)) * 16384 + lds_byte(row & 127, col0 & 63)));
                asm volatile("" ::: "memory");
            }
    }
};
struct EpiResid {
    static constexpr bool PERM = true;
    bf16_t* hb; float* ssout; float alpha;
    DI void operator()(f32x4 (&acc)[2][2][4][2], const Unit& u, int wr, int wc, int fr, int fq, int wid, int lane) const {
        const int row0 = u.orow + wr * 64 + fr, col0 = u.ocol + wc * 32 + 8 * fq;
#pragma unroll
        for (int ai = 0; ai < 2; ++ai) {
            u32x4 r[4][2];
#pragma unroll
            for (int m = 0; m < 4; ++m) {
#pragma unroll
                for (int bj = 0; bj < 2; ++bj) r[m][bj] = *(const u32x4*)((const unsigned char*)hb + img_off(row0 + ai * HALF + m * 16, col0 + bj * HALF)); }
#pragma unroll
            for (int m = 0; m < 4; ++m) {
                const int row = row0 + ai * HALF + m * 16; float ssq = 0.f;
#pragma unroll
                for (int bj = 0; bj < 2; ++bj) {
                    const u32x4 rr = r[m][bj]; const f32x4 a0 = acc[ai][bj][m][0] * alpha, a1 = acc[ai][bj][m][1] * alpha;
                    u32x4 w; w.x = cvtpk(bflo(rr.x) + a0[0], bfhi(rr.x) + a0[1]); w.y = cvtpk(bflo(rr.y) + a0[2], bfhi(rr.y) + a0[3]);
                    w.z = cvtpk(bflo(rr.z) + a1[0], bfhi(rr.z) + a1[1]); w.w = cvtpk(bflo(rr.w) + a1[2], bfhi(rr.w) + a1[3]);
                    *(u32x4*)((unsigned char*)hb + img_off(row, col0 + bj * HALF)) = w;
                    const float v0 = bflo(w.x), v1 = bfhi(w.x), v2 = bflo(w.y), v3 = bfhi(w.y), v4 = bflo(w.z), v5 = bfhi(w.z), v6 = bflo(w.w), v7 = bfhi(w.w);
                    ssq += ((v0 * v0 + v1 * v1) + (v2 * v2 + v3 * v3)) + ((v4 * v4 + v5 * v5) + (v6 * v6 + v7 * v7));
                }
                ssq += __shfl_xor(ssq, 16); ssq += __shfl_xor(ssq, 32);
                if (fq == 0) ssout[(size_t)row * 16 + u.pn * 4 + wc] = ssq;
            }
            asm volatile("" ::: "memory");
        }
    }
};
struct EpiSoftmax {
    static constexpr bool PERM = true;
    bf16_t* O; int ldc; LAS float* red; const float* ss; float scale;
    DI void operator()(f32x4 (&acc)[2][2][4][2], const Unit& u, int wr, int wc, int fr, int fq, int wid, int lane) const {
        float mloc[2][4];
#pragma unroll
        for (int ai = 0; ai < 2; ++ai)
#pragma unroll
            for (int m = 0; m < 4; ++m) {
                float mx = NEGBIG;
                const float rsc = rowss(ss, u.orow + ai * HALF + wr * 64 + m * 16 + fr) * scale;
#pragma unroll
                for (int bj = 0; bj < 2; ++bj)
#pragma unroll
                    for (int n = 0; n < 2; ++n) { const f32x4 x = acc[ai][bj][m][n] * rsc; acc[ai][bj][m][n] = x; mx = fmaxf(mx, fmaxf(fmaxf(x[0], x[1]), fmaxf(x[2], x[3]))); }
                mx = fmaxf(mx, __shfl_xor(mx, 16)); mx = fmaxf(mx, __shfl_xor(mx, 32));
                float sm = 0.f;
#pragma unroll
                for (int bj = 0; bj < 2; ++bj)
#pragma unroll
                    for (int n = 0; n < 2; ++n) { f32x4 x = acc[ai][bj][m][n]; x[0] = ex2(x[0] - mx); x[1] = ex2(x[1] - mx); x[2] = ex2(x[2] - mx); x[3] = ex2(x[3] - mx);
                        acc[ai][bj][m][n] = x; sm += (x[0] + x[1]) + (x[2] + x[3]); }
                sm += __shfl_xor(sm, 16); sm += __shfl_xor(sm, 32);
                mloc[ai][m] = mx;
                const int rl = ai * HALF + wr * 64 + m * 16 + fr;
                if (fq == 0) { red[(rl * 4 + wc) * 2] = mx; red[(rl * 4 + wc) * 2 + 1] = sm; }
            }
        asm volatile("s_waitcnt lgkmcnt(0)" ::: "memory"); __builtin_amdgcn_s_barrier(); asm volatile("" ::: "memory");
        const int row0 = u.orow + wr * 64 + fr, col0 = u.ocol + wc * 32 + 8 * fq;
#pragma unroll
        for (int ai = 0; ai < 2; ++ai)
#pragma unroll
            for (int m = 0; m < 4; ++m) {
                const int rl = ai * HALF + wr * 64 + m * 16 + fr;
                const f32x4 p0 = *(const LAS f32x4*)(red + rl * 8), p1 = *(const LAS f32x4*)(red + rl * 8 + 4);
                const float gm = fmaxf(fmaxf(p0[0], p0[2]), fmaxf(p1[0], p1[2]));
                const float tot = p0[1] * ex2(p0[0] - gm) + p0[3] * ex2(p0[2] - gm) + p1[1] * ex2(p1[0] - gm) + p1[3] * ex2(p1[2] - gm);
                const float f = ex2(mloc[ai][m] - gm) / tot;
                bf16_t* rowp = O + (size_t)(row0 + ai * HALF + m * 16) * ldc + col0;
#pragma unroll
                for (int bj = 0; bj < 2; ++bj) {
                    const f32x4 v0 = acc[ai][bj][m][0] * f, v1 = acc[ai][bj][m][1] * f;
                    u32x4 w; w.x = cvtpk(v0[0], v0[1]); w.y = cvtpk(v0[2], v0[3]); w.z = cvtpk(v1[0], v1[1]); w.w = cvtpk(v1[2], v1[3]);
                    *(u32x4*)(rowp + bj * HALF) = w;
                }
            }
        asm volatile("s_waitcnt lgkmcnt(0)" ::: "memory"); __builtin_amdgcn_s_barrier(); asm volatile("" ::: "memory");
    }
};

template <class Epi>
DI void gemm_phase(LAS unsigned char* lds, const Gemm g, const Order& S, const Epi& E) {
    int tid_ = threadIdx.x; asm volatile("" : "+v"(tid_));
    const int tid = tid_, wid = __builtin_amdgcn_readfirstlane(tid >> 6), lane = tid & 63, wr = wid >> 2, wc = wid & 3, fr = lane & 15, fq = lane >> 4;
    const int K = g.K, nt = K / BK;
    unsigned voffA[2], voffB[2];
#pragma unroll
    for (int i = 0; i < 2; ++i) { int R, C; stage_rc(tid * 16 + i * 8192, R, C); const int Rb = Epi::PERM ? ((R & ~31) + perm32(R & 31)) : R;
        voffA[i] = g.imgA ? (unsigned)(tid * 16 + i * 8192) : (unsigned)(R * g.lda + C) * 2u; voffB[i] = g.imgB ? (unsigned)(tid * 16 + i * 8192) : (unsigned)(Rb * g.ldb + C) * 2u; }
    const size_t kstepA = (size_t)g.kstepA, kstepB = (size_t)g.kstepB;
    const size_t hstepA = (size_t)HALF * g.lda * 2, hstepB = (size_t)HALF * g.ldb * 2;
    const unsigned ldsw = (unsigned)wid * 1024u;
    const int aoff = lds_byte(wr * 64 + fr, fq * 8), boff = lds_byte(wc * 32 + fr, fq * 8);
#define PG8_SA(b, h) (((b) * 2 + (h)) * HTB)
#define PG8_SB(b, h) ((4 + (b) * 2 + (h)) * HTB)
#define PG8_STAGE(bufoff, gbase, voff) do { _Pragma("unroll") for (int _i = 0; _i < 2; ++_i) \
        __builtin_amdgcn_global_load_lds((const unsigned*)((const char*)(gbase) + (voff)[_i]), (LAS unsigned*)(lds + (bufoff) + ldsw + _i * 8192), 16, 0, 0); } while (0)
#define PG8_LDA(dst, b, h) do { _Pragma("unroll") for (int m = 0; m < 4; ++m) _Pragma("unroll") for (int k = 0; k < 2; ++k) dst[m][k] = *(const LAS bf16x8*)(lds + PG8_SA(b, h) + aoff + m * 2048 + k * 1024); } while (0)
#define PG8_LDB(dst, b, h) do { _Pragma("unroll") for (int n = 0; n < 2; ++n) _Pragma("unroll") for (int k = 0; k < 2; ++k) dst[n][k] = *(const LAS bf16x8*)(lds + PG8_SB(b, h) + boff + n * 2048 + k * 1024); } while (0)
#define PG8_MMA(ai, bj, At, Bt) do { __builtin_amdgcn_s_setprio(1); _Pragma("unroll") for (int m = 0; m < 4; ++m) _Pragma("unroll") for (int n = 0; n < 2; ++n) _Pragma("unroll") for (int k = 0; k < 2; ++k) \
        acc[ai][bj][m][n] = __builtin_amdgcn_mfma_f32_16x16x32_bf16(Bt[n][k], At[m][k], acc[ai][bj][m][n], 0, 0, 0); __builtin_amdgcn_s_setprio(0); } while (0)
#define PG8_WAIT_V(n) asm volatile("s_waitcnt vmcnt(" #n ")" ::: "memory")
#define PG8_WAIT_L(n) asm volatile("s_waitcnt lgkmcnt(" #n ")" ::: "memory")
#define PG8_BAR __builtin_amdgcn_s_barrier()
#define PG8_SCHED __builtin_amdgcn_sched_barrier(0)
    Unit cur, nxt; int ui = 0;
    if (!S.next(0, cur)) return;
    f32x4 acc[2][2][4][2];
#pragma unroll
    for (int a = 0; a < 2; ++a)
#pragma unroll
        for (int b = 0; b < 2; ++b)
#pragma unroll
            for (int m = 0; m < 4; ++m)
#pragma unroll
                for (int n = 0; n < 2; ++n) acc[a][b][m][n] = (f32x4){0.f, 0.f, 0.f, 0.f};
    bf16x8 At[4][2], B0[2][2], B1[2][2];
    const char* cA = cur.a; const char* cB = cur.b;
    PG8_STAGE(PG8_SB(0, 0), cB, voffB); PG8_STAGE(PG8_SB(0, 1), cB + hstepB, voffB); PG8_STAGE(PG8_SA(0, 0), cA, voffA); PG8_STAGE(PG8_SA(0, 1), cA + hstepA, voffA);
    if (wr == 1) PG8_BAR;
    PG8_WAIT_V(2); PG8_BAR;
    PG8_STAGE(PG8_SB(1, 0), cB + kstepB, voffB); PG8_STAGE(PG8_SA(1, 0), cA + kstepA, voffA); PG8_STAGE(PG8_SB(1, 1), cB + hstepB + kstepB, voffB);
    PG8_WAIT_V(6); PG8_BAR;
    for (;;) {
        const bool has_next = S.next(ui + 1, nxt);
        const char* nA = has_next ? nxt.a : cA; const char* nB = has_next ? nxt.b : cB;
        for (int t = 0; t < nt; t += 2) {
            const bool last = (t == nt - 2);
            const char* a1 = cA + (size_t)(t + 1) * kstepA;
            const char* a2 = last ? nA : cA + (size_t)(t + 2) * kstepA; const char* b2 = last ? nB : cB + (size_t)(t + 2) * kstepB;
            const char* a3 = a2 + kstepA; const char* b3 = b2 + kstepB;
            PG8_LDB(B0, 0, 0); PG8_LDB(B1, 0, 1); PG8_SCHED; PG8_LDA(At, 0, 0); PG8_STAGE(PG8_SA(1, 1), a1 + hstepA, voffA);
            PG8_WAIT_V(8); PG8_WAIT_L(0); PG8_BAR; PG8_MMA(0, 0, At, B0); PG8_MMA(0, 1, At, B1); PG8_BAR; PG8_SCHED;
            PG8_LDA(At, 0, 1); PG8_STAGE(PG8_SB(0, 0), b2, voffB); PG8_STAGE(PG8_SB(0, 1), b2 + hstepB, voffB); PG8_STAGE(PG8_SA(0, 0), a2, voffA);
            PG8_WAIT_V(8); PG8_WAIT_L(0); PG8_BAR; PG8_MMA(1, 0, At, B0); PG8_MMA(1, 1, At, B1); PG8_BAR; PG8_SCHED;
            PG8_LDB(B0, 1, 0); PG8_LDB(B1, 1, 1); PG8_SCHED; PG8_LDA(At, 1, 0); PG8_STAGE(PG8_SA(0, 1), a2 + hstepA, voffA);
            PG8_WAIT_V(8); PG8_WAIT_L(0); PG8_BAR; PG8_MMA(0, 0, At, B0); PG8_MMA(0, 1, At, B1); PG8_BAR; PG8_SCHED;
            PG8_LDA(At, 1, 1); PG8_STAGE(PG8_SB(1, 0), b3, voffB); PG8_STAGE(PG8_SB(1, 1), b3 + hstepB, voffB); PG8_STAGE(PG8_SA(1, 0), a3, voffA);
            PG8_WAIT_V(8); PG8_WAIT_L(0); PG8_BAR; PG8_MMA(1, 0, At, B0); PG8_MMA(1, 1, At, B1); PG8_BAR; PG8_SCHED;
        }
        if (wr == 0) PG8_BAR;
        E(acc, cur, wr, wc, fr, fq, wid, lane);
        if (!has_next) break;
#pragma unroll
        for (int a = 0; a < 2; ++a)
#pragma unroll
            for (int b = 0; b < 2; ++b)
#pragma unroll
                for (int m = 0; m < 4; ++m)
#pragma unroll
                    for (int n = 0; n < 2; ++n) acc[a][b][m][n] = (f32x4){0.f, 0.f, 0.f, 0.f};
        cur = nxt; cA = nA; cB = nB; ++ui;
        if (wr == 1) PG8_BAR;
    }
    PG8_WAIT_V(0);
    PG8_BAR;
#undef PG8_SA
#undef PG8_SB
#undef PG8_STAGE
#undef PG8_LDA
#undef PG8_LDB
#undef PG8_MMA
#undef PG8_WAIT_V
#undef PG8_WAIT_L
#undef PG8_BAR
#undef PG8_SCHED
}
}

#define XB_TMO      128
#define XB_XCNT(j)  (256  + 64 * (j))
#define XB_XSUB(j)  (1280 + 64 * (j))
#define XB_XGEN(j)  (2304 + 64 * (j))
#define XB_TOP      3328
#define XB_TOPGEN   3392
#define XCD_BAR_WORDS 3456
#define XB_SPIN_CAP (1u << 20)
DI unsigned xb_ld(unsigned* p)              { return __hip_atomic_load(p, __ATOMIC_RELAXED, __HIP_MEMORY_SCOPE_AGENT); }
DI unsigned xb_add(unsigned* p, unsigned v) { return __hip_atomic_fetch_add(p, v, __ATOMIC_RELAXED, __HIP_MEMORY_SCOPE_AGENT); }
DI unsigned xb_xcc_id() { return (unsigned)__builtin_amdgcn_s_getreg((3 << 11) | 20) & 0xFu; }
#define XB_SPIN(cond, bar) do { unsigned _sp = 0; while (cond) { __builtin_amdgcn_s_sleep(1); \
    if ((++_sp & 255u) == 0u) { if (xb_ld(&(bar)[XB_TMO])) break; if (_sp > XB_SPIN_CAP) { atomicAdd(&(bar)[XB_TMO], 1u); break; } } } } while (0)
struct XcdBarrier { unsigned* bar; unsigned x; volatile LAS unsigned* st; };
DI XcdBarrier xcd_barrier_post(unsigned* bar, volatile LAS unsigned* st) {
    XcdBarrier b; b.bar = bar; b.x = xb_xcc_id(); b.st = st;
    if (threadIdx.x == 0) (void)xb_add(&bar[XB_XCNT(b.x)], 1u);
    return b;
}
DI void xcd_barrier_complete(unsigned* bar, unsigned x, unsigned& nloc, unsigned& nx) {
    const unsigned G = gridDim.x * gridDim.y * gridDim.z;
    unsigned sum, cnt, mine, sp = 0u;
    for (;;) {
        sum = 0u; cnt = 0u; mine = 0u;
#pragma unroll
        for (unsigned j = 0; j < 16; ++j) { const unsigned c = xb_ld(&bar[XB_XCNT(j)]); sum += c; cnt += (c > 0u) ? 1u : 0u; mine = (j == x) ? c : mine; }
        if (sum == G) break;
        __builtin_amdgcn_s_sleep(1);
        if ((++sp & 255u) == 0u) { if (xb_ld(&bar[XB_TMO])) break; if (sp > XB_SPIN_CAP) { atomicAdd(&bar[XB_TMO], 1u); break; } }
    }
    nloc = mine > 0u ? mine : 1u; nx = cnt > 0u ? cnt : 1u;
}
DI void xcd_barrier(const XcdBarrier& b) {
    asm volatile("s_waitcnt vmcnt(0)" ::: "memory");
    __syncthreads();
    if (threadIdx.x == 0) {
        unsigned* bar = b.bar;
        __builtin_amdgcn_s_waitcnt(0);
        unsigned nloc = b.st[0], nx = b.st[1];
        if (nloc == 0u) { xcd_barrier_complete(bar, b.x, nloc, nx); b.st[0] = nloc; b.st[1] = nx; }
        const unsigned old = xb_add(&bar[XB_XSUB(b.x)], 1u);
        const unsigned gen = old / nloc;
        if (old + 1u == (gen + 1u) * nloc) {
            __builtin_amdgcn_fence(__ATOMIC_RELEASE, "agent");
            asm volatile("s_waitcnt vmcnt(0)" ::: "memory");
            const unsigned og = xb_add(&bar[XB_TOP], 1u);
            const unsigned tg = og / nx;
            if (og + 1u == (tg + 1u) * nx) xb_add(&bar[XB_TOPGEN], 1u);
            else XB_SPIN(xb_ld(&bar[XB_TOPGEN]) == tg, bar);
            __builtin_amdgcn_fence(__ATOMIC_ACQUIRE, "agent");
            xb_add(&bar[XB_XGEN(b.x)], 1u);
            asm volatile("s_waitcnt vmcnt(0)" ::: "memory");
        } else {
            XB_SPIN(xb_ld(&bar[XB_XGEN(b.x)]) == gen, bar);
            __builtin_amdgcn_fence(__ATOMIC_ACQUIRE, "agent");
            asm volatile("s_waitcnt vmcnt(0)" ::: "memory");
        }
    }
    __syncthreads();
}

struct Ctx {
    LAS unsigned char* lds; unsigned char* ldsg;
    int tid, lane, wid, bid, G;
    unsigned char* ws; float* out;
};
DI bf16_t* wsb(const Ctx& c, size_t off) { return (bf16_t*)(c.ws + off); }
DI float* wsf(const Ctx& c, size_t off) { return (float*)(c.ws + off); }
DI float* ssbuf(const Ctx& c, int i) { return (float*)(c.ws + OFF_SS) + (size_t)i * MTOK * 16; }

DI int t5_bucket(int dist) {
    if (dist < 16) return dist;
    const float v = logf((float)dist / 16.f) / 4.852030263919617f * 16.f;
    int large = 16 + (int)v; return large < 31 ? large : 31;
}

DI Ctx fresh(const Ctx& c0) {
    Ctx c = c0; int tid = threadIdx.x; asm volatile("" : "+v"(tid)); c.tid = tid; c.lane = tid & 63; c.wid = __builtin_amdgcn_readfirstlane(tid >> 6);
    asm volatile("" : "+s"(c.ws)); asm volatile("" : "+s"(c.out)); return c;
}
DI void transpose_item(const float* W, int ldw, int scol0, int k0, const float* gain, bf16_t* WT, int K, int drow0, LAS float* scr, int lane, bool img = false) {
    {
        f32x4 v[8]; float gs[8];
#pragma unroll
        for (int i = 0; i < 8; ++i) { const int kk = 8 * i + (lane >> 3); v[i] = *(const f32x4*)(W + (size_t)(k0 + kk) * ldw + scol0 + (lane & 7) * 4); gs[i] = gain ? gain[k0 + kk] : 1.f; }
#pragma unroll
        for (int i = 0; i < 8; ++i) { const int kk = 8 * i + (lane >> 3); LAS float* d = scr + kk * 33 + (lane & 7) * 4; d[0] = v[i][0] * gs[i]; d[1] = v[i][1] * gs[i]; d[2] = v[i][2] * gs[i]; d[3] = v[i][3] * gs[i]; }
    }
    LDS_WAIT(); asm volatile("" ::: "memory");
    const int c = lane & 7;
#pragma unroll
    for (int j = 0; j < 4; ++j) { const int n = (lane >> 3) + 8 * j; const LAS float* s = scr + (8 * c) * 33 + n;
        u32x4 o; o.x = cvtpk(s[0 * 33], s[1 * 33]); o.y = cvtpk(s[2 * 33], s[3 * 33]); o.z = cvtpk(s[4 * 33], s[5 * 33]); o.w = cvtpk(s[6 * 33], s[7 * 33]);
        if (img) { const int ng = drow0 + n, nl = ng & 255, r = nl & 127, q = r & 31, rs = (r & ~31) + 16 * ((q >> 2) & 1) + 4 * (q >> 3) + (q & 3);
            const int kk0 = k0 + 8 * c;
            *(u32x4*)((unsigned char*)WT + ((size_t)((ng >> 8) * (K >> 6) + (kk0 >> 6)) * 2 + (nl >> 7)) * 16384 + pg8::lds_byte(rs, kk0 & 63)) = o; }
        else *(u32x4*)(WT + (size_t)(drow0 + n) * K + k0 + 8 * c) = o; }
    LDS_WAIT(); asm volatile("" ::: "memory");
}
DI void tjob(const float* W, int ldw, int scol0, const float* gain, bf16_t* WT, int K, int ncols, int item, LAS float* scr, int lane, bool img = false, int drow_base = 0) {
    const int nblk = ncols / 32, kb = item / nblk, nb = item % nblk;
    transpose_item(W, ldw, scol0 + 32 * nb, 64 * kb, gain, WT, K, drow_base + 32 * nb, scr, lane, img);
}
DI void tjob_gu(const float* Wg, const float* Wu, const float* gain, bf16_t* WT, int item, LAS float* scr, int lane) {
    const int nblk = 2 * FF / 32, kb = item / nblk, nb = item % nblk, n0 = 32 * nb, p = n0 >> 8, w = n0 & 255;
    transpose_item(w < 128 ? Wg : Wu, FF, 128 * p + (w & 127), 64 * kb, gain, WT, DM, n0, scr, lane, true);
}
DI void ph_prologue(const Params& p, const Ctx& c0) {
    const Ctx c = fresh(c0);
    LAS float* scr = (LAS float*)(c.lds + c.wid * 16384);
    const int gw = c.bid * 8 + c.wid, NGW = c.G * 8, lane = c.lane;
    constexpr int I_GU = 16 * (2 * FF / 32), I_D = (FF / 64) * 32, I_INA = 16 * 32, I_INB = 16 * 56, I_INC = 16, I_SQ = 16 * 32;
    constexpr int PER_LAYER = 2 * I_GU + 2 * I_D + I_INA + I_INB + I_INC + 5 * I_SQ;
    for (int it = gw; it < DEPTH * PER_LAYER; it += NGW) {
        const int l = it / PER_LAYER; int r = it % PER_LAYER;
        unsigned char* wl = c.ws + (size_t)l * W_LAYER;
        if (r < I_GU) { tjob_gu(p.in[I_F1G] + (size_t)l * DM * FF, p.in[I_F1U] + (size_t)l * DM * FF, p.in[I_F1N] + l * DM, (bf16_t*)(wl + W_GU1), r, scr, lane); continue; } r -= I_GU;
        if (r < I_D) { tjob(p.in[I_F1D] + (size_t)l * FF * DM, DM, 0, nullptr, (bf16_t*)(wl + W_D1), FF, DM, r, scr, lane, true); continue; } r -= I_D;
        if (r < I_INA) { tjob(p.in[I_WIN] + (size_t)l * DM * INW, INW, 0, p.in[I_MIXN] + l * DM, (bf16_t*)(wl + W_IN), DM, 1024, r, scr, lane, true, 0); continue; } r -= I_INA;
        if (r < I_INB) { tjob(p.in[I_WIN] + (size_t)l * DM * INW, INW, 1032, p.in[I_MIXN] + l * DM, (bf16_t*)(wl + W_IN), DM, 1792, r, scr, lane, true, 1024); continue; } r -= I_INB;
        if (r < I_INC) { tjob(p.in[I_WIN] + (size_t)l * DM * INW, INW, 1024, p.in[I_MIXN] + l * DM, (bf16_t*)(wl + W_IN), DM, 32, r, scr, lane, true, 2816); continue; } r -= I_INC;
        if (r < I_SQ) { tjob(p.in[I_WOUT] + (size_t)l * DM * DM, DM, 0, nullptr, (bf16_t*)(wl + W_OUT), DM, DM, r, scr, lane); continue; } r -= I_SQ;
        if (r < I_SQ) {
            const int kb = r >> 5, nb = r & 31; const int row = 64 * kb + lane; const float gsc = p.in[I_XN][l * DM + row];
            const f32x4* src = (const f32x4*)(p.in[I_XWQ] + (size_t)l * DM * DM + (size_t)row * DM + 32 * nb); u32x4* dst = (u32x4*)((bf16_t*)(wl + W_Q) + (size_t)row * DM + 32 * nb);
#pragma unroll
            for (int q4 = 0; q4 < 4; ++q4) { const f32x4 x0 = src[2 * q4] * gsc, x1 = src[2 * q4 + 1] * gsc; u32x4 w; w.x = cvtpk(x0[0], x0[1]); w.y = cvtpk(x0[2], x0[3]); w.z = cvtpk(x1[0], x1[1]); w.w = cvtpk(x1[2], x1[3]); dst[q4] = w; }
            continue; } r -= I_SQ;
        if (r < I_SQ) { tjob(p.in[I_XWO] + (size_t)l * DM * DM, DM, 0, nullptr, (bf16_t*)(wl + W_O), DM, DM, r, scr, lane); continue; } r -= I_SQ;
        if (r < I_GU) { tjob_gu(p.in[I_F2G] + (size_t)l * DM * FF, p.in[I_F2U] + (size_t)l * DM * FF, p.in[I_F2N] + l * DM, (bf16_t*)(wl + W_GU2), r, scr, lane); continue; } r -= I_GU;
        if (r < I_D) { tjob(p.in[I_F2D] + (size_t)l * FF * DM, DM, 0, nullptr, (bf16_t*)(wl + W_D2), FF, DM, r, scr, lane, true); continue; } r -= I_D;
        if (r < I_SQ) { tjob(p.in[I_XWKV] + (size_t)l * DM * 2 * DM, 2 * DM, 0, p.in[I_MEMN] + l * DM, wsb(c, OFF_WK) + (size_t)l * DM * DM, DM, DM, r, scr, lane); continue; } r -= I_SQ;
        tjob(p.in[I_XWKV] + (size_t)l * DM * 2 * DM, 2 * DM, DM, p.in[I_MEMN] + l * DM, wsb(c, OFF_WV) + (size_t)l * DM * DM, DM, DM, r, scr, lane);
    }
    for (int m = gw; m < MTOK + MMEM; m += NGW) {
        const bool isx = m < MTOK; const int row = isx ? m : m - MTOK;
        const f32x4* xr = (const f32x4*)((isx ? p.in[I_X] : p.in[I_MEM]) + (size_t)row * DM) + lane;
        unsigned long long* o8 = (unsigned long long*)(wsb(c, OFF_MEMB) + (size_t)row * DM) + lane; unsigned char* hbimg = (unsigned char*)wsb(c, OFF_HB);
        float s = 0.f;
#pragma unroll
        for (int j = 0; j < 4; ++j) { const f32x4 v = xr[64 * j]; s += (v[0] * v[0] + v[1] * v[1]) + (v[2] * v[2] + v[3] * v[3]);
            const unsigned long long pk = (unsigned long long)cvtpk(v[0], v[1]) | ((unsigned long long)cvtpk(v[2], v[3]) << 32);
            if (isx) *(unsigned long long*)(hbimg + pg8::img_off(row, 4 * (lane + 64 * j))) = pk; else o8[64 * j] = pk; }
        s = wave_sum(s);
        if (lane == 0) { if (isx) { f32x4* q = (f32x4*)(ssbuf(c, 0) + (size_t)row * 16); q[0] = (f32x4){s, 0.f, 0.f, 0.f}; q[1] = (f32x4){0.f, 0.f, 0.f, 0.f}; q[2] = q[1]; q[3] = q[1]; } else wsf(c, OFF_RSM)[row] = rsqrtf(s * (1.f / DM) + 1e-6f); }
    }
    for (int l = 0; l < DEPTH; ++l) { unsigned char* t11 = c.ws + (size_t)l * W_LAYER + W_IN + (size_t)11 * 16 * 32768;
        for (int i = c.bid * 512 + c.tid; i < 16 * 1792; i += c.G * 512) { const int kt = i / 1792, rem = i - kt * 1792; *(u32x4*)(t11 + (size_t)kt * 32768 + 4096 + (size_t)rem * 16) = (u32x4){0u, 0u, 0u, 0u}; } }
    const int gt = c.bid * 512 + c.tid, NGT = c.G * 512;
    const float* t5 = p.in[I_T5];
    for (int i = gt; i < 4 * 4096; i += NGT) { const int h = i >> 12, d = i & 4095; wsf(c, OFF_DIFFB)[i] = t5[t5_bucket(d) * 8 + 4 + h] * LOG2E; }
    for (int i = gt; i < 3 * 4 * 132; i += NGT) { const int pp = i / (4 * 132), h = (i / 132) & 3, dl = i % 132; const int dil = pp == 0 ? 1 : (pp == 1 ? 4 : 16);
        wsf(c, OFF_DILB)[i] = dl <= 128 ? t5[t5_bucket(dl * dil) * 8 + h] * LOG2E : 0.f; }
    if (gt < DEPTH) { const float* lv = p.in[I_LAMV] + gt * 128; float a = 0.f, b = 0.f; for (int i = 0; i < 32; ++i) { a += lv[i] * lv[32 + i]; b += lv[64 + i] * lv[96 + i]; }
        const float lam_init = 0.8f - 0.6f * expf(-0.3f * (float)gt); wsf(c, OFF_LAM)[gt] = expf(a) - expf(b) + lam_init; }
}

DI void ph_gates(const Params& p, const Ctx& c0, int l) {
    const Ctx c = fresh(c0);
    LAS float* wg = (LAS float*)c.lds;
    const float* win = p.in[I_WIN] + (size_t)l * DM * INW; const float* gn = p.in[I_MIXN] + l * DM;
    for (int i = c.tid; i < DM * 8; i += 512) { const int k = i >> 3, cc = i & 7; wg[i] = win[(size_t)k * INW + 1024 + cc] * gn[k]; }
    __syncthreads();
    const float* h = c.out; const float* ss = ssbuf(c, 4 * l + 1); float* gates = wsf(c, OFF_GATES);
    for (int row = c.bid * 8 + c.wid; row < MTOK; row += c.G * 8) {
        float a[8];
#pragma unroll
        for (int j = 0; j < 8; ++j) a[j] = 0.f;
        const f32x4* xr = (const f32x4*)(h + (size_t)row * DM) + c.lane;
#pragma unroll
        for (int j = 0; j < 4; ++j) { const f32x4 v = xr[64 * j]; const int k0 = 4 * c.lane + 256 * j;
#pragma unroll
            for (int e = 0; e < 4; ++e) { const f32x4 w0 = *(const LAS f32x4*)(wg + (k0 + e) * 8), w1 = *(const LAS f32x4*)(wg + (k0 + e) * 8 + 4);
                a[0] += v[e] * w0[0]; a[1] += v[e] * w0[1]; a[2] += v[e] * w0[2]; a[3] += v[e] * w0[3]; a[4] += v[e] * w1[0]; a[5] += v[e] * w1[1]; a[6] += v[e] * w1[2]; a[7] += v[e] * w1[3]; } }
#pragma unroll
        for (int j = 0; j < 8; ++j) a[j] = wave_sum(a[j]);
        if (c.lane == 0) { const float rs = rowss(ss, row);
            *(f32x4*)(gates + (size_t)row * 8) = (f32x4){a[0] * rs, a[1] * rs, a[2] * rs, a[3] * rs}; *(f32x4*)(gates + (size_t)row * 8 + 4) = (f32x4){a[4] * rs, a[5] * rs, a[6] * rs, a[7] * rs}; }
    }
    __syncthreads();
}

DI void osm_update(f32x16& s, float& m, float& l, f32x16 (&O)[2], bf16x8& p0, bf16x8& p1) {
    float mx = fmaxf(s[0], s[1]);
#pragma unroll
    for (int i = 2; i < 16; ++i) mx = fmaxf(mx, s[i]);
    mx = fmaxf(mx, __shfl_xor(mx, 32));
    const float mn = fmaxf(m, mx);
    if (__any(mn > m)) {
        const float al = ex2(m - mn); l *= al;
#pragma unroll
        for (int i = 0; i < 16; ++i) { O[0][i] *= al; O[1][i] *= al; }
        m = mn;
    }
    float sum = 0.f;
#pragma unroll
    for (int i = 0; i < 16; ++i) { s[i] = ex2(s[i] - m); sum += s[i]; }
    l += sum;
    p0 = pack8(s[0], s[1], s[2], s[3], s[4], s[5], s[6], s[7]);
    p1 = pack8(s[8], s[9], s[10], s[11], s[12], s[13], s[14], s[15]);
}

constexpr int DK_KP = 144, DK_VP = 136;
constexpr int DF_KOFF = 0, DF_VOFF = 2 * 64 * DK_KP, DF_TOFF = DF_VOFF + 2 * 64 * DK_VP;
DI void diff_attn_task(const Params& p, const Ctx& c, int l, int b, int h, int qb) {
    const int tid = c.tid, lane = c.lane, wid = c.wid, r32 = lane & 31, hi = lane >> 5;
    const bf16_t* z = wsb(c, OFF_Z);
    const size_t rowbase = (size_t)b * SEQ;
    LAS unsigned char* lds = c.lds;
    LAS float* tbl = (LAS float*)(lds + DF_TOFF);
    __syncthreads();
    { const float* src = wsf(c, OFF_DIFFB) + h * 4096; for (int i = tid; i < 4096; i += 512) tbl[i] = src[i]; }
    const int qw0 = qb * 256 + wid * 32, qpos = qw0 + r32;
    bf16x8 qf[4];
    { const bf16_t* qp = z + (rowbase + qpos) * ZW + ZQD + h * 64;
#pragma unroll
      for (int s = 0; s < 4; ++s) qf[s] = *(const bf16x8*)(qp + 16 * s + 8 * hi); }
    f32x16 O1[2], O2[2];
#pragma unroll
    for (int i = 0; i < 16; ++i) { O1[0][i] = 0.f; O1[1][i] = 0.f; O2[0][i] = 0.f; O2[1][i] = 0.f; }
    float m1 = NEGBIG, m2 = NEGBIG, l1 = 0.f, l2 = 0.f;
    const int NT = (qb + 1) * 4;
    const int skey = tid >> 3, schunk = tid & 7;
    const bf16_t* kbase = z + (rowbase + skey) * ZW + ZKD + h * 64 + schunk * 8;
    const bf16_t* vbase = z + (rowbase + skey) * ZW + ZVD + h * 64 + schunk * 8;
    u32x4 kreg = *(const u32x4*)kbase, vreg = *(const u32x4*)vbase;
#define DF_WRITE(buf) do { *(LAS u32x4*)(lds + DF_KOFF + (buf) * 64 * DK_KP + skey * DK_KP + schunk * 16) = kreg; \
        LAS bf16_t* vt_ = (LAS bf16_t*)(lds + DF_VOFF + (buf) * 64 * DK_VP + skey * 2); \
        vt_[(schunk * 8 + 0) * (DK_VP / 2)] = (bf16_t)(vreg.x & 0xffff); vt_[(schunk * 8 + 1) * (DK_VP / 2)] = (bf16_t)(vreg.x >> 16); \
        vt_[(schunk * 8 + 2) * (DK_VP / 2)] = (bf16_t)(vreg.y & 0xffff); vt_[(schunk * 8 + 3) * (DK_VP / 2)] = (bf16_t)(vreg.y >> 16); \
        vt_[(schunk * 8 + 4) * (DK_VP / 2)] = (bf16_t)(vreg.z & 0xffff); vt_[(schunk * 8 + 5) * (DK_VP / 2)] = (bf16_t)(vreg.z >> 16); \
        vt_[(schunk * 8 + 6) * (DK_VP / 2)] = (bf16_t)(vreg.w & 0xffff); vt_[(schunk * 8 + 7) * (DK_VP / 2)] = (bf16_t)(vreg.w >> 16); } while (0)
    DF_WRITE(0);
    __syncthreads();
    for (int t = 0; t < NT; ++t) {
        const int buf = t & 1;
        if (t + 1 < NT) { kreg = *(const u32x4*)(kbase + (size_t)(t + 1) * 64 * ZW); vreg = *(const u32x4*)(vbase + (size_t)(t + 1) * 64 * ZW); }
        if (64 * t <= qw0 + 31) {
            const LAS unsigned char* kimg = lds + DF_KOFF + buf * 64 * DK_KP;
            const LAS unsigned char* vimg = lds + DF_VOFF + buf * 64 * DK_VP;
#pragma unroll
            for (int sub = 0; sub < 2; ++sub) {
                const int key0 = 64 * t + 32 * sub;
                if (key0 <= qw0 + 31) {
                    const LAS unsigned char* kr = kimg + (32 * sub + r32) * DK_KP + hi * 16;
                    const bf16x8 k0 = *(const LAS bf16x8*)(kr), k1 = *(const LAS bf16x8*)(kr + 32), k2 = *(const LAS bf16x8*)(kr + 64), k3 = *(const LAS bf16x8*)(kr + 96);
                    f32x16 s1, s2, bv;
                    const int dbase = qpos - key0 - 4 * hi;
                    if (key0 + 31 > qw0) {
#pragma unroll
                        for (int i = 0; i < 16; ++i) { const int d = dbase - ((i & 3) + 8 * (i >> 2)); const float bi = tbl[d < 0 ? 0 : d]; bv[i] = d < 0 ? NEGBIG : bi; }
                    } else {
#pragma unroll
                        for (int i = 0; i < 16; ++i) bv[i] = tbl[dbase - ((i & 3) + 8 * (i >> 2))];
                    }
                    s1 = MFMA32(k0, qf[0], bv); s1 = MFMA32(k1, qf[1], s1);
                    s2 = MFMA32(k2, qf[2], bv); s2 = MFMA32(k3, qf[3], s2);
                    bf16x8 pa0, pa1, pb0, pb1;
                    osm_update(s1, m1, l1, O1, pa0, pa1);
                    osm_update(s2, m2, l2, O2, pb0, pb1);
#pragma unroll
                    for (int dvt = 0; dvt < 2; ++dvt) {
                        const LAS unsigned char* vr = vimg + (32 * dvt + r32) * DK_VP + (32 * sub + 4 * hi) * 2;
                        const bf16x8 v0 = mk8(*(const LAS u32x2*)(vr), *(const LAS u32x2*)(vr + 16));
                        const bf16x8 v1 = mk8(*(const LAS u32x2*)(vr + 32), *(const LAS u32x2*)(vr + 48));
                        O1[dvt] = MFMA32(v0, pa0, O1[dvt]); O1[dvt] = MFMA32(v1, pa1, O1[dvt]);
                        O2[dvt] = MFMA32(v0, pb0, O2[dvt]); O2[dvt] = MFMA32(v1, pb1, O2[dvt]);
                    }
                }
            }
        }
        if (t + 1 < NT) DF_WRITE(buf ^ 1);
        __syncthreads();
    }
#undef DF_WRITE
    l1 += __shfl_xor(l1, 32); l2 += __shfl_xor(l2, 32);
    const float lam = wsf(c, OFF_LAM)[l];
    const float lam_init = 0.8f - 0.6f * expf(-0.3f * (float)l);
    const float i1 = 1.f / l1, i2 = lam / l2;
    float ssq = 0.f;
#pragma unroll
    for (int dvt = 0; dvt < 2; ++dvt)
#pragma unroll
        for (int i = 0; i < 16; ++i) { const float o = O1[dvt][i] * i1 - O2[dvt][i] * i2; O1[dvt][i] = o; ssq += o * o; }
    ssq += __shfl_xor(ssq, 32);
    const float rn = rsqrtf(ssq * (1.f / 64.f) + 1e-5f) * (1.f - lam_init);
    const float* sg = p.in[I_SUBLN] + l * 64;
    bf16_t* yrow = wsb(c, OFF_Y) + (rowbase + qpos) * DM + 768 + h * 64;
#pragma unroll
    for (int dvt = 0; dvt < 2; ++dvt)
#pragma unroll
        for (int g = 0; g < 4; ++g) {
            const int dv = 32 * dvt + 8 * g + 4 * hi; const f32x4 gg = *(const f32x4*)(sg + dv);
            u32x2 w; w.x = cvtpk(O1[dvt][4 * g] * rn * gg[0], O1[dvt][4 * g + 1] * rn * gg[1]); w.y = cvtpk(O1[dvt][4 * g + 2] * rn * gg[2], O1[dvt][4 * g + 3] * rn * gg[3]);
            *(u32x2*)(yrow + dv) = w;
        }
}

constexpr int DL_NK = 384, DL_KP = 144, DL_VP = 776;
constexpr int DL_KOFF = 0, DL_VOFF = DL_NK * DL_KP, DL_TOFF = DL_VOFF + 64 * DL_VP;
DI void dil_attn_task(const Params& p, const Ctx& c, int pat, int b, int h, int res, int mb) {
    const int dil = pat == 0 ? 1 : (pat == 1 ? 4 : 16);
    const int tid = c.tid, lane = c.lane, wid = c.wid, r32 = lane & 31, hi = lane >> 5;
    const bf16_t* z = wsb(c, OFF_Z);
    const size_t rowbase = (size_t)b * SEQ;
    LAS unsigned char* lds = c.lds;
    LAS float* tbl = (LAS float*)(lds + DL_TOFF);
    __syncthreads();
    if (tid < 132) tbl[tid] = wsf(c, OFF_DILB)[(pat * 4 + h) * 132 + tid];
    const int mk0 = 256 * mb - 128;
    {
        u32x4 kreg[6], vreg[6];
#pragma unroll
        for (int it = 0; it < 6; ++it) {
            const int idx = tid + 512 * it, key = idx >> 3, chunk = idx & 7, mk = mk0 + key;
            kreg[it] = (u32x4){0u, 0u, 0u, 0u}; vreg[it] = (u32x4){0u, 0u, 0u, 0u};
            if (mk >= 0) { const bf16_t* rp = z + (rowbase + (size_t)mk * dil + res) * ZW + h * 64 + chunk * 8; kreg[it] = *(const u32x4*)(rp + ZKC); vreg[it] = *(const u32x4*)(rp + ZVC); }
        }
#pragma unroll
        for (int it = 0; it < 6; ++it) {
            const int idx = tid + 512 * it, key = idx >> 3, chunk = idx & 7;
            *(LAS u32x4*)(lds + DL_KOFF + key * DL_KP + chunk * 16) = kreg[it];
            LAS bf16_t* vt_ = (LAS bf16_t*)(lds + DL_VOFF + key * 2);
            vt_[(chunk * 8 + 0) * (DL_VP / 2)] = (bf16_t)(vreg[it].x & 0xffff); vt_[(chunk * 8 + 1) * (DL_VP / 2)] = (bf16_t)(vreg[it].x >> 16);
            vt_[(chunk * 8 + 2) * (DL_VP / 2)] = (bf16_t)(vreg[it].y & 0xffff); vt_[(chunk * 8 + 3) * (DL_VP / 2)] = (bf16_t)(vreg[it].y >> 16);
            vt_[(chunk * 8 + 4) * (DL_VP / 2)] = (bf16_t)(vreg[it].z & 0xffff); vt_[(chunk * 8 + 5) * (DL_VP / 2)] = (bf16_t)(vreg[it].z >> 16);
            vt_[(chunk * 8 + 6) * (DL_VP / 2)] = (bf16_t)(vreg[it].w & 0xffff); vt_[(chunk * 8 + 7) * (DL_VP / 2)] = (bf16_t)(vreg[it].w >> 16);
        }
    }
    const int mq = 256 * mb + 32 * wid + r32;
    const size_t qtok = rowbase + (size_t)mq * dil + res;
    bf16x8 qf[4];
    { const bf16_t* qp = z + qtok * ZW + ZQC + h * 64;
#pragma unroll
      for (int s = 0; s < 4; ++s) qf[s] = *(const bf16x8*)(qp + 16 * s + 8 * hi); }
    __syncthreads();
    f32x16 O[2];
#pragma unroll
    for (int i = 0; i < 16; ++i) { O[0][i] = 0.f; O[1][i] = 0.f; }
    float m = NEGBIG, lsum = 0.f;
    for (int j = 0; j < 5; ++j) {
        const int kt = wid + j;
        const LAS unsigned char* kr = lds + DL_KOFF + (32 * kt + r32) * DL_KP + hi * 16;
        f32x16 s;
        const int dbase = 128 - 32 * j + r32 - 4 * hi;
        const int mkb = mk0 + 32 * kt + 4 * hi;
        if (j == 0 || j == 4 || mb == 0) {
#pragma unroll
            for (int i = 0; i < 16; ++i) { const int cc = (i & 3) + 8 * (i >> 2); const int dl = dbase - cc; const bool ok = (dl >= 0) && (dl <= 128) && (mkb + cc >= 0);
                const int dc = dl < 0 ? 0 : (dl > 128 ? 128 : dl); s[i] = ok ? tbl[dc] : NEGBIG; }
        } else {
#pragma unroll
            for (int i = 0; i < 16; ++i) s[i] = tbl[dbase - ((i & 3) + 8 * (i >> 2))];
        }
#pragma unroll
        for (int ks = 0; ks < 4; ++ks) s = MFMA32(*(const LAS bf16x8*)(kr + 32 * ks), qf[ks], s);
        bf16x8 p0, p1;
        osm_update(s, m, lsum, O, p0, p1);
#pragma unroll
        for (int dvt = 0; dvt < 2; ++dvt) {
            const LAS unsigned char* vr = lds + DL_VOFF + (32 * dvt + r32) * DL_VP + (32 * kt + 4 * hi) * 2;
            const bf16x8 v0 = mk8(*(const LAS u32x2*)(vr), *(const LAS u32x2*)(vr + 16));
            const bf16x8 v1 = mk8(*(const LAS u32x2*)(vr + 32), *(const LAS u32x2*)(vr + 48));
            O[dvt] = MFMA32(v0, p0, O[dvt]); O[dvt] = MFMA32(v1, p1, O[dvt]);
        }
    }
    lsum += __shfl_xor(lsum, 32);
    const float inv = 1.f / lsum, lse = m + log2f(lsum);
    if (pat != 0) {
        bf16_t* orow = ((bf16_t*)((unsigned char*)c.out + (size_t)64 * 64 * 4096 * 4)) + ((size_t)(pat - 1) * MTOK + qtok) * 256 + h * 64;
#pragma unroll
        for (int dvt = 0; dvt < 2; ++dvt)
#pragma unroll
            for (int g = 0; g < 4; ++g) { u32x2 w; w.x = cvtpk(O[dvt][4 * g] * inv, O[dvt][4 * g + 1] * inv); w.y = cvtpk(O[dvt][4 * g + 2] * inv, O[dvt][4 * g + 3] * inv);
                *(u32x2*)(orow + 32 * dvt + 8 * g + 4 * hi) = w; }
        if (hi == 0) wsf(c, OFF_LSEP)[((size_t)(pat - 1) * MTOK + qtok) * 4 + h] = lse;
    } else {
        const float ls1 = wsf(c, OFF_LSEP)[qtok * 4 + h], ls2 = wsf(c, OFF_LSEP)[((size_t)MTOK + qtok) * 4 + h];
        const float mm = fmaxf(lse, fmaxf(ls1, ls2));
        const float w0 = ex2(lse - mm), w1 = ex2(ls1 - mm), w2 = ex2(ls2 - mm), wi = 1.f / (w0 + w1 + w2);
        const float a0 = w0 * wi * inv, a1 = w1 * wi, a2 = w2 * wi;
        const bf16_t* o1 = ((bf16_t*)((unsigned char*)c.out + (size_t)64 * 64 * 4096 * 4)) + qtok * 256 + h * 64; const bf16_t* o2 = o1 + (size_t)MTOK * 256;
        bf16_t* yrow = wsb(c, OFF_Y) + qtok * DM + 512 + h * 64;
#pragma unroll
        for (int dvt = 0; dvt < 2; ++dvt)
#pragma unroll
            for (int g = 0; g < 4; ++g) { const int dv = 32 * dvt + 8 * g + 4 * hi; const u32x2 x1 = *(const u32x2*)(o1 + dv), x2 = *(const u32x2*)(o2 + dv);
                const float r0 = O[dvt][4 * g] * a0 + bflo(x1.x) * a1 + bflo(x2.x) * a2, r1 = O[dvt][4 * g + 1] * a0 + bfhi(x1.x) * a1 + bfhi(x2.x) * a2;
                const float r2 = O[dvt][4 * g + 2] * a0 + bflo(x1.y) * a1 + bflo(x2.y) * a2, r3 = O[dvt][4 * g + 3] * a0 + bfhi(x1.y) * a1 + bfhi(x2.y) * a2;
                u32x2 w; w.x = cvtpk(r0, r1); w.y = cvtpk(r2, r3); *(u32x2*)(yrow + dv) = w; }
    }
}

DI void pool_x(const bf16_t* bp0, int w, int cnt, float icnt, bf16x8 (&xf)[4]) {
    float sum[4][8]; u32x4 cur[4];
#pragma unroll
    for (int ks = 0; ks < 4; ++ks) {
        const bf16_t* bp = bp0 + 16 * ks;
        cur[ks] = *(const u32x4*)bp; const u32x4 prv = (cnt > 1) ? *(const u32x4*)(bp - ZW) : (u32x4){0u, 0u, 0u, 0u};
        sum[ks][0] = bflo(cur[ks].x) + bflo(prv.x); sum[ks][1] = bfhi(cur[ks].x) + bfhi(prv.x); sum[ks][2] = bflo(cur[ks].y) + bflo(prv.y); sum[ks][3] = bfhi(cur[ks].y) + bfhi(prv.y);
        sum[ks][4] = bflo(cur[ks].z) + bflo(prv.z); sum[ks][5] = bfhi(cur[ks].z) + bfhi(prv.z); sum[ks][6] = bflo(cur[ks].w) + bflo(prv.w); sum[ks][7] = bfhi(cur[ks].w) + bfhi(prv.w);
    }
#pragma unroll 1
    for (int j0 = 2; j0 < w; j0 += 2) {
        u32x4 v0[4], v1[4];
#pragma unroll
        for (int ks = 0; ks < 4; ++ks) { v0[ks] = (u32x4){0u, 0u, 0u, 0u}; v1[ks] = (u32x4){0u, 0u, 0u, 0u};
            if (j0 < cnt) v0[ks] = *(const u32x4*)(bp0 + 16 * ks - (size_t)j0 * ZW);
            if (j0 + 1 < cnt) v1[ks] = *(const u32x4*)(bp0 + 16 * ks - (size_t)(j0 + 1) * ZW); }
#pragma unroll
        for (int ks = 0; ks < 4; ++ks) {
            sum[ks][0] += bflo(v0[ks].x) + bflo(v1[ks].x); sum[ks][1] += bfhi(v0[ks].x) + bfhi(v1[ks].x); sum[ks][2] += bflo(v0[ks].y) + bflo(v1[ks].y); sum[ks][3] += bfhi(v0[ks].y) + bfhi(v1[ks].y);
            sum[ks][4] += bflo(v0[ks].z) + bflo(v1[ks].z); sum[ks][5] += bfhi(v0[ks].z) + bfhi(v1[ks].z); sum[ks][6] += bflo(v0[ks].w) + bflo(v1[ks].w); sum[ks][7] += bfhi(v0[ks].w) + bfhi(v1[ks].w); }
    }
#pragma unroll
    for (int ks = 0; ks < 4; ++ks)
        xf[ks] = pack8(sum[ks][0] * icnt - bflo(cur[ks].x), sum[ks][1] * icnt - bfhi(cur[ks].x), sum[ks][2] * icnt - bflo(cur[ks].y), sum[ks][3] * icnt - bfhi(cur[ks].y),
                       sum[ks][4] * icnt - bflo(cur[ks].z), sum[ks][5] * icnt - bfhi(cur[ks].z), sum[ks][6] * icnt - bflo(cur[ks].w), sum[ks][7] * icnt - bfhi(cur[ks].w));
}
DI void pool_task(const Params& p, const Ctx& c, int l, int wt) {
    const int lane = c.lane, r32 = lane & 31, hi = lane >> 5;
    const int g = (wt + (wt >> 11)) & 3, rt = wt >> 2;
    const size_t row = (size_t)rt * 32 + r32; const int t = (int)(row & (SEQ - 1));
    const int w = 2 << g, cnt = (t + 1 < w) ? t + 1 : w; const float icnt = 1.f / (float)cnt;
    const bf16_t* z = wsb(c, OFF_Z);
    bf16x8 xf[4];
    const bf16_t* bp0 = z + row * ZW + ZPB + g * 64 + 8 * hi;
    pool_x(bp0, w, cnt, icnt, xf);
    const float* pw = p.in[I_POOLW] + ((size_t)l * 4 + g) * 64 * 64;
    const float* psc = p.in[I_POOLS] + l * 256 + g * 64;
    bf16_t* yrow = wsb(c, OFF_Y) + row * DM + 256 + g * 64;
#pragma unroll
    for (int dt = 0; dt < 2; ++dt) {
        f32x16 acc;
#pragma unroll
        for (int i = 0; i < 16; ++i) acc[i] = 0.f;
#pragma unroll
        for (int ks = 0; ks < 4; ++ks) {
            const float* wp = pw + (size_t)(16 * ks + 8 * hi) * 64 + 32 * dt + r32;
            const bf16x8 wf = pack8(wp[0], wp[64], wp[128], wp[192], wp[256], wp[320], wp[384], wp[448]);
            acc = MFMA32(wf, xf[ks], acc);
        }
#pragma unroll
        for (int gq = 0; gq < 4; ++gq) { const int dd = 32 * dt + 8 * gq + 4 * hi; const f32x4 sc = *(const f32x4*)(psc + dd);
            u32x2 wv; wv.x = cvtpk(acc[4 * gq] * sc[0], acc[4 * gq + 1] * sc[1]); wv.y = cvtpk(acc[4 * gq + 2] * sc[2], acc[4 * gq + 3] * sc[3]); *(u32x2*)(yrow + dd) = wv; }
    }
}

DI float scan_add(float v, int lane) {
#pragma unroll
    for (int o = 1; o < 64; o <<= 1) { const float n = __shfl_up(v, o); if (lane >= o) v += n; }
    return v;
}
DI float scan_max(float v, int lane) {
#pragma unroll
    for (int o = 1; o < 64; o <<= 1) { const float n = __shfl_up(v, o); if (lane >= o) v = fmaxf(v, n); }
    return v;
}
DI float log_sigmoid(float x) { return fminf(x, 0.f) - log1pf(expf(-fabsf(x))); }
DI void conv8(const bf16_t* zp, int t, const float* cw, const float* cb, float scale, float (&o)[8]) {
    const f32x4 b0 = *(const f32x4*)cb, b1 = *(const f32x4*)(cb + 4);
    o[0] = b0[0]; o[1] = b0[1]; o[2] = b0[2]; o[3] = b0[3]; o[4] = b1[0]; o[5] = b1[1]; o[6] = b1[2]; o[7] = b1[3];
#pragma unroll
    for (int tap = 0; tap < 4; ++tap) {
        if (t - 3 + tap >= 0) {
            const u32x4 v = *(const u32x4*)(zp - (size_t)(3 - tap) * ZW);
            const f32x4 w0 = *(const f32x4*)(cw + tap * 512), w1 = *(const f32x4*)(cw + tap * 512 + 4);
            o[0] += bflo(v.x) * w0[0]; o[1] += bfhi(v.x) * w0[1]; o[2] += bflo(v.y) * w0[2]; o[3] += bfhi(v.y) * w0[3];
            o[4] += bflo(v.z) * w1[0]; o[5] += bfhi(v.z) * w1[1]; o[6] += bflo(v.w) * w1[2]; o[7] += bfhi(v.w) * w1[3];
        }
    }
#pragma unroll
    for (int e = 0; e < 8; ++e) o[e] = silu_f(o[e]) * scale;
    asm volatile("" ::: "memory");
}
DI void conv_frag4(const bf16_t* zp, int t, const LAS float* cw, const LAS float* cb, int hi, float scale, bf16x8 (&out)[4]) {
    asm volatile("" ::: "memory");
#pragma unroll
    for (int kh = 0; kh < 2; ++kh) {
        u32x4 v[2][4];
#pragma unroll
        for (int k2 = 0; k2 < 2; ++k2)
#pragma unroll
            for (int tap = 0; tap < 4; ++tap) { v[k2][tap] = (u32x4){0u, 0u, 0u, 0u}; if (t - 3 + tap >= 0) v[k2][tap] = *(const u32x4*)(zp + 16 * (2 * kh + k2) - (size_t)(3 - tap) * ZW); }
#pragma unroll
        for (int k2 = 0; k2 < 2; ++k2) {
            const int ks = 2 * kh + k2, d0 = 16 * ks + 8 * hi;
            const f32x4 b0 = *(const LAS f32x4*)(cb + d0), b1 = *(const LAS f32x4*)(cb + d0 + 4);
            float o[8] = {b0[0], b0[1], b0[2], b0[3], b1[0], b1[1], b1[2], b1[3]};
#pragma unroll
            for (int tap = 0; tap < 4; ++tap) {
                const f32x4 w0 = *(const LAS f32x4*)(cw + tap * 64 + d0), w1 = *(const LAS f32x4*)(cw + tap * 64 + d0 + 4); const u32x4 x = v[k2][tap];
                o[0] += bflo(x.x) * w0[0]; o[1] += bfhi(x.x) * w0[1]; o[2] += bflo(x.y) * w0[2]; o[3] += bfhi(x.y) * w0[3];
                o[4] += bflo(x.z) * w1[0]; o[5] += bfhi(x.z) * w1[1]; o[6] += bflo(x.w) * w1[2]; o[7] += bfhi(x.w) * w1[3];
            }
            out[ks] = pack8(silu_f(o[0]) * scale, silu_f(o[1]) * scale, silu_f(o[2]) * scale, silu_f(o[3]) * scale, silu_f(o[4]) * scale, silu_f(o[5]) * scale, silu_f(o[6]) * scale, silu_f(o[7]) * scale);
        }
        asm volatile("" ::: "memory");
    }
}
DI void mlstm_a_task(const Params& p, const Ctx& c, int l, int task) {
    const int lane = c.lane, r32 = lane & 31, hi = lane >> 5;
    const int bh = task >> 6, ch = task & 63, b = bh >> 2, h = bh & 3, t0 = ch * 64;
    const size_t rowbase = (size_t)b * SEQ;
    const bf16_t* z = wsb(c, OFF_Z);
    const float* gates = wsf(c, OFF_GATES) + (rowbase + t0 + lane) * 8;
    const float* gb = p.in[I_GATEB] + l * 8;
    const float ig = gates[h] + gb[h], lf = log_sigmoid(gates[4 + h] + gb[4 + h]);
    const float bcs = scan_add(lf, lane);
    const float gp = ig - bcs;
    const float mu = wave_max(gp);
    const float ws_ = expf(gp - mu);
    const float Bc = __shfl(bcs, 63);
    if (lane == 0) { wsf(c, OFF_SCAL)[task] = Bc; wsf(c, OFF_SCAL)[4096 + task] = mu; }
    const float* cwl = p.in[I_CONVW] + (size_t)l * 4 * 512; const float* cbl = p.in[I_CONVB] + l * 512;
    f32x16 acc[2][2];
#pragma unroll
    for (int a = 0; a < 2; ++a)
#pragma unroll
        for (int bb = 0; bb < 2; ++bb)
#pragma unroll
            for (int i = 0; i < 16; ++i) acc[a][bb][i] = 0.f;
    float nsum[2] = {0.f, 0.f};
#pragma unroll
    for (int ks = 0; ks < 4; ++ks) {
        const int s0 = 16 * ks + 8 * hi;
        float wv[8];
#pragma unroll
        for (int j = 0; j < 8; ++j) wv[j] = __shfl(ws_, s0 + j);
        bf16x8 kf[2];
#pragma unroll
        for (int it = 0; it < 2; ++it) {
            const int chn = 256 + h * 64 + 32 * it + r32;
            const float w0 = cwl[chn], w1 = cwl[512 + chn], w2 = cwl[1024 + chn], w3 = cwl[1536 + chn], cb = cbl[chn];
            const bf16_t* kp = z + (rowbase + t0 + s0) * ZW + ZKA + h * 64 + 32 * it + r32;
            float raw[11];
#pragma unroll
            for (int x = 0; x < 11; ++x) raw[x] = (t0 + s0 - 3 + x >= 0) ? bf2f(kp[(long)(x - 3) * ZW]) : 0.f;
            float kk[8];
#pragma unroll
            for (int j = 0; j < 8; ++j) { const float o = cb + w0 * raw[j] + w1 * raw[j + 1] + w2 * raw[j + 2] + w3 * raw[j + 3]; kk[j] = silu_f(o) * 0.125f * wv[j]; nsum[it] += kk[j]; }
            kf[it] = pack8(kk[0], kk[1], kk[2], kk[3], kk[4], kk[5], kk[6], kk[7]);
        }
#pragma unroll
        for (int et = 0; et < 2; ++et) {
            const bf16_t* vp = z + (rowbase + t0 + s0) * ZW + ZVA + h * 64 + 32 * et + r32;
            u32x4 w; w.x = (unsigned)vp[0] | ((unsigned)vp[ZW] << 16); w.y = (unsigned)vp[2 * ZW] | ((unsigned)vp[3 * ZW] << 16);
            w.z = (unsigned)vp[4 * ZW] | ((unsigned)vp[5 * ZW] << 16); w.w = (unsigned)vp[6 * ZW] | ((unsigned)vp[7 * ZW] << 16);
            const bf16x8 vf = __builtin_bit_cast(bf16x8, w);
            acc[et][0] = MFMA32(vf, kf[0], acc[et][0]); acc[et][1] = MFMA32(vf, kf[1], acc[et][1]);
        }
    }
    float* D = ((float*)c.out) + (size_t)task * 4096;
#pragma unroll
    for (int et = 0; et < 2; ++et)
#pragma unroll
        for (int it = 0; it < 2; ++it)
#pragma unroll
            for (int i = 0; i < 16; ++i) D[(32 * et + crow(i, hi)) * 64 + 32 * it + r32] = acc[et][it][i];
    nsum[0] += __shfl_xor(nsum[0], 32); nsum[1] += __shfl_xor(nsum[1], 32);
    if (hi == 0) { wsf(c, OFF_NST)[(size_t)task * 64 + r32] = nsum[0]; wsf(c, OFF_NST)[(size_t)task * 64 + 32 + r32] = nsum[1]; }
}
DI void mlstm_scan(const Params& p, const Ctx& c) {
    const float* Bc = wsf(c, OFF_SCAL); const float* mu = Bc + 4096; float* mprev = wsf(c, OFF_SCAL) + 8192;
    float* D = ((float*)c.out); float* N = wsf(c, OFF_NST);
    LAS float* cwl = (LAS float*)c.lds; LAS float* swl = cwl + 64;
    for (int task = c.bid; task < 256; task += c.G) {
        const int bh = task >> 2, q = task & 3;
        __syncthreads();
        if (c.wid == 0) {
            const float B = Bc[bh * 64 + c.lane], u = mu[bh * 64 + c.lane];
            float m = 0.f, mycw = 0.f, mysw = 0.f, mymp = 0.f;
            for (int ch = 0; ch < 64; ++ch) {
                const float Bs = __shfl(B, ch), us = __shfl(u, ch);
                const float mnew = fmaxf(Bs + m, Bs + us);
                const float cw = expf(Bs + m - mnew), sw = expf(Bs + us - mnew);
                if (c.lane == ch) { mycw = cw; mysw = sw; mymp = m; }
                m = mnew;
            }
            cwl[c.lane] = mycw; swl[c.lane] = mysw;
            if (q == 0) mprev[bh * 64 + c.lane] = mymp;
        }
        __syncthreads();
        for (int idx = q * 1040 + c.tid; idx < (q + 1) * 1040; idx += 512) {
            float* base = idx < 4096 ? D + (size_t)bh * 64 * 4096 + idx : N + (size_t)bh * 64 * 64 + (idx - 4096);
            const size_t stride = idx < 4096 ? 4096 : 64;
            float d[64];
#pragma unroll
            for (int ch = 0; ch < 64; ++ch) d[ch] = base[(size_t)ch * stride];
            float C = 0.f;
#pragma unroll
            for (int ch = 0; ch < 64; ++ch) { const float dv = d[ch]; base[(size_t)ch * stride] = C; C = cwl[ch] * C + swl[ch] * dv; }
        }
    }
}
DI void mlstm_c_task(const Params& p, const Ctx& c, int l, int task) {
    const int lane = c.lane, r32 = lane & 31, hi = lane >> 5;
    const int bh = task >> 6, ch = task & 63, b = bh >> 2, h = bh & 3, t0 = ch * 64;
    const size_t rowbase = (size_t)b * SEQ;
    const bf16_t* z = wsb(c, OFF_Z);
    const float* gates = wsf(c, OFF_GATES) + (rowbase + t0 + lane) * 8;
    const float* gb = p.in[I_GATEB] + l * 8;
    const float ig = gates[h] + gb[h], lf = log_sigmoid(gates[4 + h] + gb[4 + h]);
    const float bcs = scan_add(lf, lane);
    const float gp = ig - bcs;
    const float mp = wsf(c, OFF_SCAL)[8192 + task];
    const float pm = scan_max(gp, lane);
    const float mt = bcs + fmaxf(mp, pm);
    const float bm = bcs - mt;
    const float iw = expf(bcs + mp - mt);
    const float flo = expf(-mt);
    const float* cwl = p.in[I_CONVW] + (size_t)l * 4 * 512; const float* cbl = p.in[I_CONVB] + l * 512;
    const float* Ct = ((float*)c.out) + (size_t)task * 4096;
    const float* nst = wsf(c, OFF_NST) + (size_t)task * 64;
    const float* ng = p.in[I_MLN] + l * 256 + h * 64;
#pragma unroll 1
    for (int tt = 0; tt < 2; ++tt) {
        const int tq = 32 * tt + r32;
        const float bm_t = __shfl(bm, tq), iw_t = __shfl(iw, tq), flo_t = __shfl(flo, tq);
        bf16x8 qf[4]; float qn = 0.f;
#pragma unroll
        for (int ks = 0; ks < 4; ++ks) { float o[8]; const int d0 = 16 * ks + 8 * hi;
            conv8(z + (rowbase + t0 + tq) * ZW + ZQA + h * 64 + d0, t0 + tq, cwl + h * 64 + d0, cbl + h * 64 + d0, 1.f, o);
            qf[ks] = pack8(o[0], o[1], o[2], o[3], o[4], o[5], o[6], o[7]);
            const u32x4 qw = __builtin_bit_cast(u32x4, qf[ks]);
            const f32x4 n0 = *(const f32x4*)(nst + d0), n1 = *(const f32x4*)(nst + d0 + 4);
            qn += bflo(qw.x) * n0[0] + bfhi(qw.x) * n0[1] + bflo(qw.y) * n0[2] + bfhi(qw.y) * n0[3] + bflo(qw.z) * n1[0] + bfhi(qw.z) * n1[1] + bflo(qw.w) * n1[2] + bfhi(qw.w) * n1[3]; }
        qn += __shfl_xor(qn, 32);
        f32x16 num[2];
#pragma unroll
        for (int i = 0; i < 16; ++i) { num[0][i] = 0.f; num[1][i] = 0.f; }
#pragma unroll
        for (int et = 0; et < 2; ++et)
#pragma unroll
            for (int ks = 0; ks < 4; ++ks) { const float* cp = Ct + (size_t)(32 * et + r32) * 64 + 16 * ks + 8 * hi; const f32x4 c0 = *(const f32x4*)cp, c1 = *(const f32x4*)(cp + 4);
                num[et] = MFMA32(pack8(c0[0], c0[1], c0[2], c0[3], c1[0], c1[1], c1[2], c1[3]), qf[ks], num[et]); }
#pragma unroll
        for (int i = 0; i < 16; ++i) { num[0][i] *= iw_t; num[1][i] *= iw_t; }
        float dsum = 0.f;
#pragma unroll 1
        for (int st = 0; st <= tt; ++st) {
            f32x16 s;
#pragma unroll
            for (int i = 0; i < 16; ++i) s[i] = 0.f;
#pragma unroll
            for (int ks = 0; ks < 4; ++ks) { float o[8]; const int sk = 32 * st + r32, d0 = 16 * ks + 8 * hi;
                conv8(z + (rowbase + t0 + sk) * ZW + ZKA + h * 64 + d0, t0 + sk, cwl + 256 + h * 64 + d0, cbl + 256 + h * 64 + d0, 0.125f, o);
                s = MFMA32(pack8(o[0], o[1], o[2], o[3], o[4], o[5], o[6], o[7]), qf[ks], s); }
#pragma unroll
            for (int i = 0; i < 16; ++i) { const int sp = 32 * st + crow(i, hi); const float gs = __shfl(gp, sp);
                const float wgt = (sp <= tq) ? expf(gs + bm_t) : 0.f; s[i] *= wgt; dsum += s[i]; }
            const bf16x8 p0 = pack8(s[0], s[1], s[2], s[3], s[4], s[5], s[6], s[7]), p1 = pack8(s[8], s[9], s[10], s[11], s[12], s[13], s[14], s[15]);
#pragma unroll
            for (int et = 0; et < 2; ++et)
#pragma unroll
                for (int k2 = 0; k2 < 2; ++k2) {
                    const bf16_t* vp = z + (rowbase + t0 + 32 * st + 16 * k2 + 4 * hi) * ZW + ZVA + h * 64 + 32 * et + r32;
                    u32x4 w; w.x = (unsigned)vp[0] | ((unsigned)vp[ZW] << 16); w.y = (unsigned)vp[2 * ZW] | ((unsigned)vp[3 * ZW] << 16);
                    w.z = (unsigned)vp[8 * ZW] | ((unsigned)vp[9 * ZW] << 16); w.w = (unsigned)vp[10 * ZW] | ((unsigned)vp[11 * ZW] << 16);
                    num[et] = MFMA32(__builtin_bit_cast(bf16x8, w), k2 == 0 ? p0 : p1, num[et]);
                }
        }
        dsum += __shfl_xor(dsum, 32);
        const float den = iw_t * qn + dsum;
        const float idn = 1.f / fmaxf(fabsf(den), flo_t);
        float sm = 0.f;
#pragma unroll
        for (int et = 0; et < 2; ++et)
#pragma unroll
            for (int i = 0; i < 16; ++i) { const float hv = num[et][i] * idn; num[et][i] = hv; sm += hv; }
        sm += __shfl_xor(sm, 32);
        const float mean = sm * (1.f / 64.f);
        float vs = 0.f;
#pragma unroll
        for (int et = 0; et < 2; ++et)
#pragma unroll
            for (int i = 0; i < 16; ++i) { const float d = num[et][i] - mean; num[et][i] = d; vs += d * d; }
        vs += __shfl_xor(vs, 32);
        const float rstd = rsqrtf(vs * (1.f / 64.f) + 1e-6f);
        const size_t tok = rowbase + t0 + tq;
        const bf16_t* orow = z + tok * ZW + ZOA + h * 64; bf16_t* yrow = wsb(c, OFF_Y) + tok * DM + h * 64;
#pragma unroll
        for (int et = 0; et < 2; ++et)
#pragma unroll
            for (int g = 0; g < 4; ++g) { const int e = 32 * et + 8 * g + 4 * hi; const f32x4 gg = *(const f32x4*)(ng + e); const u32x2 ov = *(const u32x2*)(orow + e);
                const float y0 = num[et][4 * g] * rstd * gg[0] * sigmoid_f(bflo(ov.x)), y1 = num[et][4 * g + 1] * rstd * gg[1] * sigmoid_f(bfhi(ov.x));
                const float y2 = num[et][4 * g + 2] * rstd * gg[2] * sigmoid_f(bflo(ov.y)), y3 = num[et][4 * g + 3] * rstd * gg[3] * sigmoid_f(bfhi(ov.y));
                u32x2 w; w.x = cvtpk(y0, y1); w.y = cvtpk(y2, y3); *(u32x2*)(yrow + e) = w; }
    }
}

DI void ph_mix1(const Params& p, const Ctx& c0, int l) {
    const Ctx c = fresh(c0);
    REP(R_DIFF) for (int pt = c.bid; pt < 512; pt += c.G) { const int bh = pt >> 3, s = pt & 7; diff_attn_task(p, c, l, bh >> 2, bh & 3, 15 - s); diff_attn_task(p, c, l, bh >> 2, bh & 3, s); }
    REP(R_DIL) for (int i = c.bid; i < 1024; i += c.G) { const int bh = i >> 4, rest = i & 15; dil_attn_task(p, c, 1, bh >> 2, bh & 3, rest >> 2, rest & 3); }
    REP(R_DIL) for (int i = c.bid; i < 1024; i += c.G) { const int bh = i >> 4; dil_attn_task(p, c, 2, bh >> 2, bh & 3, i & 15, 0); }
    __syncthreads();
    REP(R_POOL) for (int wt = c.bid * 8 + c.wid; wt < 8192; wt += c.G * 8) pool_task(p, c, l, wt);
    REP(R_MLA) for (int tk = c.bid * 8 + c.wid; tk < 4096; tk += c.G * 8) mlstm_a_task(p, c, l, tk);
}
DI void ph_mix2(const Params& p, const Ctx& c0, int l) {
    const Ctx c = fresh(c0);
    mlstm_scan(p, c);
    REP(R_DIL) for (int i = c.bid; i < 1024; i += c.G) { const int bh = i >> 4; dil_attn_task(p, c, 0, bh >> 2, bh & 3, 0, i & 15); }
    __syncthreads();
}
DI void ph_mix3(const Params& p, const Ctx& c0, int l) {
    const Ctx c = fresh(c0);
    REP(R_MLC) for (int tk = c.bid * 8 + c.wid; tk < 4096; tk += c.G * 8) mlstm_c_task(p, c, l, tk);
}
DI void ph_final(const Params& p, const Ctx& c0) {
    const Ctx c = fresh(c0);
    const float* ss = ssbuf(c, 16); const float* g = p.in[I_FINN]; const bf16_t* hb = wsb(c, OFF_HB);
    for (int row = c.bid * 8 + c.wid; row < MTOK; row += c.G * 8) {
        const float rs = rowss(ss, row);
        f32x4* xr = (f32x4*)(c.out + (size_t)row * DM) + c.lane; const f32x4* gr = (const f32x4*)g + c.lane; const unsigned char* hbimg = (const unsigned char*)hb;
#pragma unroll
        for (int j = 0; j < 4; ++j) { const u32x2 hv = *(const u32x2*)(hbimg + pg8::img_off(row, 4 * (c.lane + 64 * j))); const f32x4 gg = gr[64 * j];
            xr[64 * j] = (f32x4){bflo(hv.x) * rs * gg[0], bfhi(hv.x) * rs * gg[1], bflo(hv.y) * rs * gg[2], bfhi(hv.y) * rs * gg[3]}; }
    }
}

DI void ph_ffn_up(const Params& p, const Ctx& c0, int l, int which) {
    const Ctx c = fresh(c0);
    pg8::Gemm g = pg8::plain_gemm(wsb(c, OFF_HB), (const bf16_t*)(c.ws + (size_t)l * W_LAYER + (which ? W_GU2 : W_GU1)), MTOK, 2 * FF, DM); g.ocol_step = 128; pg8::use_img_b(g); pg8::use_img_a(g);
    pg8::Order S; S.init(g, c.G, c.bid);
    pg8::EpiSwiGLU E{wsb(c, OFF_Z), FF, ssbuf(c, 4 * l + (which ? 3 : 0))};
    pg8::gemm_phase(c.lds, g, S, E);
}
DI void ph_resid(const Params& p, const Ctx& c0, const bf16_t* A, const bf16_t* Bt, int K, int ss_out, float alpha) {
    const Ctx c = fresh(c0);
    pg8::Gemm g = pg8::plain_gemm(A, Bt, MTOK, DM, K);
    if (K == FF) { g.lda = 64; g.kstepA = 256 * 64 * 2; g.a_pmdiv = (long)(FF / 64) * 256 * 64; g.imgA = 1; pg8::use_img_b(g); }
    pg8::Order S; S.init(g, c.G, c.bid);
    pg8::EpiResid E{wsb(c, OFF_HB), ssbuf(c, ss_out), alpha};
    pg8::gemm_phase(c.lds, g, S, E);
}
DI void ph_kv(const Params& p, const Ctx& c0) {
    const Ctx c = fresh(c0);
    { pg8::Gemm g = pg8::plain_gemm(wsb(c, OFF_MEMB), wsb(c, OFF_WK), MMEM, 4096, DM); pg8::Order S; S.init(g, c.G, c.bid);
      pg8::EpiBf16 E{wsb(c, OFF_KB), 4096, nullptr, wsf(c, OFF_RSM), nullptr, 1.f, 0}; pg8::gemm_phase(c.lds, g, S, E); }
    { pg8::Gemm g = pg8::plain_gemm(wsb(c, OFF_MEMB), wsb(c, OFF_WV), MMEM, 4096, DM); pg8::Order S; S.init(g, c.G, c.bid);
      pg8::EpiBf16 E{wsb(c, OFF_VT), 4096, nullptr, wsf(c, OFF_RSM), nullptr, 1.f, 0}; pg8::gemm_phase(c.lds, g, S, E); }
}
DI void ph_win(const Params& p, const Ctx& c0, int l) {
    const Ctx c = fresh(c0);
    pg8::Gemm g = pg8::plain_gemm(wsb(c, OFF_HB), (const bf16_t*)(c.ws + (size_t)l * W_LAYER + W_IN), MTOK, 3072, DM); pg8::use_img_b(g); pg8::use_img_a(g);
    pg8::Order S; S.init(g, c.G, c.bid);
    pg8::EpiZ E{wsb(c, OFF_Z), wsf(c, OFF_GATES), ssbuf(c, 4 * l + 1)};
    pg8::gemm_phase(c.lds, g, S, E);
}
constexpr size_t OFF_MT = OFF_Z, OFF_VWT = OFF_Z + (size_t)16384 * DM * 2;
DI void ph_xpre(const Params& p, const Ctx& c0, int l) {
    const Ctx c = fresh(c0);
    const unsigned char* wl = c.ws + (size_t)l * W_LAYER;
    { pg8::Gemm g; g.A = wsb(c, OFF_KB) + l * 1024; g.B = (const bf16_t*)(wl + W_Q); g.lda = 4096; g.ldb = DM; g.K = 256; g.nM = 64; g.nN = 4;
      g.div = 4; g.a_pmdiv = 256L * 4096; g.a_pmmod = 256; g.a_pn = 0; g.b_pmdiv = 0; g.b_pmmod = 256; g.b_pn = 256L * DM; g.ocol_step = 256; g.kstepA = 128; g.kstepB = 128; g.imgA = 0; g.imgB = 0;
      pg8::Order S; S.init(g, c.G, c.bid);
      pg8::EpiBf16 E{wsb(c, OFF_MT), DM, nullptr, nullptr, nullptr, 1.f, 0}; pg8::gemm_phase(c.lds, g, S, E); }
    { pg8::Gemm g; g.A = (const bf16_t*)(wl + W_O); g.B = wsb(c, OFF_VT) + l * 1024; g.lda = DM; g.ldb = 4096; g.K = 256; g.nM = 64; g.nN = 4;
      g.div = 4; g.a_pmdiv = 0; g.a_pmmod = 256L * DM; g.a_pn = 256; g.b_pmdiv = 256L * 4096; g.b_pmmod = 0; g.b_pn = 256; g.ocol_step = 256; g.kstepA = 128; g.kstepB = 128; g.imgA = 0; g.imgB = 0;
      pg8::Order S; S.init(g, c.G, c.bid);
      pg8::EpiBf16 E{wsb(c, OFF_VWT), DM, nullptr, nullptr, nullptr, 1.f, 0}; pg8::gemm_phase(c.lds, g, S, E); }
}
DI void ph_xs(const Params& p, const Ctx& c0, int l) {
    const Ctx c = fresh(c0);
    pg8::Gemm g; g.A = wsb(c, OFF_HB); g.B = wsb(c, OFF_MT); g.lda = DM; g.ldb = DM; g.K = DM; g.nM = MTOK / 256; g.nN = 4;
    g.div = 16; g.a_pmdiv = 16L * 256 * DM; g.a_pmmod = 256L * DM; g.a_pn = 0; g.b_pmdiv = 4L * 256 * DM; g.b_pmmod = 0; g.b_pn = 256L * DM; g.ocol_step = 256; g.kstepA = 128; g.kstepB = 128; g.imgA = 0; g.imgB = 0; pg8::use_img_a(g);
    pg8::Order S; S.init(g, c.G, c.bid);
    pg8::EpiSoftmax E{wsb(c, OFF_Y), DM, (LAS float*)(c.lds + LDS_EXTRA), ssbuf(c, 4 * l + 2), 0.0625f * LOG2E};
    pg8::gemm_phase(c.lds, g, S, E);
}
DI void ph_xo(const Params& p, const Ctx& c0, int l) {
    const Ctx c = fresh(c0);
    pg8::Gemm g; g.A = wsb(c, OFF_Y); g.B = wsb(c, OFF_VWT); g.lda = DM; g.ldb = DM; g.K = DM; g.nM = MTOK / 256; g.nN = 4;
    g.div = 16; g.a_pmdiv = 16L * 256 * DM; g.a_pmmod = 256L * DM; g.a_pn = 0; g.b_pmdiv = 1024L * DM; g.b_pmmod = 0; g.b_pn = 256L * DM; g.ocol_step = 256; g.kstepA = 128; g.kstepB = 128; g.imgA = 0; g.imgB = 0;
    pg8::Order S; S.init(g, c.G, c.bid);
    pg8::EpiResid E{wsb(c, OFF_HB), ssbuf(c, 4 * l + 3), 1.f};
    pg8::gemm_phase(c.lds, g, S, E);
}

constexpr int PH_PER_LAYER = 11, PH_FINAL = 1 + PH_PER_LAYER * DEPTH, PH_TOTAL = PH_FINAL + 1;
__global__ void __launch_bounds__(512, 2) mega_fwd(Params pk) {
    extern __shared__ __attribute__((aligned(16))) unsigned char lds_raw[];
    volatile LAS unsigned* bst = (volatile LAS unsigned*)((LAS unsigned char*)lds_raw + LDS_EXTRA + 12288);
    XcdBarrier xbar; xbar.bar = (unsigned*)(pk.ws + OFF_CTL); xbar.x = 0; xbar.st = bst;
    if (pk.coop) { if (threadIdx.x < 4) bst[threadIdx.x] = 0u; __syncthreads(); xbar = xcd_barrier_post((unsigned*)(pk.ws + OFF_CTL), bst); }
    for (int ph = pk.ph_lo; ph < pk.ph_hi; ++ph) {
        int tid = threadIdx.x; asm volatile("" : "+v"(tid));
        const Params& p = pk;
        Ctx c; c.lds = (LAS unsigned char*)lds_raw; c.ldsg = lds_raw; c.tid = tid; c.lane = tid & 63; c.wid = __builtin_amdgcn_readfirstlane(tid >> 6);
        c.bid = blockIdx.x; c.G = gridDim.x; c.ws = pk.ws; c.out = pk.out;
        asm volatile("" : "+s"(c.ws)); asm volatile("" : "+s"(c.out));
        if (ph == 0) {
#ifndef NO_PRO
            REP(R_PRO) ph_prologue(p, c);
#endif
        }
        else if (ph == PH_FINAL) ph_final(p, c);
        else {
            const int l = (ph - 1) / PH_PER_LAYER, j = (ph - 1) % PH_PER_LAYER;
            const unsigned char* wl = c.ws + (size_t)l * W_LAYER;
#ifdef ONLY_CASE
            if (j != ONLY_CASE) continue;
#endif
            switch (j) {
                case 0: REP(R_UP) ph_ffn_up(p, c, l, 0); if (l == 0) ph_kv(p, c); break;
                case 1: ph_resid(p, c, wsb(c, OFF_Z), (const bf16_t*)(wl + W_D1), FF, 4 * l + 1, 0.5f); break;
                case 2: ph_win(p, c, l); break;
                case 3:
#ifndef NO_MIX1
                    ph_mix1(p, c, l);
#endif
                    break;
                case 4:
#ifndef NO_MIX2
                    ph_mix2(p, c, l);
#endif
                    break;
                case 5:
#ifndef NO_MIX3
                    ph_mix3(p, c, l);
#endif
                    break;
                case 6: ph_resid(p, c, wsb(c, OFF_Y), (const bf16_t*)(wl + W_OUT), DM, 4 * l + 2, 1.f); ph_xpre(p, c, l); break;
                case 7: ph_xs(p, c, l); break;
                case 8: ph_xo(p, c, l); break;
                case 9: ph_ffn_up(p, c, l, 1); break;
                default: ph_resid(p, c, wsb(c, OFF_Z), (const bf16_t*)(wl + W_D2), FF, 4 * l + 4, 0.5f); break;
            }
        }
        if (ph + 1 < pk.ph_hi && pk.coop) { if (ph == pk.ph_lo) cg::this_grid().sync(); else xcd_barrier(xbar); }
    }
}

extern "C" void kernel_launch(void* const* d_in, const int* in_sizes, int n_in, void* d_out, int out_size, void* d_ws, size_t ws_size, hipStream_t stream) {
    static int grid = 0;
    if (grid == 0) {
        if (n_in != 28 || out_size != MTOK * DM || ws_size < OFF_END) { fprintf(stderr, "kernel_launch: unexpected shapes (n_in %d out %d ws %zu)\n", n_in, out_size, ws_size); grid = -1; return; }
        int dev = 0, cus = 0, per_cu = 0;
        (void)hipGetDevice(&dev); (void)hipDeviceGetAttribute(&cus, hipDeviceAttributeMultiprocessorCount, dev);
        if (hipFuncSetAttribute((const void*)mega_fwd, hipFuncAttributeMaxDynamicSharedMemorySize, LDS_BYTES) != hipSuccess) { fprintf(stderr, "kernel_launch: hipFuncSetAttribute failed\n"); grid = -1; return; }
        if (hipOccupancyMaxActiveBlocksPerMultiprocessor(&per_cu, (const void*)mega_fwd, 512, LDS_BYTES) != hipSuccess || per_cu < 1) { fprintf(stderr, "kernel_launch: occupancy query says %d\n", per_cu); per_cu = 1; }
        (void)hipGetLastError();
        grid = cus * per_cu;
    }
    if (grid < 0) return;
    Params p{};
    for (int i = 0; i < 28; ++i) p.in[i] = (const float*)d_in[i];
    p.out = (float*)d_out; p.ws = (unsigned char*)d_ws; p.pad = 0;
    (void)hipMemsetAsync((unsigned char*)d_ws + OFF_CTL, 0, CTL_BYTES, stream);
#if MK_MULTI
    for (int ph = 0; ph < PH_TOTAL; ++ph) { p.ph_lo = ph; p.ph_hi = ph + 1; p.coop = 0; hipLaunchKernelGGL(mega_fwd, dim3(grid), dim3(512), LDS_BYTES, stream, p); }
#else
    p.ph_lo = 0; p.ph_hi = PH_TOTAL; p.coop = 1;
    void* args[] = {&p};
    hipError_t e = hipLaunchCooperativeKernel((const void*)mega_fwd, dim3(grid), dim3(512), args, LDS_BYTES, stream);
    if (e != hipSuccess) fprintf(stderr, "cooperative launch failed: %s (grid %d)\n", hipGetErrorString(e), grid);
#endif
}
```

```cpp
#include <hip/hip_runtime.h>
#include <hip/hip_cooperative_groups.h>
#include <cstdio>
#include <cstdint>
namespace cg = cooperative_groups;

#ifndef MK_MULTI
#define MK_MULTI 0
#endif

#ifndef R_DIFF
#define R_DIFF 1
#endif
#ifndef R_DIL
#define R_DIL 1
#endif
#ifndef R_POOL
#define R_POOL 1
#endif
#ifndef R_MLA
#define R_MLA 1
#endif
#ifndef R_MLC
#define R_MLC 1
#endif
#ifndef R_UP
#define R_UP 1
#endif
#ifndef R_WIN
#define R_WIN 1
#endif
#ifndef R_GATES
#define R_GATES 1
#endif
#ifndef R_PRO
#define R_PRO 1
#endif
#ifndef R_RES1
#define R_RES1 1
#endif
#ifndef R_RES6
#define R_RES6 1
#endif
#ifndef R_WQ
#define R_WQ 1
#endif
#define REP(n) for (int rep_ = 0; rep_ < (n); ++rep_)
#define DI __device__ __forceinline__
#define LAS __attribute__((address_space(3)))
typedef unsigned short bf16_t;
typedef short bf16x8 __attribute__((ext_vector_type(8)));
typedef float f32x4 __attribute__((ext_vector_type(4)));
typedef float f32x16 __attribute__((ext_vector_type(16)));
typedef unsigned u32x4 __attribute__((ext_vector_type(4)));
typedef unsigned u32x2 __attribute__((ext_vector_type(2)));
typedef float f32x2_t __attribute__((ext_vector_type(2)));
typedef __bf16 bf16x2_t __attribute__((ext_vector_type(2)));

constexpr int DM = 1024, NB = 16, SEQ = 4096, MTOK = NB * SEQ, DEPTH = 4, MEMLEN = 256, MMEM = NB * MEMLEN, FF = 2816, ZW = 2816, INW = 2824;
constexpr int ZQA = 0, ZKA = 256, ZVA = 512, ZOA = 768, ZPB = 1024, ZQC = 1280, ZKC = 1536, ZVC = 1792, ZQD = 2048, ZKD = 2304, ZVD = 2560;
constexpr float LOG2E = 1.4426950408889634f;
constexpr float NEGBIG = -1e30f;

constexpr size_t W_GU1 = 0, W_D1 = W_GU1 + (size_t)2 * FF * DM * 2, W_IN = W_D1 + (size_t)DM * FF * 2, W_OUT = W_IN + (size_t)3072 * DM * 2,
                 W_Q = W_OUT + (size_t)DM * DM * 2, W_O = W_Q + (size_t)DM * DM * 2, W_GU2 = W_O + (size_t)DM * DM * 2, W_D2 = W_GU2 + (size_t)2 * FF * DM * 2,
                 W_LAYER = W_D2 + (size_t)DM * FF * 2;
constexpr size_t OFF_WK = DEPTH * W_LAYER, OFF_WV = OFF_WK + (size_t)DEPTH * DM * DM * 2, OFF_HB = OFF_WV + (size_t)DEPTH * DM * DM * 2;
constexpr size_t OFF_DST = OFF_HB;
constexpr size_t OFF_OPART = OFF_HB + (size_t)64 * 64 * 4096 * 4;
constexpr size_t OFF_Z = OFF_HB + (size_t)MTOK * DM * 2;
constexpr size_t OFF_Y = OFF_Z + (size_t)MTOK * ZW * 2;
constexpr size_t OFF_KB = OFF_Y + (size_t)MTOK * DM * 2;
constexpr size_t OFF_VT = OFF_KB + (size_t)MMEM * 4096 * 2;
constexpr size_t OFF_MEMB = OFF_VT + (size_t)4096 * MMEM * 2;
constexpr size_t OFF_GATES = OFF_MEMB + (size_t)MMEM * DM * 2;
constexpr size_t OFF_SS = OFF_GATES + (size_t)MTOK * 8 * 4;
constexpr size_t OFF_LSEP = OFF_SS + (size_t)17 * MTOK * 16 * 4;
constexpr size_t OFF_NST = OFF_LSEP + (size_t)2 * MTOK * 4 * 4;
constexpr size_t OFF_SCAL = OFF_NST + (size_t)4096 * 64 * 4;
constexpr size_t OFF_DIFFB = OFF_SCAL + 65536;
constexpr size_t OFF_DILB = OFF_DIFFB + 65536;
constexpr size_t OFF_LAM = OFF_DILB + 8192;
constexpr size_t OFF_RSM = OFF_LAM + 256;
constexpr size_t OFF_CTL = OFF_RSM + 16384;
constexpr size_t CTL_BYTES = 16384;
constexpr size_t OFF_END = OFF_CTL + CTL_BYTES;
static_assert(OFF_OPART + (size_t)2 * MTOK * 256 * 2 <= OFF_Z, "alias map");
static_assert(OFF_END < (size_t)1073741824, "workspace");

constexpr int LDS_BYTES = 147456;
constexpr int LDS_EXTRA = 131072;

struct Params {
    const float* in[28];
    float* out;
    unsigned char* ws;
    int ph_lo, ph_hi, coop, pad;
};
enum { I_X = 0, I_MEM, I_T5, I_F1N, I_F1G, I_F1U, I_F1D, I_MIXN, I_WIN, I_CONVW, I_CONVB, I_GATEB, I_MLN, I_POOLW, I_POOLS, I_LAMV, I_SUBLN, I_WOUT,
       I_XN, I_MEMN, I_XWQ, I_XWKV, I_XWO, I_F2N, I_F2G, I_F2U, I_F2D, I_FINN };

DI unsigned cvtpk(float lo, float hi) { f32x2_t v = {lo, hi}; bf16x2_t b = __builtin_convertvector(v, bf16x2_t); return __builtin_bit_cast(unsigned, b); }
DI float bflo(unsigned w) { return __uint_as_float(w << 16); }
DI float bfhi(unsigned w) { return __uint_as_float(w & 0xffff0000u); }
DI float bf2f(bf16_t x) { return __uint_as_float((unsigned)x << 16); }
DI float ex2(float x) { return __builtin_amdgcn_exp2f(x); }
DI float rcpf_(float x) { return __builtin_amdgcn_rcpf(x); }
DI int crow(int i, int hi) { return (i & 3) + 8 * (i >> 2) + 4 * hi; }
DI float wave_sum(float v) {
#pragma unroll
    for (int o = 1; o < 64; o <<= 1) v += __shfl_xor(v, o);
    return v;
}
DI float wave_max(float v) {
#pragma unroll
    for (int o = 1; o < 64; o <<= 1) v = fmaxf(v, __shfl_xor(v, o));
    return v;
}
DI float silu_f(float g) { return g * rcpf_(1.f + ex2(-g * LOG2E)); }
DI float sigmoid_f(float g) { return rcpf_(1.f + ex2(-g * LOG2E)); }
#define LDS_WAIT() asm volatile("s_waitcnt lgkmcnt(0)" ::: "memory")
DI bf16x8 mk8(u32x2 lo, u32x2 hi) { u32x4 w = {lo.x, lo.y, hi.x, hi.y}; return __builtin_bit_cast(bf16x8, w); }
DI bf16x8 pack8(float a0, float a1, float a2, float a3, float a4, float a5, float a6, float a7) {
    u32x4 w = {cvtpk(a0, a1), cvtpk(a2, a3), cvtpk(a4, a5), cvtpk(a6, a7)}; return __builtin_bit_cast(bf16x8, w);
}
DI float rowss(const float* ss, int row) {
    const f32x4* q = (const f32x4*)(ss + (size_t)row * 16); const f32x4 a = q[0], b = q[1], c = q[2], d = q[3];
    const float t = ((a[0] + a[1]) + (a[2] + a[3])) + ((b[0] + b[1]) + (b[2] + b[3])) + ((c[0] + c[1]) + (c[2] + c[3])) + ((d[0] + d[1]) + (d[2] + d[3]));
    return rsqrtf(t * (1.f / 1024.f) + 1e-6f);
}
#define MFMA32(a, b, c) __builtin_amdgcn_mfma_f32_32x32x16_bf16((a), (b), (c), 0, 0, 0)

namespace pg8 {
constexpr int BM = 256, BK = 64, HALF = 128, HTB = HALF * BK * 2, STAGE_BYTES = 8 * HTB, NXCD = 8, WGM = 8;
DI int lds_byte(int r, int c) { const int st = (r >> 4) * 2 + (c >> 5), rr = r & 15, cc = c & 31, ob = rr * 64 + cc * 2; return st * 1024 + (ob ^ (((ob >> 9) & 1) << 5)); }
DI void stage_rc(int b, int& R, int& C) { const int st = b / 1024, sb = b % 1024, swz = sb ^ (((sb >> 9) & 1) << 5); R = (st >> 1) * 16 + swz / 64; C = (st & 1) * 32 + (swz % 64) / 2; }
DI int perm32(int rho) { const int n = rho >> 4, i = rho & 15; return 8 * (i >> 2) + 4 * n + (i & 3); }

DI size_t img_off(int row, int col) { return ((size_t)((row >> 8) * (DM / 64) + (col >> 6)) * 2 + ((row >> 7) & 1)) * 16384 + lds_byte(row & 127, col & 63); }
struct Unit { const char* a; const char* b; int orow, ocol, pm, pn; };
struct Gemm {
    const bf16_t* A; const bf16_t* B; int lda, ldb, K, nM, nN; long a_pmdiv, a_pmmod, a_pn, b_pmdiv, b_pmmod, b_pn; int div, ocol_step; int kstepA, kstepB;
    int imgB;
    int imgA;
};
DI Gemm plain_gemm(const bf16_t* A, const bf16_t* B, int Mrows, int N, int K) {
    Gemm g; g.A = A; g.B = B; g.lda = K; g.ldb = K; g.K = K; g.nM = Mrows / BM; g.nN = N / BM; g.a_pmdiv = (long)BM * K; g.a_pmmod = 0; g.a_pn = 0; g.b_pmdiv = 0; g.b_pmmod = 0; g.b_pn = (long)BM * K;
    g.div = 1; g.ocol_step = BM; g.kstepA = BK * 2; g.kstepB = BK * 2; g.imgA = 0; g.imgB = 0; return g;
}
DI void use_img_a(Gemm& g) { g.imgA = 1; g.lda = 64; g.kstepA = 256 * 64 * 2; }
DI void use_img_b(Gemm& g) { g.imgB = 1; g.ldb = 64; g.kstepB = 256 * 64 * 2; g.b_pn = (long)(g.K / 64) * 256 * 64; }
struct Order {
    Gemm g; int nwg, G, c;
    DI void init(const Gemm& g_, int G_, int c_) { g = g_; nwg = g.nM * g.nN; G = G_; c = c_; }
    DI bool next(int i, Unit& u) const {
        const long L = (long)i * G + c; if (L >= nwg) return false;
        int wgid = (int)L; { const int q = nwg / NXCD, r = nwg % NXCD, xcd = wgid % NXCD, off = wgid / NXCD; wgid = (xcd < r ? xcd * (q + 1) : r * (q + 1) + (xcd - r) * q) + off; }
        const int nN = g.nN, nM = g.nM, nig = WGM * nN, gid = wgid / nig, fm = gid * WGM, gsz = (nM - fm) < WGM ? (nM - fm) : WGM;
        const int pm = fm + ((wgid % nig) % gsz), pn = (wgid % nig) / gsz;
        u.pm = pm; u.pn = pn; u.orow = pm * BM; u.ocol = pn * g.ocol_step;
        const int pq = pm / g.div, pr = pm - pq * g.div;
        u.a = (const char*)(g.A + (long)pq * g.a_pmdiv + (long)pr * g.a_pmmod + (long)pn * g.a_pn);
        u.b = (const char*)(g.B + (long)pq * g.b_pmdiv + (long)pr * g.b_pmmod + (long)pn * g.b_pn);
        return true;
    }
};

struct EpiBf16 {
    static constexpr bool PERM = true;
    bf16_t* O; int ldc; const float* ss; const float* rowscale; const float* colscale; float scale; int zspecial;
    DI void operator()(f32x4 (&acc)[2][2][4][2], const Unit& u, int wr, int wc, int fr, int fq, int wid, int lane) const {
        const int row0 = u.orow + wr * 64 + fr, col0 = u.ocol + wc * 32 + 8 * fq;
        float sc = scale;
        if (zspecial) { if (u.pn == 5) sc *= 0.125f * LOG2E; else if (u.pn == 8) sc *= 0.17677669529663687f * LOG2E; }
        if (colscale) {
#pragma unroll
            for (int bj = 0; bj < 2; ++bj)
#pragma unroll
                for (int n = 0; n < 2; ++n) { const f32x4 cs = *(const f32x4*)(colscale + col0 + bj * HALF + 4 * n);
#pragma unroll
                    for (int ai = 0; ai < 2; ++ai)
#pragma unroll
                        for (int m = 0; m < 4; ++m) acc[ai][bj][m][n] *= cs; }
            asm volatile("" ::: "memory");
        }
#pragma unroll
        for (int ai = 0; ai < 2; ++ai)
#pragma unroll
            for (int m = 0; m < 4; ++m) {
                const int row = row0 + ai * HALF + m * 16;
                float rs = sc;
                if (ss) rs *= rowss(ss, row);
                if (rowscale) rs *= rowscale[row];
                bf16_t* rowp = O + (size_t)row * ldc + col0;
#pragma unroll
                for (int bj = 0; bj < 2; ++bj) {
                    const f32x4 v0 = acc[ai][bj][m][0] * rs, v1 = acc[ai][bj][m][1] * rs;
                    u32x4 w; w.x = cvtpk(v0[0], v0[1]); w.y = cvtpk(v0[2], v0[3]); w.z = cvtpk(v1[0], v1[1]); w.w = cvtpk(v1[2], v1[3]);
                    *(u32x4*)(rowp + bj * HALF) = w;
                }
                asm volatile("" ::: "memory");
            }
    }
};
struct EpiZ {
    static constexpr bool PERM = true;
    bf16_t* O; float* gates; const float* ss;
    DI void operator()(f32x4 (&acc)[2][2][4][2], const Unit& u, int wr, int wc, int fr, int fq, int wid, int lane) const {
        const int row0 = u.orow + wr * 64 + fr, col0 = u.ocol + wc * 32 + 8 * fq;
        if (u.pn == 11) {
            if (wc == 0 && fq == 0) {
#pragma unroll
                for (int ai = 0; ai < 2; ++ai)
#pragma unroll
                    for (int m = 0; m < 4; ++m) { const int row = row0 + ai * HALF + m * 16; const float rs = rowss(ss, row);
                        *(f32x4*)(gates + (size_t)row * 8) = acc[ai][0][m][0] * rs; *(f32x4*)(gates + (size_t)row * 8 + 4) = acc[ai][0][m][1] * rs; }
            }
            return;
        }
        float sc = 1.f;
        if (u.pn == 5) sc = 0.125f * LOG2E; else if (u.pn == 8) sc = 0.17677669529663687f * LOG2E;
#pragma unroll
        for (int ai = 0; ai < 2; ++ai)
#pragma unroll
            for (int m = 0; m < 4; ++m) {
                const int row = row0 + ai * HALF + m * 16;
                const float rs = sc * rowss(ss, row);
                bf16_t* rowp = O + (size_t)row * ZW + col0;
#pragma unroll
                for (int bj = 0; bj < 2; ++bj) {
                    const f32x4 v0 = acc[ai][bj][m][0] * rs, v1 = acc[ai][bj][m][1] * rs;
                    u32x4 w; w.x = cvtpk(v0[0], v0[1]); w.y = cvtpk(v0[2], v0[3]); w.z = cvtpk(v1[0], v1[1]); w.w = cvtpk(v1[2], v1[3]);
                    *(u32x4*)(rowp + bj * HALF) = w;
                }
                asm volatile("" ::: "memory");
            }
    }
};
struct EpiSwiGLU {
    static constexpr bool PERM = true;
    bf16_t* O; int ldc; const float* ss;
    DI void operator()(f32x4 (&acc)[2][2][4][2], const Unit& u, int wr, int wc, int fr, int fq, int wid, int lane) const {
        const int row0 = u.orow + wr * 64 + fr, col0 = u.ocol + wc * 32 + 8 * fq;
#pragma unroll
        for (int ai = 0; ai < 2; ++ai)
#pragma unroll
            for (int m = 0; m < 4; ++m) {
                const int row = row0 + ai * HALF + m * 16;
                const float rs = rowss(ss, row);
                float o[8];
#pragma unroll
                for (int n = 0; n < 2; ++n)
#pragma unroll
                    for (int j = 0; j < 4; ++j) { const float g = acc[ai][0][m][n][j] * rs, up = acc[ai][1][m][n][j] * rs; o[4 * n + j] = silu_f(g) * up; }
                u32x4 w; w.x = cvtpk(o[0], o[1]); w.y = cvtpk(o[2], o[3]); w.z = cvtpk(o[4], o[5]); w.w = cvtpk(o[6], o[7]);
                __builtin_nontemporal_store(w, (u32x4*)((unsigned char*)O + ((size_t)(u.pm * (FF / 64) + (col0 >> 6)) * 2 + ((row >> 7) & 1)) * 16384 + lds_byte(row & 127, col0 & 63)));
                asm volatile("" ::: "memory");
            }
    }
};
struct EpiResid {
    static constexpr bool PERM = true;
    bf16_t* hb; float* ssout; float alpha;
    DI void operator()(f32x4 (&acc)[2][2][4][2], const Unit& u, int wr, int wc, int fr, int fq, int wid, int lane) const {
        const int row0 = u.orow + wr * 64 + fr, col0 = u.ocol + wc * 32 + 8 * fq;
#pragma unroll
        for (int ai = 0; ai < 2; ++ai) {
            u32x4 r[4][2];
#pragma unroll
            for (int m = 0; m < 4; ++m) {
#pragma unroll
                for (int bj = 0; bj < 2; ++bj) r[m][bj] = *(const u32x4*)((const unsigned char*)hb + img_off(row0 + ai * HALF + m * 16, col0 + bj * HALF)); }
#pragma unroll
            for (int m = 0; m < 4; ++m) {
                const int row = row0 + ai * HALF + m * 16; float ssq = 0.f;
#pragma unroll
                for (int bj = 0; bj < 2; ++bj) {
                    const u32x4 rr = r[m][bj]; const f32x4 a0 = acc[ai][bj][m][0] * alpha, a1 = acc[ai][bj][m][1] * alpha;
                    u32x4 w; w.x = cvtpk(bflo(rr.x) + a0[0], bfhi(rr.x) + a0[1]); w.y = cvtpk(bflo(rr.y) + a0[2], bfhi(rr.y) + a0[3]);
                    w.z = cvtpk(bflo(rr.z) + a1[0], bfhi(rr.z) + a1[1]); w.w = cvtpk(bflo(rr.w) + a1[2], bfhi(rr.w) + a1[3]);
                    *(u32x4*)((unsigned char*)hb + img_off(row, col0 + bj * HALF)) = w;
                    const float v0 = bflo(w.x), v1 = bfhi(w.x), v2 = bflo(w.y), v3 = bfhi(w.y), v4 = bflo(w.z), v5 = bfhi(w.z), v6 = bflo(w.w), v7 = bfhi(w.w);
                    ssq += ((v0 * v0 + v1 * v1) + (v2 * v2 + v3 * v3)) + ((v4 * v4 + v5 * v5) + (v6 * v6 + v7 * v7));
                }
                ssq += __shfl_xor(ssq, 16); ssq += __shfl_xor(ssq, 32);
                if (fq == 0) ssout[(size_t)row * 16 + u.pn * 4 + wc] = ssq;
            }
            asm volatile("" ::: "memory");
        }
    }
};
struct EpiSoftmax {
    static constexpr bool PERM = true;
    bf16_t* O; int ldc; LAS float* red; const float* ss; float scale;
    DI void operator()(f32x4 (&acc)[2][2][4][2], const Unit& u, int wr, int wc, int fr, int fq, int wid, int lane) const {
        float mloc[2][4];
#pragma unroll
        for (int ai = 0; ai < 2; ++ai)
#pragma unroll
            for (int m = 0; m < 4; ++m) {
                float mx = NEGBIG;
                const float rsc = rowss(ss, u.orow + ai * HALF + wr * 64 + m * 16 + fr) * scale;
#pragma unroll
                for (int bj = 0; bj < 2; ++bj)
#pragma unroll
                    for (int n = 0; n < 2; ++n) { const f32x4 x = acc[ai][bj][m][n] * rsc; acc[ai][bj][m][n] = x; mx = fmaxf(mx, fmaxf(fmaxf(x[0], x[1]), fmaxf(x[2], x[3]))); }
                mx = fmaxf(mx, __shfl_xor(mx, 16)); mx = fmaxf(mx, __shfl_xor(mx, 32));
                float sm = 0.f;
#pragma unroll
                for (int bj = 0; bj < 2; ++bj)
#pragma unroll
                    for (int n = 0; n < 2; ++n) { f32x4 x = acc[ai][bj][m][n]; x[0] = ex2(x[0] - mx); x[1] = ex2(x[1] - mx); x[2] = ex2(x[2] - mx); x[3] = ex2(x[3] - mx);
                        acc[ai][bj][m][n] = x; sm += (x[0] + x[1]) + (x[2] + x[3]); }
                sm += __shfl_xor(sm, 16); sm += __shfl_xor(sm, 32);
                mloc[ai][m] = mx;
                const int rl = ai * HALF + wr * 64 + m * 16 + fr;
                if (fq == 0) { red[(rl * 4 + wc) * 2] = mx; red[(rl * 4 + wc) * 2 + 1] = sm; }
            }
        asm volatile("s_waitcnt lgkmcnt(0)" ::: "memory"); __builtin_amdgcn_s_barrier(); asm volatile("" ::: "memory");
        const int row0 = u.orow + wr * 64 + fr, col0 = u.ocol + wc * 32 + 8 * fq;
#pragma unroll
        for (int ai = 0; ai < 2; ++ai)
#pragma unroll
            for (int m = 0; m < 4; ++m) {
                const int rl = ai * HALF + wr * 64 + m * 16 + fr;
                const f32x4 p0 = *(const LAS f32x4*)(red + rl * 8), p1 = *(const LAS f32x4*)(red + rl * 8 + 4);
                const float gm = fmaxf(fmaxf(p0[0], p0[2]), fmaxf(p1[0], p1[2]));
                const float tot = p0[1] * ex2(p0[0] - gm) + p0[3] * ex2(p0[2] - gm) + p1[1] * ex2(p1[0] - gm) + p1[3] * ex2(p1[2] - gm);
                const float f = ex2(mloc[ai][m] - gm) / tot;
                const int prow = row0 + ai * HALF + m * 16;
#pragma unroll
                for (int bj = 0; bj < 2; ++bj) {
                    const f32x4 v0 = acc[ai][bj][m][0] * f, v1 = acc[ai][bj][m][1] * f;
                    u32x4 w; w.x = cvtpk(v0[0], v0[1]); w.y = cvtpk(v0[2], v0[3]); w.z = cvtpk(v1[0], v1[1]); w.w = cvtpk(v1[2], v1[3]);
                    *(u32x4*)((unsigned char*)O + img_off(prow, col0 + bj * HALF)) = w;
                }
            }
        asm volatile("s_waitcnt lgkmcnt(0)" ::: "memory"); __builtin_amdgcn_s_barrier(); asm volatile("" ::: "memory");
    }
};

template <class Epi>
DI void gemm_phase(LAS unsigned char* lds, const Gemm g, const Order& S, const Epi& E) {
    int tid_ = threadIdx.x; asm volatile("" : "+v"(tid_));
    const int tid = tid_, wid = __builtin_amdgcn_readfirstlane(tid >> 6), lane = tid & 63, wr = wid >> 2, wc = wid & 3, fr = lane & 15, fq = lane >> 4;
    const int K = g.K, nt = K / BK;
    unsigned voffA[2], voffB[2];
#pragma unroll
    for (int i = 0; i < 2; ++i) { int R, C; stage_rc(tid * 16 + i * 8192, R, C); const int Rb = Epi::PERM ? ((R & ~31) + perm32(R & 31)) : R;
        voffA[i] = g.imgA ? (unsigned)(tid * 16 + i * 8192) : (unsigned)(R * g.lda + C) * 2u; voffB[i] = g.imgB ? (unsigned)(tid * 16 + i * 8192) : (unsigned)(Rb * g.ldb + C) * 2u; }
    const size_t kstepA = (size_t)g.kstepA, kstepB = (size_t)g.kstepB;
    const size_t hstepA = (size_t)HALF * g.lda * 2, hstepB = (size_t)HALF * g.ldb * 2;
    const unsigned ldsw = (unsigned)wid * 1024u;
    const int aoff = lds_byte(wr * 64 + fr, fq * 8), boff = lds_byte(wc * 32 + fr, fq * 8);
#define PG8_SA(b, h) (((b) * 2 + (h)) * HTB)
#define PG8_SB(b, h) ((4 + (b) * 2 + (h)) * HTB)
#define PG8_STAGE(bufoff, gbase, voff) do { _Pragma("unroll") for (int _i = 0; _i < 2; ++_i) \
        __builtin_amdgcn_global_load_lds((const unsigned*)((const char*)(gbase) + (voff)[_i]), (LAS unsigned*)(lds + (bufoff) + ldsw + _i * 8192), 16, 0, 0); } while (0)
#define PG8_LDA(dst, b, h) do { _Pragma("unroll") for (int m = 0; m < 4; ++m) _Pragma("unroll") for (int k = 0; k < 2; ++k) dst[m][k] = *(const LAS bf16x8*)(lds + PG8_SA(b, h) + aoff + m * 2048 + k * 1024); } while (0)
#define PG8_LDB(dst, b, h) do { _Pragma("unroll") for (int n = 0; n < 2; ++n) _Pragma("unroll") for (int k = 0; k < 2; ++k) dst[n][k] = *(const LAS bf16x8*)(lds + PG8_SB(b, h) + boff + n * 2048 + k * 1024); } while (0)
#define PG8_MMA(ai, bj, At, Bt) do { __builtin_amdgcn_s_setprio(1); _Pragma("unroll") for (int m = 0; m < 4; ++m) _Pragma("unroll") for (int n = 0; n < 2; ++n) _Pragma("unroll") for (int k = 0; k < 2; ++k) \
        acc[ai][bj][m][n] = __builtin_amdgcn_mfma_f32_16x16x32_bf16(Bt[n][k], At[m][k], acc[ai][bj][m][n], 0, 0, 0); __builtin_amdgcn_s_setprio(0); } while (0)
#define PG8_WAIT_V(n) asm volatile("s_waitcnt vmcnt(" #n ")" ::: "memory")
#define PG8_WAIT_L(n) asm volatile("s_waitcnt lgkmcnt(" #n ")" ::: "memory")
#define PG8_BAR __builtin_amdgcn_s_barrier()
#define PG8_SCHED __builtin_amdgcn_sched_barrier(0)
    Unit cur, nxt; int ui = 0;
    if (!S.next(0, cur)) return;
    f32x4 acc[2][2][4][2];
#pragma unroll
    for (int a = 0; a < 2; ++a)
#pragma unroll
        for (int b = 0; b < 2; ++b)
#pragma unroll
            for (int m = 0; m < 4; ++m)
#pragma unroll
                for (int n = 0; n < 2; ++n) acc[a][b][m][n] = (f32x4){0.f, 0.f, 0.f, 0.f};
    bf16x8 At[4][2], B0[2][2], B1[2][2];
    const char* cA = cur.a; const char* cB = cur.b;
    PG8_STAGE(PG8_SB(0, 0), cB, voffB); PG8_STAGE(PG8_SB(0, 1), cB + hstepB, voffB); PG8_STAGE(PG8_SA(0, 0), cA, voffA); PG8_STAGE(PG8_SA(0, 1), cA + hstepA, voffA);
    if (wr == 1) PG8_BAR;
    PG8_WAIT_V(2); PG8_BAR;
    PG8_STAGE(PG8_SB(1, 0), cB + kstepB, voffB); PG8_STAGE(PG8_SA(1, 0), cA + kstepA, voffA); PG8_STAGE(PG8_SB(1, 1), cB + hstepB + kstepB, voffB);
    PG8_WAIT_V(6); PG8_BAR;
    for (;;) {
        const bool has_next = S.next(ui + 1, nxt);
        const char* nA = has_next ? nxt.a : cA; const char* nB = has_next ? nxt.b : cB;
        for (int t = 0; t < nt; t += 2) {
            const bool last = (t == nt - 2);
            const char* a1 = cA + (size_t)(t + 1) * kstepA;
            const char* a2 = last ? nA : cA + (size_t)(t + 2) * kstepA; const char* b2 = last ? nB : cB + (size_t)(t + 2) * kstepB;
            const char* a3 = a2 + kstepA; const char* b3 = b2 + kstepB;
            PG8_LDB(B0, 0, 0); PG8_LDB(B1, 0, 1); PG8_SCHED; PG8_LDA(At, 0, 0); PG8_STAGE(PG8_SA(1, 1), a1 + hstepA, voffA);
            PG8_WAIT_V(8); PG8_WAIT_L(0); PG8_BAR; PG8_MMA(0, 0, At, B0); PG8_MMA(0, 1, At, B1); PG8_BAR; PG8_SCHED;
            PG8_LDA(At, 0, 1); PG8_STAGE(PG8_SB(0, 0), b2, voffB); PG8_STAGE(PG8_SB(0, 1), b2 + hstepB, voffB); PG8_STAGE(PG8_SA(0, 0), a2, voffA);
            PG8_WAIT_V(8); PG8_WAIT_L(0); PG8_BAR; PG8_MMA(1, 0, At, B0); PG8_MMA(1, 1, At, B1); PG8_BAR; PG8_SCHED;
            PG8_LDB(B0, 1, 0); PG8_LDB(B1, 1, 1); PG8_SCHED; PG8_LDA(At, 1, 0); PG8_STAGE(PG8_SA(0, 1), a2 + hstepA, voffA);
            PG8_WAIT_V(8); PG8_WAIT_L(0); PG8_BAR; PG8_MMA(0, 0, At, B0); PG8_MMA(0, 1, At, B1); PG8_BAR; PG8_SCHED;
            PG8_LDA(At, 1, 1); PG8_STAGE(PG8_SB(1, 0), b3, voffB); PG8_STAGE(PG8_SB(1, 1), b3 + hstepB, voffB); PG8_STAGE(PG8_SA(1, 0), a3, voffA);
            PG8_WAIT_V(8); PG8_WAIT_L(0); PG8_BAR; PG8_MMA(1, 0, At, B0); PG8_MMA(1, 1, At, B1); PG8_BAR; PG8_SCHED;
        }
        if (wr == 0) PG8_BAR;
        E(acc, cur, wr, wc, fr, fq, wid, lane);
        if (!has_next) break;
#pragma unroll
        for (int a = 0; a < 2; ++a)
#pragma unroll
            for (int b = 0; b < 2; ++b)
#pragma unroll
                for (int m = 0; m < 4; ++m)
#pragma unroll
                    for (int n = 0; n < 2; ++n) acc[a][b][m][n] = (f32x4){0.f, 0.f, 0.f, 0.f};
        cur = nxt; cA = nA; cB = nB; ++ui;
        if (wr == 1) PG8_BAR;
    }
    PG8_WAIT_V(0);
    PG8_BAR;
#undef PG8_SA
#undef PG8_SB
#undef PG8_STAGE
#undef PG8_LDA
#undef PG8_LDB
#undef PG8_MMA
#undef PG8_WAIT_V
#undef PG8_WAIT_L
#undef PG8_BAR
#undef PG8_SCHED
}
}

#define XB_TMO      128
#define XB_XCNT(j)  (256  + 64 * (j))
#define XB_XSUB(j)  (1280 + 64 * (j))
#define XB_XGEN(j)  (2304 + 64 * (j))
#define XB_TOP      3328
#define XB_TOPGEN   3392
#define XCD_BAR_WORDS 3456
#define XB_SPIN_CAP (1u << 20)
DI unsigned xb_ld(unsigned* p)              { return __hip_atomic_load(p, __ATOMIC_RELAXED, __HIP_MEMORY_SCOPE_AGENT); }
DI unsigned xb_add(unsigned* p, unsigned v) { return __hip_atomic_fetch_add(p, v, __ATOMIC_RELAXED, __HIP_MEMORY_SCOPE_AGENT); }
DI unsigned xb_xcc_id() { return (unsigned)__builtin_amdgcn_s_getreg((3 << 11) | 20) & 0xFu; }
#define XB_SPIN(cond, bar) do { unsigned _sp = 0; while (cond) { __builtin_amdgcn_s_sleep(1); \
    if ((++_sp & 255u) == 0u) { if (xb_ld(&(bar)[XB_TMO])) break; if (_sp > XB_SPIN_CAP) { atomicAdd(&(bar)[XB_TMO], 1u); break; } } } } while (0)
struct XcdBarrier { unsigned* bar; unsigned x; volatile LAS unsigned* st; };
DI XcdBarrier xcd_barrier_post(unsigned* bar, volatile LAS unsigned* st) {
    XcdBarrier b; b.bar = bar; b.x = xb_xcc_id(); b.st = st;
    if (threadIdx.x == 0) (void)xb_add(&bar[XB_XCNT(b.x)], 1u);
    return b;
}
DI void xcd_barrier_complete(unsigned* bar, unsigned x, unsigned& nloc, unsigned& nx) {
    const unsigned G = gridDim.x * gridDim.y * gridDim.z;
    unsigned sum, cnt, mine, sp = 0u;
    for (;;) {
        sum = 0u; cnt = 0u; mine = 0u;
#pragma unroll
        for (unsigned j = 0; j < 16; ++j) { const unsigned c = xb_ld(&bar[XB_XCNT(j)]); sum += c; cnt += (c > 0u) ? 1u : 0u; mine = (j == x) ? c : mine; }
        if (sum == G) break;
        __builtin_amdgcn_s_sleep(1);
        if ((++sp & 255u) == 0u) { if (xb_ld(&bar[XB_TMO])) break; if (sp > XB_SPIN_CAP) { atomicAdd(&bar[XB_TMO], 1u); break; } }
    }
    nloc = mine > 0u ? mine : 1u; nx = cnt > 0u ? cnt : 1u;
}
DI void xcd_barrier(const XcdBarrier& b) {
    asm volatile("s_waitcnt vmcnt(0)" ::: "memory");
    __syncthreads();
    if (threadIdx.x == 0) {
        unsigned* bar = b.bar;
        __builtin_amdgcn_s_waitcnt(0);
        unsigned nloc = b.st[0], nx = b.st[1];
        if (nloc == 0u) { xcd_barrier_complete(bar, b.x, nloc, nx); b.st[0] = nloc; b.st[1] = nx; }
        const unsigned old = xb_add(&bar[XB_XSUB(b.x)], 1u);
        const unsigned gen = old / nloc;
        if (old + 1u == (gen + 1u) * nloc) {
            __builtin_amdgcn_fence(__ATOMIC_RELEASE, "agent");
            asm volatile("s_waitcnt vmcnt(0)" ::: "memory");
            const unsigned og = xb_add(&bar[XB_TOP], 1u);
            const unsigned tg = og / nx;
            if (og + 1u == (tg + 1u) * nx) xb_add(&bar[XB_TOPGEN], 1u);
            else XB_SPIN(xb_ld(&bar[XB_TOPGEN]) == tg, bar);
            __builtin_amdgcn_fence(__ATOMIC_ACQUIRE, "agent");
            xb_add(&bar[XB_XGEN(b.x)], 1u);
            asm volatile("s_waitcnt vmcnt(0)" ::: "memory");
        } else {
            XB_SPIN(xb_ld(&bar[XB_XGEN(b.x)]) == gen, bar);
            __builtin_amdgcn_fence(__ATOMIC_ACQUIRE, "agent");
            asm volatile("s_waitcnt vmcnt(0)" ::: "memory");
        }
    }
    __syncthreads();
}

struct Ctx {
    LAS unsigned char* lds; unsigned char* ldsg;
    int tid, lane, wid, bid, G;
    unsigned char* ws; float* out;
};
DI bf16_t* wsb(const Ctx& c, size_t off) { return (bf16_t*)(c.ws + off); }
DI float* wsf(const Ctx& c, size_t off) { return (float*)(c.ws + off); }
DI float* ssbuf(const Ctx& c, int i) { return (float*)(c.ws + OFF_SS) + (size_t)i * MTOK * 16; }

DI int t5_bucket(int dist) {
    if (dist < 16) return dist;
    const float v = logf((float)dist / 16.f) / 4.852030263919617f * 16.f;
    int large = 16 + (int)v; return large < 31 ? large : 31;
}

DI Ctx fresh(const Ctx& c0) {
    Ctx c = c0; int tid = threadIdx.x; asm volatile("" : "+v"(tid)); c.tid = tid; c.lane = tid & 63; c.wid = __builtin_amdgcn_readfirstlane(tid >> 6);
    asm volatile("" : "+s"(c.ws)); asm volatile("" : "+s"(c.out)); return c;
}
DI void transpose_item(const float* W, int ldw, int scol0, int k0, const float* gain, bf16_t* WT, int K, int drow0, LAS float* scr, int lane, bool img = false) {
    {
        f32x4 v[8]; float gs[8];
#pragma unroll
        for (int i = 0; i < 8; ++i) { const int kk = 8 * i + (lane >> 3); v[i] = *(const f32x4*)(W + (size_t)(k0 + kk) * ldw + scol0 + (lane & 7) * 4); gs[i] = gain ? gain[k0 + kk] : 1.f; }
#pragma unroll
        for (int i = 0; i < 8; ++i) { const int kk = 8 * i + (lane >> 3); LAS float* d = scr + kk * 33 + (lane & 7) * 4; d[0] = v[i][0] * gs[i]; d[1] = v[i][1] * gs[i]; d[2] = v[i][2] * gs[i]; d[3] = v[i][3] * gs[i]; }
    }
    LDS_WAIT(); asm volatile("" ::: "memory");
    const int c = lane & 7;
#pragma unroll
    for (int j = 0; j < 4; ++j) { const int n = (lane >> 3) + 8 * j; const LAS float* s = scr + (8 * c) * 33 + n;
        u32x4 o; o.x = cvtpk(s[0 * 33], s[1 * 33]); o.y = cvtpk(s[2 * 33], s[3 * 33]); o.z = cvtpk(s[4 * 33], s[5 * 33]); o.w = cvtpk(s[6 * 33], s[7 * 33]);
        if (img) { const int ng = drow0 + n, nl = ng & 255, r = nl & 127, q = r & 31, rs = (r & ~31) + 16 * ((q >> 2) & 1) + 4 * (q >> 3) + (q & 3);
            const int kk0 = k0 + 8 * c;
            *(u32x4*)((unsigned char*)WT + ((size_t)((ng >> 8) * (K >> 6) + (kk0 >> 6)) * 2 + (nl >> 7)) * 16384 + pg8::lds_byte(rs, kk0 & 63)) = o; }
        else *(u32x4*)(WT + (size_t)(drow0 + n) * K + k0 + 8 * c) = o; }
    LDS_WAIT(); asm volatile("" ::: "memory");
}
DI void tjob(const float* W, int ldw, int scol0, const float* gain, bf16_t* WT, int K, int ncols, int item, LAS float* scr, int lane, bool img = false, int drow_base = 0) {
    const int nblk = ncols / 32, kb = item / nblk, nb = item % nblk;
    transpose_item(W, ldw, scol0 + 32 * nb, 64 * kb, gain, WT, K, drow_base + 32 * nb, scr, lane, img);
}
DI void tjob_gu(const float* Wg, const float* Wu, const float* gain, bf16_t* WT, int item, LAS float* scr, int lane) {
    const int nblk = 2 * FF / 32, kb = item / nblk, nb = item % nblk, n0 = 32 * nb, p = n0 >> 8, w = n0 & 255;
    transpose_item(w < 128 ? Wg : Wu, FF, 128 * p + (w & 127), 64 * kb, gain, WT, DM, n0, scr, lane, true);
}
DI void ph_prologue(const Params& p, const Ctx& c0) {
    const Ctx c = fresh(c0);
    LAS float* scr = (LAS float*)(c.lds + c.wid * 16384);
    const int gw = c.bid * 8 + c.wid, NGW = c.G * 8, lane = c.lane;
    constexpr int I_GU = 16 * (2 * FF / 32), I_D = (FF / 64) * 32, I_INA = 16 * 32, I_INB = 16 * 56, I_INC = 16, I_SQ = 16 * 32;
    constexpr int PER_LAYER = 2 * I_GU + 2 * I_D + I_INA + I_INB + I_INC + 5 * I_SQ;
    for (int it = gw; it < DEPTH * PER_LAYER; it += NGW) {
        const int l = it / PER_LAYER; int r = it % PER_LAYER;
        unsigned char* wl = c.ws + (size_t)l * W_LAYER;
        if (r < I_GU) { tjob_gu(p.in[I_F1G] + (size_t)l * DM * FF, p.in[I_F1U] + (size_t)l * DM * FF, p.in[I_F1N] + l * DM, (bf16_t*)(wl + W_GU1), r, scr, lane); continue; } r -= I_GU;
        if (r < I_D) { tjob(p.in[I_F1D] + (size_t)l * FF * DM, DM, 0, nullptr, (bf16_t*)(wl + W_D1), FF, DM, r, scr, lane, true); continue; } r -= I_D;
        if (r < I_INA) { tjob(p.in[I_WIN] + (size_t)l * DM * INW, INW, 0, p.in[I_MIXN] + l * DM, (bf16_t*)(wl + W_IN), DM, 1024, r, scr, lane, true, 0); continue; } r -= I_INA;
        if (r < I_INB) { tjob(p.in[I_WIN] + (size_t)l * DM * INW, INW, 1032, p.in[I_MIXN] + l * DM, (bf16_t*)(wl + W_IN), DM, 1792, r, scr, lane, true, 1024); continue; } r -= I_INB;
        if (r < I_INC) { tjob(p.in[I_WIN] + (size_t)l * DM * INW, INW, 1024, p.in[I_MIXN] + l * DM, (bf16_t*)(wl + W_IN), DM, 32, r, scr, lane, true, 2816); continue; } r -= I_INC;
        if (r < I_SQ) { tjob(p.in[I_WOUT] + (size_t)l * DM * DM, DM, 0, nullptr, (bf16_t*)(wl + W_OUT), DM, DM, r, scr, lane, true); continue; } r -= I_SQ;
        if (r < I_SQ) {
            const int kb = r >> 5, nb = r & 31; const int row = 64 * kb + lane; const float gsc = p.in[I_XN][l * DM + row];
            const f32x4* src = (const f32x4*)(p.in[I_XWQ] + (size_t)l * DM * DM + (size_t)row * DM + 32 * nb); u32x4* dst = (u32x4*)((bf16_t*)(wl + W_Q) + (size_t)row * DM + 32 * nb);
#pragma unroll
            for (int q4 = 0; q4 < 4; ++q4) { const f32x4 x0 = src[2 * q4] * gsc, x1 = src[2 * q4 + 1] * gsc; u32x4 w; w.x = cvtpk(x0[0], x0[1]); w.y = cvtpk(x0[2], x0[3]); w.z = cvtpk(x1[0], x1[1]); w.w = cvtpk(x1[2], x1[3]); dst[q4] = w; }
            continue; } r -= I_SQ;
        if (r < I_SQ) { tjob(p.in[I_XWO] + (size_t)l * DM * DM, DM, 0, nullptr, (bf16_t*)(wl + W_O), DM, DM, r, scr, lane); continue; } r -= I_SQ;
        if (r < I_GU) { tjob_gu(p.in[I_F2G] + (size_t)l * DM * FF, p.in[I_F2U] + (size_t)l * DM * FF, p.in[I_F2N] + l * DM, (bf16_t*)(wl + W_GU2), r, scr, lane); continue; } r -= I_GU;
        if (r < I_D) { tjob(p.in[I_F2D] + (size_t)l * FF * DM, DM, 0, nullptr, (bf16_t*)(wl + W_D2), FF, DM, r, scr, lane, true); continue; } r -= I_D;
        if (r < I_SQ) { tjob(p.in[I_XWKV] + (size_t)l * DM * 2 * DM, 2 * DM, 0, p.in[I_MEMN] + l * DM, wsb(c, OFF_WK) + (size_t)l * DM * DM, DM, DM, r, scr, lane); continue; } r -= I_SQ;
        tjob(p.in[I_XWKV] + (size_t)l * DM * 2 * DM, 2 * DM, DM, p.in[I_MEMN] + l * DM, wsb(c, OFF_WV) + (size_t)l * DM * DM, DM, DM, r, scr, lane);
    }
    for (int m = gw; m < MTOK + MMEM; m += NGW) {
        const bool isx = m < MTOK; const int row = isx ? m : m - MTOK;
        const f32x4* xr = (const f32x4*)((isx ? p.in[I_X] : p.in[I_MEM]) + (size_t)row * DM) + lane;
        unsigned long long* o8 = (unsigned long long*)(wsb(c, OFF_MEMB) + (size_t)row * DM) + lane; unsigned char* hbimg = (unsigned char*)wsb(c, OFF_HB);
        float s = 0.f;
#pragma unroll
        for (int j = 0; j < 4; ++j) { const f32x4 v = xr[64 * j]; s += (v[0] * v[0] + v[1] * v[1]) + (v[2] * v[2] + v[3] * v[3]);
            const unsigned long long pk = (unsigned long long)cvtpk(v[0], v[1]) | ((unsigned long long)cvtpk(v[2], v[3]) << 32);
            if (isx) *(unsigned long long*)(hbimg + pg8::img_off(row, 4 * (lane + 64 * j))) = pk; else o8[64 * j] = pk; }
        s = wave_sum(s);
        if (lane == 0) { if (isx) { f32x4* q = (f32x4*)(ssbuf(c, 0) + (size_t)row * 16); q[0] = (f32x4){s, 0.f, 0.f, 0.f}; q[1] = (f32x4){0.f, 0.f, 0.f, 0.f}; q[2] = q[1]; q[3] = q[1]; } else wsf(c, OFF_RSM)[row] = rsqrtf(s * (1.f / DM) + 1e-6f); }
    }
    for (int l = 0; l < DEPTH; ++l) { unsigned char* t11 = c.ws + (size_t)l * W_LAYER + W_IN + (size_t)11 * 16 * 32768;
        for (int i = c.bid * 512 + c.tid; i < 16 * 1792; i += c.G * 512) { const int kt = i / 1792, rem = i - kt * 1792; *(u32x4*)(t11 + (size_t)kt * 32768 + 4096 + (size_t)rem * 16) = (u32x4){0u, 0u, 0u, 0u}; } }
    const int gt = c.bid * 512 + c.tid, NGT = c.G * 512;
    const float* t5 = p.in[I_T5];
    for (int i = gt; i < 4 * 4096; i += NGT) { const int h = i >> 12, d = i & 4095; wsf(c, OFF_DIFFB)[i] = t5[t5_bucket(d) * 8 + 4 + h] * LOG2E; }
    for (int i = gt; i < 3 * 4 * 132; i += NGT) { const int pp = i / (4 * 132), h = (i / 132) & 3, dl = i % 132; const int dil = pp == 0 ? 1 : (pp == 1 ? 4 : 16);
        wsf(c, OFF_DILB)[i] = dl <= 128 ? t5[t5_bucket(dl * dil) * 8 + h] * LOG2E : 0.f; }
    if (gt < DEPTH) { const float* lv = p.in[I_LAMV] + gt * 128; float a = 0.f, b = 0.f; for (int i = 0; i < 32; ++i) { a += lv[i] * lv[32 + i]; b += lv[64 + i] * lv[96 + i]; }
        const float lam_init = 0.8f - 0.6f * expf(-0.3f * (float)gt); wsf(c, OFF_LAM)[gt] = expf(a) - expf(b) + lam_init; }
}

DI void ph_gates(const Params& p, const Ctx& c0, int l) {
    const Ctx c = fresh(c0);
    LAS float* wg = (LAS float*)c.lds;
    const float* win = p.in[I_WIN] + (size_t)l * DM * INW; const float* gn = p.in[I_MIXN] + l * DM;
    for (int i = c.tid; i < DM * 8; i += 512) { const int k = i >> 3, cc = i & 7; wg[i] = win[(size_t)k * INW + 1024 + cc] * gn[k]; }
    __syncthreads();
    const float* h = c.out; const float* ss = ssbuf(c, 4 * l + 1); float* gates = wsf(c, OFF_GATES);
    for (int row = c.bid * 8 + c.wid; row < MTOK; row += c.G * 8) {
        float a[8];
#pragma unroll
        for (int j = 0; j < 8; ++j) a[j] = 0.f;
        const f32x4* xr = (const f32x4*)(h + (size_t)row * DM) + c.lane;
#pragma unroll
        for (int j = 0; j < 4; ++j) { const f32x4 v = xr[64 * j]; const int k0 = 4 * c.lane + 256 * j;
#pragma unroll
            for (int e = 0; e < 4; ++e) { const f32x4 w0 = *(const LAS f32x4*)(wg + (k0 + e) * 8), w1 = *(const LAS f32x4*)(wg + (k0 + e) * 8 + 4);
                a[0] += v[e] * w0[0]; a[1] += v[e] * w0[1]; a[2] += v[e] * w0[2]; a[3] += v[e] * w0[3]; a[4] += v[e] * w1[0]; a[5] += v[e] * w1[1]; a[6] += v[e] * w1[2]; a[7] += v[e] * w1[3]; } }
#pragma unroll
        for (int j = 0; j < 8; ++j) a[j] = wave_sum(a[j]);
        if (c.lane == 0) { const float rs = rowss(ss, row);
            *(f32x4*)(gates + (size_t)row * 8) = (f32x4){a[0] * rs, a[1] * rs, a[2] * rs, a[3] * rs}; *(f32x4*)(gates + (size_t)row * 8 + 4) = (f32x4){a[4] * rs, a[5] * rs, a[6] * rs, a[7] * rs}; }
    }
    __syncthreads();
}

#define YIMG_STORE(c_, row_, col_, w_) (*(u32x2*)((unsigned char*)wsb((c_), OFF_Y) + pg8::img_off((int)(row_), (col_))) = (w_))
DI void osm_update(f32x16& s, float& m, float& l, f32x16 (&O)[2], bf16x8& p0, bf16x8& p1) {
    float mx = fmaxf(s[0], s[1]);
#pragma unroll
    for (int i = 2; i < 16; ++i) mx = fmaxf(mx, s[i]);
    mx = fmaxf(mx, __shfl_xor(mx, 32));
    const float mn = fmaxf(m, mx);
    if (__any(mn > m)) {
        const float al = ex2(m - mn); l *= al;
#pragma unroll
        for (int i = 0; i < 16; ++i) { O[0][i] *= al; O[1][i] *= al; }
        m = mn;
    }
    float sum = 0.f;
#pragma unroll
    for (int i = 0; i < 16; ++i) { s[i] = ex2(s[i] - m); sum += s[i]; }
    l += sum;
    p0 = pack8(s[0], s[1], s[2], s[3], s[4], s[5], s[6], s[7]);
    p1 = pack8(s[8], s[9], s[10], s[11], s[12], s[13], s[14], s[15]);
}

constexpr int DK_KP = 144, DK_VP = 136;
constexpr int DF_KOFF = 0, DF_VOFF = 2 * 64 * DK_KP, DF_TOFF = DF_VOFF + 2 * 64 * DK_VP;
DI void diff_attn_task(const Params& p, const Ctx& c, int l, int b, int h, int qb) {
    const int tid = c.tid, lane = c.lane, wid = c.wid, r32 = lane & 31, hi = lane >> 5;
    const bf16_t* z = wsb(c, OFF_Z);
    const size_t rowbase = (size_t)b * SEQ;
    LAS unsigned char* lds = c.lds;
    LAS float* tbl = (LAS float*)(lds + DF_TOFF);
    __syncthreads();
    { const float* src = wsf(c, OFF_DIFFB) + h * 4096; for (int i = tid; i < 4096; i += 512) tbl[i] = src[i]; }
    const int qw0 = qb * 256 + wid * 32, qpos = qw0 + r32;
    bf16x8 qf[4];
    { const bf16_t* qp = z + (rowbase + qpos) * ZW + ZQD + h * 64;
#pragma unroll
      for (int s = 0; s < 4; ++s) qf[s] = *(const bf16x8*)(qp + 16 * s + 8 * hi); }
    f32x16 O1[2], O2[2];
#pragma unroll
    for (int i = 0; i < 16; ++i) { O1[0][i] = 0.f; O1[1][i] = 0.f; O2[0][i] = 0.f; O2[1][i] = 0.f; }
    float m1 = NEGBIG, m2 = NEGBIG, l1 = 0.f, l2 = 0.f;
    const int NT = (qb + 1) * 4;
    const int skey = tid >> 3, schunk = tid & 7;
    const bf16_t* kbase = z + (rowbase + skey) * ZW + ZKD + h * 64 + schunk * 8;
    const bf16_t* vbase = z + (rowbase + skey) * ZW + ZVD + h * 64 + schunk * 8;
    u32x4 kreg = *(const u32x4*)kbase, vreg = *(const u32x4*)vbase;
#define DF_WRITE(buf) do { *(LAS u32x4*)(lds + DF_KOFF + (buf) * 64 * DK_KP + skey * DK_KP + schunk * 16) = kreg; \
        LAS bf16_t* vt_ = (LAS bf16_t*)(lds + DF_VOFF + (buf) * 64 * DK_VP + skey * 2); \
        vt_[(schunk * 8 + 0) * (DK_VP / 2)] = (bf16_t)(vreg.x & 0xffff); vt_[(schunk * 8 + 1) * (DK_VP / 2)] = (bf16_t)(vreg.x >> 16); \
        vt_[(schunk * 8 + 2) * (DK_VP / 2)] = (bf16_t)(vreg.y & 0xffff); vt_[(schunk * 8 + 3) * (DK_VP / 2)] = (bf16_t)(vreg.y >> 16); \
        vt_[(schunk * 8 + 4) * (DK_VP / 2)] = (bf16_t)(vreg.z & 0xffff); vt_[(schunk * 8 + 5) * (DK_VP / 2)] = (bf16_t)(vreg.z >> 16); \
        vt_[(schunk * 8 + 6) * (DK_VP / 2)] = (bf16_t)(vreg.w & 0xffff); vt_[(schunk * 8 + 7) * (DK_VP / 2)] = (bf16_t)(vreg.w >> 16); } while (0)
    DF_WRITE(0);
    __syncthreads();
    for (int t = 0; t < NT; ++t) {
        const int buf = t & 1;
        if (t + 1 < NT) { kreg = *(const u32x4*)(kbase + (size_t)(t + 1) * 64 * ZW); vreg = *(const u32x4*)(vbase + (size_t)(t + 1) * 64 * ZW); }
        if (64 * t <= qw0 + 31) {
            const LAS unsigned char* kimg = lds + DF_KOFF + buf * 64 * DK_KP;
            const LAS unsigned char* vimg = lds + DF_VOFF + buf * 64 * DK_VP;
#pragma unroll
            for (int sub = 0; sub < 2; ++sub) {
                const int key0 = 64 * t + 32 * sub;
                if (key0 <= qw0 + 31) {
                    const LAS unsigned char* kr = kimg + (32 * sub + r32) * DK_KP + hi * 16;
                    const bf16x8 k0 = *(const LAS bf16x8*)(kr), k1 = *(const LAS bf16x8*)(kr + 32), k2 = *(const LAS bf16x8*)(kr + 64), k3 = *(const LAS bf16x8*)(kr + 96);
                    f32x16 s1, s2, bv;
                    const int dbase = qpos - key0 - 4 * hi;
                    if (key0 + 31 > qw0) {
#pragma unroll
                        for (int i = 0; i < 16; ++i) { const int d = dbase - ((i & 3) + 8 * (i >> 2)); const float bi = tbl[d < 0 ? 0 : d]; bv[i] = d < 0 ? NEGBIG : bi; }
                    } else {
#pragma unroll
                        for (int i = 0; i < 16; ++i) bv[i] = tbl[dbase - ((i & 3) + 8 * (i >> 2))];
                    }
                    s1 = MFMA32(k0, qf[0], bv); s1 = MFMA32(k1, qf[1], s1);
                    s2 = MFMA32(k2, qf[2], bv); s2 = MFMA32(k3, qf[3], s2);
                    bf16x8 pa0, pa1, pb0, pb1;
                    osm_update(s1, m1, l1, O1, pa0, pa1);
                    osm_update(s2, m2, l2, O2, pb0, pb1);
#pragma unroll
                    for (int dvt = 0; dvt < 2; ++dvt) {
                        const LAS unsigned char* vr = vimg + (32 * dvt + r32) * DK_VP + (32 * sub + 4 * hi) * 2;
                        const bf16x8 v0 = mk8(*(const LAS u32x2*)(vr), *(const LAS u32x2*)(vr + 16));
                        const bf16x8 v1 = mk8(*(const LAS u32x2*)(vr + 32), *(const LAS u32x2*)(vr + 48));
                        O1[dvt] = MFMA32(v0, pa0, O1[dvt]); O1[dvt] = MFMA32(v1, pa1, O1[dvt]);
                        O2[dvt] = MFMA32(v0, pb0, O2[dvt]); O2[dvt] = MFMA32(v1, pb1, O2[dvt]);
                    }
                }
            }
        }
        if (t + 1 < NT) DF_WRITE(buf ^ 1);
        __syncthreads();
    }
#undef DF_WRITE
    l1 += __shfl_xor(l1, 32); l2 += __shfl_xor(l2, 32);
    const float lam = wsf(c, OFF_LAM)[l];
    const float lam_init = 0.8f - 0.6f * expf(-0.3f * (float)l);
    const float i1 = 1.f / l1, i2 = lam / l2;
    float ssq = 0.f;
#pragma unroll
    for (int dvt = 0; dvt < 2; ++dvt)
#pragma unroll
        for (int i = 0; i < 16; ++i) { const float o = O1[dvt][i] * i1 - O2[dvt][i] * i2; O1[dvt][i] = o; ssq += o * o; }
    ssq += __shfl_xor(ssq, 32);
    const float rn = rsqrtf(ssq * (1.f / 64.f) + 1e-5f) * (1.f - lam_init);
    const float* sg = p.in[I_SUBLN] + l * 64;
#pragma unroll
    for (int dvt = 0; dvt < 2; ++dvt)
#pragma unroll
        for (int g = 0; g < 4; ++g) {
            const int dv = 32 * dvt + 8 * g + 4 * hi; const f32x4 gg = *(const f32x4*)(sg + dv);
            u32x2 w; w.x = cvtpk(O1[dvt][4 * g] * rn * gg[0], O1[dvt][4 * g + 1] * rn * gg[1]); w.y = cvtpk(O1[dvt][4 * g + 2] * rn * gg[2], O1[dvt][4 * g + 3] * rn * gg[3]);
            YIMG_STORE(c, rowbase + qpos, 768 + h * 64 + dv, w);
        }
}

constexpr int DL_NK = 384, DL_KP = 144, DL_VP = 776;
constexpr int DL_KOFF = 0, DL_VOFF = DL_NK * DL_KP, DL_TOFF = DL_VOFF + 64 * DL_VP;
DI void dil_attn_task(const Params& p, const Ctx& c, int pat, int b, int h, int res, int mb) {
    const int dil = pat == 0 ? 1 : (pat == 1 ? 4 : 16);
    const int tid = c.tid, lane = c.lane, wid = c.wid, r32 = lane & 31, hi = lane >> 5;
    const bf16_t* z = wsb(c, OFF_Z);
    const size_t rowbase = (size_t)b * SEQ;
    LAS unsigned char* lds = c.lds;
    LAS float* tbl = (LAS float*)(lds + DL_TOFF);
    __syncthreads();
    if (tid < 132) tbl[tid] = wsf(c, OFF_DILB)[(pat * 4 + h) * 132 + tid];
    const int mk0 = 256 * mb - 128;
    {
        u32x4 kreg[6], vreg[6];
#pragma unroll
        for (int it = 0; it < 6; ++it) {
            const int idx = tid + 512 * it, key = idx >> 3, chunk = idx & 7, mk = mk0 + key;
            kreg[it] = (u32x4){0u, 0u, 0u, 0u}; vreg[it] = (u32x4){0u, 0u, 0u, 0u};
            if (mk >= 0) { const bf16_t* rp = z + (rowbase + (size_t)mk * dil + res) * ZW + h * 64 + chunk * 8; kreg[it] = *(const u32x4*)(rp + ZKC); vreg[it] = *(const u32x4*)(rp + ZVC); }
        }
#pragma unroll
        for (int it = 0; it < 6; ++it) {
            const int idx = tid + 512 * it, key = idx >> 3, chunk = idx & 7;
            *(LAS u32x4*)(lds + DL_KOFF + key * DL_KP + chunk * 16) = kreg[it];
            LAS bf16_t* vt_ = (LAS bf16_t*)(lds + DL_VOFF + key * 2);
            vt_[(chunk * 8 + 0) * (DL_VP / 2)] = (bf16_t)(vreg[it].x & 0xffff); vt_[(chunk * 8 + 1) * (DL_VP / 2)] = (bf16_t)(vreg[it].x >> 16);
            vt_[(chunk * 8 + 2) * (DL_VP / 2)] = (bf16_t)(vreg[it].y & 0xffff); vt_[(chunk * 8 + 3) * (DL_VP / 2)] = (bf16_t)(vreg[it].y >> 16);
            vt_[(chunk * 8 + 4) * (DL_VP / 2)] = (bf16_t)(vreg[it].z & 0xffff); vt_[(chunk * 8 + 5) * (DL_VP / 2)] = (bf16_t)(vreg[it].z >> 16);
            vt_[(chunk * 8 + 6) * (DL_VP / 2)] = (bf16_t)(vreg[it].w & 0xffff); vt_[(chunk * 8 + 7) * (DL_VP / 2)] = (bf16_t)(vreg[it].w >> 16);
        }
    }
    const int mq = 256 * mb + 32 * wid + r32;
    const size_t qtok = rowbase + (size_t)mq * dil + res;
    bf16x8 qf[4];
    { const bf16_t* qp = z + qtok * ZW + ZQC + h * 64;
#pragma unroll
      for (int s = 0; s < 4; ++s) qf[s] = *(const bf16x8*)(qp + 16 * s + 8 * hi); }
    __syncthreads();
    f32x16 O[2];
#pragma unroll
    for (int i = 0; i < 16; ++i) { O[0][i] = 0.f; O[1][i] = 0.f; }
    float m = NEGBIG, lsum = 0.f;
    for (int j = 0; j < 5; ++j) {
        const int kt = wid + j;
        const LAS unsigned char* kr = lds + DL_KOFF + (32 * kt + r32) * DL_KP + hi * 16;
        f32x16 s;
        const int dbase = 128 - 32 * j + r32 - 4 * hi;
        const int mkb = mk0 + 32 * kt + 4 * hi;
        if (j == 0 || j == 4 || mb == 0) {
#pragma unroll
            for (int i = 0; i < 16; ++i) { const int cc = (i & 3) + 8 * (i >> 2); const int dl = dbase - cc; const bool ok = (dl >= 0) && (dl <= 128) && (mkb + cc >= 0);
                const int dc = dl < 0 ? 0 : (dl > 128 ? 128 : dl); s[i] = ok ? tbl[dc] : NEGBIG; }
        } else {
#pragma unroll
            for (int i = 0; i < 16; ++i) s[i] = tbl[dbase - ((i & 3) + 8 * (i >> 2))];
        }
#pragma unroll
        for (int ks = 0; ks < 4; ++ks) s = MFMA32(*(const LAS bf16x8*)(kr + 32 * ks), qf[ks], s);
        bf16x8 p0, p1;
        osm_update(s, m, lsum, O, p0, p1);
#pragma unroll
        for (int dvt = 0; dvt < 2; ++dvt) {
            const LAS unsigned char* vr = lds + DL_VOFF + (32 * dvt + r32) * DL_VP + (32 * kt + 4 * hi) * 2;
            const bf16x8 v0 = mk8(*(const LAS u32x2*)(vr), *(const LAS u32x2*)(vr + 16));
            const bf16x8 v1 = mk8(*(const LAS u32x2*)(vr + 32), *(const LAS u32x2*)(vr + 48));
            O[dvt] = MFMA32(v0, p0, O[dvt]); O[dvt] = MFMA32(v1, p1, O[dvt]);
        }
    }
    lsum += __shfl_xor(lsum, 32);
    const float inv = 1.f / lsum, lse = m + log2f(lsum);
    if (pat != 0) {
        bf16_t* orow = ((bf16_t*)((unsigned char*)c.out + (size_t)64 * 64 * 4096 * 4)) + ((size_t)(pat - 1) * MTOK + qtok) * 256 + h * 64;
#pragma unroll
        for (int dvt = 0; dvt < 2; ++dvt)
#pragma unroll
            for (int g = 0; g < 4; ++g) { u32x2 w; w.x = cvtpk(O[dvt][4 * g] * inv, O[dvt][4 * g + 1] * inv); w.y = cvtpk(O[dvt][4 * g + 2] * inv, O[dvt][4 * g + 3] * inv);
                *(u32x2*)(orow + 32 * dvt + 8 * g + 4 * hi) = w; }
        if (hi == 0) wsf(c, OFF_LSEP)[((size_t)(pat - 1) * MTOK + qtok) * 4 + h] = lse;
    } else {
        const float ls1 = wsf(c, OFF_LSEP)[qtok * 4 + h], ls2 = wsf(c, OFF_LSEP)[((size_t)MTOK + qtok) * 4 + h];
        const float mm = fmaxf(lse, fmaxf(ls1, ls2));
        const float w0 = ex2(lse - mm), w1 = ex2(ls1 - mm), w2 = ex2(ls2 - mm), wi = 1.f / (w0 + w1 + w2);
        const float a0 = w0 * wi * inv, a1 = w1 * wi, a2 = w2 * wi;
        const bf16_t* o1 = ((bf16_t*)((unsigned char*)c.out + (size_t)64 * 64 * 4096 * 4)) + qtok * 256 + h * 64; const bf16_t* o2 = o1 + (size_t)MTOK * 256;
#pragma unroll
        for (int dvt = 0; dvt < 2; ++dvt)
#pragma unroll
            for (int g = 0; g < 4; ++g) { const int dv = 32 * dvt + 8 * g + 4 * hi; const u32x2 x1 = *(const u32x2*)(o1 + dv), x2 = *(const u32x2*)(o2 + dv);
                const float r0 = O[dvt][4 * g] * a0 + bflo(x1.x) * a1 + bflo(x2.x) * a2, r1 = O[dvt][4 * g + 1] * a0 + bfhi(x1.x) * a1 + bfhi(x2.x) * a2;
                const float r2 = O[dvt][4 * g + 2] * a0 + bflo(x1.y) * a1 + bflo(x2.y) * a2, r3 = O[dvt][4 * g + 3] * a0 + bfhi(x1.y) * a1 + bfhi(x2.y) * a2;
                u32x2 w; w.x = cvtpk(r0, r1); w.y = cvtpk(r2, r3); YIMG_STORE(c, qtok, 512 + h * 64 + dv, w); }
    }
}

DI void pool_x(const bf16_t* bp0, int w, int cnt, float icnt, bf16x8 (&xf)[4]) {
    float sum[4][8]; u32x4 cur[4];
#pragma unroll
    for (int ks = 0; ks < 4; ++ks) {
        const bf16_t* bp = bp0 + 16 * ks;
        cur[ks] = *(const u32x4*)bp; const u32x4 prv = (cnt > 1) ? *(const u32x4*)(bp - ZW) : (u32x4){0u, 0u, 0u, 0u};
        sum[ks][0] = bflo(cur[ks].x) + bflo(prv.x); sum[ks][1] = bfhi(cur[ks].x) + bfhi(prv.x); sum[ks][2] = bflo(cur[ks].y) + bflo(prv.y); sum[ks][3] = bfhi(cur[ks].y) + bfhi(prv.y);
        sum[ks][4] = bflo(cur[ks].z) + bflo(prv.z); sum[ks][5] = bfhi(cur[ks].z) + bfhi(prv.z); sum[ks][6] = bflo(cur[ks].w) + bflo(prv.w); sum[ks][7] = bfhi(cur[ks].w) + bfhi(prv.w);
    }
#pragma unroll 1
    for (int j0 = 2; j0 < w; j0 += 2) {
        u32x4 v0[4], v1[4];
#pragma unroll
        for (int ks = 0; ks < 4; ++ks) { v0[ks] = (u32x4){0u, 0u, 0u, 0u}; v1[ks] = (u32x4){0u, 0u, 0u, 0u};
            if (j0 < cnt) v0[ks] = *(const u32x4*)(bp0 + 16 * ks - (size_t)j0 * ZW);
            if (j0 + 1 < cnt) v1[ks] = *(const u32x4*)(bp0 + 16 * ks - (size_t)(j0 + 1) * ZW); }
#pragma unroll
        for (int ks = 0; ks < 4; ++ks) {
            sum[ks][0] += bflo(v0[ks].x) + bflo(v1[ks].x); sum[ks][1] += bfhi(v0[ks].x) + bfhi(v1[ks].x); sum[ks][2] += bflo(v0[ks].y) + bflo(v1[ks].y); sum[ks][3] += bfhi(v0[ks].y) + bfhi(v1[ks].y);
            sum[ks][4] += bflo(v0[ks].z) + bflo(v1[ks].z); sum[ks][5] += bfhi(v0[ks].z) + bfhi(v1[ks].z); sum[ks][6] += bflo(v0[ks].w) + bflo(v1[ks].w); sum[ks][7] += bfhi(v0[ks].w) + bfhi(v1[ks].w); }
    }
#pragma unroll
    for (int ks = 0; ks < 4; ++ks)
        xf[ks] = pack8(sum[ks][0] * icnt - bflo(cur[ks].x), sum[ks][1] * icnt - bfhi(cur[ks].x), sum[ks][2] * icnt - bflo(cur[ks].y), sum[ks][3] * icnt - bfhi(cur[ks].y),
                       sum[ks][4] * icnt - bflo(cur[ks].z), sum[ks][5] * icnt - bfhi(cur[ks].z), sum[ks][6] * icnt - bflo(cur[ks].w), sum[ks][7] * icnt - bfhi(cur[ks].w));
}
DI void pool_task(const Params& p, const Ctx& c, int l, int wt) {
    const int lane = c.lane, r32 = lane & 31, hi = lane >> 5;
    const int g = (wt + (wt >> 11)) & 3, rt = wt >> 2;
    const size_t row = (size_t)rt * 32 + r32; const int t = (int)(row & (SEQ - 1));
    const int w = 2 << g, cnt = (t + 1 < w) ? t + 1 : w; const float icnt = 1.f / (float)cnt;
    const bf16_t* z = wsb(c, OFF_Z);
    bf16x8 xf[4];
    const bf16_t* bp0 = z + row * ZW + ZPB + g * 64 + 8 * hi;
    pool_x(bp0, w, cnt, icnt, xf);
    const float* pw = p.in[I_POOLW] + ((size_t)l * 4 + g) * 64 * 64;
    const float* psc = p.in[I_POOLS] + l * 256 + g * 64;
#pragma unroll 1
    for (int dt = 0; dt < 2; ++dt) {
        f32x16 acc;
#pragma unroll
        for (int i = 0; i < 16; ++i) acc[i] = 0.f;
#pragma unroll
        for (int ks = 0; ks < 4; ++ks) {
            const float* wp = pw + (size_t)(16 * ks + 8 * hi) * 64 + 32 * dt + r32;
            const bf16x8 wf = pack8(wp[0], wp[64], wp[128], wp[192], wp[256], wp[320], wp[384], wp[448]);
            acc = MFMA32(wf, xf[ks], acc);
        }
#pragma unroll
        for (int gq = 0; gq < 4; ++gq) { const int dd = 32 * dt + 8 * gq + 4 * hi; const f32x4 sc = *(const f32x4*)(psc + dd);
            u32x2 wv; wv.x = cvtpk(acc[4 * gq] * sc[0], acc[4 * gq + 1] * sc[1]); wv.y = cvtpk(acc[4 * gq + 2] * sc[2], acc[4 * gq + 3] * sc[3]); YIMG_STORE(c, row, 256 + g * 64 + dd, wv); }
    }
}

DI float scan_add(float v, int lane) {
#pragma unroll
    for (int o = 1; o < 64; o <<= 1) { const float n = __shfl_up(v, o); if (lane >= o) v += n; }
    return v;
}
DI float scan_max(float v, int lane) {
#pragma unroll
    for (int o = 1; o < 64; o <<= 1) { const float n = __shfl_up(v, o); if (lane >= o) v = fmaxf(v, n); }
    return v;
}
DI float log_sigmoid(float x) { return fminf(x, 0.f) - log1pf(expf(-fabsf(x))); }
DI void conv8(const bf16_t* zp, int t, const float* cw, const float* cb, float scale, float (&o)[8]) {
    const f32x4 b0 = *(const f32x4*)cb, b1 = *(const f32x4*)(cb + 4);
    o[0] = b0[0]; o[1] = b0[1]; o[2] = b0[2]; o[3] = b0[3]; o[4] = b1[0]; o[5] = b1[1]; o[6] = b1[2]; o[7] = b1[3];
#pragma unroll
    for (int tap = 0; tap < 4; ++tap) {
        if (t - 3 + tap >= 0) {
            const u32x4 v = *(const u32x4*)(zp - (size_t)(3 - tap) * ZW);
            const f32x4 w0 = *(const f32x4*)(cw + tap * 512), w1 = *(const f32x4*)(cw + tap * 512 + 4);
            o[0] += bflo(v.x) * w0[0]; o[1] += bfhi(v.x) * w0[1]; o[2] += bflo(v.y) * w0[2]; o[3] += bfhi(v.y) * w0[3];
            o[4] += bflo(v.z) * w1[0]; o[5] += bfhi(v.z) * w1[1]; o[6] += bflo(v.w) * w1[2]; o[7] += bfhi(v.w) * w1[3];
        }
    }
#pragma unroll
    for (int e = 0; e < 8; ++e) o[e] = silu_f(o[e]) * scale;
    asm volatile("" ::: "memory");
}
DI void conv_frag4(const bf16_t* zp, int t, const LAS float* cw, const LAS float* cb, int hi, float scale, bf16x8 (&out)[4]) {
    asm volatile("" ::: "memory");
#pragma unroll
    for (int kh = 0; kh < 2; ++kh) {
        u32x4 v[2][4];
#pragma unroll
        for (int k2 = 0; k2 < 2; ++k2)
#pragma unroll
            for (int tap = 0; tap < 4; ++tap) { v[k2][tap] = (u32x4){0u, 0u, 0u, 0u}; if (t - 3 + tap >= 0) v[k2][tap] = *(const u32x4*)(zp + 16 * (2 * kh + k2) - (size_t)(3 - tap) * ZW); }
#pragma unroll
        for (int k2 = 0; k2 < 2; ++k2) {
            const int ks = 2 * kh + k2, d0 = 16 * ks + 8 * hi;
            const f32x4 b0 = *(const LAS f32x4*)(cb + d0), b1 = *(const LAS f32x4*)(cb + d0 + 4);
            float o[8] = {b0[0], b0[1], b0[2], b0[3], b1[0], b1[1], b1[2], b1[3]};
#pragma unroll
            for (int tap = 0; tap < 4; ++tap) {
                const f32x4 w0 = *(const LAS f32x4*)(cw + tap * 64 + d0), w1 = *(const LAS f32x4*)(cw + tap * 64 + d0 + 4); const u32x4 x = v[k2][tap];
                o[0] += bflo(x.x) * w0[0]; o[1] += bfhi(x.x) * w0[1]; o[2] += bflo(x.y) * w0[2]; o[3] += bfhi(x.y) * w0[3];
                o[4] += bflo(x.z) * w1[0]; o[5] += bfhi(x.z) * w1[1]; o[6] += bflo(x.w) * w1[2]; o[7] += bfhi(x.w) * w1[3];
            }
            out[ks] = pack8(silu_f(o[0]) * scale, silu_f(o[1]) * scale, silu_f(o[2]) * scale, silu_f(o[3]) * scale, silu_f(o[4]) * scale, silu_f(o[5]) * scale, silu_f(o[6]) * scale, silu_f(o[7]) * scale);
        }
        asm volatile("" ::: "memory");
    }
}
DI void mlstm_a_task(const Params& p, const Ctx& c, int l, int task) {
    const int lane = c.lane, r32 = lane & 31, hi = lane >> 5;
    const int bh = task >> 6, ch = task & 63, b = bh >> 2, h = bh & 3, t0 = ch * 64;
    const size_t rowbase = (size_t)b * SEQ;
    const bf16_t* z = wsb(c, OFF_Z);
    const float* gates = wsf(c, OFF_GATES) + (rowbase + t0 + lane) * 8;
    const float* gb = p.in[I_GATEB] + l * 8;
    const float ig = gates[h] + gb[h], lf = log_sigmoid(gates[4 + h] + gb[4 + h]);
    const float bcs = scan_add(lf, lane);
    const float gp = ig - bcs;
    const float mu = wave_max(gp);
    const float ws_ = expf(gp - mu);
    const float Bc = __shfl(bcs, 63);
    if (lane == 0) { wsf(c, OFF_SCAL)[task] = Bc; wsf(c, OFF_SCAL)[4096 + task] = mu; }
    const float* cwl = p.in[I_CONVW] + (size_t)l * 4 * 512; const float* cbl = p.in[I_CONVB] + l * 512;
    f32x16 acc[2][2];
#pragma unroll
    for (int a = 0; a < 2; ++a)
#pragma unroll
        for (int bb = 0; bb < 2; ++bb)
#pragma unroll
            for (int i = 0; i < 16; ++i) acc[a][bb][i] = 0.f;
    float nsum[2] = {0.f, 0.f};
#pragma unroll
    for (int ks = 0; ks < 4; ++ks) {
        const int s0 = 16 * ks + 8 * hi;
        float wv[8];
#pragma unroll
        for (int j = 0; j < 8; ++j) wv[j] = __shfl(ws_, s0 + j);
        bf16x8 kf[2];
#pragma unroll
        for (int it = 0; it < 2; ++it) {
            const int chn = 256 + h * 64 + 32 * it + r32;
            const float w0 = cwl[chn], w1 = cwl[512 + chn], w2 = cwl[1024 + chn], w3 = cwl[1536 + chn], cb = cbl[chn];
            const bf16_t* kp = z + (rowbase + t0 + s0) * ZW + ZKA + h * 64 + 32 * it + r32;
            float raw[11];
#pragma unroll
            for (int x = 0; x < 11; ++x) raw[x] = (t0 + s0 - 3 + x >= 0) ? bf2f(kp[(long)(x - 3) * ZW]) : 0.f;
            float kk[8];
#pragma unroll
            for (int j = 0; j < 8; ++j) { const float o = cb + w0 * raw[j] + w1 * raw[j + 1] + w2 * raw[j + 2] + w3 * raw[j + 3]; kk[j] = silu_f(o) * 0.125f * wv[j]; nsum[it] += kk[j]; }
            kf[it] = pack8(kk[0], kk[1], kk[2], kk[3], kk[4], kk[5], kk[6], kk[7]);
        }
#pragma unroll
        for (int et = 0; et < 2; ++et) {
            const bf16_t* vp = z + (rowbase + t0 + s0) * ZW + ZVA + h * 64 + 32 * et + r32;
            u32x4 w; w.x = (unsigned)vp[0] | ((unsigned)vp[ZW] << 16); w.y = (unsigned)vp[2 * ZW] | ((unsigned)vp[3 * ZW] << 16);
            w.z = (unsigned)vp[4 * ZW] | ((unsigned)vp[5 * ZW] << 16); w.w = (unsigned)vp[6 * ZW] | ((unsigned)vp[7 * ZW] << 16);
            const bf16x8 vf = __builtin_bit_cast(bf16x8, w);
            acc[et][0] = MFMA32(vf, kf[0], acc[et][0]); acc[et][1] = MFMA32(vf, kf[1], acc[et][1]);
        }
    }
    float* D = ((float*)c.out) + (size_t)task * 4096;
#pragma unroll
    for (int et = 0; et < 2; ++et)
#pragma unroll
        for (int it = 0; it < 2; ++it)
#pragma unroll
            for (int i = 0; i < 16; ++i) D[(32 * et + crow(i, hi)) * 64 + 32 * it + r32] = acc[et][it][i];
    nsum[0] += __shfl_xor(nsum[0], 32); nsum[1] += __shfl_xor(nsum[1], 32);
    if (hi == 0) { wsf(c, OFF_NST)[(size_t)task * 64 + r32] = nsum[0]; wsf(c, OFF_NST)[(size_t)task * 64 + 32 + r32] = nsum[1]; }
}
DI void mlstm_scan(const Params& p, const Ctx& c) {
    const float* Bc = wsf(c, OFF_SCAL); const float* mu = Bc + 4096; float* mprev = wsf(c, OFF_SCAL) + 8192;
    float* D = ((float*)c.out); float* N = wsf(c, OFF_NST);
    LAS float* cwl = (LAS float*)c.lds; LAS float* swl = cwl + 64;
    for (int task = c.bid; task < 256; task += c.G) {
        const int bh = task >> 2, q = task & 3;
        __syncthreads();
        if (c.wid == 0) {
            const float B = Bc[bh * 64 + c.lane], u = mu[bh * 64 + c.lane];
            float m = 0.f, mycw = 0.f, mysw = 0.f, mymp = 0.f;
            for (int ch = 0; ch < 64; ++ch) {
                const float Bs = __shfl(B, ch), us = __shfl(u, ch);
                const float mnew = fmaxf(Bs + m, Bs + us);
                const float cw = expf(Bs + m - mnew), sw = expf(Bs + us - mnew);
                if (c.lane == ch) { mycw = cw; mysw = sw; mymp = m; }
                m = mnew;
            }
            cwl[c.lane] = mycw; swl[c.lane] = mysw;
            if (q == 0) mprev[bh * 64 + c.lane] = mymp;
        }
        __syncthreads();
        for (int idx = q * 1040 + c.tid; idx < (q + 1) * 1040; idx += 512) {
            float* base = idx < 4096 ? D + (size_t)bh * 64 * 4096 + idx : N + (size_t)bh * 64 * 64 + (idx - 4096);
            const size_t stride = idx < 4096 ? 4096 : 64;
            float d[64];
#pragma unroll
            for (int ch = 0; ch < 64; ++ch) d[ch] = base[(size_t)ch * stride];
            float C = 0.f;
#pragma unroll
            for (int ch = 0; ch < 64; ++ch) { const float dv = d[ch]; base[(size_t)ch * stride] = C; C = cwl[ch] * C + swl[ch] * dv; }
        }
    }
}
DI void mlstm_c_task(const Params& p, const Ctx& c, int l, int task) {
    const int lane = c.lane, r32 = lane & 31, hi = lane >> 5;
    const int bh = task >> 6, ch = task & 63, b = bh >> 2, h = bh & 3, t0 = ch * 64;
    const size_t rowbase = (size_t)b * SEQ;
    const bf16_t* z = wsb(c, OFF_Z);
    const float* gates = wsf(c, OFF_GATES) + (rowbase + t0 + lane) * 8;
    const float* gb = p.in[I_GATEB] + l * 8;
    const float ig = gates[h] + gb[h], lf = log_sigmoid(gates[4 + h] + gb[4 + h]);
    const float bcs = scan_add(lf, lane);
    const float gp = ig - bcs;
    const float mp = wsf(c, OFF_SCAL)[8192 + task];
    const float pm = scan_max(gp, lane);
    const float mt = bcs + fmaxf(mp, pm);
    const float bm = bcs - mt;
    const float iw = expf(bcs + mp - mt);
    const float flo = expf(-mt);
    const float* cwl = p.in[I_CONVW] + (size_t)l * 4 * 512; const float* cbl = p.in[I_CONVB] + l * 512;
    const float* Ct = ((float*)c.out) + (size_t)task * 4096;
    const float* nst = wsf(c, OFF_NST) + (size_t)task * 64;
    const float* ng = p.in[I_MLN] + l * 256 + h * 64;
#pragma unroll 1
    for (int tt = 0; tt < 2; ++tt) {
        const int tq = 32 * tt + r32;
        const float bm_t = __shfl(bm, tq), iw_t = __shfl(iw, tq), flo_t = __shfl(flo, tq);
        bf16x8 qf[4]; float qn = 0.f;
#pragma unroll
        for (int ks = 0; ks < 4; ++ks) { float o[8]; const int d0 = 16 * ks + 8 * hi;
            conv8(z + (rowbase + t0 + tq) * ZW + ZQA + h * 64 + d0, t0 + tq, cwl + h * 64 + d0, cbl + h * 64 + d0, 1.f, o);
            qf[ks] = pack8(o[0], o[1], o[2], o[3], o[4], o[5], o[6], o[7]);
            const u32x4 qw = __builtin_bit_cast(u32x4, qf[ks]);
            const f32x4 n0 = *(const f32x4*)(nst + d0), n1 = *(const f32x4*)(nst + d0 + 4);
            qn += bflo(qw.x) * n0[0] + bfhi(qw.x) * n0[1] + bflo(qw.y) * n0[2] + bfhi(qw.y) * n0[3] + bflo(qw.z) * n1[0] + bfhi(qw.z) * n1[1] + bflo(qw.w) * n1[2] + bfhi(qw.w) * n1[3]; }
        qn += __shfl_xor(qn, 32);
        f32x16 num[2];
#pragma unroll
        for (int i = 0; i < 16; ++i) { num[0][i] = 0.f; num[1][i] = 0.f; }
#pragma unroll
        for (int et = 0; et < 2; ++et)
#pragma unroll
            for (int ks = 0; ks < 4; ++ks) { const float* cp = Ct + (size_t)(32 * et + r32) * 64 + 16 * ks + 8 * hi; const f32x4 c0 = *(const f32x4*)cp, c1 = *(const f32x4*)(cp + 4);
                num[et] = MFMA32(pack8(c0[0], c0[1], c0[2], c0[3], c1[0], c1[1], c1[2], c1[3]), qf[ks], num[et]); }
#pragma unroll
        for (int i = 0; i < 16; ++i) { num[0][i] *= iw_t; num[1][i] *= iw_t; }
        float dsum = 0.f;
#pragma unroll 1
        for (int st = 0; st <= tt; ++st) {
            f32x16 s;
#pragma unroll
            for (int i = 0; i < 16; ++i) s[i] = 0.f;
#pragma unroll
            for (int ks = 0; ks < 4; ++ks) { float o[8]; const int sk = 32 * st + r32, d0 = 16 * ks + 8 * hi;
                conv8(z + (rowbase + t0 + sk) * ZW + ZKA + h * 64 + d0, t0 + sk, cwl + 256 + h * 64 + d0, cbl + 256 + h * 64 + d0, 0.125f, o);
                s = MFMA32(pack8(o[0], o[1], o[2], o[3], o[4], o[5], o[6], o[7]), qf[ks], s); }
#pragma unroll
            for (int i = 0; i < 16; ++i) { const int sp = 32 * st + crow(i, hi); const float gs = __shfl(gp, sp);
                const float wgt = (sp <= tq) ? expf(gs + bm_t) : 0.f; s[i] *= wgt; dsum += s[i]; }
            const bf16x8 p0 = pack8(s[0], s[1], s[2], s[3], s[4], s[5], s[6], s[7]), p1 = pack8(s[8], s[9], s[10], s[11], s[12], s[13], s[14], s[15]);
#pragma unroll
            for (int et = 0; et < 2; ++et)
#pragma unroll
                for (int k2 = 0; k2 < 2; ++k2) {
                    const bf16_t* vp = z + (rowbase + t0 + 32 * st + 16 * k2 + 4 * hi) * ZW + ZVA + h * 64 + 32 * et + r32;
                    u32x4 w; w.x = (unsigned)vp[0] | ((unsigned)vp[ZW] << 16); w.y = (unsigned)vp[2 * ZW] | ((unsigned)vp[3 * ZW] << 16);
                    w.z = (unsigned)vp[8 * ZW] | ((unsigned)vp[9 * ZW] << 16); w.w = (unsigned)vp[10 * ZW] | ((unsigned)vp[11 * ZW] << 16);
                    num[et] = MFMA32(__builtin_bit_cast(bf16x8, w), k2 == 0 ? p0 : p1, num[et]);
                }
        }
        dsum += __shfl_xor(dsum, 32);
        const float den = iw_t * qn + dsum;
        const float idn = 1.f / fmaxf(fabsf(den), flo_t);
        float sm = 0.f;
#pragma unroll
        for (int et = 0; et < 2; ++et)
#pragma unroll
            for (int i = 0; i < 16; ++i) { const float hv = num[et][i] * idn; num[et][i] = hv; sm += hv; }
        sm += __shfl_xor(sm, 32);
        const float mean = sm * (1.f / 64.f);
        float vs = 0.f;
#pragma unroll
        for (int et = 0; et < 2; ++et)
#pragma unroll
            for (int i = 0; i < 16; ++i) { const float d = num[et][i] - mean; num[et][i] = d; vs += d * d; }
        vs += __shfl_xor(vs, 32);
        const float rstd = rsqrtf(vs * (1.f / 64.f) + 1e-6f);
        const size_t tok = rowbase + t0 + tq;
        const bf16_t* orow = z + tok * ZW + ZOA + h * 64;
#pragma unroll
        for (int et = 0; et < 2; ++et)
#pragma unroll
            for (int g = 0; g < 4; ++g) { const int e = 32 * et + 8 * g + 4 * hi; const f32x4 gg = *(const f32x4*)(ng + e); const u32x2 ov = *(const u32x2*)(orow + e);
                const float y0 = num[et][4 * g] * rstd * gg[0] * sigmoid_f(bflo(ov.x)), y1 = num[et][4 * g + 1] * rstd * gg[1] * sigmoid_f(bfhi(ov.x));
                const float y2 = num[et][4 * g + 2] * rstd * gg[2] * sigmoid_f(bflo(ov.y)), y3 = num[et][4 * g + 3] * rstd * gg[3] * sigmoid_f(bfhi(ov.y));
                u32x2 w; w.x = cvtpk(y0, y1); w.y = cvtpk(y2, y3); YIMG_STORE(c, tok, h * 64 + e, w); }
    }
}

DI void ph_mix1(const Params& p, const Ctx& c0, int l) {
    const Ctx c = fresh(c0);
    REP(R_DIFF) for (int pt = c.bid; pt < 512; pt += c.G) { const int bh = pt >> 3, s = pt & 7; diff_attn_task(p, c, l, bh >> 2, bh & 3, 15 - s); diff_attn_task(p, c, l, bh >> 2, bh & 3, s); }
    REP(R_DIL) for (int i = c.bid; i < 1024; i += c.G) { const int bh = i >> 4, rest = i & 15; dil_attn_task(p, c, 1, bh >> 2, bh & 3, rest >> 2, rest & 3); }
    REP(R_DIL) for (int i = c.bid; i < 1024; i += c.G) { const int bh = i >> 4; dil_attn_task(p, c, 2, bh >> 2, bh & 3, i & 15, 0); }
    __syncthreads();
    REP(R_POOL) for (int wt = c.bid * 8 + c.wid; wt < 8192; wt += c.G * 8) pool_task(p, c, l, wt);
    REP(R_MLA) for (int tk = c.bid * 8 + c.wid; tk < 4096; tk += c.G * 8) mlstm_a_task(p, c, l, tk);
}
DI void ph_mix2(const Params& p, const Ctx& c0, int l) {
    const Ctx c = fresh(c0);
    mlstm_scan(p, c);
    REP(R_DIL) for (int i = c.bid; i < 1024; i += c.G) { const int bh = i >> 4; dil_attn_task(p, c, 0, bh >> 2, bh & 3, 0, i & 15); }
    __syncthreads();
}
DI void ph_mix3(const Params& p, const Ctx& c0, int l) {
    const Ctx c = fresh(c0);
    REP(R_MLC) for (int tk = c.bid * 8 + c.wid; tk < 4096; tk += c.G * 8) mlstm_c_task(p, c, l, tk);
}
DI void ph_final(const Params& p, const Ctx& c0) {
    const Ctx c = fresh(c0);
    const float* ss = ssbuf(c, 16); const float* g = p.in[I_FINN]; const bf16_t* hb = wsb(c, OFF_HB);
    for (int row = c.bid * 8 + c.wid; row < MTOK; row += c.G * 8) {
        const float rs = rowss(ss, row);
        f32x4* xr = (f32x4*)(c.out + (size_t)row * DM) + c.lane; const f32x4* gr = (const f32x4*)g + c.lane; const unsigned char* hbimg = (const unsigned char*)hb;
#pragma unroll
        for (int j = 0; j < 4; ++j) { const u32x2 hv = *(const u32x2*)(hbimg + pg8::img_off(row, 4 * (c.lane + 64 * j))); const f32x4 gg = gr[64 * j];
            xr[64 * j] = (f32x4){bflo(hv.x) * rs * gg[0], bfhi(hv.x) * rs * gg[1], bflo(hv.y) * rs * gg[2], bfhi(hv.y) * rs * gg[3]}; }
    }
}

DI void ph_ffn_up(const Params& p, const Ctx& c0, int l, int which) {
    const Ctx c = fresh(c0);
    pg8::Gemm g = pg8::plain_gemm(wsb(c, OFF_HB), (const bf16_t*)(c.ws + (size_t)l * W_LAYER + (which ? W_GU2 : W_GU1)), MTOK, 2 * FF, DM); g.ocol_step = 128; pg8::use_img_b(g); pg8::use_img_a(g);
    pg8::Order S; S.init(g, c.G, c.bid);
    pg8::EpiSwiGLU E{wsb(c, OFF_Z), FF, ssbuf(c, 4 * l + (which ? 3 : 0))};
    pg8::gemm_phase(c.lds, g, S, E);
}
DI void ph_resid(const Params& p, const Ctx& c0, const bf16_t* A, const bf16_t* Bt, int K, int ss_out, float alpha) {
    const Ctx c = fresh(c0);
    pg8::Gemm g = pg8::plain_gemm(A, Bt, MTOK, DM, K);
    pg8::use_img_a(g); pg8::use_img_b(g); if (K == FF) g.a_pmdiv = (long)(FF / 64) * 256 * 64;
    pg8::Order S; S.init(g, c.G, c.bid);
    pg8::EpiResid E{wsb(c, OFF_HB), ssbuf(c, ss_out), alpha};
    pg8::gemm_phase(c.lds, g, S, E);
}
DI void ph_kv(const Params& p, const Ctx& c0) {
    const Ctx c = fresh(c0);
    { pg8::Gemm g = pg8::plain_gemm(wsb(c, OFF_MEMB), wsb(c, OFF_WK), MMEM, 4096, DM); pg8::Order S; S.init(g, c.G, c.bid);
      pg8::EpiBf16 E{wsb(c, OFF_KB), 4096, nullptr, wsf(c, OFF_RSM), nullptr, 1.f, 0}; pg8::gemm_phase(c.lds, g, S, E); }
    { pg8::Gemm g = pg8::plain_gemm(wsb(c, OFF_MEMB), wsb(c, OFF_WV), MMEM, 4096, DM); pg8::Order S; S.init(g, c.G, c.bid);
      pg8::EpiBf16 E{wsb(c, OFF_VT), 4096, nullptr, wsf(c, OFF_RSM), nullptr, 1.f, 0}; pg8::gemm_phase(c.lds, g, S, E); }
}
DI void ph_win(const Params& p, const Ctx& c0, int l) {
    const Ctx c = fresh(c0);
    pg8::Gemm g = pg8::plain_gemm(wsb(c, OFF_HB), (const bf16_t*)(c.ws + (size_t)l * W_LAYER + W_IN), MTOK, 3072, DM); pg8::use_img_b(g); pg8::use_img_a(g);
    pg8::Order S; S.init(g, c.G, c.bid);
    pg8::EpiZ E{wsb(c, OFF_Z), wsf(c, OFF_GATES), ssbuf(c, 4 * l + 1)};
    pg8::gemm_phase(c.lds, g, S, E);
}
constexpr size_t OFF_MT = OFF_Z, OFF_VWT = OFF_Z + (size_t)16384 * DM * 2;
DI void ph_xpre(const Params& p, const Ctx& c0, int l) {
    const Ctx c = fresh(c0);
    const unsigned char* wl = c.ws + (size_t)l * W_LAYER;
    { pg8::Gemm g; g.A = wsb(c, OFF_KB) + l * 1024; g.B = (const bf16_t*)(wl + W_Q); g.lda = 4096; g.ldb = DM; g.K = 256; g.nM = 64; g.nN = 4;
      g.div = 4; g.a_pmdiv = 256L * 4096; g.a_pmmod = 256; g.a_pn = 0; g.b_pmdiv = 0; g.b_pmmod = 256; g.b_pn = 256L * DM; g.ocol_step = 256; g.kstepA = 128; g.kstepB = 128; g.imgA = 0; g.imgB = 0;
      pg8::Order S; S.init(g, c.G, c.bid);
      pg8::EpiBf16 E{wsb(c, OFF_MT), DM, nullptr, nullptr, nullptr, 1.f, 0}; pg8::gemm_phase(c.lds, g, S, E); }
    { pg8::Gemm g; g.A = (const bf16_t*)(wl + W_O); g.B = wsb(c, OFF_VT) + l * 1024; g.lda = DM; g.ldb = 4096; g.K = 256; g.nM = 64; g.nN = 4;
      g.div = 4; g.a_pmdiv = 0; g.a_pmmod = 256L * DM; g.a_pn = 256; g.b_pmdiv = 256L * 4096; g.b_pmmod = 0; g.b_pn = 256; g.ocol_step = 256; g.kstepA = 128; g.kstepB = 128; g.imgA = 0; g.imgB = 0;
      pg8::Order S; S.init(g, c.G, c.bid);
      pg8::EpiBf16 E{wsb(c, OFF_VWT), DM, nullptr, nullptr, nullptr, 1.f, 0}; pg8::gemm_phase(c.lds, g, S, E); }
}
DI void ph_xs(const Params& p, const Ctx& c0, int l) {
    const Ctx c = fresh(c0);
    pg8::Gemm g; g.A = wsb(c, OFF_HB); g.B = wsb(c, OFF_MT); g.lda = DM; g.ldb = DM; g.K = DM; g.nM = MTOK / 256; g.nN = 4;
    g.div = 16; g.a_pmdiv = 16L * 256 * DM; g.a_pmmod = 256L * DM; g.a_pn = 0; g.b_pmdiv = 4L * 256 * DM; g.b_pmmod = 0; g.b_pn = 256L * DM; g.ocol_step = 256; g.kstepA = 128; g.kstepB = 128; g.imgA = 0; g.imgB = 0; pg8::use_img_a(g);
    pg8::Order S; S.init(g, c.G, c.bid);
    pg8::EpiSoftmax E{wsb(c, OFF_Y), DM, (LAS float*)(c.lds + LDS_EXTRA), ssbuf(c, 4 * l + 2), 0.0625f * LOG2E};
    pg8::gemm_phase(c.lds, g, S, E);
}
DI void ph_xo(const Params& p, const Ctx& c0, int l) {
    const Ctx c = fresh(c0);
    pg8::Gemm g; g.A = wsb(c, OFF_Y); g.B = wsb(c, OFF_VWT); g.lda = DM; g.ldb = DM; g.K = DM; g.nM = MTOK / 256; g.nN = 4;
    g.div = 16; g.a_pmdiv = 16L * 256 * DM; g.a_pmmod = 256L * DM; g.a_pn = 0; g.b_pmdiv = 1024L * DM; g.b_pmmod = 0; g.b_pn = 256L * DM; g.ocol_step = 256; g.kstepA = 128; g.kstepB = 128; g.imgA = 0; g.imgB = 0; pg8::use_img_a(g);
    pg8::Order S; S.init(g, c.G, c.bid);
    pg8::EpiResid E{wsb(c, OFF_HB), ssbuf(c, 4 * l + 3), 1.f};
    pg8::gemm_phase(c.lds, g, S, E);
}

constexpr int PH_PER_LAYER = 11, PH_FINAL = 1 + PH_PER_LAYER * DEPTH, PH_TOTAL = PH_FINAL + 1;
__global__ void __launch_bounds__(512, 2) mega_fwd(Params pk) {
    extern __shared__ __attribute__((aligned(16))) unsigned char lds_raw[];
    volatile LAS unsigned* bst = (volatile LAS unsigned*)((LAS unsigned char*)lds_raw + LDS_EXTRA + 12288);
    XcdBarrier xbar; xbar.bar = (unsigned*)(pk.ws + OFF_CTL); xbar.x = 0; xbar.st = bst;
    if (pk.coop) { if (threadIdx.x < 4) bst[threadIdx.x] = 0u; __syncthreads(); xbar = xcd_barrier_post((unsigned*)(pk.ws + OFF_CTL), bst); }
    for (int ph = pk.ph_lo; ph < pk.ph_hi; ++ph) {
        int tid = threadIdx.x; asm volatile("" : "+v"(tid));
        const Params& p = pk;
        Ctx c; c.lds = (LAS unsigned char*)lds_raw; c.ldsg = lds_raw; c.tid = tid; c.lane = tid & 63; c.wid = __builtin_amdgcn_readfirstlane(tid >> 6);
        c.bid = blockIdx.x; c.G = gridDim.x; c.ws = pk.ws; c.out = pk.out;
        asm volatile("" : "+s"(c.ws)); asm volatile("" : "+s"(c.out));
        if (ph == 0) {
#ifndef NO_PRO
            REP(R_PRO) ph_prologue(p, c);
#endif
        }
        else if (ph == PH_FINAL) ph_final(p, c);
        else {
            const int l = (ph - 1) / PH_PER_LAYER, j = (ph - 1) % PH_PER_LAYER;
            const unsigned char* wl = c.ws + (size_t)l * W_LAYER;
#ifdef ONLY_CASE
            if (j != ONLY_CASE) continue;
#endif
            switch (j) {
                case 0: REP(R_UP) ph_ffn_up(p, c, l, 0); if (l == 0) ph_kv(p, c); break;
                case 1: ph_resid(p, c, wsb(c, OFF_Z), (const bf16_t*)(wl + W_D1), FF, 4 * l + 1, 0.5f); break;
                case 2: ph_win(p, c, l); break;
                case 3:
#ifndef NO_MIX1
                    ph_mix1(p, c, l);
#endif
                    break;
                case 4:
#ifndef NO_MIX2
                    ph_mix2(p, c, l);
#endif
                    break;
                case 5:
#ifndef NO_MIX3
                    ph_mix3(p, c, l);
#endif
                    break;
                case 6: ph_resid(p, c, wsb(c, OFF_Y), (const bf16_t*)(wl + W_OUT), DM, 4 * l + 2, 1.f); ph_xpre(p, c, l); break;
                case 7: ph_xs(p, c, l); break;
                case 8: ph_xo(p, c, l); break;
                case 9: ph_ffn_up(p, c, l, 1); break;
                default: ph_resid(p, c, wsb(c, OFF_Z), (const bf16_t*)(wl + W_D2), FF, 4 * l + 4, 0.5f); break;
            }
        }
        if (ph + 1 < pk.ph_hi && pk.coop) { if (ph == pk.ph_lo) cg::this_grid().sync(); else xcd_barrier(xbar); }
    }
}

extern "C" void kernel_launch(void* const* d_in, const int* in_sizes, int n_in, void* d_out, int out_size, void* d_ws, size_t ws_size, hipStream_t stream) {
    static int grid = 0;
    if (grid == 0) {
        if (n_in != 28 || out_size != MTOK * DM || ws_size < OFF_END) { fprintf(stderr, "kernel_launch: unexpected shapes (n_in %d out %d ws %zu)\n", n_in, out_size, ws_size); grid = -1; return; }
        int dev = 0, cus = 0, per_cu = 0;
        (void)hipGetDevice(&dev); (void)hipDeviceGetAttribute(&cus, hipDeviceAttributeMultiprocessorCount, dev);
        if (hipFuncSetAttribute((const void*)mega_fwd, hipFuncAttributeMaxDynamicSharedMemorySize, LDS_BYTES) != hipSuccess) { fprintf(stderr, "kernel_launch: hipFuncSetAttribute failed\n"); grid = -1; return; }
        if (hipOccupancyMaxActiveBlocksPerMultiprocessor(&per_cu, (const void*)mega_fwd, 512, LDS_BYTES) != hipSuccess || per_cu < 1) { fprintf(stderr, "kernel_launch: occupancy query says %d\n", per_cu); per_cu = 1; }
        (void)hipGetLastError();
        grid = cus * per_cu;
    }
    if (grid < 0) return;
    Params p{};
    for (int i = 0; i < 28; ++i) p.in[i] = (const float*)d_in[i];
    p.out = (float*)d_out; p.ws = (unsigned char*)d_ws; p.pad = 0;
    (void)hipMemsetAsync((unsigned char*)d_ws + OFF_CTL, 0, CTL_BYTES, stream);
#if MK_MULTI
    for (int ph = 0; ph < PH_TOTAL; ++ph) { p.ph_lo = ph; p.ph_hi = ph + 1; p.coop = 0; hipLaunchKernelGGL(mega_fwd, dim3(grid), dim3(512), LDS_BYTES, stream, p); }
#else
    p.ph_lo = 0; p.ph_hi = PH_TOTAL; p.coop = 1;
    void* args[] = {&p};
    hipError_t e = hipLaunchCooperativeKernel((const void*)mega_fwd, dim3(grid), dim3(512), args, LDS_BYTES, stream);
    if (e != hipSuccess) fprintf(stderr, "cooperative launch failed: %s (grid %d)\n", hipGetErrorString(e), grid);
#endif
}
```

```cpp
#include <hip/hip_runtime.h>
#include <hip/hip_cooperative_groups.h>
#include <cstdio>
#include <cstdint>
namespace cg = cooperative_groups;

#ifndef MK_MULTI
#define MK_MULTI 0
#endif

#ifndef R_DIFF
#define R_DIFF 1
#endif
#ifndef R_DIL
#define R_DIL 1
#endif
#ifndef R_POOL
#define R_POOL 1
#endif
#ifndef R_MLA
#define R_MLA 1
#endif
#ifndef R_MLC
#define R_MLC 1
#endif
#ifndef R_UP
#define R_UP 1
#endif
#ifndef R_WIN
#define R_WIN 1
#endif
#ifndef R_GATES
#define R_GATES 1
#endif
#ifndef R_PRO
#define R_PRO 1
#endif
#ifndef R_RES1
#define R_RES1 1
#endif
#ifndef R_RES6
#define R_RES6 1
#endif
#ifndef R_WQ
#define R_WQ 1
#endif
#define REP(n) for (int rep_ = 0; rep_ < (n); ++rep_)
#define DI __device__ __forceinline__
#define LAS __attribute__((address_space(3)))
typedef unsigned short bf16_t;
typedef short bf16x8 __attribute__((ext_vector_type(8)));
typedef float f32x4 __attribute__((ext_vector_type(4)));
typedef float f32x16 __attribute__((ext_vector_type(16)));
typedef unsigned u32x4 __attribute__((ext_vector_type(4)));
typedef unsigned u32x2 __attribute__((ext_vector_type(2)));
typedef float f32x2_t __attribute__((ext_vector_type(2)));
typedef __bf16 bf16x2_t __attribute__((ext_vector_type(2)));

constexpr int DM = 1024, NB = 16, SEQ = 4096, MTOK = NB * SEQ, DEPTH = 4, MEMLEN = 256, MMEM = NB * MEMLEN, FF = 2816, ZW = 2816, INW = 2824;
constexpr int ZQA = 0, ZKA = 256, ZVA = 512, ZOA = 768, ZPB = 1024, ZQC = 1280, ZKC = 1536, ZVC = 1792, ZQD = 2048, ZKD = 2304, ZVD = 2560;
constexpr float LOG2E = 1.4426950408889634f;
constexpr float NEGBIG = -1e30f;

constexpr size_t W_GU1 = 0, W_D1 = W_GU1 + (size_t)2 * FF * DM * 2, W_IN = W_D1 + (size_t)DM * FF * 2, W_OUT = W_IN + (size_t)3072 * DM * 2,
                 W_Q = W_OUT + (size_t)DM * DM * 2, W_O = W_Q + (size_t)DM * DM * 2, W_GU2 = W_O + (size_t)DM * DM * 2, W_D2 = W_GU2 + (size_t)2 * FF * DM * 2,
                 W_LAYER = W_D2 + (size_t)DM * FF * 2;
constexpr size_t OFF_WK = DEPTH * W_LAYER, OFF_WV = OFF_WK + (size_t)DEPTH * DM * DM * 2, OFF_HB = OFF_WV + (size_t)DEPTH * DM * DM * 2;
constexpr size_t OFF_DST = OFF_HB;
constexpr size_t OFF_OPART = OFF_HB + (size_t)64 * 64 * 4096 * 4;
constexpr size_t OFF_Z = OFF_HB + (size_t)MTOK * DM * 2;
constexpr size_t OFF_Y = OFF_Z + (size_t)MTOK * ZW * 2;
constexpr size_t OFF_KB = OFF_Y + (size_t)MTOK * DM * 2;
constexpr size_t OFF_VT = OFF_KB + (size_t)MMEM * 4096 * 2;
constexpr size_t OFF_MEMB = OFF_VT + (size_t)4096 * MMEM * 2;
constexpr size_t OFF_GATES = OFF_MEMB + (size_t)MMEM * DM * 2;
constexpr size_t OFF_SS = OFF_GATES + (size_t)MTOK * 8 * 4;
constexpr size_t OFF_LSEP = OFF_SS + (size_t)17 * MTOK * 16 * 4;
constexpr size_t OFF_NST = OFF_LSEP + (size_t)2 * MTOK * 4 * 4;
constexpr size_t OFF_SCAL = OFF_NST + (size_t)4096 * 64 * 4;
constexpr size_t OFF_DIFFB = OFF_SCAL + 65536;
constexpr size_t OFF_DILB = OFF_DIFFB + 65536;
constexpr size_t OFF_LAM = OFF_DILB + 8192;
constexpr size_t OFF_RSM = OFF_LAM + 256;
constexpr size_t OFF_CTL = OFF_RSM + 16384;
constexpr size_t CTL_BYTES = 16384;
constexpr size_t OFF_END = OFF_CTL + CTL_BYTES;
static_assert(OFF_OPART + (size_t)2 * MTOK * 256 * 2 <= OFF_Z, "alias map");
static_assert(OFF_END < (size_t)1073741824, "workspace");

constexpr int LDS_BYTES = 147456;
constexpr int LDS_EXTRA = 131072;

struct Params {
    const float* in[28];
    float* out;
    unsigned char* ws;
    int ph_lo, ph_hi, coop, pad;
};
enum { I_X = 0, I_MEM, I_T5, I_F1N, I_F1G, I_F1U, I_F1D, I_MIXN, I_WIN, I_CONVW, I_CONVB, I_GATEB, I_MLN, I_POOLW, I_POOLS, I_LAMV, I_SUBLN, I_WOUT,
       I_XN, I_MEMN, I_XWQ, I_XWKV, I_XWO, I_F2N, I_F2G, I_F2U, I_F2D, I_FINN };

DI unsigned cvtpk(float lo, float hi) { f32x2_t v = {lo, hi}; bf16x2_t b = __builtin_convertvector(v, bf16x2_t); return __builtin_bit_cast(unsigned, b); }
DI float bflo(unsigned w) { return __uint_as_float(w << 16); }
DI float bfhi(unsigned w) { return __uint_as_float(w & 0xffff0000u); }
DI float bf2f(bf16_t x) { return __uint_as_float((unsigned)x << 16); }
DI float ex2(float x) { return __builtin_amdgcn_exp2f(x); }
DI float rcpf_(float x) { return __builtin_amdgcn_rcpf(x); }
DI int crow(int i, int hi) { return (i & 3) + 8 * (i >> 2) + 4 * hi; }
DI float wave_sum(float v) {
#pragma unroll
    for (int o = 1; o < 64; o <<= 1) v += __shfl_xor(v, o);
    return v;
}
DI float wave_max(float v) {
#pragma unroll
    for (int o = 1; o < 64; o <<= 1) v = fmaxf(v, __shfl_xor(v, o));
    return v;
}
DI float silu_f(float g) { return g * rcpf_(1.f + ex2(-g * LOG2E)); }
DI float sigmoid_f(float g) { return rcpf_(1.f + ex2(-g * LOG2E)); }
#define LDS_WAIT() asm volatile("s_waitcnt lgkmcnt(0)" ::: "memory")
DI bf16x8 mk8(u32x2 lo, u32x2 hi) { u32x4 w = {lo.x, lo.y, hi.x, hi.y}; return __builtin_bit_cast(bf16x8, w); }
DI bf16x8 pack8(float a0, float a1, float a2, float a3, float a4, float a5, float a6, float a7) {
    u32x4 w = {cvtpk(a0, a1), cvtpk(a2, a3), cvtpk(a4, a5), cvtpk(a6, a7)}; return __builtin_bit_cast(bf16x8, w);
}
DI float rowss(const float* ss, int row) {
    const f32x4* q = (const f32x4*)(ss + (size_t)row * 16); const f32x4 a = q[0], b = q[1], c = q[2], d = q[3];
    const float t = ((a[0] + a[1]) + (a[2] + a[3])) + ((b[0] + b[1]) + (b[2] + b[3])) + ((c[0] + c[1]) + (c[2] + c[3])) + ((d[0] + d[1]) + (d[2] + d[3]));
    return rsqrtf(t * (1.f / 1024.f) + 1e-6f);
}
#define MFMA32(a, b, c) __builtin_amdgcn_mfma_f32_32x32x16_bf16((a), (b), (c), 0, 0, 0)

namespace pg8 {
constexpr int BM = 256, BK = 64, HALF = 128, HTB = HALF * BK * 2, STAGE_BYTES = 8 * HTB, NXCD = 8, WGM = 8;
DI int lds_byte(int r, int c) { const int st = (r >> 4) * 2 + (c >> 5), rr = r & 15, cc = c & 31, ob = rr * 64 + cc * 2; return st * 1024 + (ob ^ (((ob >> 9) & 1) << 5)); }
DI void stage_rc(int b, int& R, int& C) { const int st = b / 1024, sb = b % 1024, swz = sb ^ (((sb >> 9) & 1) << 5); R = (st >> 1) * 16 + swz / 64; C = (st & 1) * 32 + (swz % 64) / 2; }
DI int perm32(int rho) { const int n = rho >> 4, i = rho & 15; return 8 * (i >> 2) + 4 * n + (i & 3); }

DI size_t img_off(int row, int col) { return ((size_t)((row >> 8) * (DM / 64) + (col >> 6)) * 2 + ((row >> 7) & 1)) * 16384 + lds_byte(row & 127, col & 63); }
struct Unit { const char* a; const char* b; int orow, ocol, pm, pn; };
struct Gemm {
    const bf16_t* A; const bf16_t* B; int lda, ldb, K, nM, nN; long a_pmdiv, a_pmmod, a_pn, b_pmdiv, b_pmmod, b_pn; int div, ocol_step; int kstepA, kstepB;
    int imgB;
    int imgA;
};
DI Gemm plain_gemm(const bf16_t* A, const bf16_t* B, int Mrows, int N, int K) {
    Gemm g; g.A = A; g.B = B; g.lda = K; g.ldb = K; g.K = K; g.nM = Mrows / BM; g.nN = N / BM; g.a_pmdiv = (long)BM * K; g.a_pmmod = 0; g.a_pn = 0; g.b_pmdiv = 0; g.b_pmmod = 0; g.b_pn = (long)BM * K;
    g.div = 1; g.ocol_step = BM; g.kstepA = BK * 2; g.kstepB = BK * 2; g.imgA = 0; g.imgB = 0; return g;
}
DI void use_img_a(Gemm& g) { g.imgA = 1; g.lda = 64; g.kstepA = 256 * 64 * 2; }
DI void use_img_b(Gemm& g) { g.imgB = 1; g.ldb = 64; g.kstepB = 256 * 64 * 2; g.b_pn = (long)(g.K / 64) * 256 * 64; }
struct Order {
    Gemm g; int nwg, G, c;
    DI void init(const Gemm& g_, int G_, int c_) { g = g_; nwg = g.nM * g.nN; G = G_; c = c_; }
    DI bool next(int i, Unit& u) const {
        const long L = (long)i * G + c; if (L >= nwg) return false;
        int wgid = (int)L; { const int q = nwg / NXCD, r = nwg % NXCD, xcd = wgid % NXCD, off = wgid / NXCD; wgid = (xcd < r ? xcd * (q + 1) : r * (q + 1) + (xcd - r) * q) + off; }
        const int nN = g.nN, nM = g.nM, nig = WGM * nN, gid = wgid / nig, fm = gid * WGM, gsz = (nM - fm) < WGM ? (nM - fm) : WGM;
        const int pm = fm + ((wgid % nig) % gsz), pn = (wgid % nig) / gsz;
        u.pm = pm; u.pn = pn; u.orow = pm * BM; u.ocol = pn * g.ocol_step;
        const int pq = pm / g.div, pr = pm - pq * g.div;
        u.a = (const char*)(g.A + (long)pq * g.a_pmdiv + (long)pr * g.a_pmmod + (long)pn * g.a_pn);
        u.b = (const char*)(g.B + (long)pq * g.b_pmdiv + (long)pr * g.b_pmmod + (long)pn * g.b_pn);
        return true;
    }
};

struct EpiBf16 {
    static constexpr bool PERM = true;
    bf16_t* O; int ldc; const float* ss; const float* rowscale; const float* colscale; float scale; int zspecial;
    DI void operator()(f32x4 (&acc)[2][2][4][2], const Unit& u, int wr, int wc, int fr, int fq, int wid, int lane) const {
        const int row0 = u.orow + wr * 64 + fr, col0 = u.ocol + wc * 32 + 8 * fq;
        float sc = scale;
        if (zspecial) { if (u.pn == 5) sc *= 0.125f * LOG2E; else if (u.pn == 8) sc *= 0.17677669529663687f * LOG2E; }
        if (colscale) {
#pragma unroll
            for (int bj = 0; bj < 2; ++bj)
#pragma unroll
                for (int n = 0; n < 2; ++n) { const f32x4 cs = *(const f32x4*)(colscale + col0 + bj * HALF + 4 * n);
#pragma unroll
                    for (int ai = 0; ai < 2; ++ai)
#pragma unroll
                        for (int m = 0; m < 4; ++m) acc[ai][bj][m][n] *= cs; }
            asm volatile("" ::: "memory");
        }
#pragma unroll
        for (int ai = 0; ai < 2; ++ai)
#pragma unroll
            for (int m = 0; m < 4; ++m) {
                const int row = row0 + ai * HALF + m * 16;
                float rs = sc;
                if (ss) rs *= rowss(ss, row);
                if (rowscale) rs *= rowscale[row];
                bf16_t* rowp = O + (size_t)row * ldc + col0;
#pragma unroll
                for (int bj = 0; bj < 2; ++bj) {
                    const f32x4 v0 = acc[ai][bj][m][0] * rs, v1 = acc[ai][bj][m][1] * rs;
                    u32x4 w; w.x = cvtpk(v0[0], v0[1]); w.y = cvtpk(v0[2], v0[3]); w.z = cvtpk(v1[0], v1[1]); w.w = cvtpk(v1[2], v1[3]);
                    *(u32x4*)(rowp + bj * HALF) = w;
                }
                asm volatile("" ::: "memory");
            }
    }
};
struct EpiZ {
    static constexpr bool PERM = true;
    bf16_t* O; float* gates; const float* ss;
    DI void operator()(f32x4 (&acc)[2][2][4][2], const Unit& u, int wr, int wc, int fr, int fq, int wid, int lane) const {
        const int row0 = u.orow + wr * 64 + fr, col0 = u.ocol + wc * 32 + 8 * fq;
        if (u.pn == 11) {
            if (wc == 0 && fq == 0) {
#pragma unroll
                for (int ai = 0; ai < 2; ++ai)
#pragma unroll
                    for (int m = 0; m < 4; ++m) { const int row = row0 + ai * HALF + m * 16; const float rs = rowss(ss, row);
                        *(f32x4*)(gates + (size_t)row * 8) = acc[ai][0][m][0] * rs; *(f32x4*)(gates + (size_t)row * 8 + 4) = acc[ai][0][m][1] * rs; }
            }
            return;
        }
        float sc = 1.f;
        if (u.pn == 5) sc = 0.125f * LOG2E; else if (u.pn == 8) sc = 0.17677669529663687f * LOG2E;
#pragma unroll
        for (int ai = 0; ai < 2; ++ai)
#pragma unroll
            for (int m = 0; m < 4; ++m) {
                const int row = row0 + ai * HALF + m * 16;
                const float rs = sc * rowss(ss, row);
                const int zc0 = col0;
#pragma unroll
                for (int bj = 0; bj < 2; ++bj) {
                    const f32x4 v0 = acc[ai][bj][m][0] * rs, v1 = acc[ai][bj][m][1] * rs;
                    u32x4 w; w.x = cvtpk(v0[0], v0[1]); w.y = cvtpk(v0[2], v0[3]); w.z = cvtpk(v1[0], v1[1]); w.w = cvtpk(v1[2], v1[3]);
                    { const int zc = zc0 + bj * HALF; *(u32x4*)(O + ((size_t)(zc >> 6) * MTOK + (size_t)row) * 64 + (zc & 63)) = w; }
                }
                asm volatile("" ::: "memory");
            }
    }
};
struct EpiSwiGLU {
    static constexpr bool PERM = true;
    bf16_t* O; int ldc; const float* ss;
    DI void operator()(f32x4 (&acc)[2][2][4][2], const Unit& u, int wr, int wc, int fr, int fq, int wid, int lane) const {
        const int row0 = u.orow + wr * 64 + fr, col0 = u.ocol + wc * 32 + 8 * fq;
#pragma unroll
        for (int ai = 0; ai < 2; ++ai)
#pragma unroll
            for (int m = 0; m < 4; ++m) {
                const int row = row0 + ai * HALF + m * 16;
                const float rs = rowss(ss, row);
                float o[8];
#pragma unroll
                for (int n = 0; n < 2; ++n)
#pragma unroll
                    for (int j = 0; j < 4; ++j) { const float g = acc[ai][0][m][n][j] * rs, up = acc[ai][1][m][n][j] * rs; o[4 * n + j] = silu_f(g) * up; }
                u32x4 w; w.x = cvtpk(o[0], o[1]); w.y = cvtpk(o[2], o[3]); w.z = cvtpk(o[4], o[5]); w.w = cvtpk(o[6], o[7]);
                __builtin_nontemporal_store(w, (u32x4*)((unsigned char*)O + ((size_t)(u.pm * (FF / 64) + (col0 >> 6)) * 2 + ((row >> 7) & 1)) * 16384 + lds_byte(row & 127, col0 & 63)));
                asm volatile("" ::: "memory");
            }
    }
};
struct EpiResid {
    static constexpr bool PERM = true;
    bf16_t* hb; float* ssout; float alpha;
    DI void operator()(f32x4 (&acc)[2][2][4][2], const Unit& u, int wr, int wc, int fr, int fq, int wid, int lane) const {
        const int row0 = u.orow + wr * 64 + fr, col0 = u.ocol + wc * 32 + 8 * fq;
#pragma unroll
        for (int ai = 0; ai < 2; ++ai) {
            u32x4 r[4][2];
#pragma unroll
            for (int m = 0; m < 4; ++m) {
#pragma unroll
                for (int bj = 0; bj < 2; ++bj) r[m][bj] = *(const u32x4*)((const unsigned char*)hb + img_off(row0 + ai * HALF + m * 16, col0 + bj * HALF)); }
#pragma unroll
            for (int m = 0; m < 4; ++m) {
                const int row = row0 + ai * HALF + m * 16; float ssq = 0.f;
#pragma unroll
                for (int bj = 0; bj < 2; ++bj) {
                    const u32x4 rr = r[m][bj]; const f32x4 a0 = acc[ai][bj][m][0] * alpha, a1 = acc[ai][bj][m][1] * alpha;
                    u32x4 w; w.x = cvtpk(bflo(rr.x) + a0[0], bfhi(rr.x) + a0[1]); w.y = cvtpk(bflo(rr.y) + a0[2], bfhi(rr.y) + a0[3]);
                    w.z = cvtpk(bflo(rr.z) + a1[0], bfhi(rr.z) + a1[1]); w.w = cvtpk(bflo(rr.w) + a1[2], bfhi(rr.w) + a1[3]);
                    *(u32x4*)((unsigned char*)hb + img_off(row, col0 + bj * HALF)) = w;
                    const float v0 = bflo(w.x), v1 = bfhi(w.x), v2 = bflo(w.y), v3 = bfhi(w.y), v4 = bflo(w.z), v5 = bfhi(w.z), v6 = bflo(w.w), v7 = bfhi(w.w);
                    ssq += ((v0 * v0 + v1 * v1) + (v2 * v2 + v3 * v3)) + ((v4 * v4 + v5 * v5) + (v6 * v6 + v7 * v7));
                }
                ssq += __shfl_xor(ssq, 16); ssq += __shfl_xor(ssq, 32);
                if (fq == 0) ssout[(size_t)row * 16 + u.pn * 4 + wc] = ssq;
            }
            asm volatile("" ::: "memory");
        }
    }
};
struct EpiSoftmax {
    static constexpr bool PERM = true;
    bf16_t* O; int ldc; LAS float* red; const float* ss; float scale;
    DI void operator()(f32x4 (&acc)[2][2][4][2], const Unit& u, int wr, int wc, int fr, int fq, int wid, int lane) const {
        float mloc[2][4];
#pragma unroll
        for (int ai = 0; ai < 2; ++ai)
#pragma unroll
            for (int m = 0; m < 4; ++m) {
                float mx = NEGBIG;
                const float rsc = rowss(ss, u.orow + ai * HALF + wr * 64 + m * 16 + fr) * scale;
#pragma unroll
                for (int bj = 0; bj < 2; ++bj)
#pragma unroll
                    for (int n = 0; n < 2; ++n) { const f32x4 x = acc[ai][bj][m][n] * rsc; acc[ai][bj][m][n] = x; mx = fmaxf(mx, fmaxf(fmaxf(x[0], x[1]), fmaxf(x[2], x[3]))); }
                mx = fmaxf(mx, __shfl_xor(mx, 16)); mx = fmaxf(mx, __shfl_xor(mx, 32));
                float sm = 0.f;
#pragma unroll
                for (int bj = 0; bj < 2; ++bj)
#pragma unroll
                    for (int n = 0; n < 2; ++n) { f32x4 x = acc[ai][bj][m][n]; x[0] = ex2(x[0] - mx); x[1] = ex2(x[1] - mx); x[2] = ex2(x[2] - mx); x[3] = ex2(x[3] - mx);
                        acc[ai][bj][m][n] = x; sm += (x[0] + x[1]) + (x[2] + x[3]); }
                sm += __shfl_xor(sm, 16); sm += __shfl_xor(sm, 32);
                mloc[ai][m] = mx;
                const int rl = ai * HALF + wr * 64 + m * 16 + fr;
                if (fq == 0) { red[(rl * 4 + wc) * 2] = mx; red[(rl * 4 + wc) * 2 + 1] = sm; }
            }
        asm volatile("s_waitcnt lgkmcnt(0)" ::: "memory"); __builtin_amdgcn_s_barrier(); asm volatile("" ::: "memory");
        const int row0 = u.orow + wr * 64 + fr, col0 = u.ocol + wc * 32 + 8 * fq;
#pragma unroll
        for (int ai = 0; ai < 2; ++ai)
#pragma unroll
            for (int m = 0; m < 4; ++m) {
                const int rl = ai * HALF + wr * 64 + m * 16 + fr;
                const f32x4 p0 = *(const LAS f32x4*)(red + rl * 8), p1 = *(const LAS f32x4*)(red + rl * 8 + 4);
                const float gm = fmaxf(fmaxf(p0[0], p0[2]), fmaxf(p1[0], p1[2]));
                const float tot = p0[1] * ex2(p0[0] - gm) + p0[3] * ex2(p0[2] - gm) + p1[1] * ex2(p1[0] - gm) + p1[3] * ex2(p1[2] - gm);
                const float f = ex2(mloc[ai][m] - gm) / tot;
                const int prow = row0 + ai * HALF + m * 16;
#pragma unroll
                for (int bj = 0; bj < 2; ++bj) {
                    const f32x4 v0 = acc[ai][bj][m][0] * f, v1 = acc[ai][bj][m][1] * f;
                    u32x4 w; w.x = cvtpk(v0[0], v0[1]); w.y = cvtpk(v0[2], v0[3]); w.z = cvtpk(v1[0], v1[1]); w.w = cvtpk(v1[2], v1[3]);
                    *(u32x4*)((unsigned char*)O + img_off(prow, col0 + bj * HALF)) = w;
                }
            }
        asm volatile("s_waitcnt lgkmcnt(0)" ::: "memory"); __builtin_amdgcn_s_barrier(); asm volatile("" ::: "memory");
    }
};

template <class Epi>
DI void gemm_phase(LAS unsigned char* lds, const Gemm g, const Order& S, const Epi& E) {
    int tid_ = threadIdx.x; asm volatile("" : "+v"(tid_));
    const int tid = tid_, wid = __builtin_amdgcn_readfirstlane(tid >> 6), lane = tid & 63, wr = wid >> 2, wc = wid & 3, fr = lane & 15, fq = lane >> 4;
    const int K = g.K, nt = K / BK;
    unsigned voffA[2], voffB[2];
#pragma unroll
    for (int i = 0; i < 2; ++i) { int R, C; stage_rc(tid * 16 + i * 8192, R, C); const int Rb = Epi::PERM ? ((R & ~31) + perm32(R & 31)) : R;
        voffA[i] = g.imgA ? (unsigned)(tid * 16 + i * 8192) : (unsigned)(R * g.lda + C) * 2u; voffB[i] = g.imgB ? (unsigned)(tid * 16 + i * 8192) : (unsigned)(Rb * g.ldb + C) * 2u; }
    const size_t kstepA = (size_t)g.kstepA, kstepB = (size_t)g.kstepB;
    const size_t hstepA = (size_t)HALF * g.lda * 2, hstepB = (size_t)HALF * g.ldb * 2;
    const unsigned ldsw = (unsigned)wid * 1024u;
    const int aoff = lds_byte(wr * 64 + fr, fq * 8), boff = lds_byte(wc * 32 + fr, fq * 8);
#define PG8_SA(b, h) (((b) * 2 + (h)) * HTB)
#define PG8_SB(b, h) ((4 + (b) * 2 + (h)) * HTB)
#define PG8_STAGE(bufoff, gbase, voff) do { _Pragma("unroll") for (int _i = 0; _i < 2; ++_i) \
        __builtin_amdgcn_global_load_lds((const unsigned*)((const char*)(gbase) + (voff)[_i]), (LAS unsigned*)(lds + (bufoff) + ldsw + _i * 8192), 16, 0, 0); } while (0)
#define PG8_LDA(dst, b, h) do { _Pragma("unroll") for (int m = 0; m < 4; ++m) _Pragma("unroll") for (int k = 0; k < 2; ++k) dst[m][k] = *(const LAS bf16x8*)(lds + PG8_SA(b, h) + aoff + m * 2048 + k * 1024); } while (0)
#define PG8_LDB(dst, b, h) do { _Pragma("unroll") for (int n = 0; n < 2; ++n) _Pragma("unroll") for (int k = 0; k < 2; ++k) dst[n][k] = *(const LAS bf16x8*)(lds + PG8_SB(b, h) + boff + n * 2048 + k * 1024); } while (0)
#define PG8_MMA(ai, bj, At, Bt) do { __builtin_amdgcn_s_setprio(1); _Pragma("unroll") for (int m = 0; m < 4; ++m) _Pragma("unroll") for (int n = 0; n < 2; ++n) _Pragma("unroll") for (int k = 0; k < 2; ++k) \
        acc[ai][bj][m][n] = __builtin_amdgcn_mfma_f32_16x16x32_bf16(Bt[n][k], At[m][k], acc[ai][bj][m][n], 0, 0, 0); __builtin_amdgcn_s_setprio(0); } while (0)
#define PG8_WAIT_V(n) asm volatile("s_waitcnt vmcnt(" #n ")" ::: "memory")
#define PG8_WAIT_L(n) asm volatile("s_waitcnt lgkmcnt(" #n ")" ::: "memory")
#define PG8_BAR __builtin_amdgcn_s_barrier()
#define PG8_SCHED __builtin_amdgcn_sched_barrier(0)
    Unit cur, nxt; int ui = 0;
    if (!S.next(0, cur)) return;
    f32x4 acc[2][2][4][2];
#pragma unroll
    for (int a = 0; a < 2; ++a)
#pragma unroll
        for (int b = 0; b < 2; ++b)
#pragma unroll
            for (int m = 0; m < 4; ++m)
#pragma unroll
                for (int n = 0; n < 2; ++n) acc[a][b][m][n] = (f32x4){0.f, 0.f, 0.f, 0.f};
    bf16x8 At[4][2], B0[2][2], B1[2][2];
    const char* cA = cur.a; const char* cB = cur.b;
    PG8_STAGE(PG8_SB(0, 0), cB, voffB); PG8_STAGE(PG8_SB(0, 1), cB + hstepB, voffB); PG8_STAGE(PG8_SA(0, 0), cA, voffA); PG8_STAGE(PG8_SA(0, 1), cA + hstepA, voffA);
    if (wr == 1) PG8_BAR;
    PG8_WAIT_V(2); PG8_BAR;
    PG8_STAGE(PG8_SB(1, 0), cB + kstepB, voffB); PG8_STAGE(PG8_SA(1, 0), cA + kstepA, voffA); PG8_STAGE(PG8_SB(1, 1), cB + hstepB + kstepB, voffB);
    PG8_WAIT_V(6); PG8_BAR;
    for (;;) {
        const bool has_next = S.next(ui + 1, nxt);
        const char* nA = has_next ? nxt.a : cA; const char* nB = has_next ? nxt.b : cB;
        for (int t = 0; t < nt; t += 2) {
            const bool last = (t == nt - 2);
            const char* a1 = cA + (size_t)(t + 1) * kstepA;
            const char* a2 = last ? nA : cA + (size_t)(t + 2) * kstepA; const char* b2 = last ? nB : cB + (size_t)(t + 2) * kstepB;
            const char* a3 = a2 + kstepA; const char* b3 = b2 + kstepB;
            PG8_LDB(B0, 0, 0); PG8_LDB(B1, 0, 1); PG8_SCHED; PG8_LDA(At, 0, 0); PG8_STAGE(PG8_SA(1, 1), a1 + hstepA, voffA);
            PG8_WAIT_V(8); PG8_WAIT_L(0); PG8_BAR; PG8_MMA(0, 0, At, B0); PG8_MMA(0, 1, At, B1); PG8_BAR; PG8_SCHED;
            PG8_LDA(At, 0, 1); PG8_STAGE(PG8_SB(0, 0), b2, voffB); PG8_STAGE(PG8_SB(0, 1), b2 + hstepB, voffB); PG8_STAGE(PG8_SA(0, 0), a2, voffA);
            PG8_WAIT_V(8); PG8_WAIT_L(0); PG8_BAR; PG8_MMA(1, 0, At, B0); PG8_MMA(1, 1, At, B1); PG8_BAR; PG8_SCHED;
            PG8_LDB(B0, 1, 0); PG8_LDB(B1, 1, 1); PG8_SCHED; PG8_LDA(At, 1, 0); PG8_STAGE(PG8_SA(0, 1), a2 + hstepA, voffA);
            PG8_WAIT_V(8); PG8_WAIT_L(0); PG8_BAR; PG8_MMA(0, 0, At, B0); PG8_MMA(0, 1, At, B1); PG8_BAR; PG8_SCHED;
            PG8_LDA(At, 1, 1); PG8_STAGE(PG8_SB(1, 0), b3, voffB); PG8_STAGE(PG8_SB(1, 1), b3 + hstepB, voffB); PG8_STAGE(PG8_SA(1, 0), a3, voffA);
            PG8_WAIT_V(8); PG8_WAIT_L(0); PG8_BAR; PG8_MMA(1, 0, At, B0); PG8_MMA(1, 1, At, B1); PG8_BAR; PG8_SCHED;
        }
        if (wr == 0) PG8_BAR;
        E(acc, cur, wr, wc, fr, fq, wid, lane);
        if (!has_next) break;
#pragma unroll
        for (int a = 0; a < 2; ++a)
#pragma unroll
            for (int b = 0; b < 2; ++b)
#pragma unroll
                for (int m = 0; m < 4; ++m)
#pragma unroll
                    for (int n = 0; n < 2; ++n) acc[a][b][m][n] = (f32x4){0.f, 0.f, 0.f, 0.f};
        cur = nxt; cA = nA; cB = nB; ++ui;
        if (wr == 1) PG8_BAR;
    }
    PG8_WAIT_V(0);
    PG8_BAR;
#undef PG8_SA
#undef PG8_SB
#undef PG8_STAGE
#undef PG8_LDA
#undef PG8_LDB
#undef PG8_MMA
#undef PG8_WAIT_V
#undef PG8_WAIT_L
#undef PG8_BAR
#undef PG8_SCHED
}
}

#define XB_TMO      128
#define XB_XCNT(j)  (256  + 64 * (j))
#define XB_XSUB(j)  (1280 + 64 * (j))
#define XB_XGEN(j)  (2304 + 64 * (j))
#define XB_TOP      3328
#define XB_TOPGEN   3392
#define XCD_BAR_WORDS 3456
#define XB_SPIN_CAP (1u << 20)
DI unsigned xb_ld(unsigned* p)              { return __hip_atomic_load(p, __ATOMIC_RELAXED, __HIP_MEMORY_SCOPE_AGENT); }
DI unsigned xb_add(unsigned* p, unsigned v) { return __hip_atomic_fetch_add(p, v, __ATOMIC_RELAXED, __HIP_MEMORY_SCOPE_AGENT); }
DI unsigned xb_xcc_id() { return (unsigned)__builtin_amdgcn_s_getreg((3 << 11) | 20) & 0xFu; }
#define XB_SPIN(cond, bar) do { unsigned _sp = 0; while (cond) { __builtin_amdgcn_s_sleep(1); \
    if ((++_sp & 255u) == 0u) { if (xb_ld(&(bar)[XB_TMO])) break; if (_sp > XB_SPIN_CAP) { atomicAdd(&(bar)[XB_TMO], 1u); break; } } } } while (0)
struct XcdBarrier { unsigned* bar; unsigned x; volatile LAS unsigned* st; };
DI XcdBarrier xcd_barrier_post(unsigned* bar, volatile LAS unsigned* st) {
    XcdBarrier b; b.bar = bar; b.x = xb_xcc_id(); b.st = st;
    if (threadIdx.x == 0) (void)xb_add(&bar[XB_XCNT(b.x)], 1u);
    return b;
}
DI void xcd_barrier_complete(unsigned* bar, unsigned x, unsigned& nloc, unsigned& nx) {
    const unsigned G = gridDim.x * gridDim.y * gridDim.z;
    unsigned sum, cnt, mine, sp = 0u;
    for (;;) {
        sum = 0u; cnt = 0u; mine = 0u;
#pragma unroll
        for (unsigned j = 0; j < 16; ++j) { const unsigned c = xb_ld(&bar[XB_XCNT(j)]); sum += c; cnt += (c > 0u) ? 1u : 0u; mine = (j == x) ? c : mine; }
        if (sum == G) break;
        __builtin_amdgcn_s_sleep(1);
        if ((++sp & 255u) == 0u) { if (xb_ld(&bar[XB_TMO])) break; if (sp > XB_SPIN_CAP) { atomicAdd(&bar[XB_TMO], 1u); break; } }
    }
    nloc = mine > 0u ? mine : 1u; nx = cnt > 0u ? cnt : 1u;
}
DI void xcd_barrier(const XcdBarrier& b) {
    asm volatile("s_waitcnt vmcnt(0)" ::: "memory");
    __syncthreads();
    if (threadIdx.x == 0) {
        unsigned* bar = b.bar;
        __builtin_amdgcn_s_waitcnt(0);
        unsigned nloc = b.st[0], nx = b.st[1];
        if (nloc == 0u) { xcd_barrier_complete(bar, b.x, nloc, nx); b.st[0] = nloc; b.st[1] = nx; }
        const unsigned old = xb_add(&bar[XB_XSUB(b.x)], 1u);
        const unsigned gen = old / nloc;
        if (old + 1u == (gen + 1u) * nloc) {
            __builtin_amdgcn_fence(__ATOMIC_RELEASE, "agent");
            asm volatile("s_waitcnt vmcnt(0)" ::: "memory");
            const unsigned og = xb_add(&bar[XB_TOP], 1u);
            const unsigned tg = og / nx;
            if (og + 1u == (tg + 1u) * nx) xb_add(&bar[XB_TOPGEN], 1u);
            else XB_SPIN(xb_ld(&bar[XB_TOPGEN]) == tg, bar);
            __builtin_amdgcn_fence(__ATOMIC_ACQUIRE, "agent");
            xb_add(&bar[XB_XGEN(b.x)], 1u);
            asm volatile("s_waitcnt vmcnt(0)" ::: "memory");
        } else {
            XB_SPIN(xb_ld(&bar[XB_XGEN(b.x)]) == gen, bar);
            __builtin_amdgcn_fence(__ATOMIC_ACQUIRE, "agent");
            asm volatile("s_waitcnt vmcnt(0)" ::: "memory");
        }
    }
    __syncthreads();
}

struct Ctx {
    LAS unsigned char* lds; unsigned char* ldsg;
    int tid, lane, wid, bid, G;
    unsigned char* ws; float* out;
};
DI bf16_t* wsb(const Ctx& c, size_t off) { return (bf16_t*)(c.ws + off); }
DI float* wsf(const Ctx& c, size_t off) { return (float*)(c.ws + off); }
DI float* ssbuf(const Ctx& c, int i) { return (float*)(c.ws + OFF_SS) + (size_t)i * MTOK * 16; }

DI int t5_bucket(int dist) {
    if (dist < 16) return dist;
    const float v = logf((float)dist / 16.f) / 4.852030263919617f * 16.f;
    int large = 16 + (int)v; return large < 31 ? large : 31;
}

DI Ctx fresh(const Ctx& c0) {
    Ctx c = c0; int tid = threadIdx.x; asm volatile("" : "+v"(tid)); c.tid = tid; c.lane = tid & 63; c.wid = __builtin_amdgcn_readfirstlane(tid >> 6);
    asm volatile("" : "+s"(c.ws)); asm volatile("" : "+s"(c.out)); return c;
}
DI void transpose_item(const float* W, int ldw, int scol0, int k0, const float* gain, bf16_t* WT, int K, int drow0, LAS float* scr, int lane, bool img = false) {
    {
        f32x4 v[8]; float gs[8];
#pragma unroll
        for (int i = 0; i < 8; ++i) { const int kk = 8 * i + (lane >> 3); v[i] = *(const f32x4*)(W + (size_t)(k0 + kk) * ldw + scol0 + (lane & 7) * 4); gs[i] = gain ? gain[k0 + kk] : 1.f; }
#pragma unroll
        for (int i = 0; i < 8; ++i) { const int kk = 8 * i + (lane >> 3); LAS float* d = scr + kk * 33 + (lane & 7) * 4; d[0] = v[i][0] * gs[i]; d[1] = v[i][1] * gs[i]; d[2] = v[i][2] * gs[i]; d[3] = v[i][3] * gs[i]; }
    }
    LDS_WAIT(); asm volatile("" ::: "memory");
    const int c = lane & 7;
#pragma unroll
    for (int j = 0; j < 4; ++j) { const int n = (lane >> 3) + 8 * j; const LAS float* s = scr + (8 * c) * 33 + n;
        u32x4 o; o.x = cvtpk(s[0 * 33], s[1 * 33]); o.y = cvtpk(s[2 * 33], s[3 * 33]); o.z = cvtpk(s[4 * 33], s[5 * 33]); o.w = cvtpk(s[6 * 33], s[7 * 33]);
        if (img) { const int ng = drow0 + n, nl = ng & 255, r = nl & 127, q = r & 31, rs = (r & ~31) + 16 * ((q >> 2) & 1) + 4 * (q >> 3) + (q & 3);
            const int kk0 = k0 + 8 * c;
            *(u32x4*)((unsigned char*)WT + ((size_t)((ng >> 8) * (K >> 6) + (kk0 >> 6)) * 2 + (nl >> 7)) * 16384 + pg8::lds_byte(rs, kk0 & 63)) = o; }
        else *(u32x4*)(WT + (size_t)(drow0 + n) * K + k0 + 8 * c) = o; }
    LDS_WAIT(); asm volatile("" ::: "memory");
}
DI void tjob(const float* W, int ldw, int scol0, const float* gain, bf16_t* WT, int K, int ncols, int item, LAS float* scr, int lane, bool img = false, int drow_base = 0) {
    const int nblk = ncols / 32, kb = item / nblk, nb = item % nblk;
    transpose_item(W, ldw, scol0 + 32 * nb, 64 * kb, gain, WT, K, drow_base + 32 * nb, scr, lane, img);
}
DI void tjob_gu(const float* Wg, const float* Wu, const float* gain, bf16_t* WT, int item, LAS float* scr, int lane) {
    const int nblk = 2 * FF / 32, kb = item / nblk, nb = item % nblk, n0 = 32 * nb, p = n0 >> 8, w = n0 & 255;
    transpose_item(w < 128 ? Wg : Wu, FF, 128 * p + (w & 127), 64 * kb, gain, WT, DM, n0, scr, lane, true);
}
DI void ph_prologue(const Params& p, const Ctx& c0) {
    const Ctx c = fresh(c0);
    LAS float* scr = (LAS float*)(c.lds + c.wid * 16384);
    const int gw = c.bid * 8 + c.wid, NGW = c.G * 8, lane = c.lane;
    constexpr int I_GU = 16 * (2 * FF / 32), I_D = (FF / 64) * 32, I_INA = 16 * 32, I_INB = 16 * 56, I_INC = 16, I_SQ = 16 * 32;
    constexpr int PER_LAYER = 2 * I_GU + 2 * I_D + I_INA + I_INB + I_INC + 5 * I_SQ;
    for (int it = gw; it < DEPTH * PER_LAYER; it += NGW) {
        const int l = it / PER_LAYER; int r = it % PER_LAYER;
        unsigned char* wl = c.ws + (size_t)l * W_LAYER;
        if (r < I_GU) { tjob_gu(p.in[I_F1G] + (size_t)l * DM * FF, p.in[I_F1U] + (size_t)l * DM * FF, p.in[I_F1N] + l * DM, (bf16_t*)(wl + W_GU1), r, scr, lane); continue; } r -= I_GU;
        if (r < I_D) { tjob(p.in[I_F1D] + (size_t)l * FF * DM, DM, 0, nullptr, (bf16_t*)(wl + W_D1), FF, DM, r, scr, lane, true); continue; } r -= I_D;
        if (r < I_INA) { tjob(p.in[I_WIN] + (size_t)l * DM * INW, INW, 0, p.in[I_MIXN] + l * DM, (bf16_t*)(wl + W_IN), DM, 1024, r, scr, lane, true, 0); continue; } r -= I_INA;
        if (r < I_INB) { tjob(p.in[I_WIN] + (size_t)l * DM * INW, INW, 1032, p.in[I_MIXN] + l * DM, (bf16_t*)(wl + W_IN), DM, 1792, r, scr, lane, true, 1024); continue; } r -= I_INB;
        if (r < I_INC) { tjob(p.in[I_WIN] + (size_t)l * DM * INW, INW, 1024, p.in[I_MIXN] + l * DM, (bf16_t*)(wl + W_IN), DM, 32, r, scr, lane, true, 2816); continue; } r -= I_INC;
        if (r < I_SQ) { tjob(p.in[I_WOUT] + (size_t)l * DM * DM, DM, 0, nullptr, (bf16_t*)(wl + W_OUT), DM, DM, r, scr, lane, true); continue; } r -= I_SQ;
        if (r < I_SQ) {
            const int kb = r >> 5, nb = r & 31; const int row = 64 * kb + lane; const float gsc = p.in[I_XN][l * DM + row];
            const f32x4* src = (const f32x4*)(p.in[I_XWQ] + (size_t)l * DM * DM + (size_t)row * DM + 32 * nb); u32x4* dst = (u32x4*)((bf16_t*)(wl + W_Q) + (size_t)row * DM + 32 * nb);
#pragma unroll
            for (int q4 = 0; q4 < 4; ++q4) { const f32x4 x0 = src[2 * q4] * gsc, x1 = src[2 * q4 + 1] * gsc; u32x4 w; w.x = cvtpk(x0[0], x0[1]); w.y = cvtpk(x0[2], x0[3]); w.z = cvtpk(x1[0], x1[1]); w.w = cvtpk(x1[2], x1[3]); dst[q4] = w; }
            continue; } r -= I_SQ;
        if (r < I_SQ) { tjob(p.in[I_XWO] + (size_t)l * DM * DM, DM, 0, nullptr, (bf16_t*)(wl + W_O), DM, DM, r, scr, lane); continue; } r -= I_SQ;
        if (r < I_GU) { tjob_gu(p.in[I_F2G] + (size_t)l * DM * FF, p.in[I_F2U] + (size_t)l * DM * FF, p.in[I_F2N] + l * DM, (bf16_t*)(wl + W_GU2), r, scr, lane); continue; } r -= I_GU;
        if (r < I_D) { tjob(p.in[I_F2D] + (size_t)l * FF * DM, DM, 0, nullptr, (bf16_t*)(wl + W_D2), FF, DM, r, scr, lane, true); continue; } r -= I_D;
        if (r < I_SQ) { tjob(p.in[I_XWKV] + (size_t)l * DM * 2 * DM, 2 * DM, 0, p.in[I_MEMN] + l * DM, wsb(c, OFF_WK) + (size_t)l * DM * DM, DM, DM, r, scr, lane); continue; } r -= I_SQ;
        tjob(p.in[I_XWKV] + (size_t)l * DM * 2 * DM, 2 * DM, DM, p.in[I_MEMN] + l * DM, wsb(c, OFF_WV) + (size_t)l * DM * DM, DM, DM, r, scr, lane);
    }
    for (int m = gw; m < MTOK + MMEM; m += NGW) {
        const bool isx = m < MTOK; const int row = isx ? m : m - MTOK;
        const f32x4* xr = (const f32x4*)((isx ? p.in[I_X] : p.in[I_MEM]) + (size_t)row * DM) + lane;
        unsigned long long* o8 = (unsigned long long*)(wsb(c, OFF_MEMB) + (size_t)row * DM) + lane; unsigned char* hbimg = (unsigned char*)wsb(c, OFF_HB);
        float s = 0.f;
#pragma unroll
        for (int j = 0; j < 4; ++j) { const f32x4 v = xr[64 * j]; s += (v[0] * v[0] + v[1] * v[1]) + (v[2] * v[2] + v[3] * v[3]);
            const unsigned long long pk = (unsigned long long)cvtpk(v[0], v[1]) | ((unsigned long long)cvtpk(v[2], v[3]) << 32);
            if (isx) *(unsigned long long*)(hbimg + pg8::img_off(row, 4 * (lane + 64 * j))) = pk; else o8[64 * j] = pk; }
        s = wave_sum(s);
        if (lane == 0) { if (isx) { f32x4* q = (f32x4*)(ssbuf(c, 0) + (size_t)row * 16); q[0] = (f32x4){s, 0.f, 0.f, 0.f}; q[1] = (f32x4){0.f, 0.f, 0.f, 0.f}; q[2] = q[1]; q[3] = q[1]; } else wsf(c, OFF_RSM)[row] = rsqrtf(s * (1.f / DM) + 1e-6f); }
    }
    for (int l = 0; l < DEPTH; ++l) { unsigned char* t11 = c.ws + (size_t)l * W_LAYER + W_IN + (size_t)11 * 16 * 32768;
        for (int i = c.bid * 512 + c.tid; i < 16 * 1792; i += c.G * 512) { const int kt = i / 1792, rem = i - kt * 1792; *(u32x4*)(t11 + (size_t)kt * 32768 + 4096 + (size_t)rem * 16) = (u32x4){0u, 0u, 0u, 0u}; } }
    const int gt = c.bid * 512 + c.tid, NGT = c.G * 512;
    const float* t5 = p.in[I_T5];
    for (int i = gt; i < 4 * 4096; i += NGT) { const int h = i >> 12, d = i & 4095; wsf(c, OFF_DIFFB)[i] = t5[t5_bucket(d) * 8 + 4 + h] * LOG2E; }
    for (int i = gt; i < 3 * 4 * 132; i += NGT) { const int pp = i / (4 * 132), h = (i / 132) & 3, dl = i % 132; const int dil = pp == 0 ? 1 : (pp == 1 ? 4 : 16);
        wsf(c, OFF_DILB)[i] = dl <= 128 ? t5[t5_bucket(dl * dil) * 8 + h] * LOG2E : 0.f; }
    if (gt < DEPTH) { const float* lv = p.in[I_LAMV] + gt * 128; float a = 0.f, b = 0.f; for (int i = 0; i < 32; ++i) { a += lv[i] * lv[32 + i]; b += lv[64 + i] * lv[96 + i]; }
        const float lam_init = 0.8f - 0.6f * expf(-0.3f * (float)gt); wsf(c, OFF_LAM)[gt] = expf(a) - expf(b) + lam_init; }
}

DI void ph_gates(const Params& p, const Ctx& c0, int l) {
    const Ctx c = fresh(c0);
    LAS float* wg = (LAS float*)c.lds;
    const float* win = p.in[I_WIN] + (size_t)l * DM * INW; const float* gn = p.in[I_MIXN] + l * DM;
    for (int i = c.tid; i < DM * 8; i += 512) { const int k = i >> 3, cc = i & 7; wg[i] = win[(size_t)k * INW + 1024 + cc] * gn[k]; }
    __syncthreads();
    const float* h = c.out; const float* ss = ssbuf(c, 4 * l + 1); float* gates = wsf(c, OFF_GATES);
    for (int row = c.bid * 8 + c.wid; row < MTOK; row += c.G * 8) {
        float a[8];
#pragma unroll
        for (int j = 0; j < 8; ++j) a[j] = 0.f;
        const f32x4* xr = (const f32x4*)(h + (size_t)row * DM) + c.lane;
#pragma unroll
        for (int j = 0; j < 4; ++j) { const f32x4 v = xr[64 * j]; const int k0 = 4 * c.lane + 256 * j;
#pragma unroll
            for (int e = 0; e < 4; ++e) { const f32x4 w0 = *(const LAS f32x4*)(wg + (k0 + e) * 8), w1 = *(const LAS f32x4*)(wg + (k0 + e) * 8 + 4);
                a[0] += v[e] * w0[0]; a[1] += v[e] * w0[1]; a[2] += v[e] * w0[2]; a[3] += v[e] * w0[3]; a[4] += v[e] * w1[0]; a[5] += v[e] * w1[1]; a[6] += v[e] * w1[2]; a[7] += v[e] * w1[3]; } }
#pragma unroll
        for (int j = 0; j < 8; ++j) a[j] = wave_sum(a[j]);
        if (c.lane == 0) { const float rs = rowss(ss, row);
            *(f32x4*)(gates + (size_t)row * 8) = (f32x4){a[0] * rs, a[1] * rs, a[2] * rs, a[3] * rs}; *(f32x4*)(gates + (size_t)row * 8 + 4) = (f32x4){a[4] * rs, a[5] * rs, a[6] * rs, a[7] * rs}; }
    }
    __syncthreads();
}

constexpr int ZS = 64;
#define ZP(z_, row_, colbase_) ((z_) + ((size_t)((colbase_) >> 6) * MTOK + (size_t)(row_)) * ZS)
#define YIMG_STORE(c_, row_, col_, w_) (*(u32x2*)((unsigned char*)wsb((c_), OFF_Y) + pg8::img_off((int)(row_), (col_))) = (w_))
DI void osm_update(f32x16& s, float& m, float& l, f32x16 (&O)[2], bf16x8& p0, bf16x8& p1) {
    float mx = fmaxf(s[0], s[1]);
#pragma unroll
    for (int i = 2; i < 16; ++i) mx = fmaxf(mx, s[i]);
    mx = fmaxf(mx, __shfl_xor(mx, 32));
    const float mn = fmaxf(m, mx);
    if (__any(mn > m)) {
        const float al = ex2(m - mn); l *= al;
#pragma unroll
        for (int i = 0; i < 16; ++i) { O[0][i] *= al; O[1][i] *= al; }
        m = mn;
    }
    float sum = 0.f;
#pragma unroll
    for (int i = 0; i < 16; ++i) { s[i] = ex2(s[i] - m); sum += s[i]; }
    l += sum;
    p0 = pack8(s[0], s[1], s[2], s[3], s[4], s[5], s[6], s[7]);
    p1 = pack8(s[8], s[9], s[10], s[11], s[12], s[13], s[14], s[15]);
}

constexpr int DK_KP = 144, DK_VP = 136;
constexpr int DF_KOFF = 0, DF_VOFF = 2 * 64 * DK_KP, DF_TOFF = DF_VOFF + 2 * 64 * DK_VP;
DI void diff_attn_task(const Params& p, const Ctx& c, int l, int b, int h, int qb) {
    const int tid = c.tid, lane = c.lane, wid = c.wid, r32 = lane & 31, hi = lane >> 5;
    const bf16_t* z = wsb(c, OFF_Z);
    const size_t rowbase = (size_t)b * SEQ;
    LAS unsigned char* lds = c.lds;
    LAS float* tbl = (LAS float*)(lds + DF_TOFF);
    __syncthreads();
    { const float* src = wsf(c, OFF_DIFFB) + h * 4096; for (int i = tid; i < 4096; i += 512) tbl[i] = src[i]; }
    const int qw0 = qb * 256 + wid * 32, qpos = qw0 + r32;
    bf16x8 qf[4];
    { const bf16_t* qp = ZP(z, rowbase + qpos, ZQD + h * 64);
#pragma unroll
      for (int s = 0; s < 4; ++s) qf[s] = *(const bf16x8*)(qp + 16 * s + 8 * hi); }
    f32x16 O1[2], O2[2];
#pragma unroll
    for (int i = 0; i < 16; ++i) { O1[0][i] = 0.f; O1[1][i] = 0.f; O2[0][i] = 0.f; O2[1][i] = 0.f; }
    float m1 = NEGBIG, m2 = NEGBIG, l1 = 0.f, l2 = 0.f;
    const int NT = (qb + 1) * 4;
    const int skey = tid >> 3, schunk = tid & 7;
    const bf16_t* kbase = ZP(z, rowbase + skey, ZKD + h * 64) + schunk * 8;
    const bf16_t* vbase = ZP(z, rowbase + skey, ZVD + h * 64) + schunk * 8;
    u32x4 kreg = *(const u32x4*)kbase, vreg = *(const u32x4*)vbase;
#define DF_WRITE(buf) do { *(LAS u32x4*)(lds + DF_KOFF + (buf) * 64 * DK_KP + skey * DK_KP + schunk * 16) = kreg; \
        LAS bf16_t* vt_ = (LAS bf16_t*)(lds + DF_VOFF + (buf) * 64 * DK_VP + skey * 2); \
        vt_[(schunk * 8 + 0) * (DK_VP / 2)] = (bf16_t)(vreg.x & 0xffff); vt_[(schunk * 8 + 1) * (DK_VP / 2)] = (bf16_t)(vreg.x >> 16); \
        vt_[(schunk * 8 + 2) * (DK_VP / 2)] = (bf16_t)(vreg.y & 0xffff); vt_[(schunk * 8 + 3) * (DK_VP / 2)] = (bf16_t)(vreg.y >> 16); \
        vt_[(schunk * 8 + 4) * (DK_VP / 2)] = (bf16_t)(vreg.z & 0xffff); vt_[(schunk * 8 + 5) * (DK_VP / 2)] = (bf16_t)(vreg.z >> 16); \
        vt_[(schunk * 8 + 6) * (DK_VP / 2)] = (bf16_t)(vreg.w & 0xffff); vt_[(schunk * 8 + 7) * (DK_VP / 2)] = (bf16_t)(vreg.w >> 16); } while (0)
    DF_WRITE(0);
    __syncthreads();
    for (int t = 0; t < NT; ++t) {
        const int buf = t & 1;
        if (t + 1 < NT) { kreg = *(const u32x4*)(kbase + (size_t)(t + 1) * 64 * ZS); vreg = *(const u32x4*)(vbase + (size_t)(t + 1) * 64 * ZS); }
        if (64 * t <= qw0 + 31) {
            const LAS unsigned char* kimg = lds + DF_KOFF + buf * 64 * DK_KP;
            const LAS unsigned char* vimg = lds + DF_VOFF + buf * 64 * DK_VP;
#pragma unroll
            for (int sub = 0; sub < 2; ++sub) {
                const int key0 = 64 * t + 32 * sub;
                if (key0 <= qw0 + 31) {
                    const LAS unsigned char* kr = kimg + (32 * sub + r32) * DK_KP + hi * 16;
                    const bf16x8 k0 = *(const LAS bf16x8*)(kr), k1 = *(const LAS bf16x8*)(kr + 32), k2 = *(const LAS bf16x8*)(kr + 64), k3 = *(const LAS bf16x8*)(kr + 96);
                    f32x16 s1, s2, bv;
                    const int dbase = qpos - key0 - 4 * hi;
                    if (key0 + 31 > qw0) {
#pragma unroll
                        for (int i = 0; i < 16; ++i) { const int d = dbase - ((i & 3) + 8 * (i >> 2)); const float bi = tbl[d < 0 ? 0 : d]; bv[i] = d < 0 ? NEGBIG : bi; }
                    } else {
#pragma unroll
                        for (int i = 0; i < 16; ++i) bv[i] = tbl[dbase - ((i & 3) + 8 * (i >> 2))];
                    }
                    s1 = MFMA32(k0, qf[0], bv); s1 = MFMA32(k1, qf[1], s1);
                    s2 = MFMA32(k2, qf[2], bv); s2 = MFMA32(k3, qf[3], s2);
                    bf16x8 pa0, pa1, pb0, pb1;
                    osm_update(s1, m1, l1, O1, pa0, pa1);
                    osm_update(s2, m2, l2, O2, pb0, pb1);
#pragma unroll
                    for (int dvt = 0; dvt < 2; ++dvt) {
                        const LAS unsigned char* vr = vimg + (32 * dvt + r32) * DK_VP + (32 * sub + 4 * hi) * 2;
                        const bf16x8 v0 = mk8(*(const LAS u32x2*)(vr), *(const LAS u32x2*)(vr + 16));
                        const bf16x8 v1 = mk8(*(const LAS u32x2*)(vr + 32), *(const LAS u32x2*)(vr + 48));
                        O1[dvt] = MFMA32(v0, pa0, O1[dvt]); O1[dvt] = MFMA32(v1, pa1, O1[dvt]);
                        O2[dvt] = MFMA32(v0, pb0, O2[dvt]); O2[dvt] = MFMA32(v1, pb1, O2[dvt]);
                    }
                }
            }
        }
        if (t + 1 < NT) DF_WRITE(buf ^ 1);
        __syncthreads();
    }
#undef DF_WRITE
    l1 += __shfl_xor(l1, 32); l2 += __shfl_xor(l2, 32);
    const float lam = wsf(c, OFF_LAM)[l];
    const float lam_init = 0.8f - 0.6f * expf(-0.3f * (float)l);
    const float i1 = 1.f / l1, i2 = lam / l2;
    float ssq = 0.f;
#pragma unroll
    for (int dvt = 0; dvt < 2; ++dvt)
#pragma unroll
        for (int i = 0; i < 16; ++i) { const float o = O1[dvt][i] * i1 - O2[dvt][i] * i2; O1[dvt][i] = o; ssq += o * o; }
    ssq += __shfl_xor(ssq, 32);
    const float rn = rsqrtf(ssq * (1.f / 64.f) + 1e-5f) * (1.f - lam_init);
    const float* sg = p.in[I_SUBLN] + l * 64;
#pragma unroll
    for (int dvt = 0; dvt < 2; ++dvt)
#pragma unroll
        for (int g = 0; g < 4; ++g) {
            const int dv = 32 * dvt + 8 * g + 4 * hi; const f32x4 gg = *(const f32x4*)(sg + dv);
            u32x2 w; w.x = cvtpk(O1[dvt][4 * g] * rn * gg[0], O1[dvt][4 * g + 1] * rn * gg[1]); w.y = cvtpk(O1[dvt][4 * g + 2] * rn * gg[2], O1[dvt][4 * g + 3] * rn * gg[3]);
            YIMG_STORE(c, rowbase + qpos, 768 + h * 64 + dv, w);
        }
}

constexpr int DL_NK = 384, DL_KP = 144, DL_VP = 776;
constexpr int DL_KOFF = 0, DL_VOFF = DL_NK * DL_KP, DL_TOFF = DL_VOFF + 64 * DL_VP;
DI void dil_attn_task(const Params& p, const Ctx& c, int pat, int b, int h, int res, int mb) {
    const int dil = pat == 0 ? 1 : (pat == 1 ? 4 : 16);
    const int tid = c.tid, lane = c.lane, wid = c.wid, r32 = lane & 31, hi = lane >> 5;
    const bf16_t* z = wsb(c, OFF_Z);
    const size_t rowbase = (size_t)b * SEQ;
    LAS unsigned char* lds = c.lds;
    LAS float* tbl = (LAS float*)(lds + DL_TOFF);
    __syncthreads();
    if (tid < 132) tbl[tid] = wsf(c, OFF_DILB)[(pat * 4 + h) * 132 + tid];
    const int mk0 = 256 * mb - 128;
    {
        u32x4 kreg[6], vreg[6];
#pragma unroll
        for (int it = 0; it < 6; ++it) {
            const int idx = tid + 512 * it, key = idx >> 3, chunk = idx & 7, mk = mk0 + key;
            kreg[it] = (u32x4){0u, 0u, 0u, 0u}; vreg[it] = (u32x4){0u, 0u, 0u, 0u};
            if (mk >= 0) { const size_t zr = rowbase + (size_t)mk * dil + res; kreg[it] = *(const u32x4*)(ZP(z, zr, ZKC + h * 64) + chunk * 8); vreg[it] = *(const u32x4*)(ZP(z, zr, ZVC + h * 64) + chunk * 8); }
        }
#pragma unroll
        for (int it = 0; it < 6; ++it) {
            const int idx = tid + 512 * it, key = idx >> 3, chunk = idx & 7;
            *(LAS u32x4*)(lds + DL_KOFF + key * DL_KP + chunk * 16) = kreg[it];
            LAS bf16_t* vt_ = (LAS bf16_t*)(lds + DL_VOFF + key * 2);
            vt_[(chunk * 8 + 0) * (DL_VP / 2)] = (bf16_t)(vreg[it].x & 0xffff); vt_[(chunk * 8 + 1) * (DL_VP / 2)] = (bf16_t)(vreg[it].x >> 16);
            vt_[(chunk * 8 + 2) * (DL_VP / 2)] = (bf16_t)(vreg[it].y & 0xffff); vt_[(chunk * 8 + 3) * (DL_VP / 2)] = (bf16_t)(vreg[it].y >> 16);
            vt_[(chunk * 8 + 4) * (DL_VP / 2)] = (bf16_t)(vreg[it].z & 0xffff); vt_[(chunk * 8 + 5) * (DL_VP / 2)] = (bf16_t)(vreg[it].z >> 16);
            vt_[(chunk * 8 + 6) * (DL_VP / 2)] = (bf16_t)(vreg[it].w & 0xffff); vt_[(chunk * 8 + 7) * (DL_VP / 2)] = (bf16_t)(vreg[it].w >> 16);
        }
    }
    const int mq = 256 * mb + 32 * wid + r32;
    const size_t qtok = rowbase + (size_t)mq * dil + res;
    bf16x8 qf[4];
    { const bf16_t* qp = ZP(z, qtok, ZQC + h * 64);
#pragma unroll
      for (int s = 0; s < 4; ++s) qf[s] = *(const bf16x8*)(qp + 16 * s + 8 * hi); }
    __syncthreads();
    f32x16 O[2];
#pragma unroll
    for (int i = 0; i < 16; ++i) { O[0][i] = 0.f; O[1][i] = 0.f; }
    float m = NEGBIG, lsum = 0.f;
    for (int j = 0; j < 5; ++j) {
        const int kt = wid + j;
        const LAS unsigned char* kr = lds + DL_KOFF + (32 * kt + r32) * DL_KP + hi * 16;
        f32x16 s;
        const int dbase = 128 - 32 * j + r32 - 4 * hi;
        const int mkb = mk0 + 32 * kt + 4 * hi;
        if (j == 0 || j == 4 || mb == 0) {
#pragma unroll
            for (int i = 0; i < 16; ++i) { const int cc = (i & 3) + 8 * (i >> 2); const int dl = dbase - cc; const bool ok = (dl >= 0) && (dl <= 128) && (mkb + cc >= 0);
                const int dc = dl < 0 ? 0 : (dl > 128 ? 128 : dl); s[i] = ok ? tbl[dc] : NEGBIG; }
        } else {
#pragma unroll
            for (int i = 0; i < 16; ++i) s[i] = tbl[dbase - ((i & 3) + 8 * (i >> 2))];
        }
#pragma unroll
        for (int ks = 0; ks < 4; ++ks) s = MFMA32(*(const LAS bf16x8*)(kr + 32 * ks), qf[ks], s);
        bf16x8 p0, p1;
        osm_update(s, m, lsum, O, p0, p1);
#pragma unroll
        for (int dvt = 0; dvt < 2; ++dvt) {
            const LAS unsigned char* vr = lds + DL_VOFF + (32 * dvt + r32) * DL_VP + (32 * kt + 4 * hi) * 2;
            const bf16x8 v0 = mk8(*(const LAS u32x2*)(vr), *(const LAS u32x2*)(vr + 16));
            const bf16x8 v1 = mk8(*(const LAS u32x2*)(vr + 32), *(const LAS u32x2*)(vr + 48));
            O[dvt] = MFMA32(v0, p0, O[dvt]); O[dvt] = MFMA32(v1, p1, O[dvt]);
        }
    }
    lsum += __shfl_xor(lsum, 32);
    const float inv = 1.f / lsum, lse = m + log2f(lsum);
    if (pat != 0) {
        bf16_t* orow = ((bf16_t*)((unsigned char*)c.out + (size_t)64 * 64 * 4096 * 4)) + ((size_t)(pat - 1) * MTOK + qtok) * 256 + h * 64;
#pragma unroll
        for (int dvt = 0; dvt < 2; ++dvt)
#pragma unroll
            for (int g = 0; g < 4; ++g) { u32x2 w; w.x = cvtpk(O[dvt][4 * g] * inv, O[dvt][4 * g + 1] * inv); w.y = cvtpk(O[dvt][4 * g + 2] * inv, O[dvt][4 * g + 3] * inv);
                *(u32x2*)(orow + 32 * dvt + 8 * g + 4 * hi) = w; }
        if (hi == 0) wsf(c, OFF_LSEP)[((size_t)(pat - 1) * MTOK + qtok) * 4 + h] = lse;
    } else {
        const float ls1 = wsf(c, OFF_LSEP)[qtok * 4 + h], ls2 = wsf(c, OFF_LSEP)[((size_t)MTOK + qtok) * 4 + h];
        const float mm = fmaxf(lse, fmaxf(ls1, ls2));
        const float w0 = ex2(lse - mm), w1 = ex2(ls1 - mm), w2 = ex2(ls2 - mm), wi = 1.f / (w0 + w1 + w2);
        const float a0 = w0 * wi * inv, a1 = w1 * wi, a2 = w2 * wi;
        const bf16_t* o1 = ((bf16_t*)((unsigned char*)c.out + (size_t)64 * 64 * 4096 * 4)) + qtok * 256 + h * 64; const bf16_t* o2 = o1 + (size_t)MTOK * 256;
#pragma unroll
        for (int dvt = 0; dvt < 2; ++dvt)
#pragma unroll
            for (int g = 0; g < 4; ++g) { const int dv = 32 * dvt + 8 * g + 4 * hi; const u32x2 x1 = *(const u32x2*)(o1 + dv), x2 = *(const u32x2*)(o2 + dv);
                const float r0 = O[dvt][4 * g] * a0 + bflo(x1.x) * a1 + bflo(x2.x) * a2, r1 = O[dvt][4 * g + 1] * a0 + bfhi(x1.x) * a1 + bfhi(x2.x) * a2;
                const float r2 = O[dvt][4 * g + 2] * a0 + bflo(x1.y) * a1 + bflo(x2.y) * a2, r3 = O[dvt][4 * g + 3] * a0 + bfhi(x1.y) * a1 + bfhi(x2.y) * a2;
                u32x2 w; w.x = cvtpk(r0, r1); w.y = cvtpk(r2, r3); YIMG_STORE(c, qtok, 512 + h * 64 + dv, w); }
    }
}

DI void pool_x(const bf16_t* bp0, int w, int cnt, float icnt, bf16x8 (&xf)[4]) {
    float sum[4][8]; u32x4 cur[4];
#pragma unroll
    for (int ks = 0; ks < 4; ++ks) {
        const bf16_t* bp = bp0 + 16 * ks;
        cur[ks] = *(const u32x4*)bp; const u32x4 prv = (cnt > 1) ? *(const u32x4*)(bp - ZS) : (u32x4){0u, 0u, 0u, 0u};
        sum[ks][0] = bflo(cur[ks].x) + bflo(prv.x); sum[ks][1] = bfhi(cur[ks].x) + bfhi(prv.x); sum[ks][2] = bflo(cur[ks].y) + bflo(prv.y); sum[ks][3] = bfhi(cur[ks].y) + bfhi(prv.y);
        sum[ks][4] = bflo(cur[ks].z) + bflo(prv.z); sum[ks][5] = bfhi(cur[ks].z) + bfhi(prv.z); sum[ks][6] = bflo(cur[ks].w) + bflo(prv.w); sum[ks][7] = bfhi(cur[ks].w) + bfhi(prv.w);
    }
#pragma unroll 1
    for (int j0 = 2; j0 < w; j0 += 2) {
        u32x4 v0[4], v1[4];
#pragma unroll
        for (int ks = 0; ks < 4; ++ks) { v0[ks] = (u32x4){0u, 0u, 0u, 0u}; v1[ks] = (u32x4){0u, 0u, 0u, 0u};
            if (j0 < cnt) v0[ks] = *(const u32x4*)(bp0 + 16 * ks - (size_t)j0 * ZS);
            if (j0 + 1 < cnt) v1[ks] = *(const u32x4*)(bp0 + 16 * ks - (size_t)(j0 + 1) * ZS); }
#pragma unroll
        for (int ks = 0; ks < 4; ++ks) {
            sum[ks][0] += bflo(v0[ks].x) + bflo(v1[ks].x); sum[ks][1] += bfhi(v0[ks].x) + bfhi(v1[ks].x); sum[ks][2] += bflo(v0[ks].y) + bflo(v1[ks].y); sum[ks][3] += bfhi(v0[ks].y) + bfhi(v1[ks].y);
            sum[ks][4] += bflo(v0[ks].z) + bflo(v1[ks].z); sum[ks][5] += bfhi(v0[ks].z) + bfhi(v1[ks].z); sum[ks][6] += bflo(v0[ks].w) + bflo(v1[ks].w); sum[ks][7] += bfhi(v0[ks].w) + bfhi(v1[ks].w); }
    }
#pragma unroll
    for (int ks = 0; ks < 4; ++ks)
        xf[ks] = pack8(sum[ks][0] * icnt - bflo(cur[ks].x), sum[ks][1] * icnt - bfhi(cur[ks].x), sum[ks][2] * icnt - bflo(cur[ks].y), sum[ks][3] * icnt - bfhi(cur[ks].y),
                       sum[ks][4] * icnt - bflo(cur[ks].z), sum[ks][5] * icnt - bfhi(cur[ks].z), sum[ks][6] * icnt - bflo(cur[ks].w), sum[ks][7] * icnt - bfhi(cur[ks].w));
}
DI void pool_task(const Params& p, const Ctx& c, int l, int wt) {
    const int lane = c.lane, r32 = lane & 31, hi = lane >> 5;
    const int g = (wt + (wt >> 11)) & 3, rt = wt >> 2;
    const size_t row = (size_t)rt * 32 + r32; const int t = (int)(row & (SEQ - 1));
    const int w = 2 << g, cnt = (t + 1 < w) ? t + 1 : w; const float icnt = 1.f / (float)cnt;
    const bf16_t* z = wsb(c, OFF_Z);
    bf16x8 xf[4];
    const bf16_t* bp0 = ZP(z, row, ZPB + g * 64) + 8 * hi;
    pool_x(bp0, w, cnt, icnt, xf);
    const float* pw = p.in[I_POOLW] + ((size_t)l * 4 + g) * 64 * 64;
    const float* psc = p.in[I_POOLS] + l * 256 + g * 64;
#pragma unroll 1
    for (int dt = 0; dt < 2; ++dt) {
        f32x16 acc;
#pragma unroll
        for (int i = 0; i < 16; ++i) acc[i] = 0.f;
#pragma unroll
        for (int ks = 0; ks < 4; ++ks) {
            const float* wp = pw + (size_t)(16 * ks + 8 * hi) * 64 + 32 * dt + r32;
            const bf16x8 wf = pack8(wp[0], wp[64], wp[128], wp[192], wp[256], wp[320], wp[384], wp[448]);
            acc = MFMA32(wf, xf[ks], acc);
        }
#pragma unroll
        for (int gq = 0; gq < 4; ++gq) { const int dd = 32 * dt + 8 * gq + 4 * hi; const f32x4 sc = *(const f32x4*)(psc + dd);
            u32x2 wv; wv.x = cvtpk(acc[4 * gq] * sc[0], acc[4 * gq + 1] * sc[1]); wv.y = cvtpk(acc[4 * gq + 2] * sc[2], acc[4 * gq + 3] * sc[3]); YIMG_STORE(c, row, 256 + g * 64 + dd, wv); }
    }
}

DI float scan_add(float v, int lane) {
#pragma unroll
    for (int o = 1; o < 64; o <<= 1) { const float n = __shfl_up(v, o); if (lane >= o) v += n; }
    return v;
}
DI float scan_max(float v, int lane) {
#pragma unroll
    for (int o = 1; o < 64; o <<= 1) { const float n = __shfl_up(v, o); if (lane >= o) v = fmaxf(v, n); }
    return v;
}
DI float log_sigmoid(float x) { return fminf(x, 0.f) - log1pf(expf(-fabsf(x))); }
DI void conv8(const bf16_t* zp, int t, const float* cw, const float* cb, float scale, float (&o)[8]) {
    const f32x4 b0 = *(const f32x4*)cb, b1 = *(const f32x4*)(cb + 4);
    o[0] = b0[0]; o[1] = b0[1]; o[2] = b0[2]; o[3] = b0[3]; o[4] = b1[0]; o[5] = b1[1]; o[6] = b1[2]; o[7] = b1[3];
#pragma unroll
    for (int tap = 0; tap < 4; ++tap) {
        if (t - 3 + tap >= 0) {
            const u32x4 v = *(const u32x4*)(zp - (size_t)(3 - tap) * ZS);
            const f32x4 w0 = *(const f32x4*)(cw + tap * 512), w1 = *(const f32x4*)(cw + tap * 512 + 4);
            o[0] += bflo(v.x) * w0[0]; o[1] += bfhi(v.x) * w0[1]; o[2] += bflo(v.y) * w0[2]; o[3] += bfhi(v.y) * w0[3];
            o[4] += bflo(v.z) * w1[0]; o[5] += bfhi(v.z) * w1[1]; o[6] += bflo(v.w) * w1[2]; o[7] += bfhi(v.w) * w1[3];
        }
    }
#pragma unroll
    for (int e = 0; e < 8; ++e) o[e] = silu_f(o[e]) * scale;
    asm volatile("" ::: "memory");
}
DI void conv_frag4(const bf16_t* zp, int t, const LAS float* cw, const LAS float* cb, int hi, float scale, bf16x8 (&out)[4]) {
    asm volatile("" ::: "memory");
#pragma unroll
    for (int kh = 0; kh < 2; ++kh) {
        u32x4 v[2][4];
#pragma unroll
        for (int k2 = 0; k2 < 2; ++k2)
#pragma unroll
            for (int tap = 0; tap < 4; ++tap) { v[k2][tap] = (u32x4){0u, 0u, 0u, 0u}; if (t - 3 + tap >= 0) v[k2][tap] = *(const u32x4*)(zp + 16 * (2 * kh + k2) - (size_t)(3 - tap) * ZS); }
#pragma unroll
        for (int k2 = 0; k2 < 2; ++k2) {
            const int ks = 2 * kh + k2, d0 = 16 * ks + 8 * hi;
            const f32x4 b0 = *(const LAS f32x4*)(cb + d0), b1 = *(const LAS f32x4*)(cb + d0 + 4);
            float o[8] = {b0[0], b0[1], b0[2], b0[3], b1[0], b1[1], b1[2], b1[3]};
#pragma unroll
            for (int tap = 0; tap < 4; ++tap) {
                const f32x4 w0 = *(const LAS f32x4*)(cw + tap * 64 + d0), w1 = *(const LAS f32x4*)(cw + tap * 64 + d0 + 4); const u32x4 x = v[k2][tap];
                o[0] += bflo(x.x) * w0[0]; o[1] += bfhi(x.x) * w0[1]; o[2] += bflo(x.y) * w0[2]; o[3] += bfhi(x.y) * w0[3];
                o[4] += bflo(x.z) * w1[0]; o[5] += bfhi(x.z) * w1[1]; o[6] += bflo(x.w) * w1[2]; o[7] += bfhi(x.w) * w1[3];
            }
            out[ks] = pack8(silu_f(o[0]) * scale, silu_f(o[1]) * scale, silu_f(o[2]) * scale, silu_f(o[3]) * scale, silu_f(o[4]) * scale, silu_f(o[5]) * scale, silu_f(o[6]) * scale, silu_f(o[7]) * scale);
        }
        asm volatile("" ::: "memory");
    }
}
DI void mlstm_a_task(const Params& p, const Ctx& c, int l, int task) {
    const int lane = c.lane, r32 = lane & 31, hi = lane >> 5;
    const int bh = task >> 6, ch = task & 63, b = bh >> 2, h = bh & 3, t0 = ch * 64;
    const size_t rowbase = (size_t)b * SEQ;
    const bf16_t* z = wsb(c, OFF_Z);
    const float* gates = wsf(c, OFF_GATES) + (rowbase + t0 + lane) * 8;
    const float* gb = p.in[I_GATEB] + l * 8;
    const float ig = gates[h] + gb[h], lf = log_sigmoid(gates[4 + h] + gb[4 + h]);
    const float bcs = scan_add(lf, lane);
    const float gp = ig - bcs;
    const float mu = wave_max(gp);
    const float ws_ = expf(gp - mu);
    const float Bc = __shfl(bcs, 63);
    if (lane == 0) { wsf(c, OFF_SCAL)[task] = Bc; wsf(c, OFF_SCAL)[4096 + task] = mu; }
    const float* cwl = p.in[I_CONVW] + (size_t)l * 4 * 512; const float* cbl = p.in[I_CONVB] + l * 512;
    f32x16 acc[2][2];
#pragma unroll
    for (int a = 0; a < 2; ++a)
#pragma unroll
        for (int bb = 0; bb < 2; ++bb)
#pragma unroll
            for (int i = 0; i < 16; ++i) acc[a][bb][i] = 0.f;
    float nsum[2] = {0.f, 0.f};
#pragma unroll
    for (int ks = 0; ks < 4; ++ks) {
        const int s0 = 16 * ks + 8 * hi;
        float wv[8];
#pragma unroll
        for (int j = 0; j < 8; ++j) wv[j] = __shfl(ws_, s0 + j);
        bf16x8 kf[2];
#pragma unroll
        for (int it = 0; it < 2; ++it) {
            const int chn = 256 + h * 64 + 32 * it + r32;
            const float w0 = cwl[chn], w1 = cwl[512 + chn], w2 = cwl[1024 + chn], w3 = cwl[1536 + chn], cb = cbl[chn];
            const bf16_t* kp = ZP(z, rowbase + t0 + s0, ZKA + h * 64) + 32 * it + r32;
            float raw[11];
#pragma unroll
            for (int x = 0; x < 11; ++x) raw[x] = (t0 + s0 - 3 + x >= 0) ? bf2f(kp[(long)(x - 3) * ZS]) : 0.f;
            float kk[8];
#pragma unroll
            for (int j = 0; j < 8; ++j) { const float o = cb + w0 * raw[j] + w1 * raw[j + 1] + w2 * raw[j + 2] + w3 * raw[j + 3]; kk[j] = silu_f(o) * 0.125f * wv[j]; nsum[it] += kk[j]; }
            kf[it] = pack8(kk[0], kk[1], kk[2], kk[3], kk[4], kk[5], kk[6], kk[7]);
        }
#pragma unroll
        for (int et = 0; et < 2; ++et) {
            const bf16_t* vp = ZP(z, rowbase + t0 + s0, ZVA + h * 64) + 32 * et + r32;
            u32x4 w; w.x = (unsigned)vp[0] | ((unsigned)vp[ZS] << 16); w.y = (unsigned)vp[2 * ZS] | ((unsigned)vp[3 * ZS] << 16);
            w.z = (unsigned)vp[4 * ZS] | ((unsigned)vp[5 * ZS] << 16); w.w = (unsigned)vp[6 * ZS] | ((unsigned)vp[7 * ZS] << 16);
            const bf16x8 vf = __builtin_bit_cast(bf16x8, w);
            acc[et][0] = MFMA32(vf, kf[0], acc[et][0]); acc[et][1] = MFMA32(vf, kf[1], acc[et][1]);
        }
    }
    float* D = ((float*)c.out) + (size_t)task * 4096;
#pragma unroll
    for (int et = 0; et < 2; ++et)
#pragma unroll
        for (int it = 0; it < 2; ++it)
#pragma unroll
            for (int i = 0; i < 16; ++i) D[(32 * et + crow(i, hi)) * 64 + 32 * it + r32] = acc[et][it][i];
    nsum[0] += __shfl_xor(nsum[0], 32); nsum[1] += __shfl_xor(nsum[1], 32);
    if (hi == 0) { wsf(c, OFF_NST)[(size_t)task * 64 + r32] = nsum[0]; wsf(c, OFF_NST)[(size_t)task * 64 + 32 + r32] = nsum[1]; }
}
DI void mlstm_scan(const Params& p, const Ctx& c) {
    const float* Bc = wsf(c, OFF_SCAL); const float* mu = Bc + 4096; float* mprev = wsf(c, OFF_SCAL) + 8192;
    float* D = ((float*)c.out); float* N = wsf(c, OFF_NST);
    LAS float* cwl = (LAS float*)c.lds; LAS float* swl = cwl + 64;
    for (int task = c.bid; task < 256; task += c.G) {
        const int bh = task >> 2, q = task & 3;
        __syncthreads();
        if (c.wid == 0) {
            const float B = Bc[bh * 64 + c.lane], u = mu[bh * 64 + c.lane];
            float m = 0.f, mycw = 0.f, mysw = 0.f, mymp = 0.f;
            for (int ch = 0; ch < 64; ++ch) {
                const float Bs = __shfl(B, ch), us = __shfl(u, ch);
                const float mnew = fmaxf(Bs + m, Bs + us);
                const float cw = expf(Bs + m - mnew), sw = expf(Bs + us - mnew);
                if (c.lane == ch) { mycw = cw; mysw = sw; mymp = m; }
                m = mnew;
            }
            cwl[c.lane] = mycw; swl[c.lane] = mysw;
            if (q == 0) mprev[bh * 64 + c.lane] = mymp;
        }
        __syncthreads();
        for (int idx = q * 1040 + c.tid; idx < (q + 1) * 1040; idx += 512) {
            float* base = idx < 4096 ? D + (size_t)bh * 64 * 4096 + idx : N + (size_t)bh * 64 * 64 + (idx - 4096);
            const size_t stride = idx < 4096 ? 4096 : 64;
            float d[64];
#pragma unroll
            for (int ch = 0; ch < 64; ++ch) d[ch] = base[(size_t)ch * stride];
            float C = 0.f;
#pragma unroll
            for (int ch = 0; ch < 64; ++ch) { const float dv = d[ch]; base[(size_t)ch * stride] = C; C = cwl[ch] * C + swl[ch] * dv; }
        }
    }
}
DI void mlstm_c_task(const Params& p, const Ctx& c, int l, int task) {
    const int lane = c.lane, r32 = lane & 31, hi = lane >> 5;
    const int bh = task >> 6, ch = task & 63, b = bh >> 2, h = bh & 3, t0 = ch * 64;
    const size_t rowbase = (size_t)b * SEQ;
    const bf16_t* z = wsb(c, OFF_Z);
    const float* gates = wsf(c, OFF_GATES) + (rowbase + t0 + lane) * 8;
    const float* gb = p.in[I_GATEB] + l * 8;
    const float ig = gates[h] + gb[h], lf = log_sigmoid(gates[4 + h] + gb[4 + h]);
    const float bcs = scan_add(lf, lane);
    const float gp = ig - bcs;
    const float mp = wsf(c, OFF_SCAL)[8192 + task];
    const float pm = scan_max(gp, lane);
    const float mt = bcs + fmaxf(mp, pm);
    const float bm = bcs - mt;
    const float iw = expf(bcs + mp - mt);
    const float flo = expf(-mt);
    const float* cwl = p.in[I_CONVW] + (size_t)l * 4 * 512; const float* cbl = p.in[I_CONVB] + l * 512;
    const float* Ct = ((float*)c.out) + (size_t)task * 4096;
    const float* nst = wsf(c, OFF_NST) + (size_t)task * 64;
    const float* ng = p.in[I_MLN] + l * 256 + h * 64;
#pragma unroll 1
    for (int tt = 0; tt < 2; ++tt) {
        const int tq = 32 * tt + r32;
        const float bm_t = __shfl(bm, tq), iw_t = __shfl(iw, tq), flo_t = __shfl(flo, tq);
        bf16x8 qf[4]; float qn = 0.f;
#pragma unroll
        for (int ks = 0; ks < 4; ++ks) { float o[8]; const int d0 = 16 * ks + 8 * hi;
            conv8(ZP(z, rowbase + t0 + tq, ZQA + h * 64) + d0, t0 + tq, cwl + h * 64 + d0, cbl + h * 64 + d0, 1.f, o);
            qf[ks] = pack8(o[0], o[1], o[2], o[3], o[4], o[5], o[6], o[7]);
            const u32x4 qw = __builtin_bit_cast(u32x4, qf[ks]);
            const f32x4 n0 = *(const f32x4*)(nst + d0), n1 = *(const f32x4*)(nst + d0 + 4);
            qn += bflo(qw.x) * n0[0] + bfhi(qw.x) * n0[1] + bflo(qw.y) * n0[2] + bfhi(qw.y) * n0[3] + bflo(qw.z) * n1[0] + bfhi(qw.z) * n1[1] + bflo(qw.w) * n1[2] + bfhi(qw.w) * n1[3]; }
        qn += __shfl_xor(qn, 32);
        f32x16 num[2];
#pragma unroll
        for (int i = 0; i < 16; ++i) { num[0][i] = 0.f; num[1][i] = 0.f; }
#pragma unroll
        for (int et = 0; et < 2; ++et)
#pragma unroll
            for (int ks = 0; ks < 4; ++ks) { const float* cp = Ct + (size_t)(32 * et + r32) * 64 + 16 * ks + 8 * hi; const f32x4 c0 = *(const f32x4*)cp, c1 = *(const f32x4*)(cp + 4);
                num[et] = MFMA32(pack8(c0[0], c0[1], c0[2], c0[3], c1[0], c1[1], c1[2], c1[3]), qf[ks], num[et]); }
#pragma unroll
        for (int i = 0; i < 16; ++i) { num[0][i] *= iw_t; num[1][i] *= iw_t; }
        float dsum = 0.f;
#pragma unroll 1
        for (int st = 0; st <= tt; ++st) {
            f32x16 s;
#pragma unroll
            for (int i = 0; i < 16; ++i) s[i] = 0.f;
#pragma unroll
            for (int ks = 0; ks < 4; ++ks) { float o[8]; const int sk = 32 * st + r32, d0 = 16 * ks + 8 * hi;
                conv8(ZP(z, rowbase + t0 + sk, ZKA + h * 64) + d0, t0 + sk, cwl + 256 + h * 64 + d0, cbl + 256 + h * 64 + d0, 0.125f, o);
                s = MFMA32(pack8(o[0], o[1], o[2], o[3], o[4], o[5], o[6], o[7]), qf[ks], s); }
#pragma unroll
            for (int i = 0; i < 16; ++i) { const int sp = 32 * st + crow(i, hi); const float gs = __shfl(gp, sp);
                const float wgt = (sp <= tq) ? expf(gs + bm_t) : 0.f; s[i] *= wgt; dsum += s[i]; }
            const bf16x8 p0 = pack8(s[0], s[1], s[2], s[3], s[4], s[5], s[6], s[7]), p1 = pack8(s[8], s[9], s[10], s[11], s[12], s[13], s[14], s[15]);
#pragma unroll
            for (int et = 0; et < 2; ++et)
#pragma unroll
                for (int k2 = 0; k2 < 2; ++k2) {
                    const bf16_t* vp = ZP(z, rowbase + t0 + 32 * st + 16 * k2 + 4 * hi, ZVA + h * 64) + 32 * et + r32;
                    u32x4 w; w.x = (unsigned)vp[0] | ((unsigned)vp[ZS] << 16); w.y = (unsigned)vp[2 * ZS] | ((unsigned)vp[3 * ZS] << 16);
                    w.z = (unsigned)vp[8 * ZS] | ((unsigned)vp[9 * ZS] << 16); w.w = (unsigned)vp[10 * ZS] | ((unsigned)vp[11 * ZS] << 16);
                    num[et] = MFMA32(__builtin_bit_cast(bf16x8, w), k2 == 0 ? p0 : p1, num[et]);
                }
        }
        dsum += __shfl_xor(dsum, 32);
        const float den = iw_t * qn + dsum;
        const float idn = 1.f / fmaxf(fabsf(den), flo_t);
        float sm = 0.f;
#pragma unroll
        for (int et = 0; et < 2; ++et)
#pragma unroll
            for (int i = 0; i < 16; ++i) { const float hv = num[et][i] * idn; num[et][i] = hv; sm += hv; }
        sm += __shfl_xor(sm, 32);
        const float mean = sm * (1.f / 64.f);
        float vs = 0.f;
#pragma unroll
        for (int et = 0; et < 2; ++et)
#pragma unroll
            for (int i = 0; i < 16; ++i) { const float d = num[et][i] - mean; num[et][i] = d; vs += d * d; }
        vs += __shfl_xor(vs, 32);
        const float rstd = rsqrtf(vs * (1.f / 64.f) + 1e-6f);
        const size_t tok = rowbase + t0 + tq;
        const bf16_t* orow = ZP(z, tok, ZOA + h * 64);
#pragma unroll
        for (int et = 0; et < 2; ++et)
#pragma unroll
            for (int g = 0; g < 4; ++g) { const int e = 32 * et + 8 * g + 4 * hi; const f32x4 gg = *(const f32x4*)(ng + e); const u32x2 ov = *(const u32x2*)(orow + e);
                const float y0 = num[et][4 * g] * rstd * gg[0] * sigmoid_f(bflo(ov.x)), y1 = num[et][4 * g + 1] * rstd * gg[1] * sigmoid_f(bfhi(ov.x));
                const float y2 = num[et][4 * g + 2] * rstd * gg[2] * sigmoid_f(bflo(ov.y)), y3 = num[et][4 * g + 3] * rstd * gg[3] * sigmoid_f(bfhi(ov.y));
                u32x2 w; w.x = cvtpk(y0, y1); w.y = cvtpk(y2, y3); YIMG_STORE(c, tok, h * 64 + e, w); }
    }
}

DI void ph_mix1(const Params& p, const Ctx& c0, int l) {
    const Ctx c = fresh(c0);
    REP(R_DIFF) for (int pt = c.bid; pt < 512; pt += c.G) { const int bh = pt >> 3, s = pt & 7; diff_attn_task(p, c, l, bh >> 2, bh & 3, 15 - s); diff_attn_task(p, c, l, bh >> 2, bh & 3, s); }
    REP(R_DIL) for (int i = c.bid; i < 1024; i += c.G) { const int bh = i >> 4, rest = i & 15; dil_attn_task(p, c, 1, bh >> 2, bh & 3, rest >> 2, rest & 3); }
    REP(R_DIL) for (int i = c.bid; i < 1024; i += c.G) { const int bh = i >> 4; dil_attn_task(p, c, 2, bh >> 2, bh & 3, i & 15, 0); }
    __syncthreads();
    REP(R_POOL) for (int wt = c.bid * 8 + c.wid; wt < 8192; wt += c.G * 8) pool_task(p, c, l, wt);
    REP(R_MLA) for (int tk = c.bid * 8 + c.wid; tk < 4096; tk += c.G * 8) mlstm_a_task(p, c, l, tk);
}
DI void ph_mix2(const Params& p, const Ctx& c0, int l) {
    const Ctx c = fresh(c0);
    mlstm_scan(p, c);
    REP(R_DIL) for (int i = c.bid; i < 1024; i += c.G) { const int bh = i >> 4; dil_attn_task(p, c, 0, bh >> 2, bh & 3, 0, i & 15); }
    __syncthreads();
}
DI void ph_mix3(const Params& p, const Ctx& c0, int l) {
    const Ctx c = fresh(c0);
    REP(R_MLC) for (int tk = c.bid * 8 + c.wid; tk < 4096; tk += c.G * 8) mlstm_c_task(p, c, l, tk);
}
DI void ph_final(const Params& p, const Ctx& c0) {
    const Ctx c = fresh(c0);
    const float* ss = ssbuf(c, 16); const float* g = p.in[I_FINN]; const bf16_t* hb = wsb(c, OFF_HB);
    for (int row = c.bid * 8 + c.wid; row < MTOK; row += c.G * 8) {
        const float rs = rowss(ss, row);
        f32x4* xr = (f32x4*)(c.out + (size_t)row * DM) + c.lane; const f32x4* gr = (const f32x4*)g + c.lane; const unsigned char* hbimg = (const unsigned char*)hb;
#pragma unroll
        for (int j = 0; j < 4; ++j) { const u32x2 hv = *(const u32x2*)(hbimg + pg8::img_off(row, 4 * (c.lane + 64 * j))); const f32x4 gg = gr[64 * j];
            xr[64 * j] = (f32x4){bflo(hv.x) * rs * gg[0], bfhi(hv.x) * rs * gg[1], bflo(hv.y) * rs * gg[2], bfhi(hv.y) * rs * gg[3]}; }
    }
}

DI void ph_ffn_up(const Params& p, const Ctx& c0, int l, int which) {
    const Ctx c = fresh(c0);
    pg8::Gemm g = pg8::plain_gemm(wsb(c, OFF_HB), (const bf16_t*)(c.ws + (size_t)l * W_LAYER + (which ? W_GU2 : W_GU1)), MTOK, 2 * FF, DM); g.ocol_step = 128; pg8::use_img_b(g); pg8::use_img_a(g);
    pg8::Order S; S.init(g, c.G, c.bid);
    pg8::EpiSwiGLU E{wsb(c, OFF_Z), FF, ssbuf(c, 4 * l + (which ? 3 : 0))};
    pg8::gemm_phase(c.lds, g, S, E);
}
DI void ph_resid(const Params& p, const Ctx& c0, const bf16_t* A, const bf16_t* Bt, int K, int ss_out, float alpha) {
    const Ctx c = fresh(c0);
    pg8::Gemm g = pg8::plain_gemm(A, Bt, MTOK, DM, K);
    pg8::use_img_a(g); pg8::use_img_b(g); if (K == FF) g.a_pmdiv = (long)(FF / 64) * 256 * 64;
    pg8::Order S; S.init(g, c.G, c.bid);
    pg8::EpiResid E{wsb(c, OFF_HB), ssbuf(c, ss_out), alpha};
    pg8::gemm_phase(c.lds, g, S, E);
}
DI void ph_kv(const Params& p, const Ctx& c0) {
    const Ctx c = fresh(c0);
    { pg8::Gemm g = pg8::plain_gemm(wsb(c, OFF_MEMB), wsb(c, OFF_WK), MMEM, 4096, DM); pg8::Order S; S.init(g, c.G, c.bid);
      pg8::EpiBf16 E{wsb(c, OFF_KB), 4096, nullptr, wsf(c, OFF_RSM), nullptr, 1.f, 0}; pg8::gemm_phase(c.lds, g, S, E); }
    { pg8::Gemm g = pg8::plain_gemm(wsb(c, OFF_MEMB), wsb(c, OFF_WV), MMEM, 4096, DM); pg8::Order S; S.init(g, c.G, c.bid);
      pg8::EpiBf16 E{wsb(c, OFF_VT), 4096, nullptr, wsf(c, OFF_RSM), nullptr, 1.f, 0}; pg8::gemm_phase(c.lds, g, S, E); }
}
DI void ph_win(const Params& p, const Ctx& c0, int l) {
    const Ctx c = fresh(c0);
    pg8::Gemm g = pg8::plain_gemm(wsb(c, OFF_HB), (const bf16_t*)(c.ws + (size_t)l * W_LAYER + W_IN), MTOK, 3072, DM); pg8::use_img_b(g); pg8::use_img_a(g);
    pg8::Order S; S.init(g, c.G, c.bid);
    pg8::EpiZ E{wsb(c, OFF_Z), wsf(c, OFF_GATES), ssbuf(c, 4 * l + 1)};
    pg8::gemm_phase(c.lds, g, S, E);
}
constexpr size_t OFF_MT = OFF_Z, OFF_VWT = OFF_Z + (size_t)16384 * DM * 2;
DI void ph_xpre(const Params& p, const Ctx& c0, int l) {
    const Ctx c = fresh(c0);
    const unsigned char* wl = c.ws + (size_t)l * W_LAYER;
    { pg8::Gemm g; g.A = wsb(c, OFF_KB) + l * 1024; g.B = (const bf16_t*)(wl + W_Q); g.lda = 4096; g.ldb = DM; g.K = 256; g.nM = 64; g.nN = 4;
      g.div = 4; g.a_pmdiv = 256L * 4096; g.a_pmmod = 256; g.a_pn = 0; g.b_pmdiv = 0; g.b_pmmod = 256; g.b_pn = 256L * DM; g.ocol_step = 256; g.kstepA = 128; g.kstepB = 128; g.imgA = 0; g.imgB = 0;
      pg8::Order S; S.init(g, c.G, c.bid);
      pg8::EpiBf16 E{wsb(c, OFF_MT), DM, nullptr, nullptr, nullptr, 1.f, 0}; pg8::gemm_phase(c.lds, g, S, E); }
    { pg8::Gemm g; g.A = (const bf16_t*)(wl + W_O); g.B = wsb(c, OFF_VT) + l * 1024; g.lda = DM; g.ldb = 4096; g.K = 256; g.nM = 64; g.nN = 4;
      g.div = 4; g.a_pmdiv = 0; g.a_pmmod = 256L * DM; g.a_pn = 256; g.b_pmdiv = 256L * 4096; g.b_pmmod = 0; g.b_pn = 256; g.ocol_step = 256; g.kstepA = 128; g.kstepB = 128; g.imgA = 0; g.imgB = 0;
      pg8::Order S; S.init(g, c.G, c.bid);
      pg8::EpiBf16 E{wsb(c, OFF_VWT), DM, nullptr, nullptr, nullptr, 1.f, 0}; pg8::gemm_phase(c.lds, g, S, E); }
}
DI void ph_xs(const Params& p, const Ctx& c0, int l) {
    const Ctx c = fresh(c0);
    pg8::Gemm g; g.A = wsb(c, OFF_HB); g.B = wsb(c, OFF_MT); g.lda = DM; g.ldb = DM; g.K = DM; g.nM = MTOK / 256; g.nN = 4;
    g.div = 16; g.a_pmdiv = 16L * 256 * DM; g.a_pmmod = 256L * DM; g.a_pn = 0; g.b_pmdiv = 4L * 256 * DM; g.b_pmmod = 0; g.b_pn = 256L * DM; g.ocol_step = 256; g.kstepA = 128; g.kstepB = 128; g.imgA = 0; g.imgB = 0; pg8::use_img_a(g);
    pg8::Order S; S.init(g, c.G, c.bid);
    pg8::EpiSoftmax E{wsb(c, OFF_Y), DM, (LAS float*)(c.lds + LDS_EXTRA), ssbuf(c, 4 * l + 2), 0.0625f * LOG2E};
    pg8::gemm_phase(c.lds, g, S, E);
}
DI void ph_xo(const Params& p, const Ctx& c0, int l) {
    const Ctx c = fresh(c0);
    pg8::Gemm g; g.A = wsb(c, OFF_Y); g.B = wsb(c, OFF_VWT); g.lda = DM; g.ldb = DM; g.K = DM; g.nM = MTOK / 256; g.nN = 4;
    g.div = 16; g.a_pmdiv = 16L * 256 * DM; g.a_pmmod = 256L * DM; g.a_pn = 0; g.b_pmdiv = 1024L * DM; g.b_pmmod = 0; g.b_pn = 256L * DM; g.ocol_step = 256; g.kstepA = 128; g.kstepB = 128; g.imgA = 0; g.imgB = 0; pg8::use_img_a(g);
    pg8::Order S; S.init(g, c.G, c.bid);
    pg8::EpiResid E{wsb(c, OFF_HB), ssbuf(c, 4 * l + 3), 1.f};
    pg8::gemm_phase(c.lds, g, S, E);
}

constexpr int PH_PER_LAYER = 11, PH_FINAL = 1 + PH_PER_LAYER * DEPTH, PH_TOTAL = PH_FINAL + 1;
__global__ void __launch_bounds__(512, 2) mega_fwd(Params pk) {
    extern __shared__ __attribute__((aligned(16))) unsigned char lds_raw[];
    volatile LAS unsigned* bst = (volatile LAS unsigned*)((LAS unsigned char*)lds_raw + LDS_EXTRA + 12288);
    XcdBarrier xbar; xbar.bar = (unsigned*)(pk.ws + OFF_CTL); xbar.x = 0; xbar.st = bst;
    if (pk.coop) { if (threadIdx.x < 4) bst[threadIdx.x] = 0u; __syncthreads(); xbar = xcd_barrier_post((unsigned*)(pk.ws + OFF_CTL), bst); }
    for (int ph = pk.ph_lo; ph < pk.ph_hi; ++ph) {
        int tid = threadIdx.x; asm volatile("" : "+v"(tid));
        const Params& p = pk;
        Ctx c; c.lds = (LAS unsigned char*)lds_raw; c.ldsg = lds_raw; c.tid = tid; c.lane = tid & 63; c.wid = __builtin_amdgcn_readfirstlane(tid >> 6);
        c.bid = blockIdx.x; c.G = gridDim.x; c.ws = pk.ws; c.out = pk.out;
        asm volatile("" : "+s"(c.ws)); asm volatile("" : "+s"(c.out));
        if (ph == 0) {
#ifndef NO_PRO
            REP(R_PRO) ph_prologue(p, c);
#endif
        }
        else if (ph == PH_FINAL) ph_final(p, c);
        else {
            const int l = (ph - 1) / PH_PER_LAYER, j = (ph - 1) % PH_PER_LAYER;
            const unsigned char* wl = c.ws + (size_t)l * W_LAYER;
#ifdef ONLY_CASE
            if (j != ONLY_CASE) continue;
#endif
            switch (j) {
                case 0: REP(R_UP) ph_ffn_up(p, c, l, 0); if (l == 0) ph_kv(p, c); break;
                case 1: ph_resid(p, c, wsb(c, OFF_Z), (const bf16_t*)(wl + W_D1), FF, 4 * l + 1, 0.5f); break;
                case 2: ph_win(p, c, l); break;
                case 3:
#ifndef NO_MIX1
                    ph_mix1(p, c, l);
#endif
                    break;
                case 4:
#ifndef NO_MIX2
                    ph_mix2(p, c, l);
#endif
                    break;
                case 5:
#ifndef NO_MIX3
                    ph_mix3(p, c, l);
#endif
                    break;
                case 6: ph_resid(p, c, wsb(c, OFF_Y), (const bf16_t*)(wl + W_OUT), DM, 4 * l + 2, 1.f); ph_xpre(p, c, l); break;
                case 7: ph_xs(p, c, l); break;
                case 8: ph_xo(p, c, l); break;
                case 9: ph_ffn_up(p, c, l, 1); break;
                default: ph_resid(p, c, wsb(c, OFF_Z), (const bf16_t*)(wl + W_D2), FF, 4 * l + 4, 0.5f); break;
            }
        }
        if (ph + 1 < pk.ph_hi && pk.coop) { if (ph == pk.ph_lo) cg::this_grid().sync(); else xcd_barrier(xbar); }
    }
}

extern "C" void kernel_launch(void* const* d_in, const int* in_sizes, int n_in, void* d_out, int out_size, void* d_ws, size_t ws_size, hipStream_t stream) {
    static int grid = 0;
    if (grid == 0) {
        if (n_in != 28 || out_size != MTOK * DM || ws_size < OFF_END) { fprintf(stderr, "kernel_launch: unexpected shapes (n_in %d out %d ws %zu)\n", n_in, out_size, ws_size); grid = -1; return; }
        int dev = 0, cus = 0, per_cu = 0;
        (void)hipGetDevice(&dev); (void)hipDeviceGetAttribute(&cus, hipDeviceAttributeMultiprocessorCount, dev);
        if (hipFuncSetAttribute((const void*)mega_fwd, hipFuncAttributeMaxDynamicSharedMemorySize, LDS_BYTES) != hipSuccess) { fprintf(stderr, "kernel_launch: hipFuncSetAttribute failed\n"); grid = -1; return; }
        if (hipOccupancyMaxActiveBlocksPerMultiprocessor(&per_cu, (const void*)mega_fwd, 512, LDS_BYTES) != hipSuccess || per_cu < 1) { fprintf(stderr, "kernel_launch: occupancy query says %d\n", per_cu); per_cu = 1; }
        (void)hipGetLastError();
        grid = cus * per_cu;
    }
    if (grid < 0) return;
    Params p{};
    for (int i = 0; i < 28; ++i) p.in[i] = (const float*)d_in[i];
    p.out = (float*)d_out; p.ws = (unsigned char*)d_ws; p.pad = 0;
    (void)hipMemsetAsync((unsigned char*)d_ws + OFF_CTL, 0, CTL_BYTES, stream);
#if MK_MULTI
    for (int ph = 0; ph < PH_TOTAL; ++ph) { p.ph_lo = ph; p.ph_hi = ph + 1; p.coop = 0; hipLaunchKernelGGL(mega_fwd, dim3(grid), dim3(512), LDS_BYTES, stream, p); }
#else
    p.ph_lo = 0; p.ph_hi = PH_TOTAL; p.coop = 1;
    void* args[] = {&p};
    hipError_t e = hipLaunchCooperativeKernel((const void*)mega_fwd, dim3(grid), dim3(512), args, LDS_BYTES, stream);
    if (e != hipSuccess) fprintf(stderr, "cooperative launch failed: %s (grid %d)\n", hipGetErrorString(e), grid);
#endif
}
```

```cpp
#include <hip/hip_runtime.h>
#include <hip/hip_cooperative_groups.h>
#include <cstdio>
#include <cstdint>
namespace cg = cooperative_groups;

#ifndef MK_MULTI
#define MK_MULTI 0
#endif

#ifndef R_DIFF
#define R_DIFF 1
#endif
#ifndef R_DIL
#define R_DIL 1
#endif
#ifndef R_POOL
#define R_POOL 1
#endif
#ifndef R_MLA
#define R_MLA 1
#endif
#ifndef R_MLC
#define R_MLC 1
#endif
#ifndef R_UP
#define R_UP 1
#endif
#ifndef R_WIN
#define R_WIN 1
#endif
#ifndef R_GATES
#define R_GATES 1
#endif
#ifndef R_PRO
#define R_PRO 1
#endif
#ifndef R_RES1
#define R_RES1 1
#endif
#ifndef R_RES6
#define R_RES6 1
#endif
#ifndef R_WQ
#define R_WQ 1
#endif
#define REP(n) for (int rep_ = 0; rep_ < (n); ++rep_)
#define DI __device__ __forceinline__
#define LAS __attribute__((address_space(3)))
typedef unsigned short bf16_t;
typedef short bf16x8 __attribute__((ext_vector_type(8)));
typedef float f32x4 __attribute__((ext_vector_type(4)));
typedef float f32x16 __attribute__((ext_vector_type(16)));
typedef unsigned u32x4 __attribute__((ext_vector_type(4)));
typedef unsigned u32x2 __attribute__((ext_vector_type(2)));
typedef float f32x2_t __attribute__((ext_vector_type(2)));
typedef __bf16 bf16x2_t __attribute__((ext_vector_type(2)));

constexpr int DM = 1024, NB = 16, SEQ = 4096, MTOK = NB * SEQ, DEPTH = 4, MEMLEN = 256, MMEM = NB * MEMLEN, FF = 2816, ZW = 2816, INW = 2824;
constexpr int ZQA = 0, ZKA = 256, ZVA = 512, ZOA = 768, ZPB = 1024, ZQC = 1280, ZKC = 1536, ZVC = 1792, ZQD = 2048, ZKD = 2304, ZVD = 2560;
constexpr float LOG2E = 1.4426950408889634f;
constexpr float NEGBIG = -1e30f;

constexpr size_t W_GU1 = 0, W_D1 = W_GU1 + (size_t)2 * FF * DM * 2, W_IN = W_D1 + (size_t)DM * FF * 2, W_OUT = W_IN + (size_t)3072 * DM * 2,
                 W_Q = W_OUT + (size_t)DM * DM * 2, W_O = W_Q + (size_t)DM * DM * 2, W_GU2 = W_O + (size_t)DM * DM * 2, W_D2 = W_GU2 + (size_t)2 * FF * DM * 2,
                 W_LAYER = W_D2 + (size_t)DM * FF * 2;
constexpr size_t OFF_WK = DEPTH * W_LAYER, OFF_WV = OFF_WK + (size_t)DEPTH * DM * DM * 2, OFF_HB = OFF_WV + (size_t)DEPTH * DM * DM * 2;
constexpr size_t OFF_DST = OFF_HB;
constexpr size_t OFF_OPART = OFF_HB + (size_t)64 * 64 * 4096 * 4;
constexpr size_t OFF_Z = OFF_HB + (size_t)MTOK * DM * 2;
constexpr size_t OFF_Y = OFF_Z + (size_t)MTOK * ZW * 2;
constexpr size_t OFF_KB = OFF_Y + (size_t)MTOK * DM * 2;
constexpr size_t OFF_VT = OFF_KB + (size_t)MMEM * 4096 * 2;
constexpr size_t OFF_MEMB = OFF_VT + (size_t)4096 * MMEM * 2;
constexpr size_t OFF_GATES = OFF_MEMB + (size_t)MMEM * DM * 2;
constexpr size_t OFF_SS = OFF_GATES + (size_t)MTOK * 8 * 4;
constexpr size_t OFF_LSEP = OFF_SS + (size_t)17 * MTOK * 16 * 4;
constexpr size_t OFF_NST = OFF_LSEP + (size_t)2 * MTOK * 4 * 4;
constexpr size_t OFF_SCAL = OFF_NST + (size_t)4096 * 64 * 4;
constexpr size_t OFF_DIFFB = OFF_SCAL + 65536;
constexpr size_t OFF_DILB = OFF_DIFFB + 65536;
constexpr size_t OFF_LAM = OFF_DILB + 8192;
constexpr size_t OFF_RSM = OFF_LAM + 256;
constexpr size_t OFF_CTL = OFF_RSM + 16384;
constexpr size_t CTL_BYTES = 16384;
constexpr size_t OFF_END = OFF_CTL + CTL_BYTES;
static_assert(OFF_OPART + (size_t)2 * MTOK * 256 * 2 <= OFF_Z, "alias map");
static_assert(OFF_END < (size_t)1073741824, "workspace");

constexpr int LDS_BYTES = 147456;
constexpr int LDS_EXTRA = 131072;

struct Params {
    const float* in[28];
    float* out;
    unsigned char* ws;
    int ph_lo, ph_hi, coop, pad;
};
enum { I_X = 0, I_MEM, I_T5, I_F1N, I_F1G, I_F1U, I_F1D, I_MIXN, I_WIN, I_CONVW, I_CONVB, I_GATEB, I_MLN, I_POOLW, I_POOLS, I_LAMV, I_SUBLN, I_WOUT,
       I_XN, I_MEMN, I_XWQ, I_XWKV, I_XWO, I_F2N, I_F2G, I_F2U, I_F2D, I_FINN };

DI unsigned cvtpk(float lo, float hi) { f32x2_t v = {lo, hi}; bf16x2_t b = __builtin_convertvector(v, bf16x2_t); return __builtin_bit_cast(unsigned, b); }
DI float bflo(unsigned w) { return __uint_as_float(w << 16); }
DI float bfhi(unsigned w) { return __uint_as_float(w & 0xffff0000u); }
DI float bf2f(bf16_t x) { return __uint_as_float((unsigned)x << 16); }
DI float ex2(float x) { return __builtin_amdgcn_exp2f(x); }
DI float rcpf_(float x) { return __builtin_amdgcn_rcpf(x); }
DI int crow(int i, int hi) { return (i & 3) + 8 * (i >> 2) + 4 * hi; }
DI float wave_sum(float v) {
#pragma unroll
    for (int o = 1; o < 64; o <<= 1) v += __shfl_xor(v, o);
    return v;
}
DI float wave_max(float v) {
#pragma unroll
    for (int o = 1; o < 64; o <<= 1) v = fmaxf(v, __shfl_xor(v, o));
    return v;
}
DI float silu_f(float g) { return g * rcpf_(1.f + ex2(-g * LOG2E)); }
DI float sigmoid_f(float g) { return rcpf_(1.f + ex2(-g * LOG2E)); }
#define LDS_WAIT() asm volatile("s_waitcnt lgkmcnt(0)" ::: "memory")
DI bf16x8 mk8(u32x2 lo, u32x2 hi) { u32x4 w = {lo.x, lo.y, hi.x, hi.y}; return __builtin_bit_cast(bf16x8, w); }
DI bf16x8 pack8(float a0, float a1, float a2, float a3, float a4, float a5, float a6, float a7) {
    u32x4 w = {cvtpk(a0, a1), cvtpk(a2, a3), cvtpk(a4, a5), cvtpk(a6, a7)}; return __builtin_bit_cast(bf16x8, w);
}
DI float rowss(const float* ss, int row) {
    const f32x4* q = (const f32x4*)(ss + (size_t)row * 16); const f32x4 a = q[0], b = q[1], c = q[2], d = q[3];
    const float t = ((a[0] + a[1]) + (a[2] + a[3])) + ((b[0] + b[1]) + (b[2] + b[3])) + ((c[0] + c[1]) + (c[2] + c[3])) + ((d[0] + d[1]) + (d[2] + d[3]));
    return rsqrtf(t * (1.f / 1024.f) + 1e-6f);
}
#define MFMA32(a, b, c) __builtin_amdgcn_mfma_f32_32x32x16_bf16((a), (b), (c), 0, 0, 0)

namespace pg8 {
constexpr int BM = 256, BK = 64, HALF = 128, HTB = HALF * BK * 2, STAGE_BYTES = 8 * HTB, NXCD = 8, WGM = 8;
DI int lds_byte(int r, int c) { const int st = (r >> 4) * 2 + (c >> 5), rr = r & 15, cc = c & 31, ob = rr * 64 + cc * 2; return st * 1024 + (ob ^ (((ob >> 9) & 1) << 5)); }
DI void stage_rc(int b, int& R, int& C) { const int st = b / 1024, sb = b % 1024, swz = sb ^ (((sb >> 9) & 1) << 5); R = (st >> 1) * 16 + swz / 64; C = (st & 1) * 32 + (swz % 64) / 2; }
DI int perm32(int rho) { const int n = rho >> 4, i = rho & 15; return 8 * (i >> 2) + 4 * n + (i & 3); }

DI size_t img_off(int row, int col) { return ((size_t)((row >> 8) * (DM / 64) + (col >> 6)) * 2 + ((row >> 7) & 1)) * 16384 + lds_byte(row & 127, col & 63); }
struct Unit { const char* a; const char* b; int orow, ocol, pm, pn; };
struct Gemm {
    const bf16_t* A; const bf16_t* B; int lda, ldb, K, nM, nN; long a_pmdiv, a_pmmod, a_pn, b_pmdiv, b_pmmod, b_pn; int div, ocol_step; int kstepA, kstepB;
    int imgB;
    int imgA;
};
DI Gemm plain_gemm(const bf16_t* A, const bf16_t* B, int Mrows, int N, int K) {
    Gemm g; g.A = A; g.B = B; g.lda = K; g.ldb = K; g.K = K; g.nM = Mrows / BM; g.nN = N / BM; g.a_pmdiv = (long)BM * K; g.a_pmmod = 0; g.a_pn = 0; g.b_pmdiv = 0; g.b_pmmod = 0; g.b_pn = (long)BM * K;
    g.div = 1; g.ocol_step = BM; g.kstepA = BK * 2; g.kstepB = BK * 2; g.imgA = 0; g.imgB = 0; return g;
}
DI size_t img_off_b(int nrow, int kcol) { const int nl = nrow & 255, r = nl & 127, q = r & 31, rs = (r & ~31) + 16 * ((q >> 2) & 1) + 4 * (q >> 3) + (q & 3);
    return ((size_t)((nrow >> 8) * (DM / 64) + (kcol >> 6)) * 2 + (nl >> 7)) * 16384 + lds_byte(rs, kcol & 63); }
DI void use_img_a(Gemm& g) { g.imgA = 1; g.lda = 64; g.kstepA = 256 * 64 * 2; }
DI void use_img_b(Gemm& g) { g.imgB = 1; g.ldb = 64; g.kstepB = 256 * 64 * 2; g.b_pn = (long)(g.K / 64) * 256 * 64; }
struct Order {
    Gemm g; int nwg, G, c;
    DI void init(const Gemm& g_, int G_, int c_) { g = g_; nwg = g.nM * g.nN; G = G_; c = c_; }
    DI bool next(int i, Unit& u) const {
        const long L = (long)i * G + c; if (L >= nwg) return false;
        int wgid = (int)L; { const int q = nwg / NXCD, r = nwg % NXCD, xcd = wgid % NXCD, off = wgid / NXCD; wgid = (xcd < r ? xcd * (q + 1) : r * (q + 1) + (xcd - r) * q) + off; }
        const int nN = g.nN, nM = g.nM, nig = WGM * nN, gid = wgid / nig, fm = gid * WGM, gsz = (nM - fm) < WGM ? (nM - fm) : WGM;
        const int pm = fm + ((wgid % nig) % gsz), pn = (wgid % nig) / gsz;
        u.pm = pm; u.pn = pn; u.orow = pm * BM; u.ocol = pn * g.ocol_step;
        const int pq = pm / g.div, pr = pm - pq * g.div;
        u.a = (const char*)(g.A + (long)pq * g.a_pmdiv + (long)pr * g.a_pmmod + (long)pn * g.a_pn);
        u.b = (const char*)(g.B + (long)pq * g.b_pmdiv + (long)pr * g.b_pmmod + (long)pn * g.b_pn);
        return true;
    }
};

struct EpiBf16 {
    static constexpr bool PERM = true;
    bf16_t* O; int ldc; const float* ss; const float* rowscale; const float* colscale; float scale; int zspecial;
    DI void operator()(f32x4 (&acc)[2][2][4][2], const Unit& u, int wr, int wc, int fr, int fq, int wid, int lane) const {
        const int row0 = u.orow + wr * 64 + fr, col0 = u.ocol + wc * 32 + 8 * fq;
        float sc = scale;
        if (zspecial) { if (u.pn == 5) sc *= 0.125f * LOG2E; else if (u.pn == 8) sc *= 0.17677669529663687f * LOG2E; }
        if (colscale) {
#pragma unroll
            for (int bj = 0; bj < 2; ++bj)
#pragma unroll
                for (int n = 0; n < 2; ++n) { const f32x4 cs = *(const f32x4*)(colscale + col0 + bj * HALF + 4 * n);
#pragma unroll
                    for (int ai = 0; ai < 2; ++ai)
#pragma unroll
                        for (int m = 0; m < 4; ++m) acc[ai][bj][m][n] *= cs; }
            asm volatile("" ::: "memory");
        }
#pragma unroll
        for (int ai = 0; ai < 2; ++ai)
#pragma unroll
            for (int m = 0; m < 4; ++m) {
                const int row = row0 + ai * HALF + m * 16;
                float rs = sc;
                if (ss) rs *= rowss(ss, row);
                if (rowscale) rs *= rowscale[row];
                bf16_t* rowp = O + (size_t)row * ldc + col0;
#pragma unroll
                for (int bj = 0; bj < 2; ++bj) {
                    const f32x4 v0 = acc[ai][bj][m][0] * rs, v1 = acc[ai][bj][m][1] * rs;
                    u32x4 w; w.x = cvtpk(v0[0], v0[1]); w.y = cvtpk(v0[2], v0[3]); w.z = cvtpk(v1[0], v1[1]); w.w = cvtpk(v1[2], v1[3]);
                    if (zspecial == 3) *(u32x4*)((unsigned char*)O + img_off_b(row, col0 + bj * HALF)) = w;
                    else *(u32x4*)(rowp + bj * HALF) = w;
                }
                asm volatile("" ::: "memory");
            }
    }
};
struct EpiZ {
    static constexpr bool PERM = true;
    bf16_t* O; float* gates; const float* ss;
    DI void operator()(f32x4 (&acc)[2][2][4][2], const Unit& u, int wr, int wc, int fr, int fq, int wid, int lane) const {
        const int row0 = u.orow + wr * 64 + fr, col0 = u.ocol + wc * 32 + 8 * fq;
        if (u.pn == 11) {
            if (wc == 0 && fq == 0) {
#pragma unroll
                for (int ai = 0; ai < 2; ++ai)
#pragma unroll
                    for (int m = 0; m < 4; ++m) { const int row = row0 + ai * HALF + m * 16; const float rs = rowss(ss, row);
                        *(f32x4*)(gates + (size_t)row * 8) = acc[ai][0][m][0] * rs; *(f32x4*)(gates + (size_t)row * 8 + 4) = acc[ai][0][m][1] * rs; }
            }
            return;
        }
        float sc = 1.f;
        if (u.pn == 5) sc = 0.125f * LOG2E; else if (u.pn == 8) sc = 0.17677669529663687f * LOG2E;
#pragma unroll
        for (int ai = 0; ai < 2; ++ai)
#pragma unroll
            for (int m = 0; m < 4; ++m) {
                const int row = row0 + ai * HALF + m * 16;
                const float rs = sc * rowss(ss, row);
                const int zc0 = col0;
#pragma unroll
                for (int bj = 0; bj < 2; ++bj) {
                    const f32x4 v0 = acc[ai][bj][m][0] * rs, v1 = acc[ai][bj][m][1] * rs;
                    u32x4 w; w.x = cvtpk(v0[0], v0[1]); w.y = cvtpk(v0[2], v0[3]); w.z = cvtpk(v1[0], v1[1]); w.w = cvtpk(v1[2], v1[3]);
                    { const int zc = zc0 + bj * HALF; *(u32x4*)(O + ((size_t)(zc >> 6) * MTOK + (size_t)row) * 64 + (zc & 63)) = w; }
                }
                asm volatile("" ::: "memory");
            }
    }
};
struct EpiSwiGLU {
    static constexpr bool PERM = true;
    bf16_t* O; int ldc; const float* ss;
    DI void operator()(f32x4 (&acc)[2][2][4][2], const Unit& u, int wr, int wc, int fr, int fq, int wid, int lane) const {
        const int row0 = u.orow + wr * 64 + fr, col0 = u.ocol + wc * 32 + 8 * fq;
#pragma unroll
        for (int ai = 0; ai < 2; ++ai)
#pragma unroll
            for (int m = 0; m < 4; ++m) {
                const int row = row0 + ai * HALF + m * 16;
                const float rs = rowss(ss, row);
                float o[8];
#pragma unroll
                for (int n = 0; n < 2; ++n)
#pragma unroll
                    for (int j = 0; j < 4; ++j) { const float g = acc[ai][0][m][n][j] * rs, up = acc[ai][1][m][n][j] * rs; o[4 * n + j] = silu_f(g) * up; }
                u32x4 w; w.x = cvtpk(o[0], o[1]); w.y = cvtpk(o[2], o[3]); w.z = cvtpk(o[4], o[5]); w.w = cvtpk(o[6], o[7]);
                __builtin_nontemporal_store(w, (u32x4*)((unsigned char*)O + ((size_t)(u.pm * (FF / 64) + (col0 >> 6)) * 2 + ((row >> 7) & 1)) * 16384 + lds_byte(row & 127, col0 & 63)));
                asm volatile("" ::: "memory");
            }
    }
};
struct EpiResid {
    static constexpr bool PERM = true;
    bf16_t* hb; float* ssout; float alpha;
    DI void operator()(f32x4 (&acc)[2][2][4][2], const Unit& u, int wr, int wc, int fr, int fq, int wid, int lane) const {
        const int row0 = u.orow + wr * 64 + fr, col0 = u.ocol + wc * 32 + 8 * fq;
#pragma unroll
        for (int ai = 0; ai < 2; ++ai) {
            u32x4 r[4][2];
#pragma unroll
            for (int m = 0; m < 4; ++m) {
#pragma unroll
                for (int bj = 0; bj < 2; ++bj) r[m][bj] = *(const u32x4*)((const unsigned char*)hb + img_off(row0 + ai * HALF + m * 16, col0 + bj * HALF)); }
#pragma unroll
            for (int m = 0; m < 4; ++m) {
                const int row = row0 + ai * HALF + m * 16; float ssq = 0.f;
#pragma unroll
                for (int bj = 0; bj < 2; ++bj) {
                    const u32x4 rr = r[m][bj]; const f32x4 a0 = acc[ai][bj][m][0] * alpha, a1 = acc[ai][bj][m][1] * alpha;
                    u32x4 w; w.x = cvtpk(bflo(rr.x) + a0[0], bfhi(rr.x) + a0[1]); w.y = cvtpk(bflo(rr.y) + a0[2], bfhi(rr.y) + a0[3]);
                    w.z = cvtpk(bflo(rr.z) + a1[0], bfhi(rr.z) + a1[1]); w.w = cvtpk(bflo(rr.w) + a1[2], bfhi(rr.w) + a1[3]);
                    *(u32x4*)((unsigned char*)hb + img_off(row, col0 + bj * HALF)) = w;
                    const float v0 = bflo(w.x), v1 = bfhi(w.x), v2 = bflo(w.y), v3 = bfhi(w.y), v4 = bflo(w.z), v5 = bfhi(w.z), v6 = bflo(w.w), v7 = bfhi(w.w);
                    ssq += ((v0 * v0 + v1 * v1) + (v2 * v2 + v3 * v3)) + ((v4 * v4 + v5 * v5) + (v6 * v6 + v7 * v7));
                }
                ssq += __shfl_xor(ssq, 16); ssq += __shfl_xor(ssq, 32);
                if (fq == 0) ssout[(size_t)row * 16 + u.pn * 4 + wc] = ssq;
            }
            asm volatile("" ::: "memory");
        }
    }
};
struct EpiSoftmax {
    static constexpr bool PERM = true;
    bf16_t* O; int ldc; LAS float* red; const float* ss; float scale;
    DI void operator()(f32x4 (&acc)[2][2][4][2], const Unit& u, int wr, int wc, int fr, int fq, int wid, int lane) const {
        float mloc[2][4];
#pragma unroll
        for (int ai = 0; ai < 2; ++ai)
#pragma unroll
            for (int m = 0; m < 4; ++m) {
                float mx = NEGBIG;
                const float rsc = rowss(ss, u.orow + ai * HALF + wr * 64 + m * 16 + fr) * scale;
#pragma unroll
                for (int bj = 0; bj < 2; ++bj)
#pragma unroll
                    for (int n = 0; n < 2; ++n) { const f32x4 x = acc[ai][bj][m][n] * rsc; acc[ai][bj][m][n] = x; mx = fmaxf(mx, fmaxf(fmaxf(x[0], x[1]), fmaxf(x[2], x[3]))); }
                mx = fmaxf(mx, __shfl_xor(mx, 16)); mx = fmaxf(mx, __shfl_xor(mx, 32));
                float sm = 0.f;
#pragma unroll
                for (int bj = 0; bj < 2; ++bj)
#pragma unroll
                    for (int n = 0; n < 2; ++n) { f32x4 x = acc[ai][bj][m][n]; x[0] = ex2(x[0] - mx); x[1] = ex2(x[1] - mx); x[2] = ex2(x[2] - mx); x[3] = ex2(x[3] - mx);
                        acc[ai][bj][m][n] = x; sm += (x[0] + x[1]) + (x[2] + x[3]); }
                sm += __shfl_xor(sm, 16); sm += __shfl_xor(sm, 32);
                mloc[ai][m] = mx;
                const int rl = ai * HALF + wr * 64 + m * 16 + fr;
                if (fq == 0) { red[(rl * 4 + wc) * 2] = mx; red[(rl * 4 + wc) * 2 + 1] = sm; }
            }
        asm volatile("s_waitcnt lgkmcnt(0)" ::: "memory"); __builtin_amdgcn_s_barrier(); asm volatile("" ::: "memory");
        const int row0 = u.orow + wr * 64 + fr, col0 = u.ocol + wc * 32 + 8 * fq;
#pragma unroll
        for (int ai = 0; ai < 2; ++ai)
#pragma unroll
            for (int m = 0; m < 4; ++m) {
                const int rl = ai * HALF + wr * 64 + m * 16 + fr;
                const f32x4 p0 = *(const LAS f32x4*)(red + rl * 8), p1 = *(const LAS f32x4*)(red + rl * 8 + 4);
                const float gm = fmaxf(fmaxf(p0[0], p0[2]), fmaxf(p1[0], p1[2]));
                const float tot = p0[1] * ex2(p0[0] - gm) + p0[3] * ex2(p0[2] - gm) + p1[1] * ex2(p1[0] - gm) + p1[3] * ex2(p1[2] - gm);
                const float f = ex2(mloc[ai][m] - gm) / tot;
                const int prow = row0 + ai * HALF + m * 16;
#pragma unroll
                for (int bj = 0; bj < 2; ++bj) {
                    const f32x4 v0 = acc[ai][bj][m][0] * f, v1 = acc[ai][bj][m][1] * f;
                    u32x4 w; w.x = cvtpk(v0[0], v0[1]); w.y = cvtpk(v0[2], v0[3]); w.z = cvtpk(v1[0], v1[1]); w.w = cvtpk(v1[2], v1[3]);
                    *(u32x4*)((unsigned char*)O + img_off(prow, col0 + bj * HALF)) = w;
                }
            }
        asm volatile("s_waitcnt lgkmcnt(0)" ::: "memory"); __builtin_amdgcn_s_barrier(); asm volatile("" ::: "memory");
    }
};

template <class Epi>
DI void gemm_phase(LAS unsigned char* lds, const Gemm g, const Order& S, const Epi& E) {
    int tid_ = threadIdx.x; asm volatile("" : "+v"(tid_));
    const int tid = tid_, wid = __builtin_amdgcn_readfirstlane(tid >> 6), lane = tid & 63, wr = wid >> 2, wc = wid & 3, fr = lane & 15, fq = lane >> 4;
    const int K = g.K, nt = K / BK;
    unsigned voffA[2], voffB[2];
#pragma unroll
    for (int i = 0; i < 2; ++i) { int R, C; stage_rc(tid * 16 + i * 8192, R, C); const int Rb = Epi::PERM ? ((R & ~31) + perm32(R & 31)) : R;
        voffA[i] = g.imgA ? (unsigned)(tid * 16 + i * 8192) : (unsigned)(R * g.lda + C) * 2u; voffB[i] = g.imgB ? (unsigned)(tid * 16 + i * 8192) : (unsigned)(Rb * g.ldb + C) * 2u; }
    const size_t kstepA = (size_t)g.kstepA, kstepB = (size_t)g.kstepB;
    const size_t hstepA = (size_t)HALF * g.lda * 2, hstepB = (size_t)HALF * g.ldb * 2;
    const unsigned ldsw = (unsigned)wid * 1024u;
    const int aoff = lds_byte(wr * 64 + fr, fq * 8), boff = lds_byte(wc * 32 + fr, fq * 8);
#define PG8_SA(b, h) (((b) * 2 + (h)) * HTB)
#define PG8_SB(b, h) ((4 + (b) * 2 + (h)) * HTB)
#define PG8_STAGE(bufoff, gbase, voff) do { _Pragma("unroll") for (int _i = 0; _i < 2; ++_i) \
        __builtin_amdgcn_global_load_lds((const unsigned*)((const char*)(gbase) + (voff)[_i]), (LAS unsigned*)(lds + (bufoff) + ldsw + _i * 8192), 16, 0, 0); } while (0)
#define PG8_LDA(dst, b, h) do { _Pragma("unroll") for (int m = 0; m < 4; ++m) _Pragma("unroll") for (int k = 0; k < 2; ++k) dst[m][k] = *(const LAS bf16x8*)(lds + PG8_SA(b, h) + aoff + m * 2048 + k * 1024); } while (0)
#define PG8_LDB(dst, b, h) do { _Pragma("unroll") for (int n = 0; n < 2; ++n) _Pragma("unroll") for (int k = 0; k < 2; ++k) dst[n][k] = *(const LAS bf16x8*)(lds + PG8_SB(b, h) + boff + n * 2048 + k * 1024); } while (0)
#define PG8_MMA(ai, bj, At, Bt) do { __builtin_amdgcn_s_setprio(1); _Pragma("unroll") for (int m = 0; m < 4; ++m) _Pragma("unroll") for (int n = 0; n < 2; ++n) _Pragma("unroll") for (int k = 0; k < 2; ++k) \
        acc[ai][bj][m][n] = __builtin_amdgcn_mfma_f32_16x16x32_bf16(Bt[n][k], At[m][k], acc[ai][bj][m][n], 0, 0, 0); __builtin_amdgcn_s_setprio(0); } while (0)
#define PG8_WAIT_V(n) asm volatile("s_waitcnt vmcnt(" #n ")" ::: "memory")
#define PG8_WAIT_L(n) asm volatile("s_waitcnt lgkmcnt(" #n ")" ::: "memory")
#define PG8_BAR __builtin_amdgcn_s_barrier()
#define PG8_SCHED __builtin_amdgcn_sched_barrier(0)
    Unit cur, nxt; int ui = 0;
    if (!S.next(0, cur)) return;
    f32x4 acc[2][2][4][2];
#pragma unroll
    for (int a = 0; a < 2; ++a)
#pragma unroll
        for (int b = 0; b < 2; ++b)
#pragma unroll
            for (int m = 0; m < 4; ++m)
#pragma unroll
                for (int n = 0; n < 2; ++n) acc[a][b][m][n] = (f32x4){0.f, 0.f, 0.f, 0.f};
    bf16x8 At[4][2], B0[2][2], B1[2][2];
    const char* cA = cur.a; const char* cB = cur.b;
    PG8_STAGE(PG8_SB(0, 0), cB, voffB); PG8_STAGE(PG8_SB(0, 1), cB + hstepB, voffB); PG8_STAGE(PG8_SA(0, 0), cA, voffA); PG8_STAGE(PG8_SA(0, 1), cA + hstepA, voffA);
    if (wr == 1) PG8_BAR;
    PG8_WAIT_V(2); PG8_BAR;
    PG8_STAGE(PG8_SB(1, 0), cB + kstepB, voffB); PG8_STAGE(PG8_SA(1, 0), cA + kstepA, voffA); PG8_STAGE(PG8_SB(1, 1), cB + hstepB + kstepB, voffB);
    PG8_WAIT_V(6); PG8_BAR;
    for (;;) {
        const bool has_next = S.next(ui + 1, nxt);
        const char* nA = has_next ? nxt.a : cA; const char* nB = has_next ? nxt.b : cB;
        for (int t = 0; t < nt; t += 2) {
            const bool last = (t == nt - 2);
            const char* a1 = cA + (size_t)(t + 1) * kstepA;
            const char* a2 = last ? nA : cA + (size_t)(t + 2) * kstepA; const char* b2 = last ? nB : cB + (size_t)(t + 2) * kstepB;
            const char* a3 = a2 + kstepA; const char* b3 = b2 + kstepB;
            PG8_LDB(B0, 0, 0); PG8_LDB(B1, 0, 1); PG8_SCHED; PG8_LDA(At, 0, 0); PG8_STAGE(PG8_SA(1, 1), a1 + hstepA, voffA);
            PG8_WAIT_V(8); PG8_WAIT_L(0); PG8_BAR; PG8_MMA(0, 0, At, B0); PG8_MMA(0, 1, At, B1); PG8_BAR; PG8_SCHED;
            PG8_LDA(At, 0, 1); PG8_STAGE(PG8_SB(0, 0), b2, voffB); PG8_STAGE(PG8_SB(0, 1), b2 + hstepB, voffB); PG8_STAGE(PG8_SA(0, 0), a2, voffA);
            PG8_WAIT_V(8); PG8_WAIT_L(0); PG8_BAR; PG8_MMA(1, 0, At, B0); PG8_MMA(1, 1, At, B1); PG8_BAR; PG8_SCHED;
            PG8_LDB(B0, 1, 0); PG8_LDB(B1, 1, 1); PG8_SCHED; PG8_LDA(At, 1, 0); PG8_STAGE(PG8_SA(0, 1), a2 + hstepA, voffA);
            PG8_WAIT_V(8); PG8_WAIT_L(0); PG8_BAR; PG8_MMA(0, 0, At, B0); PG8_MMA(0, 1, At, B1); PG8_BAR; PG8_SCHED;
            PG8_LDA(At, 1, 1); PG8_STAGE(PG8_SB(1, 0), b3, voffB); PG8_STAGE(PG8_SB(1, 1), b3 + hstepB, voffB); PG8_STAGE(PG8_SA(1, 0), a3, voffA);
            PG8_WAIT_V(8); PG8_WAIT_L(0); PG8_BAR; PG8_MMA(1, 0, At, B0); PG8_MMA(1, 1, At, B1); PG8_BAR; PG8_SCHED;
        }
        if (wr == 0) PG8_BAR;
        E(acc, cur, wr, wc, fr, fq, wid, lane);
        if (!has_next) break;
#pragma unroll
        for (int a = 0; a < 2; ++a)
#pragma unroll
            for (int b = 0; b < 2; ++b)
#pragma unroll
                for (int m = 0; m < 4; ++m)
#pragma unroll
                    for (int n = 0; n < 2; ++n) acc[a][b][m][n] = (f32x4){0.f, 0.f, 0.f, 0.f};
        cur = nxt; cA = nA; cB = nB; ++ui;
        if (wr == 1) PG8_BAR;
    }
    PG8_WAIT_V(0);
    PG8_BAR;
#undef PG8_SA
#undef PG8_SB
#undef PG8_STAGE
#undef PG8_LDA
#undef PG8_LDB
#undef PG8_MMA
#undef PG8_WAIT_V
#undef PG8_WAIT_L
#undef PG8_BAR
#undef PG8_SCHED
}
}

#define XB_TMO      128
#define XB_XCNT(j)  (256  + 64 * (j))
#define XB_XSUB(j)  (1280 + 64 * (j))
#define XB_XGEN(j)  (2304 + 64 * (j))
#define XB_TOP      3328
#define XB_TOPGEN   3392
#define XCD_BAR_WORDS 3456
#define XB_SPIN_CAP (1u << 20)
DI unsigned xb_ld(unsigned* p)              { return __hip_atomic_load(p, __ATOMIC_RELAXED, __HIP_MEMORY_SCOPE_AGENT); }
DI unsigned xb_add(unsigned* p, unsigned v) { return __hip_atomic_fetch_add(p, v, __ATOMIC_RELAXED, __HIP_MEMORY_SCOPE_AGENT); }
DI unsigned xb_xcc_id() { return (unsigned)__builtin_amdgcn_s_getreg((3 << 11) | 20) & 0xFu; }
#define XB_SPIN(cond, bar) do { unsigned _sp = 0; while (cond) { __builtin_amdgcn_s_sleep(1); \
    if ((++_sp & 255u) == 0u) { if (xb_ld(&(bar)[XB_TMO])) break; if (_sp > XB_SPIN_CAP) { atomicAdd(&(bar)[XB_TMO], 1u); break; } } } } while (0)
struct XcdBarrier { unsigned* bar; unsigned x; volatile LAS unsigned* st; };
DI XcdBarrier xcd_barrier_post(unsigned* bar, volatile LAS unsigned* st) {
    XcdBarrier b; b.bar = bar; b.x = xb_xcc_id(); b.st = st;
    if (threadIdx.x == 0) (void)xb_add(&bar[XB_XCNT(b.x)], 1u);
    return b;
}
DI void xcd_barrier_complete(unsigned* bar, unsigned x, unsigned& nloc, unsigned& nx) {
    const unsigned G = gridDim.x * gridDim.y * gridDim.z;
    unsigned sum, cnt, mine, sp = 0u;
    for (;;) {
        sum = 0u; cnt = 0u; mine = 0u;
#pragma unroll
        for (unsigned j = 0; j < 16; ++j) { const unsigned c = xb_ld(&bar[XB_XCNT(j)]); sum += c; cnt += (c > 0u) ? 1u : 0u; mine = (j == x) ? c : mine; }
        if (sum == G) break;
        __builtin_amdgcn_s_sleep(1);
        if ((++sp & 255u) == 0u) { if (xb_ld(&bar[XB_TMO])) break; if (sp > XB_SPIN_CAP) { atomicAdd(&bar[XB_TMO], 1u); break; } }
    }
    nloc = mine > 0u ? mine : 1u; nx = cnt > 0u ? cnt : 1u;
}
DI void xcd_barrier(const XcdBarrier& b) {
    asm volatile("s_waitcnt vmcnt(0)" ::: "memory");
    __syncthreads();
    if (threadIdx.x == 0) {
        unsigned* bar = b.bar;
        __builtin_amdgcn_s_waitcnt(0);
        unsigned nloc = b.st[0], nx = b.st[1];
        if (nloc == 0u) { xcd_barrier_complete(bar, b.x, nloc, nx); b.st[0] = nloc; b.st[1] = nx; }
        const unsigned old = xb_add(&bar[XB_XSUB(b.x)], 1u);
        const unsigned gen = old / nloc;
        if (old + 1u == (gen + 1u) * nloc) {
            __builtin_amdgcn_fence(__ATOMIC_RELEASE, "agent");
            asm volatile("s_waitcnt vmcnt(0)" ::: "memory");
            const unsigned og = xb_add(&bar[XB_TOP], 1u);
            const unsigned tg = og / nx;
            if (og + 1u == (tg + 1u) * nx) xb_add(&bar[XB_TOPGEN], 1u);
            else XB_SPIN(xb_ld(&bar[XB_TOPGEN]) == tg, bar);
            __builtin_amdgcn_fence(__ATOMIC_ACQUIRE, "agent");
            xb_add(&bar[XB_XGEN(b.x)], 1u);
            asm volatile("s_waitcnt vmcnt(0)" ::: "memory");
        } else {
            XB_SPIN(xb_ld(&bar[XB_XGEN(b.x)]) == gen, bar);
            __builtin_amdgcn_fence(__ATOMIC_ACQUIRE, "agent");
            asm volatile("s_waitcnt vmcnt(0)" ::: "memory");
        }
    }
    __syncthreads();
}

struct Ctx {
    LAS unsigned char* lds; unsigned char* ldsg;
    int tid, lane, wid, bid, G;
    unsigned char* ws; float* out;
};
DI bf16_t* wsb(const Ctx& c, size_t off) { return (bf16_t*)(c.ws + off); }
DI float* wsf(const Ctx& c, size_t off) { return (float*)(c.ws + off); }
DI float* ssbuf(const Ctx& c, int i) { return (float*)(c.ws + OFF_SS) + (size_t)i * MTOK * 16; }

DI int t5_bucket(int dist) {
    if (dist < 16) return dist;
    const float v = logf((float)dist / 16.f) / 4.852030263919617f * 16.f;
    int large = 16 + (int)v; return large < 31 ? large : 31;
}

DI Ctx fresh(const Ctx& c0) {
    Ctx c = c0; int tid = threadIdx.x; asm volatile("" : "+v"(tid)); c.tid = tid; c.lane = tid & 63; c.wid = __builtin_amdgcn_readfirstlane(tid >> 6);
    asm volatile("" : "+s"(c.ws)); asm volatile("" : "+s"(c.out)); return c;
}
DI void transpose_item(const float* W, int ldw, int scol0, int k0, const float* gain, bf16_t* WT, int K, int drow0, LAS float* scr, int lane, bool img = false) {
    {
        f32x4 v[8]; float gs[8];
#pragma unroll
        for (int i = 0; i < 8; ++i) { const int kk = 8 * i + (lane >> 3); v[i] = *(const f32x4*)(W + (size_t)(k0 + kk) * ldw + scol0 + (lane & 7) * 4); gs[i] = gain ? gain[k0 + kk] : 1.f; }
#pragma unroll
        for (int i = 0; i < 8; ++i) { const int kk = 8 * i + (lane >> 3); LAS float* d = scr + kk * 33 + (lane & 7) * 4; d[0] = v[i][0] * gs[i]; d[1] = v[i][1] * gs[i]; d[2] = v[i][2] * gs[i]; d[3] = v[i][3] * gs[i]; }
    }
    LDS_WAIT(); asm volatile("" ::: "memory");
    const int c = lane & 7;
#pragma unroll
    for (int j = 0; j < 4; ++j) { const int n = (lane >> 3) + 8 * j; const LAS float* s = scr + (8 * c) * 33 + n;
        u32x4 o; o.x = cvtpk(s[0 * 33], s[1 * 33]); o.y = cvtpk(s[2 * 33], s[3 * 33]); o.z = cvtpk(s[4 * 33], s[5 * 33]); o.w = cvtpk(s[6 * 33], s[7 * 33]);
        if (img) { const int ng = drow0 + n, nl = ng & 255, r = nl & 127, q = r & 31, rs = (r & ~31) + 16 * ((q >> 2) & 1) + 4 * (q >> 3) + (q & 3);
            const int kk0 = k0 + 8 * c;
            *(u32x4*)((unsigned char*)WT + ((size_t)((ng >> 8) * (K >> 6) + (kk0 >> 6)) * 2 + (nl >> 7)) * 16384 + pg8::lds_byte(rs, kk0 & 63)) = o; }
        else *(u32x4*)(WT + (size_t)(drow0 + n) * K + k0 + 8 * c) = o; }
    LDS_WAIT(); asm volatile("" ::: "memory");
}
DI void tjob(const float* W, int ldw, int scol0, const float* gain, bf16_t* WT, int K, int ncols, int item, LAS float* scr, int lane, bool img = false, int drow_base = 0) {
    const int nblk = ncols / 32, kb = item / nblk, nb = item % nblk;
    transpose_item(W, ldw, scol0 + 32 * nb, 64 * kb, gain, WT, K, drow_base + 32 * nb, scr, lane, img);
}
DI void tjob_gu(const float* Wg, const float* Wu, const float* gain, bf16_t* WT, int item, LAS float* scr, int lane) {
    const int nblk = 2 * FF / 32, kb = item / nblk, nb = item % nblk, n0 = 32 * nb, p = n0 >> 8, w = n0 & 255;
    transpose_item(w < 128 ? Wg : Wu, FF, 128 * p + (w & 127), 64 * kb, gain, WT, DM, n0, scr, lane, true);
}
DI void ph_prologue(const Params& p, const Ctx& c0) {
    const Ctx c = fresh(c0);
    LAS float* scr = (LAS float*)(c.lds + c.wid * 16384);
    const int gw = c.bid * 8 + c.wid, NGW = c.G * 8, lane = c.lane;
    constexpr int I_GU = 16 * (2 * FF / 32), I_D = (FF / 64) * 32, I_INA = 16 * 32, I_INB = 16 * 56, I_INC = 16, I_SQ = 16 * 32;
    constexpr int PER_LAYER = 2 * I_GU + 2 * I_D + I_INA + I_INB + I_INC + 5 * I_SQ;
    for (int it = gw; it < DEPTH * PER_LAYER; it += NGW) {
        const int l = it / PER_LAYER; int r = it % PER_LAYER;
        unsigned char* wl = c.ws + (size_t)l * W_LAYER;
        if (r < I_GU) { tjob_gu(p.in[I_F1G] + (size_t)l * DM * FF, p.in[I_F1U] + (size_t)l * DM * FF, p.in[I_F1N] + l * DM, (bf16_t*)(wl + W_GU1), r, scr, lane); continue; } r -= I_GU;
        if (r < I_D) { tjob(p.in[I_F1D] + (size_t)l * FF * DM, DM, 0, nullptr, (bf16_t*)(wl + W_D1), FF, DM, r, scr, lane, true); continue; } r -= I_D;
        if (r < I_INA) { tjob(p.in[I_WIN] + (size_t)l * DM * INW, INW, 0, p.in[I_MIXN] + l * DM, (bf16_t*)(wl + W_IN), DM, 1024, r, scr, lane, true, 0); continue; } r -= I_INA;
        if (r < I_INB) { tjob(p.in[I_WIN] + (size_t)l * DM * INW, INW, 1032, p.in[I_MIXN] + l * DM, (bf16_t*)(wl + W_IN), DM, 1792, r, scr, lane, true, 1024); continue; } r -= I_INB;
        if (r < I_INC) { tjob(p.in[I_WIN] + (size_t)l * DM * INW, INW, 1024, p.in[I_MIXN] + l * DM, (bf16_t*)(wl + W_IN), DM, 32, r, scr, lane, true, 2816); continue; } r -= I_INC;
        if (r < I_SQ) { tjob(p.in[I_WOUT] + (size_t)l * DM * DM, DM, 0, nullptr, (bf16_t*)(wl + W_OUT), DM, DM, r, scr, lane, true); continue; } r -= I_SQ;
        if (r < I_SQ) {
            const int kb = r >> 5, nb = r & 31; const int row = 64 * kb + lane; const float gsc = p.in[I_XN][l * DM + row];
            const f32x4* src = (const f32x4*)(p.in[I_XWQ] + (size_t)l * DM * DM + (size_t)row * DM + 32 * nb); u32x4* dst = (u32x4*)((bf16_t*)(wl + W_Q) + (size_t)row * DM + 32 * nb);
#pragma unroll
            for (int q4 = 0; q4 < 4; ++q4) { const f32x4 x0 = src[2 * q4] * gsc, x1 = src[2 * q4 + 1] * gsc; u32x4 w; w.x = cvtpk(x0[0], x0[1]); w.y = cvtpk(x0[2], x0[3]); w.z = cvtpk(x1[0], x1[1]); w.w = cvtpk(x1[2], x1[3]); dst[q4] = w; }
            continue; } r -= I_SQ;
        if (r < I_SQ) { tjob(p.in[I_XWO] + (size_t)l * DM * DM, DM, 0, nullptr, (bf16_t*)(wl + W_O), DM, DM, r, scr, lane); continue; } r -= I_SQ;
        if (r < I_GU) { tjob_gu(p.in[I_F2G] + (size_t)l * DM * FF, p.in[I_F2U] + (size_t)l * DM * FF, p.in[I_F2N] + l * DM, (bf16_t*)(wl + W_GU2), r, scr, lane); continue; } r -= I_GU;
        if (r < I_D) { tjob(p.in[I_F2D] + (size_t)l * FF * DM, DM, 0, nullptr, (bf16_t*)(wl + W_D2), FF, DM, r, scr, lane, true); continue; } r -= I_D;
        if (r < I_SQ) { tjob(p.in[I_XWKV] + (size_t)l * DM * 2 * DM, 2 * DM, 0, p.in[I_MEMN] + l * DM, wsb(c, OFF_WK) + (size_t)l * DM * DM, DM, DM, r, scr, lane); continue; } r -= I_SQ;
        tjob(p.in[I_XWKV] + (size_t)l * DM * 2 * DM, 2 * DM, DM, p.in[I_MEMN] + l * DM, wsb(c, OFF_WV) + (size_t)l * DM * DM, DM, DM, r, scr, lane);
    }
    for (int m = gw; m < MTOK + MMEM; m += NGW) {
        const bool isx = m < MTOK; const int row = isx ? m : m - MTOK;
        const f32x4* xr = (const f32x4*)((isx ? p.in[I_X] : p.in[I_MEM]) + (size_t)row * DM) + lane;
        unsigned long long* o8 = (unsigned long long*)(wsb(c, OFF_MEMB) + (size_t)row * DM) + lane; unsigned char* hbimg = (unsigned char*)wsb(c, OFF_HB);
        float s = 0.f;
#pragma unroll
        for (int j = 0; j < 4; ++j) { const f32x4 v = xr[64 * j]; s += (v[0] * v[0] + v[1] * v[1]) + (v[2] * v[2] + v[3] * v[3]);
            const unsigned long long pk = (unsigned long long)cvtpk(v[0], v[1]) | ((unsigned long long)cvtpk(v[2], v[3]) << 32);
            if (isx) *(unsigned long long*)(hbimg + pg8::img_off(row, 4 * (lane + 64 * j))) = pk; else o8[64 * j] = pk; }
        s = wave_sum(s);
        if (lane == 0) { if (isx) { f32x4* q = (f32x4*)(ssbuf(c, 0) + (size_t)row * 16); q[0] = (f32x4){s, 0.f, 0.f, 0.f}; q[1] = (f32x4){0.f, 0.f, 0.f, 0.f}; q[2] = q[1]; q[3] = q[1]; } else wsf(c, OFF_RSM)[row] = rsqrtf(s * (1.f / DM) + 1e-6f); }
    }
    for (int l = 0; l < DEPTH; ++l) { unsigned char* t11 = c.ws + (size_t)l * W_LAYER + W_IN + (size_t)11 * 16 * 32768;
        for (int i = c.bid * 512 + c.tid; i < 16 * 1792; i += c.G * 512) { const int kt = i / 1792, rem = i - kt * 1792; *(u32x4*)(t11 + (size_t)kt * 32768 + 4096 + (size_t)rem * 16) = (u32x4){0u, 0u, 0u, 0u}; } }
    const int gt = c.bid * 512 + c.tid, NGT = c.G * 512;
    const float* t5 = p.in[I_T5];
    for (int i = gt; i < 4 * 4096; i += NGT) { const int h = i >> 12, d = i & 4095; wsf(c, OFF_DIFFB)[i] = t5[t5_bucket(d) * 8 + 4 + h] * LOG2E; }
    for (int i = gt; i < 3 * 4 * 132; i += NGT) { const int pp = i / (4 * 132), h = (i / 132) & 3, dl = i % 132; const int dil = pp == 0 ? 1 : (pp == 1 ? 4 : 16);
        wsf(c, OFF_DILB)[i] = dl <= 128 ? t5[t5_bucket(dl * dil) * 8 + h] * LOG2E : 0.f; }
    if (gt < DEPTH) { const float* lv = p.in[I_LAMV] + gt * 128; float a = 0.f, b = 0.f; for (int i = 0; i < 32; ++i) { a += lv[i] * lv[32 + i]; b += lv[64 + i] * lv[96 + i]; }
        const float lam_init = 0.8f - 0.6f * expf(-0.3f * (float)gt); wsf(c, OFF_LAM)[gt] = expf(a) - expf(b) + lam_init; }
}

DI void ph_gates(const Params& p, const Ctx& c0, int l) {
    const Ctx c = fresh(c0);
    LAS float* wg = (LAS float*)c.lds;
    const float* win = p.in[I_WIN] + (size_t)l * DM * INW; const float* gn = p.in[I_MIXN] + l * DM;
    for (int i = c.tid; i < DM * 8; i += 512) { const int k = i >> 3, cc = i & 7; wg[i] = win[(size_t)k * INW + 1024 + cc] * gn[k]; }
    __syncthreads();
    const float* h = c.out; const float* ss = ssbuf(c, 4 * l + 1); float* gates = wsf(c, OFF_GATES);
    for (int row = c.bid * 8 + c.wid; row < MTOK; row += c.G * 8) {
        float a[8];
#pragma unroll
        for (int j = 0; j < 8; ++j) a[j] = 0.f;
        const f32x4* xr = (const f32x4*)(h + (size_t)row * DM) + c.lane;
#pragma unroll
        for (int j = 0; j < 4; ++j) { const f32x4 v = xr[64 * j]; const int k0 = 4 * c.lane + 256 * j;
#pragma unroll
            for (int e = 0; e < 4; ++e) { const f32x4 w0 = *(const LAS f32x4*)(wg + (k0 + e) * 8), w1 = *(const LAS f32x4*)(wg + (k0 + e) * 8 + 4);
                a[0] += v[e] * w0[0]; a[1] += v[e] * w0[1]; a[2] += v[e] * w0[2]; a[3] += v[e] * w0[3]; a[4] += v[e] * w1[0]; a[5] += v[e] * w1[1]; a[6] += v[e] * w1[2]; a[7] += v[e] * w1[3]; } }
#pragma unroll
        for (int j = 0; j < 8; ++j) a[j] = wave_sum(a[j]);
        if (c.lane == 0) { const float rs = rowss(ss, row);
            *(f32x4*)(gates + (size_t)row * 8) = (f32x4){a[0] * rs, a[1] * rs, a[2] * rs, a[3] * rs}; *(f32x4*)(gates + (size_t)row * 8 + 4) = (f32x4){a[4] * rs, a[5] * rs, a[6] * rs, a[7] * rs}; }
    }
    __syncthreads();
}

constexpr int ZS = 64;
#define ZP(z_, row_, colbase_) ((z_) + ((size_t)((colbase_) >> 6) * MTOK + (size_t)(row_)) * ZS)
#define YIMG_STORE(c_, row_, col_, w_) (*(u32x2*)((unsigned char*)wsb((c_), OFF_Y) + pg8::img_off((int)(row_), (col_))) = (w_))
DI void osm_update(f32x16& s, float& m, float& l, f32x16 (&O)[2], bf16x8& p0, bf16x8& p1) {
    float mx = fmaxf(s[0], s[1]);
#pragma unroll
    for (int i = 2; i < 16; ++i) mx = fmaxf(mx, s[i]);
    mx = fmaxf(mx, __shfl_xor(mx, 32));
    const float mn = fmaxf(m, mx);
    if (__any(mn > m)) {
        const float al = ex2(m - mn); l *= al;
#pragma unroll
        for (int i = 0; i < 16; ++i) { O[0][i] *= al; O[1][i] *= al; }
        m = mn;
    }
    float sum = 0.f;
#pragma unroll
    for (int i = 0; i < 16; ++i) { s[i] = ex2(s[i] - m); sum += s[i]; }
    l += sum;
    p0 = pack8(s[0], s[1], s[2], s[3], s[4], s[5], s[6], s[7]);
    p1 = pack8(s[8], s[9], s[10], s[11], s[12], s[13], s[14], s[15]);
}

constexpr int DK_KP = 144, DK_VP = 136;
constexpr int DF_KOFF = 0, DF_VOFF = 2 * 64 * DK_KP, DF_TOFF = DF_VOFF + 2 * 64 * DK_VP;
DI void diff_attn_task(const Params& p, const Ctx& c, int l, int b, int h, int qb) {
    const int tid = c.tid, lane = c.lane, wid = c.wid, r32 = lane & 31, hi = lane >> 5;
    const bf16_t* z = wsb(c, OFF_Z);
    const size_t rowbase = (size_t)b * SEQ;
    LAS unsigned char* lds = c.lds;
    LAS float* tbl = (LAS float*)(lds + DF_TOFF);
    __syncthreads();
    { const float* src = wsf(c, OFF_DIFFB) + h * 4096; for (int i = tid; i < 4096; i += 512) tbl[i] = src[i]; }
    const int qw0 = qb * 256 + wid * 32, qpos = qw0 + r32;
    bf16x8 qf[4];
    { const bf16_t* qp = ZP(z, rowbase + qpos, ZQD + h * 64);
#pragma unroll
      for (int s = 0; s < 4; ++s) qf[s] = *(const bf16x8*)(qp + 16 * s + 8 * hi); }
    f32x16 O1[2], O2[2];
#pragma unroll
    for (int i = 0; i < 16; ++i) { O1[0][i] = 0.f; O1[1][i] = 0.f; O2[0][i] = 0.f; O2[1][i] = 0.f; }
    float m1 = NEGBIG, m2 = NEGBIG, l1 = 0.f, l2 = 0.f;
    const int NT = (qb + 1) * 4;
    const int skey = tid >> 3, schunk = tid & 7;
    const bf16_t* kbase = ZP(z, rowbase + skey, ZKD + h * 64) + schunk * 8;
    const bf16_t* vbase = ZP(z, rowbase + skey, ZVD + h * 64) + schunk * 8;
    u32x4 kreg = *(const u32x4*)kbase, vreg = *(const u32x4*)vbase;
#define DF_WRITE(buf) do { *(LAS u32x4*)(lds + DF_KOFF + (buf) * 64 * DK_KP + skey * DK_KP + schunk * 16) = kreg; \
        LAS bf16_t* vt_ = (LAS bf16_t*)(lds + DF_VOFF + (buf) * 64 * DK_VP + skey * 2); \
        vt_[(schunk * 8 + 0) * (DK_VP / 2)] = (bf16_t)(vreg.x & 0xffff); vt_[(schunk * 8 + 1) * (DK_VP / 2)] = (bf16_t)(vreg.x >> 16); \
        vt_[(schunk * 8 + 2) * (DK_VP / 2)] = (bf16_t)(vreg.y & 0xffff); vt_[(schunk * 8 + 3) * (DK_VP / 2)] = (bf16_t)(vreg.y >> 16); \
        vt_[(schunk * 8 + 4) * (DK_VP / 2)] = (bf16_t)(vreg.z & 0xffff); vt_[(schunk * 8 + 5) * (DK_VP / 2)] = (bf16_t)(vreg.z >> 16); \
        vt_[(schunk * 8 + 6) * (DK_VP / 2)] = (bf16_t)(vreg.w & 0xffff); vt_[(schunk * 8 + 7) * (DK_VP / 2)] = (bf16_t)(vreg.w >> 16); } while (0)
    DF_WRITE(0);
    __syncthreads();
    for (int t = 0; t < NT; ++t) {
        const int buf = t & 1;
        if (t + 1 < NT) { kreg = *(const u32x4*)(kbase + (size_t)(t + 1) * 64 * ZS); vreg = *(const u32x4*)(vbase + (size_t)(t + 1) * 64 * ZS); }
        if (64 * t <= qw0 + 31) {
            const LAS unsigned char* kimg = lds + DF_KOFF + buf * 64 * DK_KP;
            const LAS unsigned char* vimg = lds + DF_VOFF + buf * 64 * DK_VP;
#pragma unroll
            for (int sub = 0; sub < 2; ++sub) {
                const int key0 = 64 * t + 32 * sub;
                if (key0 <= qw0 + 31) {
                    const LAS unsigned char* kr = kimg + (32 * sub + r32) * DK_KP + hi * 16;
                    const bf16x8 k0 = *(const LAS bf16x8*)(kr), k1 = *(const LAS bf16x8*)(kr + 32), k2 = *(const LAS bf16x8*)(kr + 64), k3 = *(const LAS bf16x8*)(kr + 96);
                    f32x16 s1, s2, bv;
                    const int dbase = qpos - key0 - 4 * hi;
                    if (key0 + 31 > qw0) {
#pragma unroll
                        for (int i = 0; i < 16; ++i) { const int d = dbase - ((i & 3) + 8 * (i >> 2)); const float bi = tbl[d < 0 ? 0 : d]; bv[i] = d < 0 ? NEGBIG : bi; }
                    } else {
#pragma unroll
                        for (int i = 0; i < 16; ++i) bv[i] = tbl[dbase - ((i & 3) + 8 * (i >> 2))];
                    }
                    s1 = MFMA32(k0, qf[0], bv); s1 = MFMA32(k1, qf[1], s1);
                    s2 = MFMA32(k2, qf[2], bv); s2 = MFMA32(k3, qf[3], s2);
                    bf16x8 pa0, pa1, pb0, pb1;
                    osm_update(s1, m1, l1, O1, pa0, pa1);
                    osm_update(s2, m2, l2, O2, pb0, pb1);
#pragma unroll
                    for (int dvt = 0; dvt < 2; ++dvt) {
                        const LAS unsigned char* vr = vimg + (32 * dvt + r32) * DK_VP + (32 * sub + 4 * hi) * 2;
                        const bf16x8 v0 = mk8(*(const LAS u32x2*)(vr), *(const LAS u32x2*)(vr + 16));
                        const bf16x8 v1 = mk8(*(const LAS u32x2*)(vr + 32), *(const LAS u32x2*)(vr + 48));
                        O1[dvt] = MFMA32(v0, pa0, O1[dvt]); O1[dvt] = MFMA32(v1, pa1, O1[dvt]);
                        O2[dvt] = MFMA32(v0, pb0, O2[dvt]); O2[dvt] = MFMA32(v1, pb1, O2[dvt]);
                    }
                }
            }
        }
        if (t + 1 < NT) DF_WRITE(buf ^ 1);
        __syncthreads();
    }
#undef DF_WRITE
    l1 += __shfl_xor(l1, 32); l2 += __shfl_xor(l2, 32);
    const float lam = wsf(c, OFF_LAM)[l];
    const float lam_init = 0.8f - 0.6f * expf(-0.3f * (float)l);
    const float i1 = 1.f / l1, i2 = lam / l2;
    float ssq = 0.f;
#pragma unroll
    for (int dvt = 0; dvt < 2; ++dvt)
#pragma unroll
        for (int i = 0; i < 16; ++i) { const float o = O1[dvt][i] * i1 - O2[dvt][i] * i2; O1[dvt][i] = o; ssq += o * o; }
    ssq += __shfl_xor(ssq, 32);
    const float rn = rsqrtf(ssq * (1.f / 64.f) + 1e-5f) * (1.f - lam_init);
    const float* sg = p.in[I_SUBLN] + l * 64;
#pragma unroll
    for (int dvt = 0; dvt < 2; ++dvt)
#pragma unroll
        for (int g = 0; g < 4; ++g) {
            const int dv = 32 * dvt + 8 * g + 4 * hi; const f32x4 gg = *(const f32x4*)(sg + dv);
            u32x2 w; w.x = cvtpk(O1[dvt][4 * g] * rn * gg[0], O1[dvt][4 * g + 1] * rn * gg[1]); w.y = cvtpk(O1[dvt][4 * g + 2] * rn * gg[2], O1[dvt][4 * g + 3] * rn * gg[3]);
            YIMG_STORE(c, rowbase + qpos, 768 + h * 64 + dv, w);
        }
}

constexpr int DL_NK = 384, DL_KP = 144, DL_VP = 776;
constexpr int DL_KOFF = 0, DL_VOFF = DL_NK * DL_KP, DL_TOFF = DL_VOFF + 64 * DL_VP;
DI void dil_attn_task(const Params& p, const Ctx& c, int pat, int b, int h, int res, int mb) {
    const int dil = pat == 0 ? 1 : (pat == 1 ? 4 : 16);
    const int tid = c.tid, lane = c.lane, wid = c.wid, r32 = lane & 31, hi = lane >> 5;
    const bf16_t* z = wsb(c, OFF_Z);
    const size_t rowbase = (size_t)b * SEQ;
    LAS unsigned char* lds = c.lds;
    LAS float* tbl = (LAS float*)(lds + DL_TOFF);
    __syncthreads();
    if (tid < 132) tbl[tid] = wsf(c, OFF_DILB)[(pat * 4 + h) * 132 + tid];
    const int mk0 = 256 * mb - 128;
    {
        u32x4 kreg[6], vreg[6];
#pragma unroll
        for (int it = 0; it < 6; ++it) {
            const int idx = tid + 512 * it, key = idx >> 3, chunk = idx & 7, mk = mk0 + key;
            kreg[it] = (u32x4){0u, 0u, 0u, 0u}; vreg[it] = (u32x4){0u, 0u, 0u, 0u};
            if (mk >= 0) { const size_t zr = rowbase + (size_t)mk * dil + res; kreg[it] = *(const u32x4*)(ZP(z, zr, ZKC + h * 64) + chunk * 8); vreg[it] = *(const u32x4*)(ZP(z, zr, ZVC + h * 64) + chunk * 8); }
        }
#pragma unroll
        for (int it = 0; it < 6; ++it) {
            const int idx = tid + 512 * it, key = idx >> 3, chunk = idx & 7;
            *(LAS u32x4*)(lds + DL_KOFF + key * DL_KP + chunk * 16) = kreg[it];
            LAS bf16_t* vt_ = (LAS bf16_t*)(lds + DL_VOFF + key * 2);
            vt_[(chunk * 8 + 0) * (DL_VP / 2)] = (bf16_t)(vreg[it].x & 0xffff); vt_[(chunk * 8 + 1) * (DL_VP / 2)] = (bf16_t)(vreg[it].x >> 16);
            vt_[(chunk * 8 + 2) * (DL_VP / 2)] = (bf16_t)(vreg[it].y & 0xffff); vt_[(chunk * 8 + 3) * (DL_VP / 2)] = (bf16_t)(vreg[it].y >> 16);
            vt_[(chunk * 8 + 4) * (DL_VP / 2)] = (bf16_t)(vreg[it].z & 0xffff); vt_[(chunk * 8 + 5) * (DL_VP / 2)] = (bf16_t)(vreg[it].z >> 16);
            vt_[(chunk * 8 + 6) * (DL_VP / 2)] = (bf16_t)(vreg[it].w & 0xffff); vt_[(chunk * 8 + 7) * (DL_VP / 2)] = (bf16_t)(vreg[it].w >> 16);
        }
    }
    const int mq = 256 * mb + 32 * wid + r32;
    const size_t qtok = rowbase + (size_t)mq * dil + res;
    bf16x8 qf[4];
    { const bf16_t* qp = ZP(z, qtok, ZQC + h * 64);
#pragma unroll
      for (int s = 0; s < 4; ++s) qf[s] = *(const bf16x8*)(qp + 16 * s + 8 * hi); }
    __syncthreads();
    f32x16 O[2];
#pragma unroll
    for (int i = 0; i < 16; ++i) { O[0][i] = 0.f; O[1][i] = 0.f; }
    float m = NEGBIG, lsum = 0.f;
    for (int j = 0; j < 5; ++j) {
        const int kt = wid + j;
        const LAS unsigned char* kr = lds + DL_KOFF + (32 * kt + r32) * DL_KP + hi * 16;
        f32x16 s;
        const int dbase = 128 - 32 * j + r32 - 4 * hi;
        const int mkb = mk0 + 32 * kt + 4 * hi;
        if (j == 0 || j == 4 || mb == 0) {
#pragma unroll
            for (int i = 0; i < 16; ++i) { const int cc = (i & 3) + 8 * (i >> 2); const int dl = dbase - cc; const bool ok = (dl >= 0) && (dl <= 128) && (mkb + cc >= 0);
                const int dc = dl < 0 ? 0 : (dl > 128 ? 128 : dl); s[i] = ok ? tbl[dc] : NEGBIG; }
        } else {
#pragma unroll
            for (int i = 0; i < 16; ++i) s[i] = tbl[dbase - ((i & 3) + 8 * (i >> 2))];
        }
#pragma unroll
        for (int ks = 0; ks < 4; ++ks) s = MFMA32(*(const LAS bf16x8*)(kr + 32 * ks), qf[ks], s);
        bf16x8 p0, p1;
        osm_update(s, m, lsum, O, p0, p1);
#pragma unroll
        for (int dvt = 0; dvt < 2; ++dvt) {
            const LAS unsigned char* vr = lds + DL_VOFF + (32 * dvt + r32) * DL_VP + (32 * kt + 4 * hi) * 2;
            const bf16x8 v0 = mk8(*(const LAS u32x2*)(vr), *(const LAS u32x2*)(vr + 16));
            const bf16x8 v1 = mk8(*(const LAS u32x2*)(vr + 32), *(const LAS u32x2*)(vr + 48));
            O[dvt] = MFMA32(v0, p0, O[dvt]); O[dvt] = MFMA32(v1, p1, O[dvt]);
        }
    }
    lsum += __shfl_xor(lsum, 32);
    const float inv = 1.f / lsum, lse = m + log2f(lsum);
    if (pat != 0) {
        bf16_t* orow = ((bf16_t*)((unsigned char*)c.out + (size_t)64 * 64 * 4096 * 4)) + ((size_t)(pat - 1) * MTOK + qtok) * 256 + h * 64;
#pragma unroll
        for (int dvt = 0; dvt < 2; ++dvt)
#pragma unroll
            for (int g = 0; g < 4; ++g) { u32x2 w; w.x = cvtpk(O[dvt][4 * g] * inv, O[dvt][4 * g + 1] * inv); w.y = cvtpk(O[dvt][4 * g + 2] * inv, O[dvt][4 * g + 3] * inv);
                *(u32x2*)(orow + 32 * dvt + 8 * g + 4 * hi) = w; }
        if (hi == 0) wsf(c, OFF_LSEP)[((size_t)(pat - 1) * MTOK + qtok) * 4 + h] = lse;
    } else {
        const float ls1 = wsf(c, OFF_LSEP)[qtok * 4 + h], ls2 = wsf(c, OFF_LSEP)[((size_t)MTOK + qtok) * 4 + h];
        const float mm = fmaxf(lse, fmaxf(ls1, ls2));
        const float w0 = ex2(lse - mm), w1 = ex2(ls1 - mm), w2 = ex2(ls2 - mm), wi = 1.f / (w0 + w1 + w2);
        const float a0 = w0 * wi * inv, a1 = w1 * wi, a2 = w2 * wi;
        const bf16_t* o1 = ((bf16_t*)((unsigned char*)c.out + (size_t)64 * 64 * 4096 * 4)) + qtok * 256 + h * 64; const bf16_t* o2 = o1 + (size_t)MTOK * 256;
#pragma unroll
        for (int dvt = 0; dvt < 2; ++dvt)
#pragma unroll
            for (int g = 0; g < 4; ++g) { const int dv = 32 * dvt + 8 * g + 4 * hi; const u32x2 x1 = *(const u32x2*)(o1 + dv), x2 = *(const u32x2*)(o2 + dv);
                const float r0 = O[dvt][4 * g] * a0 + bflo(x1.x) * a1 + bflo(x2.x) * a2, r1 = O[dvt][4 * g + 1] * a0 + bfhi(x1.x) * a1 + bfhi(x2.x) * a2;
                const float r2 = O[dvt][4 * g + 2] * a0 + bflo(x1.y) * a1 + bflo(x2.y) * a2, r3 = O[dvt][4 * g + 3] * a0 + bfhi(x1.y) * a1 + bfhi(x2.y) * a2;
                u32x2 w; w.x = cvtpk(r0, r1); w.y = cvtpk(r2, r3); YIMG_STORE(c, qtok, 512 + h * 64 + dv, w); }
    }
}

DI void pool_x(const bf16_t* bp0, int w, int cnt, float icnt, bf16x8 (&xf)[4]) {
    float sum[4][8]; u32x4 cur[4];
#pragma unroll
    for (int ks = 0; ks < 4; ++ks) {
        const bf16_t* bp = bp0 + 16 * ks;
        cur[ks] = *(const u32x4*)bp; const u32x4 prv = (cnt > 1) ? *(const u32x4*)(bp - ZS) : (u32x4){0u, 0u, 0u, 0u};
        sum[ks][0] = bflo(cur[ks].x) + bflo(prv.x); sum[ks][1] = bfhi(cur[ks].x) + bfhi(prv.x); sum[ks][2] = bflo(cur[ks].y) + bflo(prv.y); sum[ks][3] = bfhi(cur[ks].y) + bfhi(prv.y);
        sum[ks][4] = bflo(cur[ks].z) + bflo(prv.z); sum[ks][5] = bfhi(cur[ks].z) + bfhi(prv.z); sum[ks][6] = bflo(cur[ks].w) + bflo(prv.w); sum[ks][7] = bfhi(cur[ks].w) + bfhi(prv.w);
    }
#pragma unroll 1
    for (int j0 = 2; j0 < w; j0 += 2) {
        u32x4 v0[4], v1[4];
#pragma unroll
        for (int ks = 0; ks < 4; ++ks) { v0[ks] = (u32x4){0u, 0u, 0u, 0u}; v1[ks] = (u32x4){0u, 0u, 0u, 0u};
            if (j0 < cnt) v0[ks] = *(const u32x4*)(bp0 + 16 * ks - (size_t)j0 * ZS);
            if (j0 + 1 < cnt) v1[ks] = *(const u32x4*)(bp0 + 16 * ks - (size_t)(j0 + 1) * ZS); }
#pragma unroll
        for (int ks = 0; ks < 4; ++ks) {
            sum[ks][0] += bflo(v0[ks].x) + bflo(v1[ks].x); sum[ks][1] += bfhi(v0[ks].x) + bfhi(v1[ks].x); sum[ks][2] += bflo(v0[ks].y) + bflo(v1[ks].y); sum[ks][3] += bfhi(v0[ks].y) + bfhi(v1[ks].y);
            sum[ks][4] += bflo(v0[ks].z) + bflo(v1[ks].z); sum[ks][5] += bfhi(v0[ks].z) + bfhi(v1[ks].z); sum[ks][6] += bflo(v0[ks].w) + bflo(v1[ks].w); sum[ks][7] += bfhi(v0[ks].w) + bfhi(v1[ks].w); }
    }
#pragma unroll
    for (int ks = 0; ks < 4; ++ks)
        xf[ks] = pack8(sum[ks][0] * icnt - bflo(cur[ks].x), sum[ks][1] * icnt - bfhi(cur[ks].x), sum[ks][2] * icnt - bflo(cur[ks].y), sum[ks][3] * icnt - bfhi(cur[ks].y),
                       sum[ks][4] * icnt - bflo(cur[ks].z), sum[ks][5] * icnt - bfhi(cur[ks].z), sum[ks][6] * icnt - bflo(cur[ks].w), sum[ks][7] * icnt - bfhi(cur[ks].w));
}
DI void pool_task(const Params& p, const Ctx& c, int l, int wt) {
    const int lane = c.lane, r32 = lane & 31, hi = lane >> 5;
    const int g = (wt + (wt >> 11)) & 3, rt = wt >> 2;
    const size_t row = (size_t)rt * 32 + r32; const int t = (int)(row & (SEQ - 1));
    const int w = 2 << g, cnt = (t + 1 < w) ? t + 1 : w; const float icnt = 1.f / (float)cnt;
    const bf16_t* z = wsb(c, OFF_Z);
    bf16x8 xf[4];
    const bf16_t* bp0 = ZP(z, row, ZPB + g * 64) + 8 * hi;
    pool_x(bp0, w, cnt, icnt, xf);
    const float* pw = p.in[I_POOLW] + ((size_t)l * 4 + g) * 64 * 64;
    const float* psc = p.in[I_POOLS] + l * 256 + g * 64;
#pragma unroll 1
    for (int dt = 0; dt < 2; ++dt) {
        f32x16 acc;
#pragma unroll
        for (int i = 0; i < 16; ++i) acc[i] = 0.f;
#pragma unroll
        for (int ks = 0; ks < 4; ++ks) {
            const float* wp = pw + (size_t)(16 * ks + 8 * hi) * 64 + 32 * dt + r32;
            const bf16x8 wf = pack8(wp[0], wp[64], wp[128], wp[192], wp[256], wp[320], wp[384], wp[448]);
            acc = MFMA32(wf, xf[ks], acc);
        }
#pragma unroll
        for (int gq = 0; gq < 4; ++gq) { const int dd = 32 * dt + 8 * gq + 4 * hi; const f32x4 sc = *(const f32x4*)(psc + dd);
            u32x2 wv; wv.x = cvtpk(acc[4 * gq] * sc[0], acc[4 * gq + 1] * sc[1]); wv.y = cvtpk(acc[4 * gq + 2] * sc[2], acc[4 * gq + 3] * sc[3]); YIMG_STORE(c, row, 256 + g * 64 + dd, wv); }
    }
}

DI float scan_add(float v, int lane) {
#pragma unroll
    for (int o = 1; o < 64; o <<= 1) { const float n = __shfl_up(v, o); if (lane >= o) v += n; }
    return v;
}
DI float scan_max(float v, int lane) {
#pragma unroll
    for (int o = 1; o < 64; o <<= 1) { const float n = __shfl_up(v, o); if (lane >= o) v = fmaxf(v, n); }
    return v;
}
DI float log_sigmoid(float x) { return fminf(x, 0.f) - log1pf(expf(-fabsf(x))); }
DI void conv8(const bf16_t* zp, int t, const float* cw, const float* cb, float scale, float (&o)[8]) {
    const f32x4 b0 = *(const f32x4*)cb, b1 = *(const f32x4*)(cb + 4);
    o[0] = b0[0]; o[1] = b0[1]; o[2] = b0[2]; o[3] = b0[3]; o[4] = b1[0]; o[5] = b1[1]; o[6] = b1[2]; o[7] = b1[3];
#pragma unroll
    for (int tap = 0; tap < 4; ++tap) {
        if (t - 3 + tap >= 0) {
            const u32x4 v = *(const u32x4*)(zp - (size_t)(3 - tap) * ZS);
            const f32x4 w0 = *(const f32x4*)(cw + tap * 512), w1 = *(const f32x4*)(cw + tap * 512 + 4);
            o[0] += bflo(v.x) * w0[0]; o[1] += bfhi(v.x) * w0[1]; o[2] += bflo(v.y) * w0[2]; o[3] += bfhi(v.y) * w0[3];
            o[4] += bflo(v.z) * w1[0]; o[5] += bfhi(v.z) * w1[1]; o[6] += bflo(v.w) * w1[2]; o[7] += bfhi(v.w) * w1[3];
        }
    }
#pragma unroll
    for (int e = 0; e < 8; ++e) o[e] = silu_f(o[e]) * scale;
    asm volatile("" ::: "memory");
}
DI void conv_frag4(const bf16_t* zp, int t, const LAS float* cw, const LAS float* cb, int hi, float scale, bf16x8 (&out)[4]) {
    asm volatile("" ::: "memory");
#pragma unroll
    for (int kh = 0; kh < 2; ++kh) {
        u32x4 v[2][4];
#pragma unroll
        for (int k2 = 0; k2 < 2; ++k2)
#pragma unroll
            for (int tap = 0; tap < 4; ++tap) { v[k2][tap] = (u32x4){0u, 0u, 0u, 0u}; if (t - 3 + tap >= 0) v[k2][tap] = *(const u32x4*)(zp + 16 * (2 * kh + k2) - (size_t)(3 - tap) * ZS); }
#pragma unroll
        for (int k2 = 0; k2 < 2; ++k2) {
            const int ks = 2 * kh + k2, d0 = 16 * ks + 8 * hi;
            const f32x4 b0 = *(const LAS f32x4*)(cb + d0), b1 = *(const LAS f32x4*)(cb + d0 + 4);
            float o[8] = {b0[0], b0[1], b0[2], b0[3], b1[0], b1[1], b1[2], b1[3]};
#pragma unroll
            for (int tap = 0; tap < 4; ++tap) {
                const f32x4 w0 = *(const LAS f32x4*)(cw + tap * 64 + d0), w1 = *(const LAS f32x4*)(cw + tap * 64 + d0 + 4); const u32x4 x = v[k2][tap];
                o[0] += bflo(x.x) * w0[0]; o[1] += bfhi(x.x) * w0[1]; o[2] += bflo(x.y) * w0[2]; o[3] += bfhi(x.y) * w0[3];
                o[4] += bflo(x.z) * w1[0]; o[5] += bfhi(x.z) * w1[1]; o[6] += bflo(x.w) * w1[2]; o[7] += bfhi(x.w) * w1[3];
            }
            out[ks] = pack8(silu_f(o[0]) * scale, silu_f(o[1]) * scale, silu_f(o[2]) * scale, silu_f(o[3]) * scale, silu_f(o[4]) * scale, silu_f(o[5]) * scale, silu_f(o[6]) * scale, silu_f(o[7]) * scale);
        }
        asm volatile("" ::: "memory");
    }
}
DI void mlstm_a_task(const Params& p, const Ctx& c, int l, int task) {
    const int lane = c.lane, r32 = lane & 31, hi = lane >> 5;
    const int bh = task >> 6, ch = task & 63, b = bh >> 2, h = bh & 3, t0 = ch * 64;
    const size_t rowbase = (size_t)b * SEQ;
    const bf16_t* z = wsb(c, OFF_Z);
    const float* gates = wsf(c, OFF_GATES) + (rowbase + t0 + lane) * 8;
    const float* gb = p.in[I_GATEB] + l * 8;
    const float ig = gates[h] + gb[h], lf = log_sigmoid(gates[4 + h] + gb[4 + h]);
    const float bcs = scan_add(lf, lane);
    const float gp = ig - bcs;
    const float mu = wave_max(gp);
    const float ws_ = expf(gp - mu);
    const float Bc = __shfl(bcs, 63);
    if (lane == 0) { wsf(c, OFF_SCAL)[task] = Bc; wsf(c, OFF_SCAL)[4096 + task] = mu; }
    const float* cwl = p.in[I_CONVW] + (size_t)l * 4 * 512; const float* cbl = p.in[I_CONVB] + l * 512;
    f32x16 acc[2][2];
#pragma unroll
    for (int a = 0; a < 2; ++a)
#pragma unroll
        for (int bb = 0; bb < 2; ++bb)
#pragma unroll
            for (int i = 0; i < 16; ++i) acc[a][bb][i] = 0.f;
    float nsum[2] = {0.f, 0.f};
#pragma unroll
    for (int ks = 0; ks < 4; ++ks) {
        const int s0 = 16 * ks + 8 * hi;
        float wv[8];
#pragma unroll
        for (int j = 0; j < 8; ++j) wv[j] = __shfl(ws_, s0 + j);
        bf16x8 kf[2];
#pragma unroll
        for (int it = 0; it < 2; ++it) {
            const int chn = 256 + h * 64 + 32 * it + r32;
            const float w0 = cwl[chn], w1 = cwl[512 + chn], w2 = cwl[1024 + chn], w3 = cwl[1536 + chn], cb = cbl[chn];
            const bf16_t* kp = ZP(z, rowbase + t0 + s0, ZKA + h * 64) + 32 * it + r32;
            float raw[11];
#pragma unroll
            for (int x = 0; x < 11; ++x) raw[x] = (t0 + s0 - 3 + x >= 0) ? bf2f(kp[(long)(x - 3) * ZS]) : 0.f;
            float kk[8];
#pragma unroll
            for (int j = 0; j < 8; ++j) { const float o = cb + w0 * raw[j] + w1 * raw[j + 1] + w2 * raw[j + 2] + w3 * raw[j + 3]; kk[j] = silu_f(o) * 0.125f * wv[j]; nsum[it] += kk[j]; }
            kf[it] = pack8(kk[0], kk[1], kk[2], kk[3], kk[4], kk[5], kk[6], kk[7]);
        }
#pragma unroll
        for (int et = 0; et < 2; ++et) {
            const bf16_t* vp = ZP(z, rowbase + t0 + s0, ZVA + h * 64) + 32 * et + r32;
            u32x4 w; w.x = (unsigned)vp[0] | ((unsigned)vp[ZS] << 16); w.y = (unsigned)vp[2 * ZS] | ((unsigned)vp[3 * ZS] << 16);
            w.z = (unsigned)vp[4 * ZS] | ((unsigned)vp[5 * ZS] << 16); w.w = (unsigned)vp[6 * ZS] | ((unsigned)vp[7 * ZS] << 16);
            const bf16x8 vf = __builtin_bit_cast(bf16x8, w);
            acc[et][0] = MFMA32(vf, kf[0], acc[et][0]); acc[et][1] = MFMA32(vf, kf[1], acc[et][1]);
        }
    }
    float* D = ((float*)c.out) + (size_t)task * 4096;
#pragma unroll
    for (int et = 0; et < 2; ++et)
#pragma unroll
        for (int it = 0; it < 2; ++it)
#pragma unroll
            for (int i = 0; i < 16; ++i) D[(32 * et + crow(i, hi)) * 64 + 32 * it + r32] = acc[et][it][i];
    nsum[0] += __shfl_xor(nsum[0], 32); nsum[1] += __shfl_xor(nsum[1], 32);
    if (hi == 0) { wsf(c, OFF_NST)[(size_t)task * 64 + r32] = nsum[0]; wsf(c, OFF_NST)[(size_t)task * 64 + 32 + r32] = nsum[1]; }
}
DI void mlstm_scan(const Params& p, const Ctx& c) {
    const float* Bc = wsf(c, OFF_SCAL); const float* mu = Bc + 4096; float* mprev = wsf(c, OFF_SCAL) + 8192;
    float* D = ((float*)c.out); float* N = wsf(c, OFF_NST);
    LAS float* cwl = (LAS float*)c.lds; LAS float* swl = cwl + 64;
    for (int task = c.bid; task < 256; task += c.G) {
        const int bh = task >> 2, q = task & 3;
        __syncthreads();
        if (c.wid == 0) {
            const float B = Bc[bh * 64 + c.lane], u = mu[bh * 64 + c.lane];
            float m = 0.f, mycw = 0.f, mysw = 0.f, mymp = 0.f;
            for (int ch = 0; ch < 64; ++ch) {
                const float Bs = __shfl(B, ch), us = __shfl(u, ch);
                const float mnew = fmaxf(Bs + m, Bs + us);
                const float cw = expf(Bs + m - mnew), sw = expf(Bs + us - mnew);
                if (c.lane == ch) { mycw = cw; mysw = sw; mymp = m; }
                m = mnew;
            }
            cwl[c.lane] = mycw; swl[c.lane] = mysw;
            if (q == 0) mprev[bh * 64 + c.lane] = mymp;
        }
        __syncthreads();
        for (int idx = q * 1040 + c.tid; idx < (q + 1) * 1040; idx += 512) {
            float* base = idx < 4096 ? D + (size_t)bh * 64 * 4096 + idx : N + (size_t)bh * 64 * 64 + (idx - 4096);
            const size_t stride = idx < 4096 ? 4096 : 64;
            float d[64];
#pragma unroll
            for (int ch = 0; ch < 64; ++ch) d[ch] = base[(size_t)ch * stride];
            float C = 0.f;
#pragma unroll
            for (int ch = 0; ch < 64; ++ch) { const float dv = d[ch]; base[(size_t)ch * stride] = C; C = cwl[ch] * C + swl[ch] * dv; }
        }
    }
}
DI void mlstm_c_task(const Params& p, const Ctx& c, int l, int task) {
    const int lane = c.lane, r32 = lane & 31, hi = lane >> 5;
    const int bh = task >> 6, ch = task & 63, b = bh >> 2, h = bh & 3, t0 = ch * 64;
    const size_t rowbase = (size_t)b * SEQ;
    const bf16_t* z = wsb(c, OFF_Z);
    const float* gates = wsf(c, OFF_GATES) + (rowbase + t0 + lane) * 8;
    const float* gb = p.in[I_GATEB] + l * 8;
    const float ig = gates[h] + gb[h], lf = log_sigmoid(gates[4 + h] + gb[4 + h]);
    const float bcs = scan_add(lf, lane);
    const float gp = ig - bcs;
    const float mp = wsf(c, OFF_SCAL)[8192 + task];
    const float pm = scan_max(gp, lane);
    const float mt = bcs + fmaxf(mp, pm);
    const float bm = bcs - mt;
    const float iw = expf(bcs + mp - mt);
    const float flo = expf(-mt);
    const float* cwl = p.in[I_CONVW] + (size_t)l * 4 * 512; const float* cbl = p.in[I_CONVB] + l * 512;
    const float* Ct = ((float*)c.out) + (size_t)task * 4096;
    const float* nst = wsf(c, OFF_NST) + (size_t)task * 64;
    const float* ng = p.in[I_MLN] + l * 256 + h * 64;
#pragma unroll 1
    for (int tt = 0; tt < 2; ++tt) {
        const int tq = 32 * tt + r32;
        const float bm_t = __shfl(bm, tq), iw_t = __shfl(iw, tq), flo_t = __shfl(flo, tq);
        bf16x8 qf[4]; float qn = 0.f;
#pragma unroll
        for (int ks = 0; ks < 4; ++ks) { float o[8]; const int d0 = 16 * ks + 8 * hi;
            conv8(ZP(z, rowbase + t0 + tq, ZQA + h * 64) + d0, t0 + tq, cwl + h * 64 + d0, cbl + h * 64 + d0, 1.f, o);
            qf[ks] = pack8(o[0], o[1], o[2], o[3], o[4], o[5], o[6], o[7]);
            const u32x4 qw = __builtin_bit_cast(u32x4, qf[ks]);
            const f32x4 n0 = *(const f32x4*)(nst + d0), n1 = *(const f32x4*)(nst + d0 + 4);
            qn += bflo(qw.x) * n0[0] + bfhi(qw.x) * n0[1] + bflo(qw.y) * n0[2] + bfhi(qw.y) * n0[3] + bflo(qw.z) * n1[0] + bfhi(qw.z) * n1[1] + bflo(qw.w) * n1[2] + bfhi(qw.w) * n1[3]; }
        qn += __shfl_xor(qn, 32);
        f32x16 num[2];
#pragma unroll
        for (int i = 0; i < 16; ++i) { num[0][i] = 0.f; num[1][i] = 0.f; }
#pragma unroll
        for (int et = 0; et < 2; ++et)
#pragma unroll
            for (int ks = 0; ks < 4; ++ks) { const float* cp = Ct + (size_t)(32 * et + r32) * 64 + 16 * ks + 8 * hi; const f32x4 c0 = *(const f32x4*)cp, c1 = *(const f32x4*)(cp + 4);
                num[et] = MFMA32(pack8(c0[0], c0[1], c0[2], c0[3], c1[0], c1[1], c1[2], c1[3]), qf[ks], num[et]); }
#pragma unroll
        for (int i = 0; i < 16; ++i) { num[0][i] *= iw_t; num[1][i] *= iw_t; }
        float dsum = 0.f;
#pragma unroll 1
        for (int st = 0; st <= tt; ++st) {
            f32x16 s;
#pragma unroll
            for (int i = 0; i < 16; ++i) s[i] = 0.f;
#pragma unroll
            for (int ks = 0; ks < 4; ++ks) { float o[8]; const int sk = 32 * st + r32, d0 = 16 * ks + 8 * hi;
                conv8(ZP(z, rowbase + t0 + sk, ZKA + h * 64) + d0, t0 + sk, cwl + 256 + h * 64 + d0, cbl + 256 + h * 64 + d0, 0.125f, o);
                s = MFMA32(pack8(o[0], o[1], o[2], o[3], o[4], o[5], o[6], o[7]), qf[ks], s); }
#pragma unroll
            for (int i = 0; i < 16; ++i) { const int sp = 32 * st + crow(i, hi); const float gs = __shfl(gp, sp);
                const float wgt = (sp <= tq) ? expf(gs + bm_t) : 0.f; s[i] *= wgt; dsum += s[i]; }
            const bf16x8 p0 = pack8(s[0], s[1], s[2], s[3], s[4], s[5], s[6], s[7]), p1 = pack8(s[8], s[9], s[10], s[11], s[12], s[13], s[14], s[15]);
#pragma unroll
            for (int et = 0; et < 2; ++et)
#pragma unroll
                for (int k2 = 0; k2 < 2; ++k2) {
                    const bf16_t* vp = ZP(z, rowbase + t0 + 32 * st + 16 * k2 + 4 * hi, ZVA + h * 64) + 32 * et + r32;
                    u32x4 w; w.x = (unsigned)vp[0] | ((unsigned)vp[ZS] << 16); w.y = (unsigned)vp[2 * ZS] | ((unsigned)vp[3 * ZS] << 16);
                    w.z = (unsigned)vp[8 * ZS] | ((unsigned)vp[9 * ZS] << 16); w.w = (unsigned)vp[10 * ZS] | ((unsigned)vp[11 * ZS] << 16);
                    num[et] = MFMA32(__builtin_bit_cast(bf16x8, w), k2 == 0 ? p0 : p1, num[et]);
                }
        }
        dsum += __shfl_xor(dsum, 32);
        const float den = iw_t * qn + dsum;
        const float idn = 1.f / fmaxf(fabsf(den), flo_t);
        float sm = 0.f;
#pragma unroll
        for (int et = 0; et < 2; ++et)
#pragma unroll
            for (int i = 0; i < 16; ++i) { const float hv = num[et][i] * idn; num[et][i] = hv; sm += hv; }
        sm += __shfl_xor(sm, 32);
        const float mean = sm * (1.f / 64.f);
        float vs = 0.f;
#pragma unroll
        for (int et = 0; et < 2; ++et)
#pragma unroll
            for (int i = 0; i < 16; ++i) { const float d = num[et][i] - mean; num[et][i] = d; vs += d * d; }
        vs += __shfl_xor(vs, 32);
        const float rstd = rsqrtf(vs * (1.f / 64.f) + 1e-6f);
        const size_t tok = rowbase + t0 + tq;
        const bf16_t* orow = ZP(z, tok, ZOA + h * 64);
#pragma unroll
        for (int et = 0; et < 2; ++et)
#pragma unroll
            for (int g = 0; g < 4; ++g) { const int e = 32 * et + 8 * g + 4 * hi; const f32x4 gg = *(const f32x4*)(ng + e); const u32x2 ov = *(const u32x2*)(orow + e);
                const float y0 = num[et][4 * g] * rstd * gg[0] * sigmoid_f(bflo(ov.x)), y1 = num[et][4 * g + 1] * rstd * gg[1] * sigmoid_f(bfhi(ov.x));
                const float y2 = num[et][4 * g + 2] * rstd * gg[2] * sigmoid_f(bflo(ov.y)), y3 = num[et][4 * g + 3] * rstd * gg[3] * sigmoid_f(bfhi(ov.y));
                u32x2 w; w.x = cvtpk(y0, y1); w.y = cvtpk(y2, y3); YIMG_STORE(c, tok, h * 64 + e, w); }
    }
}

DI void ph_mix1(const Params& p, const Ctx& c0, int l) {
    const Ctx c = fresh(c0);
    REP(R_DIFF) for (int pt = c.bid; pt < 512; pt += c.G) { const int bh = pt >> 3, s = pt & 7; diff_attn_task(p, c, l, bh >> 2, bh & 3, 15 - s); diff_attn_task(p, c, l, bh >> 2, bh & 3, s); }
    REP(R_DIL) for (int i = c.bid; i < 1024; i += c.G) { const int bh = i >> 4, rest = i & 15; dil_attn_task(p, c, 1, bh >> 2, bh & 3, rest >> 2, rest & 3); }
    REP(R_DIL) for (int i = c.bid; i < 1024; i += c.G) { const int bh = i >> 4; dil_attn_task(p, c, 2, bh >> 2, bh & 3, i & 15, 0); }
    __syncthreads();
    REP(R_POOL) for (int wt = c.bid * 8 + c.wid; wt < 8192; wt += c.G * 8) pool_task(p, c, l, wt);
    REP(R_MLA) for (int tk = c.bid * 8 + c.wid; tk < 4096; tk += c.G * 8) mlstm_a_task(p, c, l, tk);
}
DI void ph_mix2(const Params& p, const Ctx& c0, int l) {
    const Ctx c = fresh(c0);
    mlstm_scan(p, c);
    REP(R_DIL) for (int i = c.bid; i < 1024; i += c.G) { const int bh = i >> 4; dil_attn_task(p, c, 0, bh >> 2, bh & 3, 0, i & 15); }
    __syncthreads();
}
DI void ph_mix3(const Params& p, const Ctx& c0, int l) {
    const Ctx c = fresh(c0);
    REP(R_MLC) for (int tk = c.bid * 8 + c.wid; tk < 4096; tk += c.G * 8) mlstm_c_task(p, c, l, tk);
}
DI void ph_final(const Params& p, const Ctx& c0) {
    const Ctx c = fresh(c0);
    const float* ss = ssbuf(c, 16); const float* g = p.in[I_FINN]; const bf16_t* hb = wsb(c, OFF_HB);
    for (int row = c.bid * 8 + c.wid; row < MTOK; row += c.G * 8) {
        const float rs = rowss(ss, row);
        f32x4* xr = (f32x4*)(c.out + (size_t)row * DM) + c.lane; const f32x4* gr = (const f32x4*)g + c.lane; const unsigned char* hbimg = (const unsigned char*)hb;
#pragma unroll
        for (int j = 0; j < 4; ++j) { const u32x2 hv = *(const u32x2*)(hbimg + pg8::img_off(row, 4 * (c.lane + 64 * j))); const f32x4 gg = gr[64 * j];
            xr[64 * j] = (f32x4){bflo(hv.x) * rs * gg[0], bfhi(hv.x) * rs * gg[1], bflo(hv.y) * rs * gg[2], bfhi(hv.y) * rs * gg[3]}; }
    }
}

DI void ph_ffn_up(const Params& p, const Ctx& c0, int l, int which) {
    const Ctx c = fresh(c0);
    pg8::Gemm g = pg8::plain_gemm(wsb(c, OFF_HB), (const bf16_t*)(c.ws + (size_t)l * W_LAYER + (which ? W_GU2 : W_GU1)), MTOK, 2 * FF, DM); g.ocol_step = 128; pg8::use_img_b(g); pg8::use_img_a(g);
    pg8::Order S; S.init(g, c.G, c.bid);
    pg8::EpiSwiGLU E{wsb(c, OFF_Z), FF, ssbuf(c, 4 * l + (which ? 3 : 0))};
    pg8::gemm_phase(c.lds, g, S, E);
}
DI void ph_resid(const Params& p, const Ctx& c0, const bf16_t* A, const bf16_t* Bt, int K, int ss_out, float alpha) {
    const Ctx c = fresh(c0);
    pg8::Gemm g = pg8::plain_gemm(A, Bt, MTOK, DM, K);
    pg8::use_img_a(g); pg8::use_img_b(g); if (K == FF) g.a_pmdiv = (long)(FF / 64) * 256 * 64;
    pg8::Order S; S.init(g, c.G, c.bid);
    pg8::EpiResid E{wsb(c, OFF_HB), ssbuf(c, ss_out), alpha};
    pg8::gemm_phase(c.lds, g, S, E);
}
DI void ph_kv(const Params& p, const Ctx& c0) {
    const Ctx c = fresh(c0);
    { pg8::Gemm g = pg8::plain_gemm(wsb(c, OFF_MEMB), wsb(c, OFF_WK), MMEM, 4096, DM); pg8::Order S; S.init(g, c.G, c.bid);
      pg8::EpiBf16 E{wsb(c, OFF_KB), 4096, nullptr, wsf(c, OFF_RSM), nullptr, 1.f, 0}; pg8::gemm_phase(c.lds, g, S, E); }
    { pg8::Gemm g = pg8::plain_gemm(wsb(c, OFF_MEMB), wsb(c, OFF_WV), MMEM, 4096, DM); pg8::Order S; S.init(g, c.G, c.bid);
      pg8::EpiBf16 E{wsb(c, OFF_VT), 4096, nullptr, wsf(c, OFF_RSM), nullptr, 1.f, 0}; pg8::gemm_phase(c.lds, g, S, E); }
}
DI void ph_win(const Params& p, const Ctx& c0, int l) {
    const Ctx c = fresh(c0);
    pg8::Gemm g = pg8::plain_gemm(wsb(c, OFF_HB), (const bf16_t*)(c.ws + (size_t)l * W_LAYER + W_IN), MTOK, 3072, DM); pg8::use_img_b(g); pg8::use_img_a(g);
    pg8::Order S; S.init(g, c.G, c.bid);
    pg8::EpiZ E{wsb(c, OFF_Z), wsf(c, OFF_GATES), ssbuf(c, 4 * l + 1)};
    pg8::gemm_phase(c.lds, g, S, E);
}
constexpr size_t OFF_MT = OFF_Z, OFF_VWT = OFF_Z + (size_t)16384 * DM * 2;
DI void ph_xpre(const Params& p, const Ctx& c0, int l) {
    const Ctx c = fresh(c0);
    const unsigned char* wl = c.ws + (size_t)l * W_LAYER;
    { pg8::Gemm g; g.A = wsb(c, OFF_KB) + l * 1024; g.B = (const bf16_t*)(wl + W_Q); g.lda = 4096; g.ldb = DM; g.K = 256; g.nM = 64; g.nN = 4;
      g.div = 4; g.a_pmdiv = 256L * 4096; g.a_pmmod = 256; g.a_pn = 0; g.b_pmdiv = 0; g.b_pmmod = 256; g.b_pn = 256L * DM; g.ocol_step = 256; g.kstepA = 128; g.kstepB = 128; g.imgA = 0; g.imgB = 0;
      pg8::Order S; S.init(g, c.G, c.bid);
      pg8::EpiBf16 E{wsb(c, OFF_MT), DM, nullptr, nullptr, nullptr, 1.f, 3}; pg8::gemm_phase(c.lds, g, S, E); }
    { pg8::Gemm g; g.A = (const bf16_t*)(wl + W_O); g.B = wsb(c, OFF_VT) + l * 1024; g.lda = DM; g.ldb = 4096; g.K = 256; g.nM = 64; g.nN = 4;
      g.div = 4; g.a_pmdiv = 0; g.a_pmmod = 256L * DM; g.a_pn = 256; g.b_pmdiv = 256L * 4096; g.b_pmmod = 0; g.b_pn = 256; g.ocol_step = 256; g.kstepA = 128; g.kstepB = 128; g.imgA = 0; g.imgB = 0;
      pg8::Order S; S.init(g, c.G, c.bid);
      pg8::EpiBf16 E{wsb(c, OFF_VWT), DM, nullptr, nullptr, nullptr, 1.f, 3}; pg8::gemm_phase(c.lds, g, S, E); }
}
DI void ph_xs(const Params& p, const Ctx& c0, int l) {
    const Ctx c = fresh(c0);
    pg8::Gemm g; g.A = wsb(c, OFF_HB); g.B = wsb(c, OFF_MT); g.lda = DM; g.ldb = DM; g.K = DM; g.nM = MTOK / 256; g.nN = 4;
    g.div = 16; g.a_pmdiv = 16L * 256 * DM; g.a_pmmod = 256L * DM; g.a_pn = 0; g.b_pmdiv = 4L * 256 * DM; g.b_pmmod = 0; g.b_pn = 256L * DM; g.ocol_step = 256; g.kstepA = 128; g.kstepB = 128; g.imgA = 0; g.imgB = 0; pg8::use_img_a(g); g.imgB = 1; g.ldb = 64; g.kstepB = 256 * 64 * 2;
    pg8::Order S; S.init(g, c.G, c.bid);
    pg8::EpiSoftmax E{wsb(c, OFF_Y), DM, (LAS float*)(c.lds + LDS_EXTRA), ssbuf(c, 4 * l + 2), 0.0625f * LOG2E};
    pg8::gemm_phase(c.lds, g, S, E);
}
DI void ph_xo(const Params& p, const Ctx& c0, int l) {
    const Ctx c = fresh(c0);
    pg8::Gemm g; g.A = wsb(c, OFF_Y); g.B = wsb(c, OFF_VWT); g.lda = DM; g.ldb = DM; g.K = DM; g.nM = MTOK / 256; g.nN = 4;
    g.div = 16; g.a_pmdiv = 16L * 256 * DM; g.a_pmmod = 256L * DM; g.a_pn = 0; g.b_pmdiv = 1024L * DM; g.b_pmmod = 0; g.b_pn = 256L * DM; g.ocol_step = 256; g.kstepA = 128; g.kstepB = 128; g.imgA = 0; g.imgB = 0; pg8::use_img_a(g); g.imgB = 1; g.ldb = 64; g.kstepB = 256 * 64 * 2;
    pg8::Order S; S.init(g, c.G, c.bid);
    pg8::EpiResid E{wsb(c, OFF_HB), ssbuf(c, 4 * l + 3), 1.f};
    pg8::gemm_phase(c.lds, g, S, E);
}

constexpr int PH_PER_LAYER = 11, PH_FINAL = 1 + PH_PER_LAYER * DEPTH, PH_TOTAL = PH_FINAL + 1;
__global__ void __launch_bounds__(512, 2) mega_fwd(Params pk) {
    extern __shared__ __attribute__((aligned(16))) unsigned char lds_raw[];
    volatile LAS unsigned* bst = (volatile LAS unsigned*)((LAS unsigned char*)lds_raw + LDS_EXTRA + 12288);
    XcdBarrier xbar; xbar.bar = (unsigned*)(pk.ws + OFF_CTL); xbar.x = 0; xbar.st = bst;
    if (pk.coop) { if (threadIdx.x < 4) bst[threadIdx.x] = 0u; __syncthreads(); xbar = xcd_barrier_post((unsigned*)(pk.ws + OFF_CTL), bst); }
    for (int ph = pk.ph_lo; ph < pk.ph_hi; ++ph) {
        int tid = threadIdx.x; asm volatile("" : "+v"(tid));
        const Params& p = pk;
        Ctx c; c.lds = (LAS unsigned char*)lds_raw; c.ldsg = lds_raw; c.tid = tid; c.lane = tid & 63; c.wid = __builtin_amdgcn_readfirstlane(tid >> 6);
        c.bid = blockIdx.x; c.G = gridDim.x; c.ws = pk.ws; c.out = pk.out;
        asm volatile("" : "+s"(c.ws)); asm volatile("" : "+s"(c.out));
        if (ph == 0) {
#ifndef NO_PRO
            REP(R_PRO) ph_prologue(p, c);
#endif
        }
        else if (ph == PH_FINAL) ph_final(p, c);
        else {
            const int l = (ph - 1) / PH_PER_LAYER, j = (ph - 1) % PH_PER_LAYER;
            const unsigned char* wl = c.ws + (size_t)l * W_LAYER;
#ifdef ONLY_CASE
            if (j != ONLY_CASE) continue;
#endif
            switch (j) {
                case 0: REP(R_UP) ph_ffn_up(p, c, l, 0); if (l == 0) ph_kv(p, c); break;
                case 1: ph_resid(p, c, wsb(c, OFF_Z), (const bf16_t*)(wl + W_D1), FF, 4 * l + 1, 0.5f); break;
                case 2: ph_win(p, c, l); break;
                case 3:
#ifndef NO_MIX1
                    ph_mix1(p, c, l);
#endif
                    break;
                case 4:
#ifndef NO_MIX2
                    ph_mix2(p, c, l);
#endif
                    break;
                case 5:
#ifndef NO_MIX3
                    ph_mix3(p, c, l);
#endif
                    break;
                case 6: ph_resid(p, c, wsb(c, OFF_Y), (const bf16_t*)(wl + W_OUT), DM, 4 * l + 2, 1.f); ph_xpre(p, c, l); break;
                case 7: ph_xs(p, c, l); break;
                case 8: ph_xo(p, c, l); break;
                case 9: ph_ffn_up(p, c, l, 1); break;
                default: ph_resid(p, c, wsb(c, OFF_Z), (const bf16_t*)(wl + W_D2), FF, 4 * l + 4, 0.5f); break;
            }
        }
        if (ph + 1 < pk.ph_hi && pk.coop) { if (ph == pk.ph_lo) cg::this_grid().sync(); else xcd_barrier(xbar); }
    }
}

extern "C" void kernel_launch(void* const* d_in, const int* in_sizes, int n_in, void* d_out, int out_size, void* d_ws, size_t ws_size, hipStream_t stream) {
    static int grid = 0;
    if (grid == 0) {
        if (n_in != 28 || out_size != MTOK * DM || ws_size < OFF_END) { fprintf(stderr, "kernel_launch: unexpected shapes (n_in %d out %d ws %zu)\n", n_in, out_size, ws_size); grid = -1; return; }
        int dev = 0, cus = 0, per_cu = 0;
        (void)hipGetDevice(&dev); (void)hipDeviceGetAttribute(&cus, hipDeviceAttributeMultiprocessorCount, dev);
        if (hipFuncSetAttribute((const void*)mega_fwd, hipFuncAttributeMaxDynamicSharedMemorySize, LDS_BYTES) != hipSuccess) { fprintf(stderr, "kernel_launch: hipFuncSetAttribute failed\n"); grid = -1; return; }
        if (hipOccupancyMaxActiveBlocksPerMultiprocessor(&per_cu, (const void*)mega_fwd, 512, LDS_BYTES) != hipSuccess || per_cu < 1) { fprintf(stderr, "kernel_launch: occupancy query says %d\n", per_cu); per_cu = 1; }
        (void)hipGetLastError();
        grid = cus * per_cu;
    }
    if (grid < 0) return;
    Params p{};
    for (int i = 0; i < 28; ++i) p.in[i] = (const float*)d_in[i];
    p.out = (float*)d_out; p.ws = (unsigned char*)d_ws; p.pad = 0;
    (void)hipMemsetAsync((unsigned char*)d_ws + OFF_CTL, 0, CTL_BYTES, stream);
#if MK_MULTI
    for (int ph = 0; ph < PH_TOTAL; ++ph) { p.ph_lo = ph; p.ph_hi = ph + 1; p.coop = 0; hipLaunchKernelGGL(mega_fwd, dim3(grid), dim3(512), LDS_BYTES, stream, p); }
#else
    p.ph_lo = 0; p.ph_hi = PH_TOTAL; p.coop = 1;
    void* args[] = {&p};
    hipError_t e = hipLaunchCooperativeKernel((const void*)mega_fwd, dim3(grid), dim3(512), args, LDS_BYTES, stream);
    if (e != hipSuccess) fprintf(stderr, "cooperative launch failed: %s (grid %d)\n", hipGetErrorString(e), grid);
#endif
}
```

```cpp
#include <hip/hip_runtime.h>
#include <hip/hip_cooperative_groups.h>
#include <cstdio>
#include <cstdint>
namespace cg = cooperative_groups;

#ifndef MK_MULTI
#define MK_MULTI 0
#endif

#ifndef R_DIFF
#define R_DIFF 1
#endif
#ifndef R_DIL
#define R_DIL 1
#endif
#ifndef R_POOL
#define R_POOL 1
#endif
#ifndef R_MLA
#define R_MLA 1
#endif
#ifndef R_MLC
#define R_MLC 1
#endif
#ifndef R_UP
#define R_UP 1
#endif
#ifndef R_WIN
#define R_WIN 1
#endif
#ifndef R_GATES
#define R_GATES 1
#endif
#ifndef R_PRO
#define R_PRO 1
#endif
#ifndef R_RES1
#define R_RES1 1
#endif
#ifndef R_RES6
#define R_RES6 1
#endif
#ifndef R_WQ
#define R_WQ 1
#endif
#define REP(n) for (int rep_ = 0; rep_ < (n); ++rep_)
#define DI __device__ __forceinline__
#define LAS __attribute__((address_space(3)))
typedef unsigned short bf16_t;
typedef short bf16x8 __attribute__((ext_vector_type(8)));
typedef float f32x4 __attribute__((ext_vector_type(4)));
typedef float f32x16 __attribute__((ext_vector_type(16)));
typedef unsigned u32x4 __attribute__((ext_vector_type(4)));
typedef unsigned u32x2 __attribute__((ext_vector_type(2)));
typedef float f32x2_t __attribute__((ext_vector_type(2)));
typedef __bf16 bf16x2_t __attribute__((ext_vector_type(2)));

constexpr int DM = 1024, NB = 16, SEQ = 4096, MTOK = NB * SEQ, DEPTH = 4, MEMLEN = 256, MMEM = NB * MEMLEN, FF = 2816, ZW = 2816, INW = 2824;
constexpr int ZQA = 0, ZKA = 256, ZVA = 512, ZOA = 768, ZPB = 1024, ZQC = 1280, ZKC = 1536, ZVC = 1792, ZQD = 2048, ZKD = 2304, ZVD = 2560;
constexpr float LOG2E = 1.4426950408889634f;
constexpr float NEGBIG = -1e30f;

constexpr size_t W_GU1 = 0, W_D1 = W_GU1 + (size_t)2 * FF * DM * 2, W_IN = W_D1 + (size_t)DM * FF * 2, W_OUT = W_IN + (size_t)3072 * DM * 2,
                 W_Q = W_OUT + (size_t)DM * DM * 2, W_O = W_Q + (size_t)DM * DM * 2, W_GU2 = W_O + (size_t)DM * DM * 2, W_D2 = W_GU2 + (size_t)2 * FF * DM * 2,
                 W_LAYER = W_D2 + (size_t)DM * FF * 2;
constexpr size_t OFF_WK = DEPTH * W_LAYER, OFF_WV = OFF_WK + (size_t)DEPTH * DM * DM * 2, OFF_HB = OFF_WV + (size_t)DEPTH * DM * DM * 2;
constexpr size_t OFF_DST = OFF_HB;
constexpr size_t OFF_OPART = OFF_HB + (size_t)64 * 64 * 4096 * 4;
constexpr size_t OFF_Z = OFF_HB + (size_t)MTOK * DM * 2;
constexpr size_t OFF_Y = OFF_Z + (size_t)MTOK * ZW * 2;
constexpr size_t OFF_KB = OFF_Y + (size_t)MTOK * DM * 2;
constexpr size_t OFF_VT = OFF_KB + (size_t)MMEM * 4096 * 2;
constexpr size_t OFF_MEMB = OFF_VT + (size_t)4096 * MMEM * 2;
constexpr size_t OFF_GATES = OFF_MEMB + (size_t)MMEM * DM * 2;
constexpr size_t OFF_SS = OFF_GATES + (size_t)MTOK * 8 * 4;
constexpr size_t OFF_LSEP = OFF_SS + (size_t)17 * MTOK * 16 * 4;
constexpr size_t OFF_NST = OFF_LSEP + (size_t)2 * MTOK * 4 * 4;
constexpr size_t OFF_SCAL = OFF_NST + (size_t)4096 * 64 * 4;
constexpr size_t OFF_DIFFB = OFF_SCAL + 65536;
constexpr size_t OFF_DILB = OFF_DIFFB + 65536;
constexpr size_t OFF_LAM = OFF_DILB + 8192;
constexpr size_t OFF_RSM = OFF_LAM + 256;
constexpr size_t OFF_CTL = OFF_RSM + 16384;
constexpr size_t CTL_BYTES = 16384;
constexpr size_t OFF_END = OFF_CTL + CTL_BYTES;
static_assert(OFF_OPART + (size_t)2 * MTOK * 256 * 2 <= OFF_Z, "alias map");
static_assert(OFF_END < (size_t)1073741824, "workspace");

constexpr int LDS_BYTES = 147456;
constexpr int LDS_EXTRA = 131072;

struct Params {
    const float* in[28];
    float* out;
    unsigned char* ws;
    int ph_lo, ph_hi, coop, pad;
};
enum { I_X = 0, I_MEM, I_T5, I_F1N, I_F1G, I_F1U, I_F1D, I_MIXN, I_WIN, I_CONVW, I_CONVB, I_GATEB, I_MLN, I_POOLW, I_POOLS, I_LAMV, I_SUBLN, I_WOUT,
       I_XN, I_MEMN, I_XWQ, I_XWKV, I_XWO, I_F2N, I_F2G, I_F2U, I_F2D, I_FINN };

DI unsigned cvtpk(float lo, float hi) { f32x2_t v = {lo, hi}; bf16x2_t b = __builtin_convertvector(v, bf16x2_t); return __builtin_bit_cast(unsigned, b); }
DI float bflo(unsigned w) { return __uint_as_float(w << 16); }
DI float bfhi(unsigned w) { return __uint_as_float(w & 0xffff0000u); }
DI float bf2f(bf16_t x) { return __uint_as_float((unsigned)x << 16); }
DI float ex2(float x) { return __builtin_amdgcn_exp2f(x); }
DI float rcpf_(float x) { return __builtin_amdgcn_rcpf(x); }
DI int crow(int i, int hi) { return (i & 3) + 8 * (i >> 2) + 4 * hi; }
DI float wave_sum(float v) {
#pragma unroll
    for (int o = 1; o < 64; o <<= 1) v += __shfl_xor(v, o);
    return v;
}
DI float wave_max(float v) {
#pragma unroll
    for (int o = 1; o < 64; o <<= 1) v = fmaxf(v, __shfl_xor(v, o));
    return v;
}
DI float silu_f(float g) { return g * rcpf_(1.f + ex2(-g * LOG2E)); }
DI float sigmoid_f(float g) { return rcpf_(1.f + ex2(-g * LOG2E)); }
#define LDS_WAIT() asm volatile("s_waitcnt lgkmcnt(0)" ::: "memory")
DI bf16x8 mk8(u32x2 lo, u32x2 hi) { u32x4 w = {lo.x, lo.y, hi.x, hi.y}; return __builtin_bit_cast(bf16x8, w); }
DI bf16x8 pack8(float a0, float a1, float a2, float a3, float a4, float a5, float a6, float a7) {
    u32x4 w = {cvtpk(a0, a1), cvtpk(a2, a3), cvtpk(a4, a5), cvtpk(a6, a7)}; return __builtin_bit_cast(bf16x8, w);
}
DI float rowss(const float* ss, int row) {
    const f32x4* q = (const f32x4*)(ss + (size_t)row * 16); const f32x4 a = q[0], b = q[1], c = q[2], d = q[3];
    const float t = ((a[0] + a[1]) + (a[2] + a[3])) + ((b[0] + b[1]) + (b[2] + b[3])) + ((c[0] + c[1]) + (c[2] + c[3])) + ((d[0] + d[1]) + (d[2] + d[3]));
    return rsqrtf(t * (1.f / 1024.f) + 1e-6f);
}
#define MFMA32(a, b, c) __builtin_amdgcn_mfma_f32_32x32x16_bf16((a), (b), (c), 0, 0, 0)

namespace pg8 {
constexpr int BM = 256, BK = 64, HALF = 128, HTB = HALF * BK * 2, STAGE_BYTES = 8 * HTB, NXCD = 8, WGM = 8;
DI int lds_byte(int r, int c) { const int st = (r >> 4) * 2 + (c >> 5), rr = r & 15, cc = c & 31, ob = rr * 64 + cc * 2; return st * 1024 + (ob ^ (((ob >> 9) & 1) << 5)); }
DI void stage_rc(int b, int& R, int& C) { const int st = b / 1024, sb = b % 1024, swz = sb ^ (((sb >> 9) & 1) << 5); R = (st >> 1) * 16 + swz / 64; C = (st & 1) * 32 + (swz % 64) / 2; }
DI int perm32(int rho) { const int n = rho >> 4, i = rho & 15; return 8 * (i >> 2) + 4 * n + (i & 3); }

DI size_t img_off(int row, int col) { return ((size_t)((row >> 8) * (DM / 64) + (col >> 6)) * 2 + ((row >> 7) & 1)) * 16384 + lds_byte(row & 127, col & 63); }
struct Unit { const char* a; const char* b; int orow, ocol, pm, pn; };
struct Gemm {
    const bf16_t* A; const bf16_t* B; int lda, ldb, K, nM, nN; long a_pmdiv, a_pmmod, a_pn, b_pmdiv, b_pmmod, b_pn; int div, ocol_step; int kstepA, kstepB;
    int imgB;
    int imgA;
};
DI Gemm plain_gemm(const bf16_t* A, const bf16_t* B, int Mrows, int N, int K) {
    Gemm g; g.A = A; g.B = B; g.lda = K; g.ldb = K; g.K = K; g.nM = Mrows / BM; g.nN = N / BM; g.a_pmdiv = (long)BM * K; g.a_pmmod = 0; g.a_pn = 0; g.b_pmdiv = 0; g.b_pmmod = 0; g.b_pn = (long)BM * K;
    g.div = 1; g.ocol_step = BM; g.kstepA = BK * 2; g.kstepB = BK * 2; g.imgA = 0; g.imgB = 0; return g;
}
DI size_t img_off_b(int nrow, int kcol) { const int nl = nrow & 255, r = nl & 127, q = r & 31, rs = (r & ~31) + 16 * ((q >> 2) & 1) + 4 * (q >> 3) + (q & 3);
    return ((size_t)((nrow >> 8) * (DM / 64) + (kcol >> 6)) * 2 + (nl >> 7)) * 16384 + lds_byte(rs, kcol & 63); }
DI void use_img_a(Gemm& g) { g.imgA = 1; g.lda = 64; g.kstepA = 256 * 64 * 2; }
DI void use_img_b(Gemm& g) { g.imgB = 1; g.ldb = 64; g.kstepB = 256 * 64 * 2; g.b_pn = (long)(g.K / 64) * 256 * 64; }
struct Order {
    Gemm g; int nwg, G, c;
    DI void init(const Gemm& g_, int G_, int c_) { g = g_; nwg = g.nM * g.nN; G = G_; c = c_; }
    DI bool next(int i, Unit& u) const {
        const long L = (long)i * G + c; if (L >= nwg) return false;
        int wgid = (int)L; { const int q = nwg / NXCD, r = nwg % NXCD, xcd = wgid % NXCD, off = wgid / NXCD; wgid = (xcd < r ? xcd * (q + 1) : r * (q + 1) + (xcd - r) * q) + off; }
        const int nN = g.nN, nM = g.nM, nig = WGM * nN, gid = wgid / nig, fm = gid * WGM, gsz = (nM - fm) < WGM ? (nM - fm) : WGM;
        const int pm = fm + ((wgid % nig) % gsz), pn = (wgid % nig) / gsz;
        u.pm = pm; u.pn = pn; u.orow = pm * BM; u.ocol = pn * g.ocol_step;
        const int pq = pm / g.div, pr = pm - pq * g.div;
        u.a = (const char*)(g.A + (long)pq * g.a_pmdiv + (long)pr * g.a_pmmod + (long)pn * g.a_pn);
        u.b = (const char*)(g.B + (long)pq * g.b_pmdiv + (long)pr * g.b_pmmod + (long)pn * g.b_pn);
        return true;
    }
};

struct EpiBf16 {
    static constexpr bool PERM = true;
    bf16_t* O; int ldc; const float* ss; const float* rowscale; const float* colscale; float scale; int zspecial;
    DI void operator()(f32x4 (&acc)[2][2][4][2], const Unit& u, int wr, int wc, int fr, int fq, int wid, int lane) const {
        const int row0 = u.orow + wr * 64 + fr, col0 = u.ocol + wc * 32 + 8 * fq;
        float sc = scale;
        if (zspecial) { if (u.pn == 5) sc *= 0.125f * LOG2E; else if (u.pn == 8) sc *= 0.17677669529663687f * LOG2E; }
        if (colscale) {
#pragma unroll
            for (int bj = 0; bj < 2; ++bj)
#pragma unroll
                for (int n = 0; n < 2; ++n) { const f32x4 cs = *(const f32x4*)(colscale + col0 + bj * HALF + 4 * n);
#pragma unroll
                    for (int ai = 0; ai < 2; ++ai)
#pragma unroll
                        for (int m = 0; m < 4; ++m) acc[ai][bj][m][n] *= cs; }
            asm volatile("" ::: "memory");
        }
#pragma unroll
        for (int ai = 0; ai < 2; ++ai)
#pragma unroll
            for (int m = 0; m < 4; ++m) {
                const int row = row0 + ai * HALF + m * 16;
                float rs = sc;
                if (ss) rs *= rowss(ss, row);
                if (rowscale) rs *= rowscale[row];
                bf16_t* rowp = O + (size_t)row * ldc + col0;
#pragma unroll
                for (int bj = 0; bj < 2; ++bj) {
                    const f32x4 v0 = acc[ai][bj][m][0] * rs, v1 = acc[ai][bj][m][1] * rs;
                    u32x4 w; w.x = cvtpk(v0[0], v0[1]); w.y = cvtpk(v0[2], v0[3]); w.z = cvtpk(v1[0], v1[1]); w.w = cvtpk(v1[2], v1[3]);
                    if (zspecial == 3) *(u32x4*)((unsigned char*)O + img_off_b(row, col0 + bj * HALF)) = w;
                    else *(u32x4*)(rowp + bj * HALF) = w;
                }
            }
    }
};
struct EpiZ {
    static constexpr bool PERM = true;
    bf16_t* O; float* gates; const float* ss;
    DI void operator()(f32x4 (&acc)[2][2][4][2], const Unit& u, int wr, int wc, int fr, int fq, int wid, int lane) const {
        const int row0 = u.orow + wr * 64 + fr, col0 = u.ocol + wc * 32 + 8 * fq;
        if (u.pn == 11) {
            if (wc == 0 && fq == 0) {
#pragma unroll
                for (int ai = 0; ai < 2; ++ai)
#pragma unroll
                    for (int m = 0; m < 4; ++m) { const int row = row0 + ai * HALF + m * 16; const float rs = rowss(ss, row);
                        *(f32x4*)(gates + (size_t)row * 8) = acc[ai][0][m][0] * rs; *(f32x4*)(gates + (size_t)row * 8 + 4) = acc[ai][0][m][1] * rs; }
            }
            return;
        }
        float sc = 1.f;
        if (u.pn == 5) sc = 0.125f * LOG2E; else if (u.pn == 8) sc = 0.17677669529663687f * LOG2E;
#pragma unroll
        for (int ai = 0; ai < 2; ++ai)
#pragma unroll
            for (int m = 0; m < 4; ++m) {
                const int row = row0 + ai * HALF + m * 16;
                const float rs = sc * rowss(ss, row);
                const int zc0 = col0;
#pragma unroll
                for (int bj = 0; bj < 2; ++bj) {
                    const f32x4 v0 = acc[ai][bj][m][0] * rs, v1 = acc[ai][bj][m][1] * rs;
                    u32x4 w; w.x = cvtpk(v0[0], v0[1]); w.y = cvtpk(v0[2], v0[3]); w.z = cvtpk(v1[0], v1[1]); w.w = cvtpk(v1[2], v1[3]);
                    { const int zc = zc0 + bj * HALF; *(u32x4*)(O + ((size_t)(zc >> 6) * MTOK + (size_t)row) * 64 + (zc & 63)) = w; }
                }
            }
    }
};
struct EpiSwiGLU {
    static constexpr bool PERM = true;
    bf16_t* O; int ldc; const float* ss;
    DI void operator()(f32x4 (&acc)[2][2][4][2], const Unit& u, int wr, int wc, int fr, int fq, int wid, int lane) const {
        const int row0 = u.orow + wr * 64 + fr, col0 = u.ocol + wc * 32 + 8 * fq;
#pragma unroll
        for (int ai = 0; ai < 2; ++ai)
#pragma unroll
            for (int m = 0; m < 4; ++m) {
                const int row = row0 + ai * HALF + m * 16;
                const float rs = rowss(ss, row);
                float o[8];
#pragma unroll
                for (int n = 0; n < 2; ++n)
#pragma unroll
                    for (int j = 0; j < 4; ++j) { const float g = acc[ai][0][m][n][j] * rs, up = acc[ai][1][m][n][j] * rs; o[4 * n + j] = silu_f(g) * up; }
                u32x4 w; w.x = cvtpk(o[0], o[1]); w.y = cvtpk(o[2], o[3]); w.z = cvtpk(o[4], o[5]); w.w = cvtpk(o[6], o[7]);
                __builtin_nontemporal_store(w, (u32x4*)((unsigned char*)O + ((size_t)(u.pm * (FF / 64) + (col0 >> 6)) * 2 + ((row >> 7) & 1)) * 16384 + lds_byte(row & 127, col0 & 63)));
                asm volatile("" ::: "memory");
            }
    }
};
struct EpiResid {
    static constexpr bool PERM = true;
    bf16_t* hb; float* ssout; float alpha;
    DI void operator()(f32x4 (&acc)[2][2][4][2], const Unit& u, int wr, int wc, int fr, int fq, int wid, int lane) const {
        const int row0 = u.orow + wr * 64 + fr, col0 = u.ocol + wc * 32 + 8 * fq;
#pragma unroll
        for (int ai = 0; ai < 2; ++ai) {
            u32x4 r[4][2];
#pragma unroll
            for (int m = 0; m < 4; ++m) {
#pragma unroll
                for (int bj = 0; bj < 2; ++bj) r[m][bj] = *(const u32x4*)((const unsigned char*)hb + img_off(row0 + ai * HALF + m * 16, col0 + bj * HALF)); }
#pragma unroll
            for (int m = 0; m < 4; ++m) {
                const int row = row0 + ai * HALF + m * 16; float ssq = 0.f;
#pragma unroll
                for (int bj = 0; bj < 2; ++bj) {
                    const u32x4 rr = r[m][bj]; const f32x4 a0 = acc[ai][bj][m][0] * alpha, a1 = acc[ai][bj][m][1] * alpha;
                    u32x4 w; w.x = cvtpk(bflo(rr.x) + a0[0], bfhi(rr.x) + a0[1]); w.y = cvtpk(bflo(rr.y) + a0[2], bfhi(rr.y) + a0[3]);
                    w.z = cvtpk(bflo(rr.z) + a1[0], bfhi(rr.z) + a1[1]); w.w = cvtpk(bflo(rr.w) + a1[2], bfhi(rr.w) + a1[3]);
                    *(u32x4*)((unsigned char*)hb + img_off(row, col0 + bj * HALF)) = w;
                    const float v0 = bflo(w.x), v1 = bfhi(w.x), v2 = bflo(w.y), v3 = bfhi(w.y), v4 = bflo(w.z), v5 = bfhi(w.z), v6 = bflo(w.w), v7 = bfhi(w.w);
                    ssq += ((v0 * v0 + v1 * v1) + (v2 * v2 + v3 * v3)) + ((v4 * v4 + v5 * v5) + (v6 * v6 + v7 * v7));
                }
                ssq += __shfl_xor(ssq, 16); ssq += __shfl_xor(ssq, 32);
                if (fq == 0) ssout[(size_t)row * 16 + u.pn * 4 + wc] = ssq;
            }
            asm volatile("" ::: "memory");
        }
    }
};
struct EpiSoftmax {
    static constexpr bool PERM = true;
    bf16_t* O; int ldc; LAS float* red; const float* ss; float scale;
    DI void operator()(f32x4 (&acc)[2][2][4][2], const Unit& u, int wr, int wc, int fr, int fq, int wid, int lane) const {
        float mloc[2][4];
#pragma unroll
        for (int ai = 0; ai < 2; ++ai)
#pragma unroll
            for (int m = 0; m < 4; ++m) {
                float mx = NEGBIG;
                const float rsc = rowss(ss, u.orow + ai * HALF + wr * 64 + m * 16 + fr) * scale;
#pragma unroll
                for (int bj = 0; bj < 2; ++bj)
#pragma unroll
                    for (int n = 0; n < 2; ++n) { const f32x4 x = acc[ai][bj][m][n] * rsc; acc[ai][bj][m][n] = x; mx = fmaxf(mx, fmaxf(fmaxf(x[0], x[1]), fmaxf(x[2], x[3]))); }
                mx = fmaxf(mx, __shfl_xor(mx, 16)); mx = fmaxf(mx, __shfl_xor(mx, 32));
                float sm = 0.f;
#pragma unroll
                for (int bj = 0; bj < 2; ++bj)
#pragma unroll
                    for (int n = 0; n < 2; ++n) { f32x4 x = acc[ai][bj][m][n]; x[0] = ex2(x[0] - mx); x[1] = ex2(x[1] - mx); x[2] = ex2(x[2] - mx); x[3] = ex2(x[3] - mx);
                        acc[ai][bj][m][n] = x; sm += (x[0] + x[1]) + (x[2] + x[3]); }
                sm += __shfl_xor(sm, 16); sm += __shfl_xor(sm, 32);
                mloc[ai][m] = mx;
                const int rl = ai * HALF + wr * 64 + m * 16 + fr;
                if (fq == 0) { red[(rl * 4 + wc) * 2] = mx; red[(rl * 4 + wc) * 2 + 1] = sm; }
            }
        asm volatile("s_waitcnt lgkmcnt(0)" ::: "memory"); __builtin_amdgcn_s_barrier(); asm volatile("" ::: "memory");
        const int row0 = u.orow + wr * 64 + fr, col0 = u.ocol + wc * 32 + 8 * fq;
#pragma unroll
        for (int ai = 0; ai < 2; ++ai)
#pragma unroll
            for (int m = 0; m < 4; ++m) {
                const int rl = ai * HALF + wr * 64 + m * 16 + fr;
                const f32x4 p0 = *(const LAS f32x4*)(red + rl * 8), p1 = *(const LAS f32x4*)(red + rl * 8 + 4);
                const float gm = fmaxf(fmaxf(p0[0], p0[2]), fmaxf(p1[0], p1[2]));
                const float tot = p0[1] * ex2(p0[0] - gm) + p0[3] * ex2(p0[2] - gm) + p1[1] * ex2(p1[0] - gm) + p1[3] * ex2(p1[2] - gm);
                const float f = ex2(mloc[ai][m] - gm) / tot;
                const int prow = row0 + ai * HALF + m * 16;
#pragma unroll
                for (int bj = 0; bj < 2; ++bj) {
                    const f32x4 v0 = acc[ai][bj][m][0] * f, v1 = acc[ai][bj][m][1] * f;
                    u32x4 w; w.x = cvtpk(v0[0], v0[1]); w.y = cvtpk(v0[2], v0[3]); w.z = cvtpk(v1[0], v1[1]); w.w = cvtpk(v1[2], v1[3]);
                    *(u32x4*)((unsigned char*)O + img_off(prow, col0 + bj * HALF)) = w;
                }
            }
        asm volatile("s_waitcnt lgkmcnt(0)" ::: "memory"); __builtin_amdgcn_s_barrier(); asm volatile("" ::: "memory");
    }
};

template <class Epi>
DI void gemm_phase(LAS unsigned char* lds, const Gemm g, const Order& S, const Epi& E) {
    int tid_ = threadIdx.x; asm volatile("" : "+v"(tid_));
    const int tid = tid_, wid = __builtin_amdgcn_readfirstlane(tid >> 6), lane = tid & 63, wr = wid >> 2, wc = wid & 3, fr = lane & 15, fq = lane >> 4;
    const int K = g.K, nt = K / BK;
    unsigned voffA[2], voffB[2];
#pragma unroll
    for (int i = 0; i < 2; ++i) { int R, C; stage_rc(tid * 16 + i * 8192, R, C); const int Rb = Epi::PERM ? ((R & ~31) + perm32(R & 31)) : R;
        voffA[i] = g.imgA ? (unsigned)(tid * 16 + i * 8192) : (unsigned)(R * g.lda + C) * 2u; voffB[i] = g.imgB ? (unsigned)(tid * 16 + i * 8192) : (unsigned)(Rb * g.ldb + C) * 2u; }
    const size_t kstepA = (size_t)g.kstepA, kstepB = (size_t)g.kstepB;
    const size_t hstepA = (size_t)HALF * g.lda * 2, hstepB = (size_t)HALF * g.ldb * 2;
    const unsigned ldsw = (unsigned)wid * 1024u;
    const int aoff = lds_byte(wr * 64 + fr, fq * 8), boff = lds_byte(wc * 32 + fr, fq * 8);
#define PG8_SA(b, h) (((b) * 2 + (h)) * HTB)
#define PG8_SB(b, h) ((4 + (b) * 2 + (h)) * HTB)
#define PG8_STAGE(bufoff, gbase, voff) do { _Pragma("unroll") for (int _i = 0; _i < 2; ++_i) \
        __builtin_amdgcn_global_load_lds((const unsigned*)((const char*)(gbase) + (voff)[_i]), (LAS unsigned*)(lds + (bufoff) + ldsw + _i * 8192), 16, 0, 0); } while (0)
#define PG8_LDA(dst, b, h) do { _Pragma("unroll") for (int m = 0; m < 4; ++m) _Pragma("unroll") for (int k = 0; k < 2; ++k) dst[m][k] = *(const LAS bf16x8*)(lds + PG8_SA(b, h) + aoff + m * 2048 + k * 1024); } while (0)
#define PG8_LDB(dst, b, h) do { _Pragma("unroll") for (int n = 0; n < 2; ++n) _Pragma("unroll") for (int k = 0; k < 2; ++k) dst[n][k] = *(const LAS bf16x8*)(lds + PG8_SB(b, h) + boff + n * 2048 + k * 1024); } while (0)
#define PG8_MMA(ai, bj, At, Bt) do { __builtin_amdgcn_s_setprio(1); _Pragma("unroll") for (int m = 0; m < 4; ++m) _Pragma("unroll") for (int n = 0; n < 2; ++n) _Pragma("unroll") for (int k = 0; k < 2; ++k) \
        acc[ai][bj][m][n] = __builtin_amdgcn_mfma_f32_16x16x32_bf16(Bt[n][k], At[m][k], acc[ai][bj][m][n], 0, 0, 0); __builtin_amdgcn_s_setprio(0); } while (0)
#define PG8_WAIT_V(n) asm volatile("s_waitcnt vmcnt(" #n ")" ::: "memory")
#define PG8_WAIT_L(n) asm volatile("s_waitcnt lgkmcnt(" #n ")" ::: "memory")
#define PG8_BAR __builtin_amdgcn_s_barrier()
#define PG8_SCHED __builtin_amdgcn_sched_barrier(0)
    Unit cur, nxt; int ui = 0;
    if (!S.next(0, cur)) return;
    f32x4 acc[2][2][4][2];
#pragma unroll
    for (int a = 0; a < 2; ++a)
#pragma unroll
        for (int b = 0; b < 2; ++b)
#pragma unroll
            for (int m = 0; m < 4; ++m)
#pragma unroll
                for (int n = 0; n < 2; ++n) acc[a][b][m][n] = (f32x4){0.f, 0.f, 0.f, 0.f};
    bf16x8 At[4][2], B0[2][2], B1[2][2];
    const char* cA = cur.a; const char* cB = cur.b;
    PG8_STAGE(PG8_SB(0, 0), cB, voffB); PG8_STAGE(PG8_SB(0, 1), cB + hstepB, voffB); PG8_STAGE(PG8_SA(0, 0), cA, voffA); PG8_STAGE(PG8_SA(0, 1), cA + hstepA, voffA);
    if (wr == 1) PG8_BAR;
    PG8_WAIT_V(2); PG8_BAR;
    PG8_STAGE(PG8_SB(1, 0), cB + kstepB, voffB); PG8_STAGE(PG8_SA(1, 0), cA + kstepA, voffA); PG8_STAGE(PG8_SB(1, 1), cB + hstepB + kstepB, voffB);
    PG8_WAIT_V(6); PG8_BAR;
    for (;;) {
        const bool has_next = S.next(ui + 1, nxt);
        const char* nA = has_next ? nxt.a : cA; const char* nB = has_next ? nxt.b : cB;
        for (int t = 0; t < nt; t += 2) {
            const bool last = (t == nt - 2);
            const char* a1 = cA + (size_t)(t + 1) * kstepA;
            const char* a2 = last ? nA : cA + (size_t)(t + 2) * kstepA; const char* b2 = last ? nB : cB + (size_t)(t + 2) * kstepB;
            const char* a3 = a2 + kstepA; const char* b3 = b2 + kstepB;
            PG8_LDB(B0, 0, 0); PG8_LDB(B1, 0, 1); PG8_SCHED; PG8_LDA(At, 0, 0); PG8_STAGE(PG8_SA(1, 1), a1 + hstepA, voffA);
            PG8_WAIT_V(8); PG8_WAIT_L(0); PG8_BAR; PG8_MMA(0, 0, At, B0); PG8_MMA(0, 1, At, B1); PG8_BAR; PG8_SCHED;
            PG8_LDA(At, 0, 1); PG8_STAGE(PG8_SB(0, 0), b2, voffB); PG8_STAGE(PG8_SB(0, 1), b2 + hstepB, voffB); PG8_STAGE(PG8_SA(0, 0), a2, voffA);
            PG8_WAIT_V(8); PG8_WAIT_L(0); PG8_BAR; PG8_MMA(1, 0, At, B0); PG8_MMA(1, 1, At, B1); PG8_BAR; PG8_SCHED;
            PG8_LDB(B0, 1, 0); PG8_LDB(B1, 1, 1); PG8_SCHED; PG8_LDA(At, 1, 0); PG8_STAGE(PG8_SA(0, 1), a2 + hstepA, voffA);
            PG8_WAIT_V(8); PG8_WAIT_L(0); PG8_BAR; PG8_MMA(0, 0, At, B0); PG8_MMA(0, 1, At, B1); PG8_BAR; PG8_SCHED;
            PG8_LDA(At, 1, 1); PG8_STAGE(PG8_SB(1, 0), b3, voffB); PG8_STAGE(PG8_SB(1, 1), b3 + hstepB, voffB); PG8_STAGE(PG8_SA(1, 0), a3, voffA);
            PG8_WAIT_V(8); PG8_WAIT_L(0); PG8_BAR; PG8_MMA(1, 0, At, B0); PG8_MMA(1, 1, At, B1); PG8_BAR; PG8_SCHED;
        }
        if (wr == 0) PG8_BAR;
        E(acc, cur, wr, wc, fr, fq, wid, lane);
        if (!has_next) break;
#pragma unroll
        for (int a = 0; a < 2; ++a)
#pragma unroll
            for (int b = 0; b < 2; ++b)
#pragma unroll
                for (int m = 0; m < 4; ++m)
#pragma unroll
                    for (int n = 0; n < 2; ++n) acc[a][b][m][n] = (f32x4){0.f, 0.f, 0.f, 0.f};
        cur = nxt; cA = nA; cB = nB; ++ui;
        if (wr == 1) PG8_BAR;
    }
    PG8_WAIT_V(0);
    PG8_BAR;
#undef PG8_SA
#undef PG8_SB
#undef PG8_STAGE
#undef PG8_LDA
#undef PG8_LDB
#undef PG8_MMA
#undef PG8_WAIT_V
#undef PG8_WAIT_L
#undef PG8_BAR
#undef PG8_SCHED
}
}

#define XB_TMO      128
#define XB_XCNT(j)  (256  + 64 * (j))
#define XB_XSUB(j)  (1280 + 64 * (j))
#define XB_XGEN(j)  (2304 + 64 * (j))
#define XB_TOP      3328
#define XB_TOPGEN   3392
#define XCD_BAR_WORDS 3456
#define XB_SPIN_CAP (1u << 20)
DI unsigned xb_ld(unsigned* p)              { return __hip_atomic_load(p, __ATOMIC_RELAXED, __HIP_MEMORY_SCOPE_AGENT); }
DI unsigned xb_add(unsigned* p, unsigned v) { return __hip_atomic_fetch_add(p, v, __ATOMIC_RELAXED, __HIP_MEMORY_SCOPE_AGENT); }
DI unsigned xb_xcc_id() { return (unsigned)__builtin_amdgcn_s_getreg((3 << 11) | 20) & 0xFu; }
#define XB_SPIN(cond, bar) do { unsigned _sp = 0; while (cond) { __builtin_amdgcn_s_sleep(1); \
    if ((++_sp & 255u) == 0u) { if (xb_ld(&(bar)[XB_TMO])) break; if (_sp > XB_SPIN_CAP) { atomicAdd(&(bar)[XB_TMO], 1u); break; } } } } while (0)
struct XcdBarrier { unsigned* bar; unsigned x; volatile LAS unsigned* st; };
DI XcdBarrier xcd_barrier_post(unsigned* bar, volatile LAS unsigned* st) {
    XcdBarrier b; b.bar = bar; b.x = xb_xcc_id(); b.st = st;
    if (threadIdx.x == 0) (void)xb_add(&bar[XB_XCNT(b.x)], 1u);
    return b;
}
DI void xcd_barrier_complete(unsigned* bar, unsigned x, unsigned& nloc, unsigned& nx) {
    const unsigned G = gridDim.x * gridDim.y * gridDim.z;
    unsigned sum, cnt, mine, sp = 0u;
    for (;;) {
        sum = 0u; cnt = 0u; mine = 0u;
#pragma unroll
        for (unsigned j = 0; j < 16; ++j) { const unsigned c = xb_ld(&bar[XB_XCNT(j)]); sum += c; cnt += (c > 0u) ? 1u : 0u; mine = (j == x) ? c : mine; }
        if (sum == G) break;
        __builtin_amdgcn_s_sleep(1);
        if ((++sp & 255u) == 0u) { if (xb_ld(&bar[XB_TMO])) break; if (sp > XB_SPIN_CAP) { atomicAdd(&bar[XB_TMO], 1u); break; } }
    }
    nloc = mine > 0u ? mine : 1u; nx = cnt > 0u ? cnt : 1u;
}
DI void xcd_barrier(const XcdBarrier& b) {
    asm volatile("s_waitcnt vmcnt(0)" ::: "memory");
    __syncthreads();
    if (threadIdx.x == 0) {
        unsigned* bar = b.bar;
        __builtin_amdgcn_s_waitcnt(0);
        unsigned nloc = b.st[0], nx = b.st[1];
        if (nloc == 0u) { xcd_barrier_complete(bar, b.x, nloc, nx); b.st[0] = nloc; b.st[1] = nx; }
        const unsigned old = xb_add(&bar[XB_XSUB(b.x)], 1u);
        const unsigned gen = old / nloc;
        if (old + 1u == (gen + 1u) * nloc) {
            __builtin_amdgcn_fence(__ATOMIC_RELEASE, "agent");
            asm volatile("s_waitcnt vmcnt(0)" ::: "memory");
            const unsigned og = xb_add(&bar[XB_TOP], 1u);
            const unsigned tg = og / nx;
            if (og + 1u == (tg + 1u) * nx) xb_add(&bar[XB_TOPGEN], 1u);
            else XB_SPIN(xb_ld(&bar[XB_TOPGEN]) == tg, bar);
            __builtin_amdgcn_fence(__ATOMIC_ACQUIRE, "agent");
            xb_add(&bar[XB_XGEN(b.x)], 1u);
            asm volatile("s_waitcnt vmcnt(0)" ::: "memory");
        } else {
            XB_SPIN(xb_ld(&bar[XB_XGEN(b.x)]) == gen, bar);
            __builtin_amdgcn_fence(__ATOMIC_ACQUIRE, "agent");
            asm volatile("s_waitcnt vmcnt(0)" ::: "memory");
        }
    }
    __syncthreads();
}

struct Ctx {
    LAS unsigned char* lds; unsigned char* ldsg;
    int tid, lane, wid, bid, G;
    unsigned char* ws; float* out;
};
DI bf16_t* wsb(const Ctx& c, size_t off) { return (bf16_t*)(c.ws + off); }
DI float* wsf(const Ctx& c, size_t off) { return (float*)(c.ws + off); }
DI float* ssbuf(const Ctx& c, int i) { return (float*)(c.ws + OFF_SS) + (size_t)i * MTOK * 16; }

DI int t5_bucket(int dist) {
    if (dist < 16) return dist;
    const float v = logf((float)dist / 16.f) / 4.852030263919617f * 16.f;
    int large = 16 + (int)v; return large < 31 ? large : 31;
}

DI Ctx fresh(const Ctx& c0) {
    Ctx c = c0; int tid = threadIdx.x; asm volatile("" : "+v"(tid)); c.tid = tid; c.lane = tid & 63; c.wid = __builtin_amdgcn_readfirstlane(tid >> 6);
    asm volatile("" : "+s"(c.ws)); asm volatile("" : "+s"(c.out)); return c;
}
DI void transpose_item(const float* W, int ldw, int scol0, int k0, const float* gain, bf16_t* WT, int K, int drow0, LAS float* scr, int lane, bool img = false) {
    {
        f32x4 v[8]; float gs[8];
#pragma unroll
        for (int i = 0; i < 8; ++i) { const int kk = 8 * i + (lane >> 3); v[i] = *(const f32x4*)(W + (size_t)(k0 + kk) * ldw + scol0 + (lane & 7) * 4); gs[i] = gain ? gain[k0 + kk] : 1.f; }
#pragma unroll
        for (int i = 0; i < 8; ++i) { const int kk = 8 * i + (lane >> 3); LAS float* d = scr + kk * 33 + (lane & 7) * 4; d[0] = v[i][0] * gs[i]; d[1] = v[i][1] * gs[i]; d[2] = v[i][2] * gs[i]; d[3] = v[i][3] * gs[i]; }
    }
    LDS_WAIT(); asm volatile("" ::: "memory");
    const int c = lane & 7;
#pragma unroll
    for (int j = 0; j < 4; ++j) { const int n = (lane >> 3) + 8 * j; const LAS float* s = scr + (8 * c) * 33 + n;
        u32x4 o; o.x = cvtpk(s[0 * 33], s[1 * 33]); o.y = cvtpk(s[2 * 33], s[3 * 33]); o.z = cvtpk(s[4 * 33], s[5 * 33]); o.w = cvtpk(s[6 * 33], s[7 * 33]);
        if (img) { const int ng = drow0 + n, nl = ng & 255, r = nl & 127, q = r & 31, rs = (r & ~31) + 16 * ((q >> 2) & 1) + 4 * (q >> 3) + (q & 3);
            const int kk0 = k0 + 8 * c;
            *(u32x4*)((unsigned char*)WT + ((size_t)((ng >> 8) * (K >> 6) + (kk0 >> 6)) * 2 + (nl >> 7)) * 16384 + pg8::lds_byte(rs, kk0 & 63)) = o; }
        else *(u32x4*)(WT + (size_t)(drow0 + n) * K + k0 + 8 * c) = o; }
    LDS_WAIT(); asm volatile("" ::: "memory");
}
DI void tjob(const float* W, int ldw, int scol0, const float* gain, bf16_t* WT, int K, int ncols, int item, LAS float* scr, int lane, bool img = false, int drow_base = 0) {
    const int nblk = ncols / 32, kb = item / nblk, nb = item % nblk;
    transpose_item(W, ldw, scol0 + 32 * nb, 64 * kb, gain, WT, K, drow_base + 32 * nb, scr, lane, img);
}
DI void tjob_gu(const float* Wg, const float* Wu, const float* gain, bf16_t* WT, int item, LAS float* scr, int lane) {
    const int nblk = 2 * FF / 32, kb = item / nblk, nb = item % nblk, n0 = 32 * nb, p = n0 >> 8, w = n0 & 255;
    transpose_item(w < 128 ? Wg : Wu, FF, 128 * p + (w & 127), 64 * kb, gain, WT, DM, n0, scr, lane, true);
}
DI void ph_prologue(const Params& p, const Ctx& c0) {
    const Ctx c = fresh(c0);
    LAS float* scr = (LAS float*)(c.lds + c.wid * 16384);
    const int gw = c.bid * 8 + c.wid, NGW = c.G * 8, lane = c.lane;
    constexpr int I_GU = 16 * (2 * FF / 32), I_D = (FF / 64) * 32, I_INA = 16 * 32, I_INB = 16 * 56, I_INC = 16, I_SQ = 16 * 32;
    constexpr int PER_LAYER = 2 * I_GU + 2 * I_D + I_INA + I_INB + I_INC + 5 * I_SQ;
    for (int it = gw; it < DEPTH * PER_LAYER; it += NGW) {
        const int l = it / PER_LAYER; int r = it % PER_LAYER;
        unsigned char* wl = c.ws + (size_t)l * W_LAYER;
        if (r < I_GU) { tjob_gu(p.in[I_F1G] + (size_t)l * DM * FF, p.in[I_F1U] + (size_t)l * DM * FF, p.in[I_F1N] + l * DM, (bf16_t*)(wl + W_GU1), r, scr, lane); continue; } r -= I_GU;
        if (r < I_D) { tjob(p.in[I_F1D] + (size_t)l * FF * DM, DM, 0, nullptr, (bf16_t*)(wl + W_D1), FF, DM, r, scr, lane, true); continue; } r -= I_D;
        if (r < I_INA) { tjob(p.in[I_WIN] + (size_t)l * DM * INW, INW, 0, p.in[I_MIXN] + l * DM, (bf16_t*)(wl + W_IN), DM, 1024, r, scr, lane, true, 0); continue; } r -= I_INA;
        if (r < I_INB) { tjob(p.in[I_WIN] + (size_t)l * DM * INW, INW, 1032, p.in[I_MIXN] + l * DM, (bf16_t*)(wl + W_IN), DM, 1792, r, scr, lane, true, 1024); continue; } r -= I_INB;
        if (r < I_INC) { tjob(p.in[I_WIN] + (size_t)l * DM * INW, INW, 1024, p.in[I_MIXN] + l * DM, (bf16_t*)(wl + W_IN), DM, 32, r, scr, lane, true, 2816); continue; } r -= I_INC;
        if (r < I_SQ) { tjob(p.in[I_WOUT] + (size_t)l * DM * DM, DM, 0, nullptr, (bf16_t*)(wl + W_OUT), DM, DM, r, scr, lane, true); continue; } r -= I_SQ;
        if (r < I_SQ) {
            const int kb = r >> 5, nb = r & 31; const int row = 64 * kb + lane; const float gsc = p.in[I_XN][l * DM + row];
            const f32x4* src = (const f32x4*)(p.in[I_XWQ] + (size_t)l * DM * DM + (size_t)row * DM + 32 * nb); u32x4* dst = (u32x4*)((bf16_t*)(wl + W_Q) + (size_t)row * DM + 32 * nb);
#pragma unroll
            for (int q4 = 0; q4 < 4; ++q4) { const f32x4 x0 = src[2 * q4] * gsc, x1 = src[2 * q4 + 1] * gsc; u32x4 w; w.x = cvtpk(x0[0], x0[1]); w.y = cvtpk(x0[2], x0[3]); w.z = cvtpk(x1[0], x1[1]); w.w = cvtpk(x1[2], x1[3]); dst[q4] = w; }
            continue; } r -= I_SQ;
        if (r < I_SQ) { tjob(p.in[I_XWO] + (size_t)l * DM * DM, DM, 0, nullptr, (bf16_t*)(wl + W_O), DM, DM, r, scr, lane); continue; } r -= I_SQ;
        if (r < I_GU) { tjob_gu(p.in[I_F2G] + (size_t)l * DM * FF, p.in[I_F2U] + (size_t)l * DM * FF, p.in[I_F2N] + l * DM, (bf16_t*)(wl + W_GU2), r, scr, lane); continue; } r -= I_GU;
        if (r < I_D) { tjob(p.in[I_F2D] + (size_t)l * FF * DM, DM, 0, nullptr, (bf16_t*)(wl + W_D2), FF, DM, r, scr, lane, true); continue; } r -= I_D;
        if (r < I_SQ) { tjob(p.in[I_XWKV] + (size_t)l * DM * 2 * DM, 2 * DM, 0, p.in[I_MEMN] + l * DM, wsb(c, OFF_WK) + (size_t)l * DM * DM, DM, DM, r, scr, lane); continue; } r -= I_SQ;
        tjob(p.in[I_XWKV] + (size_t)l * DM * 2 * DM, 2 * DM, DM, p.in[I_MEMN] + l * DM, wsb(c, OFF_WV) + (size_t)l * DM * DM, DM, DM, r, scr, lane);
    }
    for (int m = gw; m < MTOK + MMEM; m += NGW) {
        const bool isx = m < MTOK; const int row = isx ? m : m - MTOK;
        const f32x4* xr = (const f32x4*)((isx ? p.in[I_X] : p.in[I_MEM]) + (size_t)row * DM) + lane;
        unsigned long long* o8 = (unsigned long long*)(wsb(c, OFF_MEMB) + (size_t)row * DM) + lane; unsigned char* hbimg = (unsigned char*)wsb(c, OFF_HB);
        float s = 0.f;
#pragma unroll
        for (int j = 0; j < 4; ++j) { const f32x4 v = xr[64 * j]; s += (v[0] * v[0] + v[1] * v[1]) + (v[2] * v[2] + v[3] * v[3]);
            const unsigned long long pk = (unsigned long long)cvtpk(v[0], v[1]) | ((unsigned long long)cvtpk(v[2], v[3]) << 32);
            if (isx) *(unsigned long long*)(hbimg + pg8::img_off(row, 4 * (lane + 64 * j))) = pk; else o8[64 * j] = pk; }
        s = wave_sum(s);
        if (lane == 0) { if (isx) { f32x4* q = (f32x4*)(ssbuf(c, 0) + (size_t)row * 16); q[0] = (f32x4){s, 0.f, 0.f, 0.f}; q[1] = (f32x4){0.f, 0.f, 0.f, 0.f}; q[2] = q[1]; q[3] = q[1]; } else wsf(c, OFF_RSM)[row] = rsqrtf(s * (1.f / DM) + 1e-6f); }
    }
    for (int l = 0; l < DEPTH; ++l) { unsigned char* t11 = c.ws + (size_t)l * W_LAYER + W_IN + (size_t)11 * 16 * 32768;
        for (int i = c.bid * 512 + c.tid; i < 16 * 1792; i += c.G * 512) { const int kt = i / 1792, rem = i - kt * 1792; *(u32x4*)(t11 + (size_t)kt * 32768 + 4096 + (size_t)rem * 16) = (u32x4){0u, 0u, 0u, 0u}; } }
    const int gt = c.bid * 512 + c.tid, NGT = c.G * 512;
    const float* t5 = p.in[I_T5];
    for (int i = gt; i < 4 * 4096; i += NGT) { const int h = i >> 12, d = i & 4095; wsf(c, OFF_DIFFB)[i] = t5[t5_bucket(d) * 8 + 4 + h] * LOG2E; }
    for (int i = gt; i < 3 * 4 * 132; i += NGT) { const int pp = i / (4 * 132), h = (i / 132) & 3, dl = i % 132; const int dil = pp == 0 ? 1 : (pp == 1 ? 4 : 16);
        wsf(c, OFF_DILB)[i] = dl <= 128 ? t5[t5_bucket(dl * dil) * 8 + h] * LOG2E : 0.f; }
    if (gt < DEPTH) { const float* lv = p.in[I_LAMV] + gt * 128; float a = 0.f, b = 0.f; for (int i = 0; i < 32; ++i) { a += lv[i] * lv[32 + i]; b += lv[64 + i] * lv[96 + i]; }
        const float lam_init = 0.8f - 0.6f * expf(-0.3f * (float)gt); wsf(c, OFF_LAM)[gt] = expf(a) - expf(b) + lam_init; }
}

DI void ph_gates(const Params& p, const Ctx& c0, int l) {
    const Ctx c = fresh(c0);
    LAS float* wg = (LAS float*)c.lds;
    const float* win = p.in[I_WIN] + (size_t)l * DM * INW; const float* gn = p.in[I_MIXN] + l * DM;
    for (int i = c.tid; i < DM * 8; i += 512) { const int k = i >> 3, cc = i & 7; wg[i] = win[(size_t)k * INW + 1024 + cc] * gn[k]; }
    __syncthreads();
    const float* h = c.out; const float* ss = ssbuf(c, 4 * l + 1); float* gates = wsf(c, OFF_GATES);
    for (int row = c.bid * 8 + c.wid; row < MTOK; row += c.G * 8) {
        float a[8];
#pragma unroll
        for (int j = 0; j < 8; ++j) a[j] = 0.f;
        const f32x4* xr = (const f32x4*)(h + (size_t)row * DM) + c.lane;
#pragma unroll
        for (int j = 0; j < 4; ++j) { const f32x4 v = xr[64 * j]; const int k0 = 4 * c.lane + 256 * j;
#pragma unroll
            for (int e = 0; e < 4; ++e) { const f32x4 w0 = *(const LAS f32x4*)(wg + (k0 + e) * 8), w1 = *(const LAS f32x4*)(wg + (k0 + e) * 8 + 4);
                a[0] += v[e] * w0[0]; a[1] += v[e] * w0[1]; a[2] += v[e] * w0[2]; a[3] += v[e] * w0[3]; a[4] += v[e] * w1[0]; a[5] += v[e] * w1[1]; a[6] += v[e] * w1[2]; a[7] += v[e] * w1[3]; } }
#pragma unroll
        for (int j = 0; j < 8; ++j) a[j] = wave_sum(a[j]);
        if (c.lane == 0) { const float rs = rowss(ss, row);
            *(f32x4*)(gates + (size_t)row * 8) = (f32x4){a[0] * rs, a[1] * rs, a[2] * rs, a[3] * rs}; *(f32x4*)(gates + (size_t)row * 8 + 4) = (f32x4){a[4] * rs, a[5] * rs, a[6] * rs, a[7] * rs}; }
    }
    __syncthreads();
}

constexpr int ZS = 64;
#define ZP(z_, row_, colbase_) ((z_) + ((size_t)((colbase_) >> 6) * MTOK + (size_t)(row_)) * ZS)
#define YIMG_STORE(c_, row_, col_, w_) (*(u32x2*)((unsigned char*)wsb((c_), OFF_Y) + pg8::img_off((int)(row_), (col_))) = (w_))
DI void osm_update(f32x16& s, float& m, float& l, f32x16 (&O)[2], bf16x8& p0, bf16x8& p1) {
    float mx = fmaxf(s[0], s[1]);
#pragma unroll
    for (int i = 2; i < 16; ++i) mx = fmaxf(mx, s[i]);
    mx = fmaxf(mx, __shfl_xor(mx, 32));
    const float mn = fmaxf(m, mx);
    if (__any(mn > m)) {
        const float al = ex2(m - mn); l *= al;
#pragma unroll
        for (int i = 0; i < 16; ++i) { O[0][i] *= al; O[1][i] *= al; }
        m = mn;
    }
    float sum = 0.f;
#pragma unroll
    for (int i = 0; i < 16; ++i) { s[i] = ex2(s[i] - m); sum += s[i]; }
    l += sum;
    p0 = pack8(s[0], s[1], s[2], s[3], s[4], s[5], s[6], s[7]);
    p1 = pack8(s[8], s[9], s[10], s[11], s[12], s[13], s[14], s[15]);
}

constexpr int DK_KP = 144, DK_VP = 136;
constexpr int DF_KOFF = 0, DF_VOFF = 2 * 64 * DK_KP, DF_TOFF = DF_VOFF + 2 * 64 * DK_VP;
DI void diff_attn_task(const Params& p, const Ctx& c, int l, int b, int h, int qb) {
    const int tid = c.tid, lane = c.lane, wid = c.wid, r32 = lane & 31, hi = lane >> 5;
    const bf16_t* z = wsb(c, OFF_Z);
    const size_t rowbase = (size_t)b * SEQ;
    LAS unsigned char* lds = c.lds;
    LAS float* tbl = (LAS float*)(lds + DF_TOFF);
    __syncthreads();
    { const float* src = wsf(c, OFF_DIFFB) + h * 4096; for (int i = tid; i < 4096; i += 512) tbl[i] = src[i]; }
    const int qw0 = qb * 256 + wid * 32, qpos = qw0 + r32;
    bf16x8 qf[4];
    { const bf16_t* qp = ZP(z, rowbase + qpos, ZQD + h * 64);
#pragma unroll
      for (int s = 0; s < 4; ++s) qf[s] = *(const bf16x8*)(qp + 16 * s + 8 * hi); }
    f32x16 O1[2], O2[2];
#pragma unroll
    for (int i = 0; i < 16; ++i) { O1[0][i] = 0.f; O1[1][i] = 0.f; O2[0][i] = 0.f; O2[1][i] = 0.f; }
    float m1 = NEGBIG, m2 = NEGBIG, l1 = 0.f, l2 = 0.f;
    const int NT = (qb + 1) * 4;
    const int skey = tid >> 3, schunk = tid & 7;
    const bf16_t* kbase = ZP(z, rowbase + skey, ZKD + h * 64) + schunk * 8;
    const bf16_t* vbase = ZP(z, rowbase + skey, ZVD + h * 64) + schunk * 8;
    u32x4 kreg = *(const u32x4*)kbase, vreg = *(const u32x4*)vbase;
#define DF_WRITE(buf) do { *(LAS u32x4*)(lds + DF_KOFF + (buf) * 64 * DK_KP + skey * DK_KP + schunk * 16) = kreg; \
        LAS bf16_t* vt_ = (LAS bf16_t*)(lds + DF_VOFF + (buf) * 64 * DK_VP + skey * 2); \
        vt_[(schunk * 8 + 0) * (DK_VP / 2)] = (bf16_t)(vreg.x & 0xffff); vt_[(schunk * 8 + 1) * (DK_VP / 2)] = (bf16_t)(vreg.x >> 16); \
        vt_[(schunk * 8 + 2) * (DK_VP / 2)] = (bf16_t)(vreg.y & 0xffff); vt_[(schunk * 8 + 3) * (DK_VP / 2)] = (bf16_t)(vreg.y >> 16); \
        vt_[(schunk * 8 + 4) * (DK_VP / 2)] = (bf16_t)(vreg.z & 0xffff); vt_[(schunk * 8 + 5) * (DK_VP / 2)] = (bf16_t)(vreg.z >> 16); \
        vt_[(schunk * 8 + 6) * (DK_VP / 2)] = (bf16_t)(vreg.w & 0xffff); vt_[(schunk * 8 + 7) * (DK_VP / 2)] = (bf16_t)(vreg.w >> 16); } while (0)
    DF_WRITE(0);
    __syncthreads();
    for (int t = 0; t < NT; ++t) {
        const int buf = t & 1;
        if (t + 1 < NT) { kreg = *(const u32x4*)(kbase + (size_t)(t + 1) * 64 * ZS); vreg = *(const u32x4*)(vbase + (size_t)(t + 1) * 64 * ZS); }
        if (64 * t <= qw0 + 31) {
            const LAS unsigned char* kimg = lds + DF_KOFF + buf * 64 * DK_KP;
            const LAS unsigned char* vimg = lds + DF_VOFF + buf * 64 * DK_VP;
#pragma unroll
            for (int sub = 0; sub < 2; ++sub) {
                const int key0 = 64 * t + 32 * sub;
                if (key0 <= qw0 + 31) {
                    const LAS unsigned char* kr = kimg + (32 * sub + r32) * DK_KP + hi * 16;
                    const bf16x8 k0 = *(const LAS bf16x8*)(kr), k1 = *(const LAS bf16x8*)(kr + 32), k2 = *(const LAS bf16x8*)(kr + 64), k3 = *(const LAS bf16x8*)(kr + 96);
                    f32x16 s1, s2, bv;
                    const int dbase = qpos - key0 - 4 * hi;
                    if (key0 + 31 > qw0) {
#pragma unroll
                        for (int i = 0; i < 16; ++i) { const int d = dbase - ((i & 3) + 8 * (i >> 2)); const float bi = tbl[d < 0 ? 0 : d]; bv[i] = d < 0 ? NEGBIG : bi; }
                    } else {
#pragma unroll
                        for (int i = 0; i < 16; ++i) bv[i] = tbl[dbase - ((i & 3) + 8 * (i >> 2))];
                    }
                    s1 = MFMA32(k0, qf[0], bv); s1 = MFMA32(k1, qf[1], s1);
                    s2 = MFMA32(k2, qf[2], bv); s2 = MFMA32(k3, qf[3], s2);
                    bf16x8 pa0, pa1, pb0, pb1;
                    osm_update(s1, m1, l1, O1, pa0, pa1);
                    osm_update(s2, m2, l2, O2, pb0, pb1);
#pragma unroll
                    for (int dvt = 0; dvt < 2; ++dvt) {
                        const LAS unsigned char* vr = vimg + (32 * dvt + r32) * DK_VP + (32 * sub + 4 * hi) * 2;
                        const bf16x8 v0 = mk8(*(const LAS u32x2*)(vr), *(const LAS u32x2*)(vr + 16));
                        const bf16x8 v1 = mk8(*(const LAS u32x2*)(vr + 32), *(const LAS u32x2*)(vr + 48));
                        O1[dvt] = MFMA32(v0, pa0, O1[dvt]); O1[dvt] = MFMA32(v1, pa1, O1[dvt]);
                        O2[dvt] = MFMA32(v0, pb0, O2[dvt]); O2[dvt] = MFMA32(v1, pb1, O2[dvt]);
                    }
                }
            }
        }
        if (t + 1 < NT) DF_WRITE(buf ^ 1);
        __syncthreads();
    }
#undef DF_WRITE
    l1 += __shfl_xor(l1, 32); l2 += __shfl_xor(l2, 32);
    const float lam = wsf(c, OFF_LAM)[l];
    const float lam_init = 0.8f - 0.6f * expf(-0.3f * (float)l);
    const float i1 = 1.f / l1, i2 = lam / l2;
    float ssq = 0.f;
#pragma unroll
    for (int dvt = 0; dvt < 2; ++dvt)
#pragma unroll
        for (int i = 0; i < 16; ++i) { const float o = O1[dvt][i] * i1 - O2[dvt][i] * i2; O1[dvt][i] = o; ssq += o * o; }
    ssq += __shfl_xor(ssq, 32);
    const float rn = rsqrtf(ssq * (1.f / 64.f) + 1e-5f) * (1.f - lam_init);
    const float* sg = p.in[I_SUBLN] + l * 64;
#pragma unroll
    for (int dvt = 0; dvt < 2; ++dvt)
#pragma unroll
        for (int g = 0; g < 4; ++g) {
            const int dv = 32 * dvt + 8 * g + 4 * hi; const f32x4 gg = *(const f32x4*)(sg + dv);
            u32x2 w; w.x = cvtpk(O1[dvt][4 * g] * rn * gg[0], O1[dvt][4 * g + 1] * rn * gg[1]); w.y = cvtpk(O1[dvt][4 * g + 2] * rn * gg[2], O1[dvt][4 * g + 3] * rn * gg[3]);
            YIMG_STORE(c, rowbase + qpos, 768 + h * 64 + dv, w);
        }
}

constexpr int DL_NK = 384, DL_KP = 144, DL_VP = 776;
constexpr int DL_KOFF = 0, DL_VOFF = DL_NK * DL_KP, DL_TOFF = DL_VOFF + 64 * DL_VP;
DI void dil_attn_task(const Params& p, const Ctx& c, int pat, int b, int h, int res, int mb) {
    const int dil = pat == 0 ? 1 : (pat == 1 ? 4 : 16);
    const int tid = c.tid, lane = c.lane, wid = c.wid, r32 = lane & 31, hi = lane >> 5;
    const bf16_t* z = wsb(c, OFF_Z);
    const size_t rowbase = (size_t)b * SEQ;
    LAS unsigned char* lds = c.lds;
    LAS float* tbl = (LAS float*)(lds + DL_TOFF);
    __syncthreads();
    if (tid < 132) tbl[tid] = wsf(c, OFF_DILB)[(pat * 4 + h) * 132 + tid];
    const int mk0 = 256 * mb - 128;
    {
        u32x4 kreg[6], vreg[6];
#pragma unroll
        for (int it = 0; it < 6; ++it) {
            const int idx = tid + 512 * it, key = idx >> 3, chunk = idx & 7, mk = mk0 + key;
            kreg[it] = (u32x4){0u, 0u, 0u, 0u}; vreg[it] = (u32x4){0u, 0u, 0u, 0u};
            if (mk >= 0) { const size_t zr = rowbase + (size_t)mk * dil + res; kreg[it] = *(const u32x4*)(ZP(z, zr, ZKC + h * 64) + chunk * 8); vreg[it] = *(const u32x4*)(ZP(z, zr, ZVC + h * 64) + chunk * 8); }
        }
#pragma unroll
        for (int it = 0; it < 6; ++it) {
            const int idx = tid + 512 * it, key = idx >> 3, chunk = idx & 7;
            *(LAS u32x4*)(lds + DL_KOFF + key * DL_KP + chunk * 16) = kreg[it];
            LAS bf16_t* vt_ = (LAS bf16_t*)(lds + DL_VOFF + key * 2);
            vt_[(chunk * 8 + 0) * (DL_VP / 2)] = (bf16_t)(vreg[it].x & 0xffff); vt_[(chunk * 8 + 1) * (DL_VP / 2)] = (bf16_t)(vreg[it].x >> 16);
            vt_[(chunk * 8 + 2) * (DL_VP / 2)] = (bf16_t)(vreg[it].y & 0xffff); vt_[(chunk * 8 + 3) * (DL_VP / 2)] = (bf16_t)(vreg[it].y >> 16);
            vt_[(chunk * 8 + 4) * (DL_VP / 2)] = (bf16_t)(vreg[it].z & 0xffff); vt_[(chunk * 8 + 5) * (DL_VP / 2)] = (bf16_t)(vreg[it].z >> 16);
            vt_[(chunk * 8 + 6) * (DL_VP / 2)] = (bf16_t)(vreg[it].w & 0xffff); vt_[(chunk * 8 + 7) * (DL_VP / 2)] = (bf16_t)(vreg[it].w >> 16);
        }
    }
    const int mq = 256 * mb + 32 * wid + r32;
    const size_t qtok = rowbase + (size_t)mq * dil + res;
    bf16x8 qf[4];
    { const bf16_t* qp = ZP(z, qtok, ZQC + h * 64);
#pragma unroll
      for (int s = 0; s < 4; ++s) qf[s] = *(const bf16x8*)(qp + 16 * s + 8 * hi); }
    __syncthreads();
    f32x16 O[2];
#pragma unroll
    for (int i = 0; i < 16; ++i) { O[0][i] = 0.f; O[1][i] = 0.f; }
    float m = NEGBIG, lsum = 0.f;
    for (int j = 0; j < 5; ++j) {
        const int kt = wid + j;
        const LAS unsigned char* kr = lds + DL_KOFF + (32 * kt + r32) * DL_KP + hi * 16;
        f32x16 s;
        const int dbase = 128 - 32 * j + r32 - 4 * hi;
        const int mkb = mk0 + 32 * kt + 4 * hi;
        if (j == 0 || j == 4 || mb == 0) {
#pragma unroll
            for (int i = 0; i < 16; ++i) { const int cc = (i & 3) + 8 * (i >> 2); const int dl = dbase - cc; const bool ok = (dl >= 0) && (dl <= 128) && (mkb + cc >= 0);
                const int dc = dl < 0 ? 0 : (dl > 128 ? 128 : dl); s[i] = ok ? tbl[dc] : NEGBIG; }
        } else {
#pragma unroll
            for (int i = 0; i < 16; ++i) s[i] = tbl[dbase - ((i & 3) + 8 * (i >> 2))];
        }
#pragma unroll
        for (int ks = 0; ks < 4; ++ks) s = MFMA32(*(const LAS bf16x8*)(kr + 32 * ks), qf[ks], s);
        bf16x8 p0, p1;
        osm_update(s, m, lsum, O, p0, p1);
#pragma unroll
        for (int dvt = 0; dvt < 2; ++dvt) {
            const LAS unsigned char* vr = lds + DL_VOFF + (32 * dvt + r32) * DL_VP + (32 * kt + 4 * hi) * 2;
            const bf16x8 v0 = mk8(*(const LAS u32x2*)(vr), *(const LAS u32x2*)(vr + 16));
            const bf16x8 v1 = mk8(*(const LAS u32x2*)(vr + 32), *(const LAS u32x2*)(vr + 48));
            O[dvt] = MFMA32(v0, p0, O[dvt]); O[dvt] = MFMA32(v1, p1, O[dvt]);
        }
    }
    lsum += __shfl_xor(lsum, 32);
    const float inv = 1.f / lsum, lse = m + log2f(lsum);
    if (pat != 0) {
        bf16_t* orow = ((bf16_t*)((unsigned char*)c.out + (size_t)64 * 64 * 4096 * 4)) + ((size_t)(pat - 1) * MTOK + qtok) * 256 + h * 64;
#pragma unroll
        for (int dvt = 0; dvt < 2; ++dvt)
#pragma unroll
            for (int g = 0; g < 4; ++g) { u32x2 w; w.x = cvtpk(O[dvt][4 * g] * inv, O[dvt][4 * g + 1] * inv); w.y = cvtpk(O[dvt][4 * g + 2] * inv, O[dvt][4 * g + 3] * inv);
                *(u32x2*)(orow + 32 * dvt + 8 * g + 4 * hi) = w; }
        if (hi == 0) wsf(c, OFF_LSEP)[((size_t)(pat - 1) * MTOK + qtok) * 4 + h] = lse;
    } else {
        const float ls1 = wsf(c, OFF_LSEP)[qtok * 4 + h], ls2 = wsf(c, OFF_LSEP)[((size_t)MTOK + qtok) * 4 + h];
        const float mm = fmaxf(lse, fmaxf(ls1, ls2));
        const float w0 = ex2(lse - mm), w1 = ex2(ls1 - mm), w2 = ex2(ls2 - mm), wi = 1.f / (w0 + w1 + w2);
        const float a0 = w0 * wi * inv, a1 = w1 * wi, a2 = w2 * wi;
        const bf16_t* o1 = ((bf16_t*)((unsigned char*)c.out + (size_t)64 * 64 * 4096 * 4)) + qtok * 256 + h * 64; const bf16_t* o2 = o1 + (size_t)MTOK * 256;
#pragma unroll
        for (int dvt = 0; dvt < 2; ++dvt)
#pragma unroll
            for (int g = 0; g < 4; ++g) { const int dv = 32 * dvt + 8 * g + 4 * hi; const u32x2 x1 = *(const u32x2*)(o1 + dv), x2 = *(const u32x2*)(o2 + dv);
                const float r0 = O[dvt][4 * g] * a0 + bflo(x1.x) * a1 + bflo(x2.x) * a2, r1 = O[dvt][4 * g + 1] * a0 + bfhi(x1.x) * a1 + bfhi(x2.x) * a2;
                const float r2 = O[dvt][4 * g + 2] * a0 + bflo(x1.y) * a1 + bflo(x2.y) * a2, r3 = O[dvt][4 * g + 3] * a0 + bfhi(x1.y) * a1 + bfhi(x2.y) * a2;
                u32x2 w; w.x = cvtpk(r0, r1); w.y = cvtpk(r2, r3); YIMG_STORE(c, qtok, 512 + h * 64 + dv, w); }
    }
}

DI void pool_x(const bf16_t* bp0, int w, int cnt, float icnt, bf16x8 (&xf)[4]) {
    float sum[4][8]; u32x4 cur[4];
#pragma unroll
    for (int ks = 0; ks < 4; ++ks) {
        const bf16_t* bp = bp0 + 16 * ks;
        cur[ks] = *(const u32x4*)bp; const u32x4 prv = (cnt > 1) ? *(const u32x4*)(bp - ZS) : (u32x4){0u, 0u, 0u, 0u};
        sum[ks][0] = bflo(cur[ks].x) + bflo(prv.x); sum[ks][1] = bfhi(cur[ks].x) + bfhi(prv.x); sum[ks][2] = bflo(cur[ks].y) + bflo(prv.y); sum[ks][3] = bfhi(cur[ks].y) + bfhi(prv.y);
        sum[ks][4] = bflo(cur[ks].z) + bflo(prv.z); sum[ks][5] = bfhi(cur[ks].z) + bfhi(prv.z); sum[ks][6] = bflo(cur[ks].w) + bflo(prv.w); sum[ks][7] = bfhi(cur[ks].w) + bfhi(prv.w);
    }
#pragma unroll 1
    for (int j0 = 2; j0 < w; j0 += 2) {
        u32x4 v0[4], v1[4];
#pragma unroll
        for (int ks = 0; ks < 4; ++ks) { v0[ks] = (u32x4){0u, 0u, 0u, 0u}; v1[ks] = (u32x4){0u, 0u, 0u, 0u};
            if (j0 < cnt) v0[ks] = *(const u32x4*)(bp0 + 16 * ks - (size_t)j0 * ZS);
            if (j0 + 1 < cnt) v1[ks] = *(const u32x4*)(bp0 + 16 * ks - (size_t)(j0 + 1) * ZS); }
#pragma unroll
        for (int ks = 0; ks < 4; ++ks) {
            sum[ks][0] += bflo(v0[ks].x) + bflo(v1[ks].x); sum[ks][1] += bfhi(v0[ks].x) + bfhi(v1[ks].x); sum[ks][2] += bflo(v0[ks].y) + bflo(v1[ks].y); sum[ks][3] += bfhi(v0[ks].y) + bfhi(v1[ks].y);
            sum[ks][4] += bflo(v0[ks].z) + bflo(v1[ks].z); sum[ks][5] += bfhi(v0[ks].z) + bfhi(v1[ks].z); sum[ks][6] += bflo(v0[ks].w) + bflo(v1[ks].w); sum[ks][7] += bfhi(v0[ks].w) + bfhi(v1[ks].w); }
    }
#pragma unroll
    for (int ks = 0; ks < 4; ++ks)
        xf[ks] = pack8(sum[ks][0] * icnt - bflo(cur[ks].x), sum[ks][1] * icnt - bfhi(cur[ks].x), sum[ks][2] * icnt - bflo(cur[ks].y), sum[ks][3] * icnt - bfhi(cur[ks].y),
                       sum[ks][4] * icnt - bflo(cur[ks].z), sum[ks][5] * icnt - bfhi(cur[ks].z), sum[ks][6] * icnt - bflo(cur[ks].w), sum[ks][7] * icnt - bfhi(cur[ks].w));
}
DI void pool_task(const Params& p, const Ctx& c, int l, int wt) {
    const int lane = c.lane, r32 = lane & 31, hi = lane >> 5;
    const int g = (wt + (wt >> 11)) & 3, rt = wt >> 2;
    const size_t row = (size_t)rt * 32 + r32; const int t = (int)(row & (SEQ - 1));
    const int w = 2 << g, cnt = (t + 1 < w) ? t + 1 : w; const float icnt = 1.f / (float)cnt;
    const bf16_t* z = wsb(c, OFF_Z);
    bf16x8 xf[4];
    const bf16_t* bp0 = ZP(z, row, ZPB + g * 64) + 8 * hi;
    pool_x(bp0, w, cnt, icnt, xf);
    const float* pw = p.in[I_POOLW] + ((size_t)l * 4 + g) * 64 * 64;
    const float* psc = p.in[I_POOLS] + l * 256 + g * 64;
#pragma unroll 1
    for (int dt = 0; dt < 2; ++dt) {
        f32x16 acc;
#pragma unroll
        for (int i = 0; i < 16; ++i) acc[i] = 0.f;
#pragma unroll
        for (int ks = 0; ks < 4; ++ks) {
            const float* wp = pw + (size_t)(16 * ks + 8 * hi) * 64 + 32 * dt + r32;
            const bf16x8 wf = pack8(wp[0], wp[64], wp[128], wp[192], wp[256], wp[320], wp[384], wp[448]);
            acc = MFMA32(wf, xf[ks], acc);
        }
#pragma unroll
        for (int gq = 0; gq < 4; ++gq) { const int dd = 32 * dt + 8 * gq + 4 * hi; const f32x4 sc = *(const f32x4*)(psc + dd);
            u32x2 wv; wv.x = cvtpk(acc[4 * gq] * sc[0], acc[4 * gq + 1] * sc[1]); wv.y = cvtpk(acc[4 * gq + 2] * sc[2], acc[4 * gq + 3] * sc[3]); YIMG_STORE(c, row, 256 + g * 64 + dd, wv); }
    }
}

DI float scan_add(float v, int lane) {
#pragma unroll
    for (int o = 1; o < 64; o <<= 1) { const float n = __shfl_up(v, o); if (lane >= o) v += n; }
    return v;
}
DI float scan_max(float v, int lane) {
#pragma unroll
    for (int o = 1; o < 64; o <<= 1) { const float n = __shfl_up(v, o); if (lane >= o) v = fmaxf(v, n); }
    return v;
}
DI float log_sigmoid(float x) { return fminf(x, 0.f) - log1pf(expf(-fabsf(x))); }
DI void conv8(const bf16_t* zp, int t, const float* cw, const float* cb, float scale, float (&o)[8]) {
    const f32x4 b0 = *(const f32x4*)cb, b1 = *(const f32x4*)(cb + 4);
    o[0] = b0[0]; o[1] = b0[1]; o[2] = b0[2]; o[3] = b0[3]; o[4] = b1[0]; o[5] = b1[1]; o[6] = b1[2]; o[7] = b1[3];
#pragma unroll
    for (int tap = 0; tap < 4; ++tap) {
        if (t - 3 + tap >= 0) {
            const u32x4 v = *(const u32x4*)(zp - (size_t)(3 - tap) * ZS);
            const f32x4 w0 = *(const f32x4*)(cw + tap * 512), w1 = *(const f32x4*)(cw + tap * 512 + 4);
            o[0] += bflo(v.x) * w0[0]; o[1] += bfhi(v.x) * w0[1]; o[2] += bflo(v.y) * w0[2]; o[3] += bfhi(v.y) * w0[3];
            o[4] += bflo(v.z) * w1[0]; o[5] += bfhi(v.z) * w1[1]; o[6] += bflo(v.w) * w1[2]; o[7] += bfhi(v.w) * w1[3];
        }
    }
#pragma unroll
    for (int e = 0; e < 8; ++e) o[e] = silu_f(o[e]) * scale;
    asm volatile("" ::: "memory");
}
DI void conv_frag4(const bf16_t* zp, int t, const LAS float* cw, const LAS float* cb, int hi, float scale, bf16x8 (&out)[4]) {
    asm volatile("" ::: "memory");
#pragma unroll
    for (int kh = 0; kh < 2; ++kh) {
        u32x4 v[2][4];
#pragma unroll
        for (int k2 = 0; k2 < 2; ++k2)
#pragma unroll
            for (int tap = 0; tap < 4; ++tap) { v[k2][tap] = (u32x4){0u, 0u, 0u, 0u}; if (t - 3 + tap >= 0) v[k2][tap] = *(const u32x4*)(zp + 16 * (2 * kh + k2) - (size_t)(3 - tap) * ZS); }
#pragma unroll
        for (int k2 = 0; k2 < 2; ++k2) {
            const int ks = 2 * kh + k2, d0 = 16 * ks + 8 * hi;
            const f32x4 b0 = *(const LAS f32x4*)(cb + d0), b1 = *(const LAS f32x4*)(cb + d0 + 4);
            float o[8] = {b0[0], b0[1], b0[2], b0[3], b1[0], b1[1], b1[2], b1[3]};
#pragma unroll
            for (int tap = 0; tap < 4; ++tap) {
                const f32x4 w0 = *(const LAS f32x4*)(cw + tap * 64 + d0), w1 = *(const LAS f32x4*)(cw + tap * 64 + d0 + 4); const u32x4 x = v[k2][tap];
                o[0] += bflo(x.x) * w0[0]; o[1] += bfhi(x.x) * w0[1]; o[2] += bflo(x.y) * w0[2]; o[3] += bfhi(x.y) * w0[3];
                o[4] += bflo(x.z) * w1[0]; o[5] += bfhi(x.z) * w1[1]; o[6] += bflo(x.w) * w1[2]; o[7] += bfhi(x.w) * w1[3];
            }
            out[ks] = pack8(silu_f(o[0]) * scale, silu_f(o[1]) * scale, silu_f(o[2]) * scale, silu_f(o[3]) * scale, silu_f(o[4]) * scale, silu_f(o[5]) * scale, silu_f(o[6]) * scale, silu_f(o[7]) * scale);
        }
        asm volatile("" ::: "memory");
    }
}
DI void mlstm_a_task(const Params& p, const Ctx& c, int l, int task) {
    const int lane = c.lane, r32 = lane & 31, hi = lane >> 5;
    const int bh = task >> 6, ch = task & 63, b = bh >> 2, h = bh & 3, t0 = ch * 64;
    const size_t rowbase = (size_t)b * SEQ;
    const bf16_t* z = wsb(c, OFF_Z);
    const float* gates = wsf(c, OFF_GATES) + (rowbase + t0 + lane) * 8;
    const float* gb = p.in[I_GATEB] + l * 8;
    const float ig = gates[h] + gb[h], lf = log_sigmoid(gates[4 + h] + gb[4 + h]);
    const float bcs = scan_add(lf, lane);
    const float gp = ig - bcs;
    const float mu = wave_max(gp);
    const float ws_ = expf(gp - mu);
    const float Bc = __shfl(bcs, 63);
    if (lane == 0) { wsf(c, OFF_SCAL)[task] = Bc; wsf(c, OFF_SCAL)[4096 + task] = mu; }
    const float* cwl = p.in[I_CONVW] + (size_t)l * 4 * 512; const float* cbl = p.in[I_CONVB] + l * 512;
    f32x16 acc[2][2];
#pragma unroll
    for (int a = 0; a < 2; ++a)
#pragma unroll
        for (int bb = 0; bb < 2; ++bb)
#pragma unroll
            for (int i = 0; i < 16; ++i) acc[a][bb][i] = 0.f;
    float nsum[2] = {0.f, 0.f};
#pragma unroll
    for (int ks = 0; ks < 4; ++ks) {
        const int s0 = 16 * ks + 8 * hi;
        float wv[8];
#pragma unroll
        for (int j = 0; j < 8; ++j) wv[j] = __shfl(ws_, s0 + j);
        bf16x8 kf[2];
#pragma unroll
        for (int it = 0; it < 2; ++it) {
            const int chn = 256 + h * 64 + 32 * it + r32;
            const float w0 = cwl[chn], w1 = cwl[512 + chn], w2 = cwl[1024 + chn], w3 = cwl[1536 + chn], cb = cbl[chn];
            const bf16_t* kp = ZP(z, rowbase + t0 + s0, ZKA + h * 64) + 32 * it + r32;
            float raw[11];
#pragma unroll
            for (int x = 0; x < 11; ++x) raw[x] = (t0 + s0 - 3 + x >= 0) ? bf2f(kp[(long)(x - 3) * ZS]) : 0.f;
            float kk[8];
#pragma unroll
            for (int j = 0; j < 8; ++j) { const float o = cb + w0 * raw[j] + w1 * raw[j + 1] + w2 * raw[j + 2] + w3 * raw[j + 3]; kk[j] = silu_f(o) * 0.125f * wv[j]; nsum[it] += kk[j]; }
            kf[it] = pack8(kk[0], kk[1], kk[2], kk[3], kk[4], kk[5], kk[6], kk[7]);
        }
#pragma unroll
        for (int et = 0; et < 2; ++et) {
            const bf16_t* vp = ZP(z, rowbase + t0 + s0, ZVA + h * 64) + 32 * et + r32;
            u32x4 w; w.x = (unsigned)vp[0] | ((unsigned)vp[ZS] << 16); w.y = (unsigned)vp[2 * ZS] | ((unsigned)vp[3 * ZS] << 16);
            w.z = (unsigned)vp[4 * ZS] | ((unsigned)vp[5 * ZS] << 16); w.w = (unsigned)vp[6 * ZS] | ((unsigned)vp[7 * ZS] << 16);
            const bf16x8 vf = __builtin_bit_cast(bf16x8, w);
            acc[et][0] = MFMA32(vf, kf[0], acc[et][0]); acc[et][1] = MFMA32(vf, kf[1], acc[et][1]);
        }
    }
    float* D = ((float*)c.out) + (size_t)task * 4096;
#pragma unroll
    for (int et = 0; et < 2; ++et)
#pragma unroll
        for (int it = 0; it < 2; ++it)
#pragma unroll
            for (int i = 0; i < 16; ++i) D[(32 * et + crow(i, hi)) * 64 + 32 * it + r32] = acc[et][it][i];
    nsum[0] += __shfl_xor(nsum[0], 32); nsum[1] += __shfl_xor(nsum[1], 32);
    if (hi == 0) { wsf(c, OFF_NST)[(size_t)task * 64 + r32] = nsum[0]; wsf(c, OFF_NST)[(size_t)task * 64 + 32 + r32] = nsum[1]; }
}
DI void mlstm_scan(const Params& p, const Ctx& c) {
    const float* Bc = wsf(c, OFF_SCAL); const float* mu = Bc + 4096; float* mprev = wsf(c, OFF_SCAL) + 8192;
    float* D = ((float*)c.out); float* N = wsf(c, OFF_NST);
    LAS float* cwl = (LAS float*)c.lds; LAS float* swl = cwl + 64;
    for (int task = c.bid; task < 256; task += c.G) {
        const int bh = task >> 2, q = task & 3;
        __syncthreads();
        if (c.wid == 0) {
            const float B = Bc[bh * 64 + c.lane], u = mu[bh * 64 + c.lane];
            float m = 0.f, mycw = 0.f, mysw = 0.f, mymp = 0.f;
            for (int ch = 0; ch < 64; ++ch) {
                const float Bs = __shfl(B, ch), us = __shfl(u, ch);
                const float mnew = fmaxf(Bs + m, Bs + us);
                const float cw = expf(Bs + m - mnew), sw = expf(Bs + us - mnew);
                if (c.lane == ch) { mycw = cw; mysw = sw; mymp = m; }
                m = mnew;
            }
            cwl[c.lane] = mycw; swl[c.lane] = mysw;
            if (q == 0) mprev[bh * 64 + c.lane] = mymp;
        }
        __syncthreads();
        for (int idx = q * 1040 + c.tid; idx < (q + 1) * 1040; idx += 512) {
            float* base = idx < 4096 ? D + (size_t)bh * 64 * 4096 + idx : N + (size_t)bh * 64 * 64 + (idx - 4096);
            const size_t stride = idx < 4096 ? 4096 : 64;
            float d[64];
#pragma unroll
            for (int ch = 0; ch < 64; ++ch) d[ch] = base[(size_t)ch * stride];
            float C = 0.f;
#pragma unroll
            for (int ch = 0; ch < 64; ++ch) { const float dv = d[ch]; base[(size_t)ch * stride] = C; C = cwl[ch] * C + swl[ch] * dv; }
        }
    }
}
DI void mlstm_c_task(const Params& p, const Ctx& c, int l, int task) {
    const int lane = c.lane, r32 = lane & 31, hi = lane >> 5;
    const int bh = task >> 6, ch = task & 63, b = bh >> 2, h = bh & 3, t0 = ch * 64;
    const size_t rowbase = (size_t)b * SEQ;
    const bf16_t* z = wsb(c, OFF_Z);
    const float* gates = wsf(c, OFF_GATES) + (rowbase + t0 + lane) * 8;
    const float* gb = p.in[I_GATEB] + l * 8;
    const float ig = gates[h] + gb[h], lf = log_sigmoid(gates[4 + h] + gb[4 + h]);
    const float bcs = scan_add(lf, lane);
    const float gp = ig - bcs;
    const float mp = wsf(c, OFF_SCAL)[8192 + task];
    const float pm = scan_max(gp, lane);
    const float mt = bcs + fmaxf(mp, pm);
    const float bm = bcs - mt;
    const float iw = expf(bcs + mp - mt);
    const float flo = expf(-mt);
    const float* cwl = p.in[I_CONVW] + (size_t)l * 4 * 512; const float* cbl = p.in[I_CONVB] + l * 512;
    const float* Ct = ((float*)c.out) + (size_t)task * 4096;
    const float* nst = wsf(c, OFF_NST) + (size_t)task * 64;
    const float* ng = p.in[I_MLN] + l * 256 + h * 64;
#pragma unroll 1
    for (int tt = 0; tt < 2; ++tt) {
        const int tq = 32 * tt + r32;
        const float bm_t = __shfl(bm, tq), iw_t = __shfl(iw, tq), flo_t = __shfl(flo, tq);
        bf16x8 qf[4]; float qn = 0.f;
#pragma unroll
        for (int ks = 0; ks < 4; ++ks) { float o[8]; const int d0 = 16 * ks + 8 * hi;
            conv8(ZP(z, rowbase + t0 + tq, ZQA + h * 64) + d0, t0 + tq, cwl + h * 64 + d0, cbl + h * 64 + d0, 1.f, o);
            qf[ks] = pack8(o[0], o[1], o[2], o[3], o[4], o[5], o[6], o[7]);
            const u32x4 qw = __builtin_bit_cast(u32x4, qf[ks]);
            const f32x4 n0 = *(const f32x4*)(nst + d0), n1 = *(const f32x4*)(nst + d0 + 4);
            qn += bflo(qw.x) * n0[0] + bfhi(qw.x) * n0[1] + bflo(qw.y) * n0[2] + bfhi(qw.y) * n0[3] + bflo(qw.z) * n1[0] + bfhi(qw.z) * n1[1] + bflo(qw.w) * n1[2] + bfhi(qw.w) * n1[3]; }
        qn += __shfl_xor(qn, 32);
        f32x16 num[2];
#pragma unroll
        for (int i = 0; i < 16; ++i) { num[0][i] = 0.f; num[1][i] = 0.f; }
#pragma unroll
        for (int et = 0; et < 2; ++et)
#pragma unroll
            for (int ks = 0; ks < 4; ++ks) { const float* cp = Ct + (size_t)(32 * et + r32) * 64 + 16 * ks + 8 * hi; const f32x4 c0 = *(const f32x4*)cp, c1 = *(const f32x4*)(cp + 4);
                num[et] = MFMA32(pack8(c0[0], c0[1], c0[2], c0[3], c1[0], c1[1], c1[2], c1[3]), qf[ks], num[et]); }
#pragma unroll
        for (int i = 0; i < 16; ++i) { num[0][i] *= iw_t; num[1][i] *= iw_t; }
        float dsum = 0.f;
#pragma unroll 1
        for (int st = 0; st <= tt; ++st) {
            f32x16 s;
#pragma unroll
            for (int i = 0; i < 16; ++i) s[i] = 0.f;
#pragma unroll
            for (int ks = 0; ks < 4; ++ks) { float o[8]; const int sk = 32 * st + r32, d0 = 16 * ks + 8 * hi;
                conv8(ZP(z, rowbase + t0 + sk, ZKA + h * 64) + d0, t0 + sk, cwl + 256 + h * 64 + d0, cbl + 256 + h * 64 + d0, 0.125f, o);
                s = MFMA32(pack8(o[0], o[1], o[2], o[3], o[4], o[5], o[6], o[7]), qf[ks], s); }
#pragma unroll
            for (int i = 0; i < 16; ++i) { const int sp = 32 * st + crow(i, hi); const float gs = __shfl(gp, sp);
                const float wgt = (sp <= tq) ? expf(gs + bm_t) : 0.f; s[i] *= wgt; dsum += s[i]; }
            const bf16x8 p0 = pack8(s[0], s[1], s[2], s[3], s[4], s[5], s[6], s[7]), p1 = pack8(s[8], s[9], s[10], s[11], s[12], s[13], s[14], s[15]);
#pragma unroll
            for (int et = 0; et < 2; ++et)
#pragma unroll
                for (int k2 = 0; k2 < 2; ++k2) {
                    const bf16_t* vp = ZP(z, rowbase + t0 + 32 * st + 16 * k2 + 4 * hi, ZVA + h * 64) + 32 * et + r32;
                    u32x4 w; w.x = (unsigned)vp[0] | ((unsigned)vp[ZS] << 16); w.y = (unsigned)vp[2 * ZS] | ((unsigned)vp[3 * ZS] << 16);
                    w.z = (unsigned)vp[8 * ZS] | ((unsigned)vp[9 * ZS] << 16); w.w = (unsigned)vp[10 * ZS] | ((unsigned)vp[11 * ZS] << 16);
                    num[et] = MFMA32(__builtin_bit_cast(bf16x8, w), k2 == 0 ? p0 : p1, num[et]);
                }
        }
        dsum += __shfl_xor(dsum, 32);
        const float den = iw_t * qn + dsum;
        const float idn = 1.f / fmaxf(fabsf(den), flo_t);
        float sm = 0.f;
#pragma unroll
        for (int et = 0; et < 2; ++et)
#pragma unroll
            for (int i = 0; i < 16; ++i) { const float hv = num[et][i] * idn; num[et][i] = hv; sm += hv; }
        sm += __shfl_xor(sm, 32);
        const float mean = sm * (1.f / 64.f);
        float vs = 0.f;
#pragma unroll
        for (int et = 0; et < 2; ++et)
#pragma unroll
            for (int i = 0; i < 16; ++i) { const float d = num[et][i] - mean; num[et][i] = d; vs += d * d; }
        vs += __shfl_xor(vs, 32);
        const float rstd = rsqrtf(vs * (1.f / 64.f) + 1e-6f);
        const size_t tok = rowbase + t0 + tq;
        const bf16_t* orow = ZP(z, tok, ZOA + h * 64);
#pragma unroll
        for (int et = 0; et < 2; ++et)
#pragma unroll
            for (int g = 0; g < 4; ++g) { const int e = 32 * et + 8 * g + 4 * hi; const f32x4 gg = *(const f32x4*)(ng + e); const u32x2 ov = *(const u32x2*)(orow + e);
                const float y0 = num[et][4 * g] * rstd * gg[0] * sigmoid_f(bflo(ov.x)), y1 = num[et][4 * g + 1] * rstd * gg[1] * sigmoid_f(bfhi(ov.x));
                const float y2 = num[et][4 * g + 2] * rstd * gg[2] * sigmoid_f(bflo(ov.y)), y3 = num[et][4 * g + 3] * rstd * gg[3] * sigmoid_f(bfhi(ov.y));
                u32x2 w; w.x = cvtpk(y0, y1); w.y = cvtpk(y2, y3); YIMG_STORE(c, tok, h * 64 + e, w); }
    }
}

DI void ph_mix1(const Params& p, const Ctx& c0, int l) {
    const Ctx c = fresh(c0);
    REP(R_DIFF) for (int pt = c.bid; pt < 512; pt += c.G) { const int bh = pt >> 3, s = pt & 7; diff_attn_task(p, c, l, bh >> 2, bh & 3, 15 - s); diff_attn_task(p, c, l, bh >> 2, bh & 3, s); }
    REP(R_DIL) for (int i = c.bid; i < 1024; i += c.G) { const int bh = i >> 4, rest = i & 15; dil_attn_task(p, c, 1, bh >> 2, bh & 3, rest >> 2, rest & 3); }
    REP(R_DIL) for (int i = c.bid; i < 1024; i += c.G) { const int bh = i >> 4; dil_attn_task(p, c, 2, bh >> 2, bh & 3, i & 15, 0); }
    __syncthreads();
    REP(R_POOL) for (int wt = c.bid * 8 + c.wid; wt < 8192; wt += c.G * 8) pool_task(p, c, l, wt);
    REP(R_MLA) for (int tk = c.bid * 8 + c.wid; tk < 4096; tk += c.G * 8) mlstm_a_task(p, c, l, tk);
}
DI void ph_mix2(const Params& p, const Ctx& c0, int l) {
    const Ctx c = fresh(c0);
    mlstm_scan(p, c);
    REP(R_DIL) for (int i = c.bid; i < 1024; i += c.G) { const int bh = i >> 4; dil_attn_task(p, c, 0, bh >> 2, bh & 3, 0, i & 15); }
    __syncthreads();
}
DI void ph_mix3(const Params& p, const Ctx& c0, int l) {
    const Ctx c = fresh(c0);
    REP(R_MLC) for (int tk = c.bid * 8 + c.wid; tk < 4096; tk += c.G * 8) mlstm_c_task(p, c, l, tk);
}
DI void ph_final(const Params& p, const Ctx& c0) {
    const Ctx c = fresh(c0);
    const float* ss = ssbuf(c, 16); const float* g = p.in[I_FINN]; const bf16_t* hb = wsb(c, OFF_HB);
    for (int row = c.bid * 8 + c.wid; row < MTOK; row += c.G * 8) {
        const float rs = rowss(ss, row);
        f32x4* xr = (f32x4*)(c.out + (size_t)row * DM) + c.lane; const f32x4* gr = (const f32x4*)g + c.lane; const unsigned char* hbimg = (const unsigned char*)hb;
#pragma unroll
        for (int j = 0; j < 4; ++j) { const u32x2 hv = *(const u32x2*)(hbimg + pg8::img_off(row, 4 * (c.lane + 64 * j))); const f32x4 gg = gr[64 * j];
            xr[64 * j] = (f32x4){bflo(hv.x) * rs * gg[0], bfhi(hv.x) * rs * gg[1], bflo(hv.y) * rs * gg[2], bfhi(hv.y) * rs * gg[3]}; }
    }
}

DI void ph_ffn_up(const Params& p, const Ctx& c0, int l, int which) {
    const Ctx c = fresh(c0);
    pg8::Gemm g = pg8::plain_gemm(wsb(c, OFF_HB), (const bf16_t*)(c.ws + (size_t)l * W_LAYER + (which ? W_GU2 : W_GU1)), MTOK, 2 * FF, DM); g.ocol_step = 128; pg8::use_img_b(g); pg8::use_img_a(g);
    pg8::Order S; S.init(g, c.G, c.bid);
    pg8::EpiSwiGLU E{wsb(c, OFF_Z), FF, ssbuf(c, 4 * l + (which ? 3 : 0))};
    pg8::gemm_phase(c.lds, g, S, E);
}
DI void ph_resid(const Params& p, const Ctx& c0, const bf16_t* A, const bf16_t* Bt, int K, int ss_out, float alpha) {
    const Ctx c = fresh(c0);
    pg8::Gemm g = pg8::plain_gemm(A, Bt, MTOK, DM, K);
    pg8::use_img_a(g); pg8::use_img_b(g); if (K == FF) g.a_pmdiv = (long)(FF / 64) * 256 * 64;
    pg8::Order S; S.init(g, c.G, c.bid);
    pg8::EpiResid E{wsb(c, OFF_HB), ssbuf(c, ss_out), alpha};
    pg8::gemm_phase(c.lds, g, S, E);
}
DI void ph_kv(const Params& p, const Ctx& c0) {
    const Ctx c = fresh(c0);
    { pg8::Gemm g = pg8::plain_gemm(wsb(c, OFF_MEMB), wsb(c, OFF_WK), MMEM, 4096, DM); pg8::Order S; S.init(g, c.G, c.bid);
      pg8::EpiBf16 E{wsb(c, OFF_KB), 4096, nullptr, wsf(c, OFF_RSM), nullptr, 1.f, 0}; pg8::gemm_phase(c.lds, g, S, E); }
    { pg8::Gemm g = pg8::plain_gemm(wsb(c, OFF_MEMB), wsb(c, OFF_WV), MMEM, 4096, DM); pg8::Order S; S.init(g, c.G, c.bid);
      pg8::EpiBf16 E{wsb(c, OFF_VT), 4096, nullptr, wsf(c, OFF_RSM), nullptr, 1.f, 0}; pg8::gemm_phase(c.lds, g, S, E); }
}
DI void ph_win(const Params& p, const Ctx& c0, int l) {
    const Ctx c = fresh(c0);
    pg8::Gemm g = pg8::plain_gemm(wsb(c, OFF_HB), (const bf16_t*)(c.ws + (size_t)l * W_LAYER + W_IN), MTOK, 3072, DM); pg8::use_img_b(g); pg8::use_img_a(g);
    pg8::Order S; S.init(g, c.G, c.bid);
    pg8::EpiZ E{wsb(c, OFF_Z), wsf(c, OFF_GATES), ssbuf(c, 4 * l + 1)};
    pg8::gemm_phase(c.lds, g, S, E);
}
constexpr size_t OFF_MT = OFF_Z, OFF_VWT = OFF_Z + (size_t)16384 * DM * 2;
DI void ph_xpre(const Params& p, const Ctx& c0, int l) {
    const Ctx c = fresh(c0);
    const unsigned char* wl = c.ws + (size_t)l * W_LAYER;
    { pg8::Gemm g; g.A = wsb(c, OFF_KB) + l * 1024; g.B = (const bf16_t*)(wl + W_Q); g.lda = 4096; g.ldb = DM; g.K = 256; g.nM = 64; g.nN = 4;
      g.div = 4; g.a_pmdiv = 256L * 4096; g.a_pmmod = 256; g.a_pn = 0; g.b_pmdiv = 0; g.b_pmmod = 256; g.b_pn = 256L * DM; g.ocol_step = 256; g.kstepA = 128; g.kstepB = 128; g.imgA = 0; g.imgB = 0;
      pg8::Order S; S.init(g, c.G, c.bid);
      pg8::EpiBf16 E{wsb(c, OFF_MT), DM, nullptr, nullptr, nullptr, 1.f, 3}; pg8::gemm_phase(c.lds, g, S, E); }
    { pg8::Gemm g; g.A = (const bf16_t*)(wl + W_O); g.B = wsb(c, OFF_VT) + l * 1024; g.lda = DM; g.ldb = 4096; g.K = 256; g.nM = 64; g.nN = 4;
      g.div = 4; g.a_pmdiv = 0; g.a_pmmod = 256L * DM; g.a_pn = 256; g.b_pmdiv = 256L * 4096; g.b_pmmod = 0; g.b_pn = 256; g.ocol_step = 256; g.kstepA = 128; g.kstepB = 128; g.imgA = 0; g.imgB = 0;
      pg8::Order S; S.init(g, c.G, c.bid);
      pg8::EpiBf16 E{wsb(c, OFF_VWT), DM, nullptr, nullptr, nullptr, 1.f, 3}; pg8::gemm_phase(c.lds, g, S, E); }
}
DI void ph_xs(const Params& p, const Ctx& c0, int l) {
    const Ctx c = fresh(c0);
    pg8::Gemm g; g.A = wsb(c, OFF_HB); g.B = wsb(c, OFF_MT); g.lda = DM; g.ldb = DM; g.K = DM; g.nM = MTOK / 256; g.nN = 4;
    g.div = 16; g.a_pmdiv = 16L * 256 * DM; g.a_pmmod = 256L * DM; g.a_pn = 0; g.b_pmdiv = 4L * 256 * DM; g.b_pmmod = 0; g.b_pn = 256L * DM; g.ocol_step = 256; g.kstepA = 128; g.kstepB = 128; g.imgA = 0; g.imgB = 0; pg8::use_img_a(g); g.imgB = 1; g.ldb = 64; g.kstepB = 256 * 64 * 2;
    pg8::Order S; S.init(g, c.G, c.bid);
    pg8::EpiSoftmax E{wsb(c, OFF_Y), DM, (LAS float*)(c.lds + LDS_EXTRA), ssbuf(c, 4 * l + 2), 0.0625f * LOG2E};
    pg8::gemm_phase(c.lds, g, S, E);
}
DI void ph_xo(const Params& p, const Ctx& c0, int l) {
    const Ctx c = fresh(c0);
    pg8::Gemm g; g.A = wsb(c, OFF_Y); g.B = wsb(c, OFF_VWT); g.lda = DM; g.ldb = DM; g.K = DM; g.nM = MTOK / 256; g.nN = 4;
    g.div = 16; g.a_pmdiv = 16L * 256 * DM; g.a_pmmod = 256L * DM; g.a_pn = 0; g.b_pmdiv = 1024L * DM; g.b_pmmod = 0; g.b_pn = 256L * DM; g.ocol_step = 256; g.kstepA = 128; g.kstepB = 128; g.imgA = 0; g.imgB = 0; pg8::use_img_a(g); g.imgB = 1; g.ldb = 64; g.kstepB = 256 * 64 * 2;
    pg8::Order S; S.init(g, c.G, c.bid);
    pg8::EpiResid E{wsb(c, OFF_HB), ssbuf(c, 4 * l + 3), 1.f};
    pg8::gemm_phase(c.lds, g, S, E);
}

constexpr int PH_PER_LAYER = 11, PH_FINAL = 1 + PH_PER_LAYER * DEPTH, PH_TOTAL = PH_FINAL + 1;
__global__ void __launch_bounds__(512, 2) mega_fwd(Params pk) {
    extern __shared__ __attribute__((aligned(16))) unsigned char lds_raw[];
    volatile LAS unsigned* bst = (volatile LAS unsigned*)((LAS unsigned char*)lds_raw + LDS_EXTRA + 12288);
    XcdBarrier xbar; xbar.bar = (unsigned*)(pk.ws + OFF_CTL); xbar.x = 0; xbar.st = bst;
    if (pk.coop) { if (threadIdx.x < 4) bst[threadIdx.x] = 0u; __syncthreads(); xbar = xcd_barrier_post((unsigned*)(pk.ws + OFF_CTL), bst); }
    for (int ph = pk.ph_lo; ph < pk.ph_hi; ++ph) {
        int tid = threadIdx.x; asm volatile("" : "+v"(tid));
        const Params& p = pk;
        Ctx c; c.lds = (LAS unsigned char*)lds_raw; c.ldsg = lds_raw; c.tid = tid; c.lane = tid & 63; c.wid = __builtin_amdgcn_readfirstlane(tid >> 6);
        c.bid = blockIdx.x; c.G = gridDim.x; c.ws = pk.ws; c.out = pk.out;
        asm volatile("" : "+s"(c.ws)); asm volatile("" : "+s"(c.out));
        if (ph == 0) {
#ifndef NO_PRO
            REP(R_PRO) ph_prologue(p, c);
#endif
        }
        else if (ph == PH_FINAL) ph_final(p, c);
        else {
            const int l = (ph - 1) / PH_PER_LAYER, j = (ph - 1) % PH_PER_LAYER;
            const unsigned char* wl = c.ws + (size_t)l * W_LAYER;
#ifdef ONLY_CASE
            if (j != ONLY_CASE) continue;
#endif
            switch (j) {
                case 0: REP(R_UP) ph_ffn_up(p, c, l, 0); if (l == 0) ph_kv(p, c); break;
                case 1: ph_resid(p, c, wsb(c, OFF_Z), (const bf16_t*)(wl + W_D1), FF, 4 * l + 1, 0.5f); break;
                case 2: ph_win(p, c, l); break;
                case 3:
#ifndef NO_MIX1
                    ph_mix1(p, c, l);
#endif
                    break;
                case 4:
#ifndef NO_MIX2
                    ph_mix2(p, c, l);
#endif
                    break;
                case 5:
#ifndef NO_MIX3
                    ph_mix3(p, c, l);
#endif
                    break;
                case 6: ph_resid(p, c, wsb(c, OFF_Y), (const bf16_t*)(wl + W_OUT), DM, 4 * l + 2, 1.f); ph_xpre(p, c, l); break;
                case 7: ph_xs(p, c, l); break;
                case 8: ph_xo(p, c, l); break;
                case 9: ph_ffn_up(p, c, l, 1); break;
                default: ph_resid(p, c, wsb(c, OFF_Z), (const bf16_t*)(wl + W_D2), FF, 4 * l + 4, 0.5f); break;
            }
        }
        if (ph + 1 < pk.ph_hi && pk.coop) { if (ph == pk.ph_lo) cg::this_grid().sync(); else xcd_barrier(xbar); }
    }
}

extern "C" void kernel_launch(void* const* d_in, const int* in_sizes, int n_in, void* d_out, int out_size, void* d_ws, size_t ws_size, hipStream_t stream) {
    static int grid = 0;
    if (grid == 0) {
        if (n_in != 28 || out_size != MTOK * DM || ws_size < OFF_END) { fprintf(stderr, "kernel_launch: unexpected shapes (n_in %d out %d ws %zu)\n", n_in, out_size, ws_size); grid = -1; return; }
        int dev = 0, cus = 0, per_cu = 0;
        (void)hipGetDevice(&dev); (void)hipDeviceGetAttribute(&cus, hipDeviceAttributeMultiprocessorCount, dev);
        if (hipFuncSetAttribute((const void*)mega_fwd, hipFuncAttributeMaxDynamicSharedMemorySize, LDS_BYTES) != hipSuccess) { fprintf(stderr, "kernel_launch: hipFuncSetAttribute failed\n"); grid = -1; return; }
        if (hipOccupancyMaxActiveBlocksPerMultiprocessor(&per_cu, (const void*)mega_fwd, 512, LDS_BYTES) != hipSuccess || per_cu < 1) { fprintf(stderr, "kernel_launch: occupancy query says %d\n", per_cu); per_cu = 1; }
        (void)hipGetLastError();
        grid = cus * per_cu;
    }
    if (grid < 0) return;
    Params p{};
    for (int i = 0; i < 28; ++i) p.in[i] = (const float*)d_in[i];
    p.out = (float*)d_out; p.ws = (unsigned char*)d_ws; p.pad = 0;
    (void)hipMemsetAsync((unsigned char*)d_ws + OFF_CTL, 0, CTL_BYTES, stream);
#if MK_MULTI
    for (int ph = 0; ph < PH_TOTAL; ++ph) { p.ph_lo = ph; p.ph_hi = ph + 1; p.coop = 0; hipLaunchKernelGGL(mega_fwd, dim3(grid), dim3(512), LDS_BYTES, stream, p); }
#else
    p.ph_lo = 0; p.ph_hi = PH_TOTAL; p.coop = 1;
    void* args[] = {&p};
    hipError_t e = hipLaunchCooperativeKernel((const void*)mega_fwd, dim3(grid), dim3(512), args, LDS_BYTES, stream);
    if (e != hipSuccess) fprintf(stderr, "cooperative launch failed: %s (grid %d)\n", hipGetErrorString(e), grid);
#endif
}
```
